# Optimizing an MI355X kernel written in HIP

```python
import math
import jax, jax.numpy as jnp
from jax import lax
import numpy as np

D_MODEL = 1024
BATCH = 8
SEQ = 2048
DEPTH = 1
DEC_BATCH = 8
DEC_SEQ = 64
PAST_LEN = 4096

CHUNK = 64
N_META = 16
SSD_HEADS = 16
SSD_HEAD_DIM = 64
SSD_INNER = SSD_HEADS * SSD_HEAD_DIM
SSD_GROUPS = 4
SSD_STATE = 128
SSD_BLOCK = 64
CONV_WIDTH = 4
CONV_DIM = SSD_INNER + 2 * SSD_GROUPS * SSD_STATE
N_HEADS = 8
N_KV_HEADS = 2
HEAD_DIM = 128
ATT_INNER = N_HEADS * HEAD_DIM
KV_DIM = N_KV_HEADS * HEAD_DIM
IDX_HEADS = 8
IDX_DIM = 64
TOPK_MAX = 256
Q_BLOCK = 128
REL_BUCKETS = 32
REL_MAX_DIST = 128
D_FF = -(-8 * D_MODEL // (3 * 256)) * 256
IN_WIDTHS = (SSD_INNER, CONV_DIM, SSD_HEADS, ATT_INNER, KV_DIM, KV_DIM, IDX_HEADS * IDX_DIM, IDX_DIM, IDX_HEADS, D_MODEL, D_MODEL)
IN_DIM = sum(IN_WIDTHS)
EPS = 1e-6

kernel_name = 'hybrid_ssd_dsa_streaming_step'


def rmsnorm(x, w):
    xf = x.astype(jnp.float32)
    y = xf * lax.rsqrt(jnp.mean(xf * xf, axis=-1, keepdims=True) + EPS)
    return (y * w.astype(jnp.float32)).astype(x.dtype)


def split_columns(h):
    outs = []
    o = 0
    for w in IN_WIDTHS:
        outs.append(h[..., o:o + w])
        o += w
    return outs


def t5_bucket(rel):
    nb = REL_BUCKETS // 2
    max_exact = nb // 2
    ret = jnp.where(rel > 0, nb, 0)
    n = jnp.abs(rel)
    nf = jnp.maximum(n, 1).astype(jnp.float32)
    large = max_exact + (jnp.log(nf / max_exact) / math.log(REL_MAX_DIST / max_exact) * (nb - max_exact)).astype(jnp.int32)
    large = jnp.minimum(large, nb - 1)
    return ret + jnp.where(n < max_exact, n, large)


def causal_conv(xbc, prev, w, b):
    T = xbc.shape[1]
    xpad = jnp.concatenate([prev.astype(xbc.dtype), xbc], axis=1)
    y = b + sum(xpad[:, i:i + T] * w[i] for i in range(CONV_WIDTH))
    return jax.nn.silu(y), xpad[:, xpad.shape[1] - (CONV_WIDTH - 1):]


def ssd_scan(x, dt, a, bm, cm, s0):
    Bsz, T = x.shape[:2]
    pad = (-T) % SSD_BLOCK
    nc = (T + pad) // SSD_BLOCK
    R = SSD_HEADS // SSD_GROUPS

    def blocks(u, tail):
        u = jnp.pad(u.astype(jnp.float32), [(0, 0), (0, pad)] + [(0, 0)] * (u.ndim - 2))
        return u.reshape((Bsz, nc, SSD_BLOCK) + tail)

    x = blocks(x, (SSD_GROUPS, R, SSD_HEAD_DIM))
    dt = blocks(dt, (SSD_GROUPS, R))
    bm = blocks(bm, (SSD_GROUPS, SSD_STATE))
    cm = blocks(cm, (SSD_GROUPS, SSD_STATE))
    acum = jnp.cumsum(dt * a.astype(jnp.float32).reshape(SSD_GROUPS, R), axis=2)
    causal = jnp.tril(jnp.ones((SSD_BLOCK, SSD_BLOCK), bool))[:, :, None, None]
    seg = acum[:, :, :, None] - acum[:, :, None, :]
    lmat = jnp.exp(jnp.where(causal, seg, -jnp.inf))
    cb = jnp.einsum('bcign,bcjgn->bcijg', cm, bm)
    wmat = cb[..., None] * lmat * dt[:, :, None]
    y_diag = jnp.einsum('bcijgr,bcjgrp->bcigrp', wmat, x)
    decay_end = jnp.exp(acum[:, :, -1:] - acum)
    st = jnp.einsum('bcjgn,bcjgrp->bcgrpn', bm, x * (decay_end * dt)[..., None])
    blk_decay = jnp.exp(acum[:, :, -1])

    def step(s, inp):
        st_c, dec_c = inp
        return s * dec_c[..., None, None] + st_c, s

    s0 = s0.astype(jnp.float32).reshape(Bsz, SSD_GROUPS, R, SSD_HEAD_DIM, SSD_STATE)
    s_fin, s_in = lax.scan(step, s0, (jnp.moveaxis(st, 1, 0), jnp.moveaxis(blk_decay, 1, 0)))
    s_in = jnp.moveaxis(s_in, 0, 1)
    y_off = jnp.einsum('bcign,bcgrpn->bcigrp', cm, s_in) * jnp.exp(acum)[..., None]
    y = (y_diag + y_off).reshape(Bsz, nc * SSD_BLOCK, SSD_HEADS, SSD_HEAD_DIM)[:, :T]
    return y, s_fin.reshape(Bsz, SSD_HEADS, SSD_HEAD_DIM, SSD_STATE)


def ssd_mixer(z, xbc, dt_raw, conv_prev, ssm_prev, conv_w, conv_b, dt_bias, a_log, d_skip, norm_w):
    Bsz, T = z.shape[:2]
    xbc, conv_new = causal_conv(xbc, conv_prev, conv_w, conv_b)
    gn = SSD_GROUPS * SSD_STATE
    xs = xbc[..., :SSD_INNER].reshape(Bsz, T, SSD_HEADS, SSD_HEAD_DIM)
    bm = xbc[..., SSD_INNER:SSD_INNER + gn].reshape(Bsz, T, SSD_GROUPS, SSD_STATE)
    cm = xbc[..., SSD_INNER + gn:].reshape(Bsz, T, SSD_GROUPS, SSD_STATE)
    dt = jax.nn.softplus(dt_raw.astype(jnp.float32) + dt_bias.astype(jnp.float32))
    a = -jnp.exp(a_log.astype(jnp.float32))
    y, s_new = ssd_scan(xs, dt, a, bm, cm, ssm_prev)
    y = y + xs.astype(jnp.float32) * d_skip.astype(jnp.float32)[:, None]
    y = y.reshape(Bsz, T, SSD_INNER) * jax.nn.silu(z.astype(jnp.float32))
    return rmsnorm(y, norm_w).astype(z.dtype), conv_new, s_new.astype(ssm_prev.dtype)


def sparse_attn_block(q, qi, wi, qpos, qchunk, k_all, v_all, ki_all, kpos, kchunk, n_sel, rel_bias):
    Bsz, Tq = q.shape[:2]
    R = N_HEADS // N_KV_HEADS
    s_idx = jnp.einsum('bthd,bsd->bths', qi.astype(jnp.float32), ki_all.astype(jnp.float32)) * IDX_DIM ** -0.5
    score = jnp.einsum('bth,bths->bts', wi.astype(jnp.float32), jax.nn.relu(s_idx))
    admissible = kchunk[None, :] <= qchunk[:, None]
    score = jnp.where(admissible[None], score, -jnp.inf)
    _, idx = lax.top_k(score, n_sel)
    take = jax.vmap(lambda rows, ids: rows[ids])
    k_sel = take(k_all, idx)
    v_sel = take(v_all, idx)
    valid = kchunk[idx] <= qchunk[None, :, None]
    bias = rel_bias[t5_bucket(kpos[idx] - qpos[None, :, None])]
    bias = bias.reshape(Bsz, Tq, n_sel, N_KV_HEADS, R).transpose(0, 1, 3, 4, 2)
    qg = q.reshape(Bsz, Tq, N_KV_HEADS, R, HEAD_DIM)
    logits = jnp.einsum('btgrd,btngd->btgrn', qg, k_sel, preferred_element_type=jnp.float32) * HEAD_DIM ** -0.5 + bias.astype(jnp.float32)
    logits = jnp.where(valid[:, :, None, None, :], logits, -1e30)
    p = jax.nn.softmax(logits, axis=-1)
    out = jnp.einsum('btgrn,btngd->btgrd', p.astype(v_sel.dtype), v_sel)
    return out.reshape(Bsz, Tq, ATT_INNER)


def attend(q, qi, wi, qpos, qchunk, k_all, v_all, ki_all, kpos, kchunk, n_sel, rel_bias):
    Bsz, T = q.shape[:2]
    if T <= Q_BLOCK:
        return sparse_attn_block(q, qi, wi, qpos, qchunk, k_all, v_all, ki_all, kpos, kchunk, n_sel, rel_bias)
    pad = (-T) % Q_BLOCK
    nb = (T + pad) // Q_BLOCK

    def blk(u):
        u = jnp.pad(u, [(0, 0), (0, pad)] + [(0, 0)] * (u.ndim - 2))
        return jnp.moveaxis(u.reshape((Bsz, nb, Q_BLOCK) + u.shape[2:]), 1, 0)

    qpos_b = jnp.pad(qpos, (0, pad), mode='edge').reshape(nb, Q_BLOCK)
    qchunk_b = jnp.pad(qchunk, (0, pad), mode='edge').reshape(nb, Q_BLOCK)
    out = lax.map(lambda u: sparse_attn_block(u[0], u[1], u[2], u[3], u[4], k_all, v_all, ki_all, kpos, kchunk, n_sel, rel_bias),
                  (blk(q), blk(qi), blk(wi), qpos_b, qchunk_b))
    return jnp.moveaxis(out, 0, 1).reshape(Bsz, nb * Q_BLOCK, ATT_INNER)[:, :T]


def trunk_layer(x, conv_prev, ssm_prev, k_past, v_past, ki_past, qpos, qchunk, kpos, kchunk, n_sel, rel_bias,
                norm1_w, w_in, conv_w, conv_b, dt_bias, a_log, d_skip, ssd_norm_w, q_norm_w, k_norm_w, idx_k_norm_w,
                w_br_ssd, w_br_att, w_out, norm2_w, w_gate, w_up, w_down):
    Bsz, T, _ = x.shape
    hn = rmsnorm(x, norm1_w)
    z, xbc, dt_raw, q, k, v, qi, ki, wi, g_ssd, g_att = split_columns(hn @ w_in)
    y_ssd, conv_new, ssm_new = ssd_mixer(z, xbc, dt_raw, conv_prev, ssm_prev, conv_w, conv_b, dt_bias, a_log, d_skip, ssd_norm_w)
    q = rmsnorm(q.reshape(Bsz, T, N_HEADS, HEAD_DIM), q_norm_w)
    k = rmsnorm(k.reshape(Bsz, T, N_KV_HEADS, HEAD_DIM), k_norm_w)
    v = v.reshape(Bsz, T, N_KV_HEADS, HEAD_DIM)
    qi = qi.reshape(Bsz, T, IDX_HEADS, IDX_DIM)
    ki = rmsnorm(ki, idx_k_norm_w)
    wi = wi * IDX_HEADS ** -0.5
    if k_past is None:
        k_all, v_all, ki_all = k, v, ki
    else:
        k_all = jnp.concatenate([k_past.astype(k.dtype), k], axis=1)
        v_all = jnp.concatenate([v_past.astype(v.dtype), v], axis=1)
        ki_all = jnp.concatenate([ki_past.astype(ki.dtype), ki], axis=1)
    y_att = attend(q, qi, wi, qpos, qchunk, k_all, v_all, ki_all, kpos, kchunk, n_sel, rel_bias)
    merged = jax.nn.sigmoid(g_ssd) * (y_ssd @ w_br_ssd) + jax.nn.sigmoid(g_att) * (y_att @ w_br_att)
    h = x + merged @ w_out
    hn2 = rmsnorm(h, norm2_w)
    y = h + (jax.nn.silu(hn2 @ w_gate) * (hn2 @ w_up)) @ w_down
    return y, k, v, ki, ssm_new, conv_new


def setup_inputs(seed: int = 0) -> dict:
    key = jax.random.key(seed)
    ks = jax.random.split(key, 32)
    f32 = jnp.float32

    def nrm(k, shape, scale):
        return jax.random.normal(k, shape, f32) * scale

    dt0 = jnp.exp(jax.random.uniform(ks[13], (DEPTH, SSD_HEADS), f32, math.log(1e-3), math.log(1e-1)))
    return {
        'x_prompt': nrm(ks[0], (BATCH, SEQ, D_MODEL), 1.0),
        'x_sample': nrm(ks[1], (DEC_BATCH, DEC_SEQ, D_MODEL), 1.0),
        'cache_k': nrm(ks[2], (DEPTH, DEC_BATCH, PAST_LEN, N_KV_HEADS, HEAD_DIM), 1.0),
        'cache_v': nrm(ks[3], (DEPTH, DEC_BATCH, PAST_LEN, N_KV_HEADS, HEAD_DIM), 1.0),
        'cache_kidx': nrm(ks[4], (DEPTH, DEC_BATCH, PAST_LEN, IDX_DIM), 1.0),
        'state_ssm': nrm(ks[5], (DEPTH, DEC_BATCH, SSD_HEADS, SSD_HEAD_DIM, SSD_STATE), 0.2),
        'state_conv': nrm(ks[6], (DEPTH, DEC_BATCH, CONV_WIDTH - 1, CONV_DIM), 1.0),
        'meta_tokens': nrm(ks[7], (N_META, D_MODEL), 1.0),
        'rel_bias': nrm(ks[8], (REL_BUCKETS, N_HEADS), 0.5),
        'norm1_w': 1.0 + nrm(ks[9], (DEPTH, D_MODEL), 0.02),
        'w_in': nrm(ks[10], (DEPTH, D_MODEL, IN_DIM), D_MODEL ** -0.5),
        'conv_w': nrm(ks[11], (DEPTH, CONV_WIDTH, CONV_DIM), CONV_WIDTH ** -0.5),
        'conv_b': nrm(ks[12], (DEPTH, CONV_DIM), 0.02),
        'dt_bias': dt0 + jnp.log(-jnp.expm1(-dt0)),
        'a_log': jnp.log(jax.random.uniform(ks[14], (DEPTH, SSD_HEADS), f32, 1.0, 16.0)),
        'd_skip': 1.0 + nrm(ks[15], (DEPTH, SSD_HEADS), 0.1),
        'ssd_norm_w': 1.0 + nrm(ks[16], (DEPTH, SSD_INNER), 0.02),
        'q_norm_w': 1.0 + nrm(ks[17], (DEPTH, HEAD_DIM), 0.02),
        'k_norm_w': 1.0 + nrm(ks[18], (DEPTH, HEAD_DIM), 0.02),
        'idx_k_norm_w': 1.0 + nrm(ks[19], (DEPTH, IDX_DIM), 0.02),
        'w_br_ssd': nrm(ks[20], (DEPTH, SSD_INNER, D_MODEL), SSD_INNER ** -0.5),
        'w_br_att': nrm(ks[21], (DEPTH, ATT_INNER, D_MODEL), ATT_INNER ** -0.5),
        'w_out': nrm(ks[22], (DEPTH, D_MODEL, D_MODEL), D_MODEL ** -0.5),
        'norm2_w': 1.0 + nrm(ks[23], (DEPTH, D_MODEL), 0.02),
        'w_gate': nrm(ks[24], (DEPTH, D_MODEL, D_FF), D_MODEL ** -0.5),
        'w_up': nrm(ks[25], (DEPTH, D_MODEL, D_FF), D_MODEL ** -0.5),
        'w_down': nrm(ks[26], (DEPTH, D_FF, D_MODEL), D_FF ** -0.5),
    }


def reference(x_prompt, x_sample, cache_k, cache_v, cache_kidx, state_ssm, state_conv, meta_tokens, rel_bias,
              norm1_w, w_in, conv_w, conv_b, dt_bias, a_log, d_skip, ssd_norm_w, q_norm_w, k_norm_w, idx_k_norm_w,
              w_br_ssd, w_br_att, w_out, norm2_w, w_gate, w_up, w_down):
    bp, sp = x_prompt.shape[:2]
    hp = jnp.concatenate([jnp.broadcast_to(meta_tokens.astype(x_prompt.dtype)[None], (bp, N_META, D_MODEL)), x_prompt], axis=1)
    pos_p = jnp.arange(N_META + sp)
    chunk_p = jnp.where(pos_p < N_META, 0, (pos_p - N_META) // CHUNK + 1)
    n_sel_p = min(TOPK_MAX, sp // 4)
    conv0 = jnp.zeros((bp, CONV_WIDTH - 1, CONV_DIM), x_prompt.dtype)
    ssm0 = jnp.zeros((bp, SSD_HEADS, SSD_HEAD_DIM, SSD_STATE), state_ssm.dtype)
    past = cache_k.shape[2]
    ts = x_sample.shape[1]
    kpos_s = jnp.arange(past + ts)
    kchunk_s = kpos_s // CHUNK
    n_sel_s = min(TOPK_MAX, (past + ts) // 4)
    hs = x_sample
    kp_l, vp_l, kip_l, sp_l, cp_l = [], [], [], [], []
    ks_l, vs_l, kis_l, ss_l, cs_l = [], [], [], [], []
    for l in range(DEPTH):
        lw = (norm1_w[l], w_in[l], conv_w[l], conv_b[l], dt_bias[l], a_log[l], d_skip[l], ssd_norm_w[l],
              q_norm_w[l], k_norm_w[l], idx_k_norm_w[l], w_br_ssd[l], w_br_att[l], w_out[l], norm2_w[l],
              w_gate[l], w_up[l], w_down[l])
        hp, kp, vp, kip, ssp, cvp = trunk_layer(hp, conv0, ssm0, None, None, None, pos_p, chunk_p, pos_p, chunk_p,
                                               n_sel_p, rel_bias, *lw)
        hs, kss, vss, kis, sss, cvs = trunk_layer(hs, state_conv[l], state_ssm[l], cache_k[l], cache_v[l], cache_kidx[l],
                                                 kpos_s[past:], kchunk_s[past:], kpos_s, kchunk_s, n_sel_s, rel_bias, *lw)
        kp_l.append(kp); vp_l.append(vp); kip_l.append(kip); sp_l.append(ssp); cp_l.append(cvp)
        ks_l.append(kss); vs_l.append(vss); kis_l.append(kis); ss_l.append(sss); cs_l.append(cvs)
    y_prompt = hp[:, N_META:]
    y_sample = hs
    k_prompt = jnp.stack(kp_l, 0)
    v_prompt = jnp.stack(vp_l, 0)
    kidx_prompt = jnp.stack(kip_l, 0)
    ssm_prompt = jnp.stack(sp_l, 0)
    conv_prompt = jnp.stack(cp_l, 0)
    k_sample = jnp.stack(ks_l, 0)
    v_sample = jnp.stack(vs_l, 0)
    kidx_sample = jnp.stack(kis_l, 0)
    ssm_sample = jnp.stack(ss_l, 0)
    conv_sample = jnp.stack(cs_l, 0)
    return (y_prompt, y_sample, k_prompt, v_prompt, kidx_prompt, ssm_prompt, conv_prompt, k_sample, v_sample, kidx_sample, ssm_sample, conv_sample)
```

```cpp
#include <hip/hip_runtime.h>
#include <cstdio>
#include <cstdint>

constexpr int DM = 1024, NBATCH = 8, SEQ = 2048, NMETA = 16, TP = NMETA + SEQ  , DSEQ = 64, PAST = 4096, LS = PAST + DSEQ  ;
constexpr int RPR = NBATCH * TP  , RSR = NBATCH * DSEQ  , RR = RPR + RSR  , RPAD = 17152  ;
constexpr int YPR = NBATCH * SEQ  , YR = YPR + RSR  ;
constexpr int NIN = 7424  , DFF = 2816, NGU = 2 * DFF;
constexpr int SSD_H = 16, SSD_P = 64, SSD_G = 4, SSD_N = 128, CONV_DIM = 2048;
constexpr int NH = 8, NKV = 2, HD = 128, IDXH = 8, IDXD = 64, TOPK = 256;
constexpr float EPS = 1e-6f;
constexpr int SMLD = 96;

constexpr size_t O_YP = 0, O_YS = O_YP + (size_t)YPR * DM, O_KP = O_YS + (size_t)RSR * DM, O_VP = O_KP + (size_t)RPR * 256, O_KIP = O_VP + (size_t)RPR * 256,
                 O_SSMP = O_KIP + (size_t)RPR * 64, O_CVP = O_SSMP + (size_t)NBATCH * 16 * 64 * 128, O_KS = O_CVP + (size_t)NBATCH * 3 * CONV_DIM, O_VS = O_KS + (size_t)RSR * 256,
                 O_KIS = O_VS + (size_t)RSR * 256, O_SSMS = O_KIS + (size_t)RSR * 64, O_CVS = O_SSMS + (size_t)NBATCH * 16 * 64 * 128, O_END = O_CVS + (size_t)NBATCH * 3 * CONV_DIM;
static_assert(O_END == 29302784, "d_out size");
constexpr size_t DO_Q = 0, DO_QI = DO_Q + (size_t)RR * 1024 * 2, DO_CV = DO_QI + (size_t)RR * 512 * 2, DO_YEND = DO_CV + (size_t)NBATCH * PAST * 256 * 2;
static_assert(DO_YEND <= O_KP * 4, "y-region scratch");
constexpr size_t DO_HN = O_KP * 4;
static_assert(DO_HN + (size_t)RPAD * 1024 * 2 <= O_CVP * 4, "hn scratch in tail");

constexpr size_t al256(size_t x) { return (x + 255) / 256 * 256; }
constexpr size_t WS_CTL = 0, CTL_BYTES = 1u << 20;
constexpr size_t WS_WIN = CTL_BYTES, WS_WBS = WS_WIN + (size_t)NIN * 1024 * 2, WS_WBA = WS_WBS + 1024 * 1024 * 2, WS_WOUT = WS_WBA + 1024 * 1024 * 2, WS_WGU = WS_WOUT + 1024 * 1024 * 2,
                 WS_WDN = WS_WGU + (size_t)NGU * 1024 * 2, WS_Z = WS_WDN + (size_t)1024 * DFF * 2, WS_XS = WS_Z + (size_t)RR * 1024 * 2, WS_BC = WS_XS + (size_t)RR * 1024 * 2,
                 WS_GA = WS_BC + (size_t)RR * 1024 * 2, WS_GS = WS_GA + (size_t)RR * 1024 * 2, WS_K = WS_GS + (size_t)RR * 1024 * 2, WS_V = WS_K + (size_t)RR * 256 * 2,
                 WS_SM = WS_V + (size_t)RR * 256 * 2, WS_KI = WS_SM + (size_t)RR * SMLD * 4, WS_CK = WS_KI + (size_t)RR * 64 * 2, WS_MASK = WS_CK + (size_t)NBATCH * PAST * 256 * 2;
constexpr int MASK_LDP = 68, MASK_LDS = 132;
constexpr size_t WS_MASKS = WS_MASK + (size_t)RPR * MASK_LDP * 4, WS_SSQ1 = WS_MASKS + (size_t)RSR * MASK_LDS * 4, WS_SSQ2 = WS_SSQ1 + al256((size_t)RR * 4),
                 WS_PART = WS_SSQ2 + al256((size_t)YR * 4), WS_END = WS_PART + (size_t)32 * 256 * 132 * 4;
constexpr size_t WS_MERGED = WS_Z, WS_ACT = WS_XS, WS_HB = WS_GS, WS_HAL = WS_PART;
static_assert(WS_END <= 268435456, "d_ws map exceeds 256 MiB");
static_assert((size_t)YR * DFF * 2 <= WS_GS - WS_XS, "act overlay");
static_assert((size_t)NBATCH * 33 * 3 * CONV_DIM * 2 <= WS_END - WS_PART, "halo overlay");
constexpr int CW_TMO = 0, CW_BAR = 4096, CW_Q = 16384;

#define GAS __attribute__((address_space(1)))
#define LAS __attribute__((address_space(3)))
typedef unsigned short bf16_t;
typedef short bf16x8 __attribute__((ext_vector_type(8)));
typedef short s16x4 __attribute__((ext_vector_type(4)));
typedef float f32x4 __attribute__((ext_vector_type(4)));
typedef float f32x2 __attribute__((ext_vector_type(2)));
typedef float f32x16 __attribute__((ext_vector_type(16)));
typedef unsigned u32x4 __attribute__((ext_vector_type(4)));
typedef unsigned u32x2 __attribute__((ext_vector_type(2)));
typedef GAS unsigned gu32;
#define RLX_AGENT __ATOMIC_RELAXED, __HIP_MEMORY_SCOPE_AGENT
#define LDS_WAIT() asm volatile("s_waitcnt lgkmcnt(0)" ::: "memory")
#define VM_WAIT() asm volatile("s_waitcnt vmcnt(0)" ::: "memory")
__device__ __forceinline__ unsigned cvt_pk_bf16(float lo, float hi) { unsigned r; asm volatile("v_cvt_pk_bf16_f32 %0, %1, %2" : "=v"(r) : "v"(lo), "v"(hi)); return r; }
__device__ __forceinline__ float bf_lo(unsigned w) { return __uint_as_float(w << 16); }
__device__ __forceinline__ float bf_hi(unsigned w) { return __uint_as_float(w & 0xffff0000u); }
__device__ __forceinline__ float bf2f(bf16_t b) { return __uint_as_float((unsigned)b << 16); }
__device__ __forceinline__ bf16_t f2bf(float f) { return (bf16_t)(cvt_pk_bf16(f, 0.f) & 0xffffu); }
__device__ __forceinline__ float sigmoidf_(float x) { return __builtin_amdgcn_rcpf(1.f + __builtin_amdgcn_exp2f(-1.4426950408889634f * x)); }
__device__ __forceinline__ float siluf_(float x) { return x * sigmoidf_(x); }
__device__ __forceinline__ float wave_sum(float v) {
#pragma unroll
    for (int o = 1; o < 64; o <<= 1) v += __shfl_xor(v, o);
    return v;
}

#define XB_TMO      128
#define XB_XCNT(j)  (256  + 64 * (j))
#define XB_XSUB(j)  (1280 + 64 * (j))
#define XB_XGEN(j)  (2304 + 64 * (j))
#define XB_TOP      3328
#define XB_TOPGEN   3392
#define XCD_BAR_WORDS 3456
#define XB_SPIN_CAP (1u << 18)
__device__ __forceinline__ unsigned xb_ld(unsigned* p)              { return __hip_atomic_load(p, __ATOMIC_RELAXED, __HIP_MEMORY_SCOPE_AGENT); }
__device__ __forceinline__ unsigned xb_add(unsigned* p, unsigned v) { return __hip_atomic_fetch_add(p, v, __ATOMIC_RELAXED, __HIP_MEMORY_SCOPE_AGENT); }
__device__ __forceinline__ unsigned xb_xcc_id() { return (unsigned)__builtin_amdgcn_s_getreg((3 << 11) | 20) & 0xFu; }
#define XB_SPIN(cond, bar) do { unsigned _sp = 0; while (cond) { __builtin_amdgcn_s_sleep(1); \
    if ((++_sp & 255u) == 0u) { if (xb_ld(&(bar)[XB_TMO])) break; if (_sp > XB_SPIN_CAP) { atomicAdd(&(bar)[XB_TMO], 1u); break; } } } } while (0)
struct XcdBarrier { unsigned* bar; unsigned x; volatile LAS unsigned* st; };
__device__ __forceinline__ XcdBarrier xcd_barrier_post(unsigned* bar, volatile LAS unsigned* st) {
    XcdBarrier b; b.bar = bar; b.x = xb_xcc_id(); b.st = st;
    if (threadIdx.x == 0) (void)xb_add(&bar[XB_XCNT(b.x)], 1u);
    return b;
}
__device__ __forceinline__ void xcd_barrier_complete(unsigned* bar, unsigned x, unsigned& nloc, unsigned& nx) {
    const unsigned G = gridDim.x * gridDim.y * gridDim.z;
    unsigned sum, cnt, mine, sp = 0u;
    for (;;) {
        sum = 0u; cnt = 0u; mine = 0u;
#pragma unroll
        for (unsigned j = 0; j < 16; ++j) { const unsigned c = xb_ld(&bar[XB_XCNT(j)]); sum += c; cnt += (c > 0u) ? 1u : 0u; mine = (j == x) ? c : mine; }
        if (sum == G) break;
        __builtin_amdgcn_s_sleep(1);
        if ((++sp & 255u) == 0u) { if (xb_ld(&bar[XB_TMO])) break; if (sp > XB_SPIN_CAP) { atomicAdd(&bar[XB_TMO], 1u); break; } }
    }
    nloc = mine > 0u ? mine : 1u; nx = cnt > 0u ? cnt : 1u;
}
__device__ __forceinline__ void xcd_barrier(const XcdBarrier& b) {
    asm volatile("s_waitcnt vmcnt(0)" ::: "memory");
    __syncthreads();
    if (threadIdx.x == 0) {
        unsigned* bar = b.bar;
        __builtin_amdgcn_s_waitcnt(0);
        unsigned nloc = b.st[0], nx = b.st[1];
        if (nloc == 0u) { xcd_barrier_complete(bar, b.x, nloc, nx); b.st[0] = nloc; b.st[1] = nx; }
        const unsigned old = xb_add(&bar[XB_XSUB(b.x)], 1u);
        const unsigned gen = old / nloc;
        if (old + 1u == (gen + 1u) * nloc) {
            __builtin_amdgcn_fence(__ATOMIC_RELEASE, "agent");
            asm volatile("s_waitcnt vmcnt(0)" ::: "memory");
            const unsigned og = xb_add(&bar[XB_TOP], 1u);
            const unsigned tg = og / nx;
            if (og + 1u == (tg + 1u) * nx) xb_add(&bar[XB_TOPGEN], 1u);
            else XB_SPIN(xb_ld(&bar[XB_TOPGEN]) == tg, bar);
            __builtin_amdgcn_fence(__ATOMIC_ACQUIRE, "agent");
            xb_add(&bar[XB_XGEN(b.x)], 1u);
            asm volatile("s_waitcnt vmcnt(0)" ::: "memory");
        } else {
            XB_SPIN(xb_ld(&bar[XB_XGEN(b.x)]) == gen, bar);
            __builtin_amdgcn_fence(__ATOMIC_ACQUIRE, "agent");
            asm volatile("s_waitcnt vmcnt(0)" ::: "memory");
        }
    }
    __syncthreads();
}

namespace pg8 {
constexpr int BM = 256, BK = 64, HALF = 128, HTB = HALF * BK * 2, STAGE_BYTES = 8 * HTB, NXCD = 8, WGM = 8;
__host__ __device__ __forceinline__ int lds_byte(int r, int c) { const int st = (r >> 4) * 2 + (c >> 5), rr = r & 15, cc = c & 31, ob = rr * 64 + cc * 2; return st * 1024 + (ob ^ (((ob >> 9) & 1) << 5)); }
__host__ __device__ __forceinline__ void stage_rc(int b, int& R, int& C) { const int st = b / 1024, sb = b % 1024, swz = sb ^ (((sb >> 9) & 1) << 5); R = (st >> 1) * 16 + swz / 64; C = (st & 1) * 32 + (swz % 64) / 2; }
__host__ __device__ __forceinline__ int perm32(int rho) { const int n = rho >> 4, i = rho & 15; return 8 * (i >> 2) + 4 * n + (i & 3); }
struct Unit { int pm, pn, part; const char* A; const char* B; };
__device__ __forceinline__ void tile_of(int L, int nM, int nN, int& pm, int& pn) {
    const int nwg = nM * nN; int wgid = L; { const int q = nwg / NXCD, r = nwg % NXCD, xcd = wgid % NXCD, off = wgid / NXCD; wgid = (xcd < r ? xcd * (q + 1) : r * (q + 1) + (xcd - r) * q) + off; }
    const int nig = WGM * nN, gid = wgid / nig, fm = gid * WGM, gsz = (nM - fm) < WGM ? (nM - fm) : WGM;
    pm = fm + ((wgid % nig) % gsz); pn = (wgid % nig) / gsz;
}
typedef f32x4 Acc[2][2][4][2];
template <class Epi, class Sched>
__device__ __forceinline__ void gemm_phase(LAS unsigned char* lds, const int K, const Sched& S, const Epi& E) {
    const int tid = threadIdx.x, wid = __builtin_amdgcn_readfirstlane(tid >> 6), lane = tid & 63, wr = wid >> 2, wc = wid & 3, fr = lane & 15, fq = lane >> 4;
    const int nt = K / BK;
    unsigned voffA[2], voffB[2];
#pragma unroll
    for (int i = 0; i < 2; ++i) { int R, C; stage_rc(tid * 16 + i * 8192, R, C); const int Rb = Epi::PERM ? ((R & ~31) + perm32(R & 31)) : R;
        voffA[i] = (unsigned)(R * K + C) * 2u; voffB[i] = (unsigned)(Rb * K + C) * 2u; }
    const size_t kstep = (size_t)(BK * 2);
    const size_t hstep = (size_t)HALF * K * 2;
    const unsigned ldsw = (unsigned)wid * 1024u;
    const int aoff = lds_byte(wr * 64 + fr, fq * 8), boff = lds_byte(wc * 32 + fr, fq * 8);
#define PG8_SA(b, h) (((b) * 2 + (h)) * HTB)
#define PG8_SB(b, h) ((4 + (b) * 2 + (h)) * HTB)
#define PG8_STAGE(bufoff, gbase, voff) do { _Pragma("unroll") for (int _i = 0; _i < 2; ++_i) \
        __builtin_amdgcn_global_load_lds((const unsigned*)((const char*)(gbase) + (voff)[_i]), (LAS unsigned*)(lds + (bufoff) + ldsw + _i * 8192), 16, 0, 0); } while (0)
#define PG8_LDA(dst, b, h) do { _Pragma("unroll") for (int m = 0; m < 4; ++m) _Pragma("unroll") for (int k = 0; k < 2; ++k) dst[m][k] = *(const LAS bf16x8*)(lds + PG8_SA(b, h) + aoff + m * 2048 + k * 1024); } while (0)
#define PG8_LDB(dst, b, h) do { _Pragma("unroll") for (int n = 0; n < 2; ++n) _Pragma("unroll") for (int k = 0; k < 2; ++k) dst[n][k] = *(const LAS bf16x8*)(lds + PG8_SB(b, h) + boff + n * 2048 + k * 1024); } while (0)
#define PG8_MMA(ai, bj, At, Bt) do { __builtin_amdgcn_s_setprio(1); _Pragma("unroll") for (int m = 0; m < 4; ++m) _Pragma("unroll") for (int n = 0; n < 2; ++n) _Pragma("unroll") for (int k = 0; k < 2; ++k) \
        acc[ai][bj][m][n] = __builtin_amdgcn_mfma_f32_16x16x32_bf16(Bt[n][k], At[m][k], acc[ai][bj][m][n], 0, 0, 0); __builtin_amdgcn_s_setprio(0); } while (0)
#define PG8_WAIT_V(n) asm volatile("s_waitcnt vmcnt(" #n ")" ::: "memory")
#define PG8_WAIT_L(n) asm volatile("s_waitcnt lgkmcnt(" #n ")" ::: "memory")
#define PG8_BAR __builtin_amdgcn_s_barrier()
#define PG8_SCHED __builtin_amdgcn_sched_barrier(0)
    Unit cur, nxt; int ui = 0;
    if (!S.next(0, cur)) return;
    Acc acc;
#pragma unroll
    for (int a = 0; a < 2; ++a)
#pragma unroll
        for (int b = 0; b < 2; ++b)
#pragma unroll
            for (int m = 0; m < 4; ++m)
#pragma unroll
                for (int n = 0; n < 2; ++n) acc[a][b][m][n] = (f32x4){0.f, 0.f, 0.f, 0.f};
    bf16x8 At[4][2], B0[2][2], B1[2][2];
    const char* cA = cur.A; const char* cB = cur.B;
    PG8_STAGE(PG8_SB(0, 0), cB, voffB); PG8_STAGE(PG8_SB(0, 1), cB + hstep, voffB); PG8_STAGE(PG8_SA(0, 0), cA, voffA); PG8_STAGE(PG8_SA(0, 1), cA + hstep, voffA);
    if (wr == 1) PG8_BAR;
    PG8_WAIT_V(2); PG8_BAR;
    PG8_STAGE(PG8_SB(1, 0), cB + kstep, voffB); PG8_STAGE(PG8_SA(1, 0), cA + kstep, voffA); PG8_STAGE(PG8_SB(1, 1), cB + hstep + kstep, voffB);
    PG8_WAIT_V(6); PG8_BAR;
    for (;;) {
        const bool has_next = S.next(ui + 1, nxt);
        const char* nA = has_next ? nxt.A : cA; const char* nB = has_next ? nxt.B : cB;
        for (int t = 0; t < nt; t += 2) {
            const bool last = (t == nt - 2);
            const char* a1 = cA + (size_t)(t + 1) * kstep;
            const char* a2 = last ? nA : cA + (size_t)(t + 2) * kstep; const char* b2 = last ? nB : cB + (size_t)(t + 2) * kstep;
            const char* a3 = a2 + kstep; const char* b3 = b2 + kstep;
            PG8_LDB(B0, 0, 0); PG8_LDB(B1, 0, 1); PG8_SCHED; PG8_LDA(At, 0, 0); PG8_STAGE(PG8_SA(1, 1), a1 + hstep, voffA);
            PG8_WAIT_V(8); PG8_WAIT_L(0); PG8_BAR; PG8_MMA(0, 0, At, B0); PG8_MMA(0, 1, At, B1); PG8_BAR; PG8_SCHED;
            PG8_LDA(At, 0, 1); PG8_STAGE(PG8_SB(0, 0), b2, voffB); PG8_STAGE(PG8_SB(0, 1), b2 + hstep, voffB); PG8_STAGE(PG8_SA(0, 0), a2, voffA);
            PG8_WAIT_V(8); PG8_WAIT_L(0); PG8_BAR; PG8_MMA(1, 0, At, B0); PG8_MMA(1, 1, At, B1); PG8_BAR; PG8_SCHED;
            PG8_LDB(B0, 1, 0); PG8_LDB(B1, 1, 1); PG8_SCHED; PG8_LDA(At, 1, 0); PG8_STAGE(PG8_SA(0, 1), a2 + hstep, voffA);
            PG8_WAIT_V(8); PG8_WAIT_L(0); PG8_BAR; PG8_MMA(0, 0, At, B0); PG8_MMA(0, 1, At, B1); PG8_BAR; PG8_SCHED;
            PG8_LDA(At, 1, 1); PG8_STAGE(PG8_SB(1, 0), b3, voffB); PG8_STAGE(PG8_SB(1, 1), b3 + hstep, voffB); PG8_STAGE(PG8_SA(1, 0), a3, voffA);
            PG8_WAIT_V(8); PG8_WAIT_L(0); PG8_BAR; PG8_MMA(1, 0, At, B0); PG8_MMA(1, 1, At, B1); PG8_BAR; PG8_SCHED;
        }
        if (wr == 0) PG8_BAR;
        const bool keep = E(acc, cur, wr, wc, fr, fq);
        if (!has_next) break;
        if (!keep) {
#pragma unroll
            for (int a = 0; a < 2; ++a)
#pragma unroll
                for (int b = 0; b < 2; ++b)
#pragma unroll
                    for (int m = 0; m < 4; ++m)
#pragma unroll
                        for (int n = 0; n < 2; ++n) acc[a][b][m][n] = (f32x4){0.f, 0.f, 0.f, 0.f};
        }
        cur = nxt; cA = nA; cB = nB; ++ui;
        if (wr == 1) PG8_BAR;
    }
    PG8_WAIT_V(0);
    PG8_BAR;
#undef PG8_SA
#undef PG8_SB
#undef PG8_STAGE
#undef PG8_LDA
#undef PG8_LDB
#undef PG8_MMA
#undef PG8_WAIT_V
#undef PG8_WAIT_L
#undef PG8_BAR
#undef PG8_SCHED
}
}

struct Args { const float* in[27]; float* out; unsigned char* ws; int ph_lo, ph_hi, li, pad; };
constexpr int NWAVES = 8, NTHR = 512;
constexpr int RING_BYTES = 131072, LDSCTL_OFF = RING_BYTES, MISC_OFF = LDSCTL_OFF + 320, LDS_BYTES = 147456;

struct Frame {
    LAS unsigned char* lds; volatile LAS unsigned* MISC; gu32* ctl;
    int tid, lane, wave, vcu, G;
    const float* const* in; float* out; unsigned char* ws; unsigned char* ob;
};

__device__ __forceinline__ int win_src(int n) {
    if (n < 3072) return n;
    if (n < 4096) return 3088 + (n - 3072);
    if (n < 4352) return 4112 + (n - 4096);
    if (n < 4608) return 4368 + (n - 4352);
    if (n < 5120) return 4624 + (n - 4608);
    if (n < 6144) return 5208 + (n - 5120);
    if (n < 7168) return 6232 + (n - 6144);
    if (n < 7184) return 3072 + (n - 7168);
    if (n < 7248) return 5136 + (n - 7184);
    if (n < 7256) return 5200 + (n - 7248);
    return -1;
}
template <class SrcFn>
__device__ __forceinline__ void p0_transpose_item(SrcFn src, int ldw, int Kdim, bf16_t* WT, LAS float* scr, int kb, int nb, int lane) {
    const int k0 = 64 * kb, n0 = 32 * nb;
    const float* cp = src(n0 + (lane & 31));
#pragma unroll 8
    for (int i = 0; i < 32; ++i) { const int kk = 2 * i + (lane >> 5); scr[kk * 33 + (lane & 31)] = cp ? cp[(size_t)(k0 + kk) * ldw] : 0.f; }
    LDS_WAIT(); asm volatile("" ::: "memory");
    const int c = lane & 7;
#pragma unroll
    for (int j = 0; j < 4; ++j) { const int n = (lane >> 3) + 8 * j; const LAS float* s = scr + (8 * c) * 33 + n;
        u32x4 o; o.x = cvt_pk_bf16(s[0 * 33], s[1 * 33]); o.y = cvt_pk_bf16(s[2 * 33], s[3 * 33]); o.z = cvt_pk_bf16(s[4 * 33], s[5 * 33]); o.w = cvt_pk_bf16(s[6 * 33], s[7 * 33]);
        *(GAS u32x4*)(WT + (size_t)(n0 + n) * Kdim + k0 + 8 * c) = o; }
    LDS_WAIT(); asm volatile("" ::: "memory");
}
__device__ __forceinline__ void p0_prologue(Frame& F) {
    LAS float* scr = (LAS float*)(F.lds + F.wave * 16384);
    const int gw = F.vcu * NWAVES + F.wave, NGW = F.G * NWAVES, lane = F.lane;
    const float* w_in = F.in[10]; const float* w_bs = F.in[20]; const float* w_ba = F.in[21]; const float* w_out = F.in[22];
    const float* w_gate = F.in[24]; const float* w_up = F.in[25]; const float* w_dn = F.in[26];
    bf16_t* WIN = (bf16_t*)(F.ws + WS_WIN); bf16_t* WBS = (bf16_t*)(F.ws + WS_WBS); bf16_t* WBA = (bf16_t*)(F.ws + WS_WBA); bf16_t* WOUT = (bf16_t*)(F.ws + WS_WOUT);
    bf16_t* WGU = (bf16_t*)(F.ws + WS_WGU); bf16_t* WDN = (bf16_t*)(F.ws + WS_WDN);
    constexpr int I_IN = 16 * (NIN / 32), I_SQ = 16 * 32, I_GU = 16 * (NGU / 32), I_DN = (DFF / 64) * 32;
    constexpr int NITEMS = I_IN + 3 * I_SQ + I_GU + I_DN;
    for (int it = gw; it < NITEMS; it += NGW) {
        int r = it;
        if (r < I_IN) { const int nb = r % (NIN / 32), kb = r / (NIN / 32);
            p0_transpose_item([&](int n) -> const float* { const int s = win_src(n); return s >= 0 ? w_in + s : nullptr; }, 7256, 1024, WIN, scr, kb, nb, lane); continue; } r -= I_IN;
        if (r < I_SQ) { p0_transpose_item([&](int n) -> const float* { return w_bs + n; }, 1024, 1024, WBS, scr, r / 32, r % 32, lane); continue; } r -= I_SQ;
        if (r < I_SQ) { p0_transpose_item([&](int n) -> const float* { return w_ba + n; }, 1024, 1024, WBA, scr, r / 32, r % 32, lane); continue; } r -= I_SQ;
        if (r < I_SQ) { p0_transpose_item([&](int n) -> const float* { return w_out + n; }, 1024, 1024, WOUT, scr, r / 32, r % 32, lane); continue; } r -= I_SQ;
        if (r < I_GU) { const int nb = r % (NGU / 32), kb = r / (NGU / 32);
            p0_transpose_item([&](int n) -> const float* { const int t = n >> 8, j = n & 255, ch = t * 128 + (j >> 3) * 4 + (j & 3); return ((j & 4) ? w_up : w_gate) + ch; }, DFF, 1024, WGU, scr, kb, nb, lane); continue; } r -= I_GU;
        p0_transpose_item([&](int n) -> const float* { return w_dn + n; }, 1024, DFF, WDN, scr, r / 32, r % 32, lane);
    }
    const float* xp = F.in[0]; const float* xs = F.in[1]; const float* meta = F.in[7]; const float* n1w = F.in[9];
    bf16_t* HN = (bf16_t*)(F.ob + DO_HN);
    f32x4 wv[4];
#pragma unroll
    for (int j = 0; j < 4; ++j) wv[j] = *((const f32x4*)n1w + lane + 64 * j);
    for (int m = gw; m < RPAD; m += NGW) {
        GAS u32x2* o8 = (GAS u32x2*)(HN + (size_t)m * DM) + lane;
        if (m >= RR) {
#pragma unroll
            for (int j = 0; j < 4; ++j) o8[64 * j] = (u32x2){0u, 0u};
            continue; }
        const float* xrow;
        if (m < RPR) { const int b = m / TP, t = m - b * TP; xrow = t < NMETA ? meta + (size_t)t * DM : xp + ((size_t)b * SEQ + (t - NMETA)) * DM; }
        else xrow = xs + (size_t)(m - RPR) * DM;
        const f32x4* xr = (const f32x4*)xrow + lane;
        f32x4 v[4]; float s = 0.f;
#pragma unroll
        for (int j = 0; j < 4; ++j) { v[j] = xr[64 * j]; s += (v[j].x * v[j].x + v[j].y * v[j].y) + (v[j].z * v[j].z + v[j].w * v[j].w); }
        const float rs = __builtin_amdgcn_rsqf(wave_sum(s) * (1.f / DM) + EPS);
#pragma unroll
        for (int j = 0; j < 4; ++j) { const f32x4 y = v[j] * rs * wv[j]; o8[64 * j] = (u32x2){cvt_pk_bf16(y.x, y.y), cvt_pk_bf16(y.z, y.w)}; }
    }
    { const f32x4* ck = (const f32x4*)F.in[2]; const f32x4* cv = (const f32x4*)F.in[3]; GAS u32x4* ok = (GAS u32x4*)(F.ws + WS_CK); GAS u32x4* ov = (GAS u32x4*)(F.ob + DO_CV);
      const long n8 = (long)NBATCH * PAST * 256 / 8; const long gt = (long)F.vcu * NTHR + F.tid, GT = (long)F.G * NTHR;
      for (long i = gt; i < 2 * n8; i += GT) { const bool isk = i < n8; const long j = isk ? i : i - n8; const f32x4* s = (isk ? ck : cv) + 2 * j;
          const f32x4 a = s[0], b = s[1]; u32x4 o; o.x = cvt_pk_bf16(a.x, a.y); o.y = cvt_pk_bf16(a.z, a.w); o.z = cvt_pk_bf16(b.x, b.y); o.w = cvt_pk_bf16(b.z, b.w);
          (isk ? ok : ov)[j] = o; } }
    { float* s1 = (float*)(F.ws + WS_SSQ1); const int gt = F.vcu * NTHR + F.tid, GT = F.G * NTHR;
      for (int i = gt; i < (int)((WS_PART - WS_SSQ1) / 4); i += GT) s1[i] = 0.f; }
}

struct SchedP1 {
    const char* A; const char* B; int G, c;
    __device__ __forceinline__ bool next(int i, pg8::Unit& u) const {
        const int L = i * G + c; if (L >= 67 * 29) return false;
        pg8::tile_of(L, 67, 29, u.pm, u.pn); u.part = 0; u.A = A + (size_t)u.pm * 256 * 1024 * 2; u.B = B + (size_t)u.pn * 256 * 1024 * 2; return true; }
};
struct EpiP1 {
    static constexpr bool PERM = true;
    unsigned char* ws; unsigned char* ob;
    __device__ __forceinline__ bool operator()(pg8::Acc& acc, const pg8::Unit& u, int wr, int wc, int fr, int fq) const {
        const int pn = u.pn; const int row0 = u.pm * 256 + wr * 64 + fr, cw = wc * 32 + 8 * fq;
        if (pn == 28) {
            float* SM = (float*)(ws + WS_SM);
            if (cw < SMLD) {
#pragma unroll
                for (int ai = 0; ai < 2; ++ai)
#pragma unroll
                    for (int m = 0; m < 4; ++m) { const int r = row0 + ai * 128 + m * 16; if (r < RR) { float* p = SM + (size_t)r * SMLD + cw; *(f32x4*)p = acc[ai][0][m][0]; *(f32x4*)(p + 4) = acc[ai][0][m][1]; } }
            }
            return false;
        }
        bf16_t* base; int ld, c0;
        if (pn < 4) { base = (bf16_t*)(ws + WS_Z); ld = 1024; c0 = pn * 256; }
        else if (pn < 8) { base = (bf16_t*)(ws + WS_XS); ld = 1024; c0 = (pn - 4) * 256; }
        else if (pn < 12) { base = (bf16_t*)(ws + WS_BC); ld = 1024; c0 = (pn - 8) * 256; }
        else if (pn < 16) { base = (bf16_t*)(ob + DO_Q); ld = 1024; c0 = (pn - 12) * 256; }
        else if (pn == 16) { base = (bf16_t*)(ws + WS_K); ld = 256; c0 = 0; }
        else if (pn == 17) { base = (bf16_t*)(ws + WS_V); ld = 256; c0 = 0; }
        else if (pn < 20) { base = (bf16_t*)(ob + DO_QI); ld = 512; c0 = (pn - 18) * 256; }
        else if (pn < 24) { base = (bf16_t*)(ws + WS_GS); ld = 1024; c0 = (pn - 20) * 256; }
        else { base = (bf16_t*)(ws + WS_GA); ld = 1024; c0 = (pn - 24) * 256; }
#pragma unroll
        for (int ai = 0; ai < 2; ++ai)
#pragma unroll
            for (int m = 0; m < 4; ++m) { const int r = row0 + ai * 128 + m * 16;
                if (r < RR) { bf16_t* rowp = base + (size_t)r * ld + c0 + cw;
#pragma unroll
                    for (int bj = 0; bj < 2; ++bj) { const f32x4 v0 = acc[ai][bj][m][0], v1 = acc[ai][bj][m][1];
                        u32x4 w; w.x = cvt_pk_bf16(v0[0], v0[1]); w.y = cvt_pk_bf16(v0[2], v0[3]); w.z = cvt_pk_bf16(v1[0], v1[1]); w.w = cvt_pk_bf16(v1[2], v1[3]);
                        *(u32x4*)(rowp + bj * 128) = w; } } }
        return false;
    }
};

__device__ __forceinline__ void p2_rows(Frame& F) {
    const int gw = F.vcu * NWAVES + F.wave, NGW = F.G * NWAVES, lane = F.lane;
    bf16_t* Q = (bf16_t*)(F.ob + DO_Q); bf16_t* K = (bf16_t*)(F.ws + WS_K); const bf16_t* V = (const bf16_t*)(F.ws + WS_V);
    float* SM = (float*)(F.ws + WS_SM); bf16_t* KI = (bf16_t*)(F.ws + WS_KI);
    const float* qnw = F.in[17]; const float* knw = F.in[18]; const float* ikw = F.in[19]; const float* dtb = F.in[13];
    f32x4 qw[4];
#pragma unroll
    for (int j = 0; j < 4; ++j) qw[j] = *(const f32x4*)(qnw + (lane & 7) * 16 + 4 * j);
    const f32x4 kw = *(const f32x4*)(knw + (lane & 31) * 4);
    const float iw = ikw[lane]; const float dbias = lane < 16 ? dtb[lane] : 0.f;
    constexpr float QSC = 0.08838834764831845f * 1.4426950408889634f;
    for (int r = gw; r < RR; r += NGW) {
        const bool pr = r < RPR; const size_t orow = pr ? (size_t)r : (size_t)(r - RPR);
        float* k_out = F.out + (pr ? O_KP : O_KS) + orow * 256; float* v_out = F.out + (pr ? O_VP : O_VS) + orow * 256; float* ki_out = F.out + (pr ? O_KIP : O_KIS) + orow * 64;
        { u32x4* qp = (u32x4*)(Q + (size_t)r * 1024) + lane * 2; const u32x4 a = qp[0], b = qp[1];
          float x[16]; x[0] = bf_lo(a.x); x[1] = bf_hi(a.x); x[2] = bf_lo(a.y); x[3] = bf_hi(a.y); x[4] = bf_lo(a.z); x[5] = bf_hi(a.z); x[6] = bf_lo(a.w); x[7] = bf_hi(a.w);
          x[8] = bf_lo(b.x); x[9] = bf_hi(b.x); x[10] = bf_lo(b.y); x[11] = bf_hi(b.y); x[12] = bf_lo(b.z); x[13] = bf_hi(b.z); x[14] = bf_lo(b.w); x[15] = bf_hi(b.w);
          float s = 0.f;
#pragma unroll
          for (int j = 0; j < 16; ++j) s += x[j] * x[j];
          s += __shfl_xor(s, 1); s += __shfl_xor(s, 2); s += __shfl_xor(s, 4);
          const float rs = __builtin_amdgcn_rsqf(s * (1.f / HD) + EPS) * QSC;
#pragma unroll
          for (int j = 0; j < 16; ++j) x[j] = x[j] * rs * qw[j >> 2][j & 3];
          u32x4 oa, ob; oa.x = cvt_pk_bf16(x[0], x[1]); oa.y = cvt_pk_bf16(x[2], x[3]); oa.z = cvt_pk_bf16(x[4], x[5]); oa.w = cvt_pk_bf16(x[6], x[7]);
          ob.x = cvt_pk_bf16(x[8], x[9]); ob.y = cvt_pk_bf16(x[10], x[11]); ob.z = cvt_pk_bf16(x[12], x[13]); ob.w = cvt_pk_bf16(x[14], x[15]);
          qp[0] = oa; qp[1] = ob; }
        { u32x2* kp = (u32x2*)(K + (size_t)r * 256) + lane; const u32x2 a = *kp;
          f32x4 x = {bf_lo(a.x), bf_hi(a.x), bf_lo(a.y), bf_hi(a.y)};
          float s = (x.x * x.x + x.y * x.y) + (x.z * x.z + x.w * x.w);
          s += __shfl_xor(s, 1); s += __shfl_xor(s, 2); s += __shfl_xor(s, 4); s += __shfl_xor(s, 8); s += __shfl_xor(s, 16);
          const float rs = __builtin_amdgcn_rsqf(s * (1.f / HD) + EPS);
          x = x * rs * kw;
          *kp = (u32x2){cvt_pk_bf16(x.x, x.y), cvt_pk_bf16(x.z, x.w)};
          *((f32x4*)k_out + lane) = x;
          const u32x2 vv = *((const u32x2*)(V + (size_t)r * 256) + lane);
          *((f32x4*)v_out + lane) = (f32x4){bf_lo(vv.x), bf_hi(vv.x), bf_lo(vv.y), bf_hi(vv.y)}; }
        { float* sm = SM + (size_t)r * SMLD;
          const float kv = sm[16 + lane]; const float ss = wave_sum(kv * kv);
          const float kn = kv * __builtin_amdgcn_rsqf(ss * (1.f / IDXD) + EPS) * iw;
          KI[(size_t)r * 64 + lane] = f2bf(kn); ki_out[lane] = kn;
          if (lane < 16) { const float x = sm[lane] + dbias; sm[lane] = x > 20.f ? x : log1pf(expf(x)); }
          if (lane < 8) sm[80 + lane] *= 0.04419417382415922f; }
    }
    { const bf16_t* XS = (const bf16_t*)(F.ws + WS_XS); const bf16_t* BC = (const bf16_t*)(F.ws + WS_BC); bf16_t* HAL = (bf16_t*)(F.ws + WS_HAL);
      for (int it = gw; it < 48 + 768; it += NGW) {
          if (it < 48) { const int s = it / 3, i = it % 3; const int r = s < 8 ? s * TP + (TP - 3 + i) : RPR + (s - 8) * DSEQ + (DSEQ - 3 + i);
              float* o = F.out + (s < 8 ? O_CVP + (size_t)(s * 3 + i) * CONV_DIM : O_CVS + (size_t)((s - 8) * 3 + i) * CONV_DIM);
#pragma unroll
              for (int j = 0; j < 4; ++j) { const int c = j * 256 + lane * 4;
                  const u32x2 a = *(const u32x2*)(XS + (size_t)r * 1024 + c); *(f32x4*)(o + c) = (f32x4){bf_lo(a.x), bf_hi(a.x), bf_lo(a.y), bf_hi(a.y)};
                  const u32x2 b = *(const u32x2*)(BC + (size_t)r * 1024 + c); *(f32x4*)(o + 1024 + c) = (f32x4){bf_lo(b.x), bf_hi(b.x), bf_lo(b.y), bf_hi(b.y)}; } }
          else { const int h = it - 48, b = h / 96, jb = (h % 96) / 3, i = h % 3; const int r = b * TP + 64 * (jb + 1) - 3 + i;
              bf16_t* o = HAL + (size_t)((b * 33 + jb + 1) * 3 + i) * CONV_DIM;
#pragma unroll
              for (int j = 0; j < 2; ++j) { const int c = j * 512 + lane * 8;
                  *(u32x4*)(o + c) = *(const u32x4*)(XS + (size_t)r * 1024 + c); *(u32x4*)(o + 1024 + c) = *(const u32x4*)(BC + (size_t)r * 1024 + c); } }
      } }
}

__device__ __forceinline__ int t5_bucket(int rel) {
    const int n = rel < 0 ? -rel : rel; const int ret = rel > 0 ? 16 : 0;
    const int v = n < 8 ? n : (n < 12 ? 8 : n < 16 ? 9 : n < 23 ? 10 : n < 32 ? 11 : n < 46 ? 12 : n < 64 ? 13 : n < 91 ? 14 : 15);
    return ret + v;
}
__device__ __forceinline__ void ssd_slow(Frame& F) {
    if (F.wave != 0) return;
    const int lane = F.lane;
    bf16_t* XS = (bf16_t*)(F.ws + WS_XS); const bf16_t* BC = (const bf16_t*)(F.ws + WS_BC); const bf16_t* Z = (const bf16_t*)(F.ws + WS_Z);
    const float* SM = (const float*)(F.ws + WS_SM); float* SSQ1 = (float*)(F.ws + WS_SSQ1);
    const float* conv_w = F.in[11]; const float* conv_b = F.in[12]; const float* a_log = F.in[14]; const float* d_skip = F.in[15]; const float* snw = F.in[16];
    const float* st_ssm = F.in[5]; const float* st_conv = F.in[6];
    LAS float* sbc = (LAS float*)F.lds;
    for (int item = F.vcu; item < 256; item += F.G) {
        const bool pr = item < 128; const int bh = item & 127, b = bh >> 4, h = bh & 15, g = h >> 2;
        const int T = pr ? TP : DSEQ; const int row0 = pr ? b * TP : RPR + b * DSEQ;
        const int xch = h * 64 + lane;
        const int bcc = lane < 32 ? g * 128 + 4 * lane : 512 + g * 128 + 4 * (lane - 32);
        float wx[4], bx; f32x4 wb[4], bb;
#pragma unroll
        for (int i = 0; i < 4; ++i) { wx[i] = conv_w[i * CONV_DIM + xch]; wb[i] = *(const f32x4*)(conv_w + i * CONV_DIM + 1024 + bcc); }
        bx = conv_b[xch]; bb = *(const f32x4*)(conv_b + 1024 + bcc);
        float xp[3]; f32x4 bp[3];
#pragma unroll
        for (int i = 0; i < 3; ++i) { if (pr) { xp[i] = 0.f; bp[i] = (f32x4){0.f, 0.f, 0.f, 0.f}; } else { xp[i] = st_conv[(size_t)(b * 3 + i) * CONV_DIM + xch]; bp[i] = *(const f32x4*)(st_conv + (size_t)(b * 3 + i) * CONV_DIM + 1024 + bcc); } }
        float hs[128];
        float* sout = F.out + (pr ? O_SSMP : O_SSMS) + ((size_t)(b * 16 + h) * 64 + lane) * 128;
        if (pr) {
#pragma unroll
            for (int n = 0; n < 128; ++n) hs[n] = 0.f;
        } else { const float* sp = st_ssm + ((size_t)(b * 16 + h) * 64 + lane) * 128;
#pragma unroll
            for (int n = 0; n < 128; n += 4) { const f32x4 v = *(const f32x4*)(sp + n); hs[n] = v.x; hs[n + 1] = v.y; hs[n + 2] = v.z; hs[n + 3] = v.w; } }
        const float a_h = -expf(a_log[h]), dsk = d_skip[h], nw = snw[xch];
        for (int t = 0; t < T; ++t) {
            const size_t r = (size_t)(row0 + t);
            const float xr = bf2f(XS[r * 1024 + xch]);
            const u32x2 bcr = *(const u32x2*)(BC + r * 1024 + bcc);
            const f32x4 br = {bf_lo(bcr.x), bf_hi(bcr.x), bf_lo(bcr.y), bf_hi(bcr.y)};
            const float zv = bf2f(Z[r * 1024 + xch]);
            const float dt = SM[r * SMLD + h];
            float xc = bx + xp[0] * wx[0] + xp[1] * wx[1] + xp[2] * wx[2] + xr * wx[3];
            f32x4 bc = bb + bp[0] * wb[0] + bp[1] * wb[1] + bp[2] * wb[2] + br * wb[3];
            xp[0] = xp[1]; xp[1] = xp[2]; xp[2] = xr; bp[0] = bp[1]; bp[1] = bp[2]; bp[2] = br;
            xc = siluf_(xc); bc.x = siluf_(bc.x); bc.y = siluf_(bc.y); bc.z = siluf_(bc.z); bc.w = siluf_(bc.w);
            *(LAS f32x4*)(sbc + 4 * lane) = bc;
            LDS_WAIT(); asm volatile("" ::: "memory");
            const float dA = expf(dt * a_h), dx = dt * xc;
            float y = 0.f;
#pragma unroll
            for (int n = 0; n < 128; n += 4) { const f32x4 Bv = *(const LAS f32x4*)(sbc + n); const f32x4 Cv = *(const LAS f32x4*)(sbc + 128 + n);
                hs[n] = hs[n] * dA + dx * Bv.x; y += Cv.x * hs[n];
                hs[n + 1] = hs[n + 1] * dA + dx * Bv.y; y += Cv.y * hs[n + 1];
                hs[n + 2] = hs[n + 2] * dA + dx * Bv.z; y += Cv.z * hs[n + 2];
                hs[n + 3] = hs[n + 3] * dA + dx * Bv.w; y += Cv.w * hs[n + 3]; }
            LDS_WAIT(); asm volatile("" ::: "memory");
            y = (y + dsk * xc) * siluf_(zv);
            const float ss = wave_sum(y * y);
            if (lane == 0) atomicAdd(SSQ1 + r, ss);
            XS[r * 1024 + xch] = f2bf(y * nw);
        }
#pragma unroll
        for (int n = 0; n < 128; n += 4) *(f32x4*)(sout + n) = (f32x4){hs[n], hs[n + 1], hs[n + 2], hs[n + 3]};
    }
}

template <bool PR>
__device__ __forceinline__ void attn_slow_query(Frame& F, int r, LAS unsigned char* wl) {
    const int lane = F.lane;
    bf16_t* Q = (bf16_t*)(F.ob + DO_Q); const bf16_t* QI = (const bf16_t*)(F.ob + DO_QI); const bf16_t* KI = (const bf16_t*)(F.ws + WS_KI);
    const bf16_t* Kb = (const bf16_t*)(F.ws + WS_K); const bf16_t* Vb = (const bf16_t*)(F.ws + WS_V); const bf16_t* CK = (const bf16_t*)(F.ws + WS_CK); const bf16_t* CV = (const bf16_t*)(F.ob + DO_CV);
    const float* SM = (const float*)(F.ws + WS_SM); const float* ckidx = F.in[4]; const float* relb = F.in[8];
    int b, tq, L, qpos, krow0;
    if (PR) { b = r / TP; tq = r - b * TP; const int qc = (tq - NMETA) / 64 + 1; L = NMETA + 64 * qc; qpos = tq; krow0 = b * TP; }
    else { b = (r - RPR) / DSEQ; tq = (r - RPR) - b * DSEQ; L = LS; qpos = PAST + tq; krow0 = RPR + b * DSEQ; }
    LAS float* qf = (LAS float*)wl;
    LAS unsigned* list = (LAS unsigned*)(wl + 2048);
    LAS float* pl = (LAS float*)(wl + 3072);
    LAS unsigned* keys = (LAS unsigned*)(wl + 7168);
    const int ni = (L + 63) >> 6;
    { const u32x4 a = *((const u32x4*)(QI + (size_t)r * 512) + lane);
      LAS float* d = qf + lane * 8; d[0] = bf_lo(a.x); d[1] = bf_hi(a.x); d[2] = bf_lo(a.y); d[3] = bf_hi(a.y); d[4] = bf_lo(a.z); d[5] = bf_hi(a.z); d[6] = bf_lo(a.w); d[7] = bf_hi(a.w); }
    LDS_WAIT(); asm volatile("" ::: "memory");
    float wv[8];
#pragma unroll
    for (int h = 0; h < 8; ++h) wv[h] = SM[(size_t)r * SMLD + 80 + h];
#pragma unroll 1
    for (int i = 0; i < ni; ++i) {
        const int s = i * 64 + lane; const int sc_ = s < L ? s : L - 1;
        float d[8] = {0.f, 0.f, 0.f, 0.f, 0.f, 0.f, 0.f, 0.f};
        const bool cache = !PR && (i * 64 < PAST);
        const float* kpf = ckidx + ((size_t)b * PAST + (cache ? sc_ : 0)) * 64;
        const bf16_t* kpb = KI + (size_t)(PR ? krow0 + sc_ : (cache ? krow0 : krow0 + sc_ - PAST)) * 64;
#pragma unroll 1
        for (int c = 0; c < 8; ++c) {
            float k8[8];
            if (cache) { const f32x4 v0 = *((const f32x4*)kpf + 2 * c), v1 = *((const f32x4*)kpf + 2 * c + 1); k8[0] = v0.x; k8[1] = v0.y; k8[2] = v0.z; k8[3] = v0.w; k8[4] = v1.x; k8[5] = v1.y; k8[6] = v1.z; k8[7] = v1.w; }
            else { const u32x4 v = *((const u32x4*)kpb + c); k8[0] = bf_lo(v.x); k8[1] = bf_hi(v.x); k8[2] = bf_lo(v.y); k8[3] = bf_hi(v.y); k8[4] = bf_lo(v.z); k8[5] = bf_hi(v.z); k8[6] = bf_lo(v.w); k8[7] = bf_hi(v.w); }
#pragma unroll
            for (int h = 0; h < 8; ++h) { const f32x4 qa = *(const LAS f32x4*)(qf + h * 64 + c * 8), qb = *(const LAS f32x4*)(qf + h * 64 + c * 8 + 4);
                d[h] += qa.x * k8[0] + qa.y * k8[1] + qa.z * k8[2] + qa.w * k8[3] + qb.x * k8[4] + qb.y * k8[5] + qb.z * k8[6] + qb.w * k8[7]; }
        }
        float sc = 0.f;
#pragma unroll
        for (int h = 0; h < 8; ++h) sc += wv[h] * fmaxf(d[h], 0.f);
        if (sc == 0.f) sc = 0.f;
        const unsigned u = __float_as_uint(sc);
        keys[s] = s < L ? ((u & 0x80000000u) ? ~u : (u | 0x80000000u)) : 0u;
    }
    LDS_WAIT(); asm volatile("" ::: "memory");
    int nsel;
    const unsigned long long lt_mask = (1ull << lane) - 1ull;
    if (L <= TOPK) { nsel = L;
#pragma unroll
        for (int i = 0; i < 4; ++i) { const int s = i * 64 + lane; if (s < L) list[s] = (unsigned)s; } }
    else {
        unsigned prefix = 0u;
        for (int bit = 31; bit >= 0; --bit) { const unsigned cand = prefix | (1u << bit); int cnt = 0;
#pragma unroll 1
            for (int i = 0; i < ni; ++i) cnt += __popcll(__ballot(keys[i * 64 + lane] >= cand));
            if (cnt >= TOPK) prefix = cand; }
        int ngt = 0;
#pragma unroll 1
        for (int i = 0; i < ni; ++i) ngt += __popcll(__ballot(keys[i * 64 + lane] > prefix));
        const int need = TOPK - ngt; int eqseen = 0, pos = 0;
#pragma unroll 1
        for (int i = 0; i < ni; ++i) { const unsigned kv = keys[i * 64 + lane]; const bool gt = kv > prefix, eq = kv == prefix; const unsigned long long meq = __ballot(eq);
            const bool sel = gt || (eq && (eqseen + __popcll(meq & lt_mask)) < need); const unsigned long long ms = __ballot(sel);
            if (sel) list[pos + __popcll(ms & lt_mask)] = (unsigned)(i * 64 + lane);
            pos += __popcll(ms); eqseen += __popcll(meq); }
        nsel = TOPK; }
    LDS_WAIT(); asm volatile("" ::: "memory");
#pragma unroll 1
    for (int g = 0; g < 2; ++g) {
        { const u32x4 a = *((const u32x4*)(Q + (size_t)r * 1024 + g * 512) + lane);
          LAS float* d = qf + lane * 8; d[0] = bf_lo(a.x); d[1] = bf_hi(a.x); d[2] = bf_lo(a.y); d[3] = bf_hi(a.y); d[4] = bf_lo(a.z); d[5] = bf_hi(a.z); d[6] = bf_lo(a.w); d[7] = bf_hi(a.w); }
        LDS_WAIT(); asm volatile("" ::: "memory");
        float mx[4] = {-1e30f, -1e30f, -1e30f, -1e30f};
        const int njj = (nsel + 63) >> 6;
#pragma unroll 1
        for (int jj = 0; jj < njj; ++jj) { const int j = jj * 64 + lane;
            const int s = j < nsel ? (int)list[j] : (int)list[0];
            const bf16_t* kp = (!PR && s < PAST) ? CK + ((size_t)b * PAST + s) * 256 + g * 128 : Kb + (size_t)(PR ? krow0 + s : krow0 + s - PAST) * 256 + g * 128;
            float d0 = 0.f, d1 = 0.f, d2 = 0.f, d3 = 0.f;
#pragma unroll 1
            for (int c = 0; c < 16; ++c) { const u32x4 v = *((const u32x4*)kp + c);
                const float k0 = bf_lo(v.x), k1 = bf_hi(v.x), k2 = bf_lo(v.y), k3 = bf_hi(v.y), k4 = bf_lo(v.z), k5 = bf_hi(v.z), k6 = bf_lo(v.w), k7 = bf_hi(v.w);
#define DOT8(hh, acc) { const f32x4 qa = *(const LAS f32x4*)(qf + hh * 128 + c * 8), qb = *(const LAS f32x4*)(qf + hh * 128 + c * 8 + 4); \
                    acc += qa.x * k0 + qa.y * k1 + qa.z * k2 + qa.w * k3 + qb.x * k4 + qb.y * k5 + qb.z * k6 + qb.w * k7; }
                DOT8(0, d0) DOT8(1, d1) DOT8(2, d2) DOT8(3, d3)
#undef DOT8
            }
            const int bk = t5_bucket(s - qpos);
            const f32x4 bv = *(const f32x4*)(relb + bk * 8 + g * 4);
            constexpr float L2E = 1.4426950408889634f;
            const bool ok = j < nsel;
            f32x4 lgv; lgv.x = ok ? d0 + bv.x * L2E : -1e30f; lgv.y = ok ? d1 + bv.y * L2E : -1e30f; lgv.z = ok ? d2 + bv.z * L2E : -1e30f; lgv.w = ok ? d3 + bv.w * L2E : -1e30f;
            *(LAS f32x4*)(pl + j * 4) = lgv;
            mx[0] = fmaxf(mx[0], lgv.x); mx[1] = fmaxf(mx[1], lgv.y); mx[2] = fmaxf(mx[2], lgv.z); mx[3] = fmaxf(mx[3], lgv.w);
        }
        float sm[4] = {0.f, 0.f, 0.f, 0.f};
#pragma unroll
        for (int h = 0; h < 4; ++h) {
#pragma unroll
            for (int o = 1; o < 64; o <<= 1) mx[h] = fmaxf(mx[h], __shfl_xor(mx[h], o)); }
        LDS_WAIT(); asm volatile("" ::: "memory");
#pragma unroll 1
        for (int jj = 0; jj < njj; ++jj) { const int j = jj * 64 + lane;
            f32x4 lgv = *(const LAS f32x4*)(pl + j * 4);
            lgv.x = __builtin_amdgcn_exp2f(lgv.x - mx[0]); lgv.y = __builtin_amdgcn_exp2f(lgv.y - mx[1]); lgv.z = __builtin_amdgcn_exp2f(lgv.z - mx[2]); lgv.w = __builtin_amdgcn_exp2f(lgv.w - mx[3]);
            sm[0] += lgv.x; sm[1] += lgv.y; sm[2] += lgv.z; sm[3] += lgv.w;
            *(LAS f32x4*)(pl + j * 4) = lgv; }
#pragma unroll
        for (int h = 0; h < 4; ++h) sm[h] = __builtin_amdgcn_rcpf(wave_sum(sm[h]));
        LDS_WAIT(); asm volatile("" ::: "memory");
        float o[4][2] = {};
        for (int j = 0; j < nsel; ++j) {
            const int s = (int)list[j]; const f32x4 p = *(const LAS f32x4*)(pl + j * 4);
            const bf16_t* vp = (!PR && s < PAST) ? CV + ((size_t)b * PAST + s) * 256 + g * 128 : Vb + (size_t)(PR ? krow0 + s : krow0 + s - PAST) * 256 + g * 128;
            const unsigned vv = *((const unsigned*)vp + lane); const float v0 = bf_lo(vv), v1 = bf_hi(vv);
            o[0][0] += p.x * v0; o[0][1] += p.x * v1; o[1][0] += p.y * v0; o[1][1] += p.y * v1; o[2][0] += p.z * v0; o[2][1] += p.z * v1; o[3][0] += p.w * v0; o[3][1] += p.w * v1;
        }
#pragma unroll
        for (int h = 0; h < 4; ++h) *((unsigned*)(Q + (size_t)r * 1024 + g * 512 + h * 128) + lane) = cvt_pk_bf16(o[h][0] * sm[h], o[h][1] * sm[h]);
        LDS_WAIT(); asm volatile("" ::: "memory");
    }
}
__device__ __forceinline__ void attn_slow(Frame& F) {
    const int gw = F.vcu * NWAVES + F.wave, NGW = F.G * NWAVES;
    for (int q = gw; q < YPR; q += NGW) { const int b = q / SEQ, t = q - b * SEQ; attn_slow_query<true>(F, b * TP + NMETA + t, F.lds + F.wave * 16384); }
    __syncthreads();
    if (F.wave < 4) { const int gw4 = F.vcu * 4 + F.wave;
        for (int q = gw4; q < RSR; q += F.G * 4) attn_slow_query<false>(F, RPR + q, F.lds + F.wave * 32768); }
}
__device__ __forceinline__ int yrow_to_r(int pm) { return pm * 256 + (pm < 64 ? 16 * ((pm >> 3) + 1) : 128); }
struct SchedP5 {
    const char* A0; const char* A1; const char* B0; const char* B1; int G, c;
    __device__ __forceinline__ bool next(int i, pg8::Unit& u) const {
        const int L = (i >> 1) * G + c; if (L >= 66 * 4) return false;
        pg8::tile_of(L, 66, 4, u.pm, u.pn); u.part = i & 1;
        u.A = (u.part ? A1 : A0) + (size_t)yrow_to_r(u.pm) * 1024 * 2; u.B = (u.part ? B1 : B0) + (size_t)u.pn * 256 * 1024 * 2; return true; }
};
struct EpiP5 {
    static constexpr bool PERM = true;
    const bf16_t* GS; const bf16_t* GA; const float* SSQ1; bf16_t* MERGED;
    __device__ __forceinline__ bool operator()(pg8::Acc& acc, const pg8::Unit& u, int wr, int wc, int fr, int fq) const {
        const int rr0 = yrow_to_r(u.pm) + wr * 64 + fr, ry0 = u.pm * 256 + wr * 64 + fr, col = u.pn * 256 + wc * 32 + 8 * fq;
#pragma unroll
        for (int ai = 0; ai < 2; ++ai)
#pragma unroll
            for (int m = 0; m < 4; ++m) { const int rr = rr0 + ai * 128 + m * 16, ry = ry0 + ai * 128 + m * 16;
                float rstd = 0.f; if (u.part == 0) rstd = __builtin_amdgcn_rsqf(SSQ1[rr] * (1.f / 1024.f) + EPS);
#pragma unroll
                for (int bj = 0; bj < 2; ++bj) {
                    const u32x4 ga = *(const u32x4*)(GA + (size_t)rr * 1024 + col + bj * 128);
                    float sa[8] = {bf_lo(ga.x), bf_hi(ga.x), bf_lo(ga.y), bf_hi(ga.y), bf_lo(ga.z), bf_hi(ga.z), bf_lo(ga.w), bf_hi(ga.w)};
                    if (u.part == 0) {
                        const u32x4 gs = *(const u32x4*)(GS + (size_t)rr * 1024 + col + bj * 128);
                        const float ss[8] = {bf_lo(gs.x), bf_hi(gs.x), bf_lo(gs.y), bf_hi(gs.y), bf_lo(gs.z), bf_hi(gs.z), bf_lo(gs.w), bf_hi(gs.w)};
#pragma unroll
                        for (int e = 0; e < 8; ++e) {
                            const float f = rstd * (1.f + __builtin_amdgcn_exp2f(-1.4426950408889634f * sa[e])) * __builtin_amdgcn_rcpf(1.f + __builtin_amdgcn_exp2f(-1.4426950408889634f * ss[e]));
                            acc[ai][bj][m][e >> 2][e & 3] *= f; }
                    } else {
                        float o[8];
#pragma unroll
                        for (int e = 0; e < 8; ++e) o[e] = acc[ai][bj][m][e >> 2][e & 3] * sigmoidf_(sa[e]);
                        u32x4 w; w.x = cvt_pk_bf16(o[0], o[1]); w.y = cvt_pk_bf16(o[2], o[3]); w.z = cvt_pk_bf16(o[4], o[5]); w.w = cvt_pk_bf16(o[6], o[7]);
                        *(u32x4*)(MERGED + (size_t)ry * 1024 + col + bj * 128) = w; } } }
        return u.part == 0;
    }
};
struct SchedY {
    const char* A; const char* B; int nN, K, G, c;
    __device__ __forceinline__ bool next(int i, pg8::Unit& u) const {
        const int L = i * G + c; if (L >= 66 * nN) return false;
        pg8::tile_of(L, 66, nN, u.pm, u.pn); u.part = 0; u.A = A + (size_t)u.pm * 256 * K * 2; u.B = B + (size_t)u.pn * 256 * K * 2; return true; }
};
struct EpiP6 {
    static constexpr bool PERM = false;
    const float* xp; const float* xs; const float* n2w; float* H; bf16_t* HB; float* SSQ2;
    __device__ __forceinline__ bool operator()(pg8::Acc& acc, const pg8::Unit& u, int wr, int wc, int fr, int fq) const {
        const int ry0 = u.pm * 256 + wr * 64 + fr, col0 = u.pn * 256 + wc * 32 + 4 * fq;
        f32x4 nw[2][2];
#pragma unroll
        for (int bj = 0; bj < 2; ++bj)
#pragma unroll
            for (int n = 0; n < 2; ++n) nw[bj][n] = *(const f32x4*)(n2w + col0 + bj * 128 + n * 16);
#pragma unroll
        for (int ai = 0; ai < 2; ++ai)
#pragma unroll
            for (int m = 0; m < 4; ++m) { const int ry = ry0 + ai * 128 + m * 16;
                const float* xrow = ry < YPR ? xp + (size_t)ry * 1024 : xs + (size_t)(ry - YPR) * 1024; float ss = 0.f;
#pragma unroll
                for (int bj = 0; bj < 2; ++bj)
#pragma unroll
                    for (int n = 0; n < 2; ++n) { const int c = col0 + bj * 128 + n * 16; const f32x4 h = *(const f32x4*)(xrow + c) + acc[ai][bj][m][n];
                        *(f32x4*)(H + (size_t)ry * 1024 + c) = h; ss += (h.x * h.x + h.y * h.y) + (h.z * h.z + h.w * h.w);
                        const f32x4 hn = h * nw[bj][n]; *(u32x2*)(HB + (size_t)ry * 1024 + c) = (u32x2){cvt_pk_bf16(hn.x, hn.y), cvt_pk_bf16(hn.z, hn.w)}; }
                ss += __shfl_xor(ss, 16); ss += __shfl_xor(ss, 32);
                if (fq == 0) atomicAdd(SSQ2 + ry, ss); }
        return false;
    }
};
struct EpiP7 {
    static constexpr bool PERM = true;
    const float* SSQ2; bf16_t* ACT;
    __device__ __forceinline__ bool operator()(pg8::Acc& acc, const pg8::Unit& u, int wr, int wc, int fr, int fq) const {
        const int ry0 = u.pm * 256 + wr * 64 + fr, ch0 = u.pn * 128 + wc * 16 + 4 * fq;
#pragma unroll
        for (int ai = 0; ai < 2; ++ai)
#pragma unroll
            for (int m = 0; m < 4; ++m) { const int ry = ry0 + ai * 128 + m * 16; const float rs = __builtin_amdgcn_rsqf(SSQ2[ry] * (1.f / 1024.f) + EPS);
#pragma unroll
                for (int bj = 0; bj < 2; ++bj) { const f32x4 g = acc[ai][bj][m][0] * rs, up = acc[ai][bj][m][1] * rs;
                    const float a0 = siluf_(g.x) * up.x, a1 = siluf_(g.y) * up.y, a2 = siluf_(g.z) * up.z, a3 = siluf_(g.w) * up.w;
                    *(u32x2*)(ACT + (size_t)ry * DFF + ch0 + bj * 64) = (u32x2){cvt_pk_bf16(a0, a1), cvt_pk_bf16(a2, a3)}; } }
        return false;
    }
};
struct EpiP8 {
    static constexpr bool PERM = false;
    float* H;
    __device__ __forceinline__ bool operator()(pg8::Acc& acc, const pg8::Unit& u, int wr, int wc, int fr, int fq) const {
        const int ry0 = u.pm * 256 + wr * 64 + fr, col0 = u.pn * 256 + wc * 32 + 4 * fq;
#pragma unroll
        for (int ai = 0; ai < 2; ++ai)
#pragma unroll
            for (int m = 0; m < 4; ++m) { float* hrow = H + (size_t)(ry0 + ai * 128 + m * 16) * 1024 + col0;
#pragma unroll
                for (int bj = 0; bj < 2; ++bj)
#pragma unroll
                    for (int n = 0; n < 2; ++n) { f32x4* p = (f32x4*)(hrow + bj * 128 + n * 16); *p = *p + acc[ai][bj][m][n]; } }
        return false;
    }
};

constexpr int NPHASE = 9;
__global__ void __launch_bounds__(NTHR, 2) hybrid_fwd(Args args) {
    extern __shared__ __attribute__((aligned(16))) unsigned char lds[];
    Frame F;
    F.lds = (LAS unsigned char*)lds; F.MISC = (volatile LAS unsigned*)(F.lds + MISC_OFF);
    F.tid = threadIdx.x; F.lane = F.tid & 63; F.wave = __builtin_amdgcn_readfirstlane(F.tid >> 6);
    F.G = gridDim.x; { const int bx = blockIdx.x; F.vcu = (F.G % 8 == 0) ? (bx % 8) * (F.G / 8) + bx / 8 : bx; }
    F.in = args.in; F.out = args.out; F.ws = args.ws; F.ob = (unsigned char*)args.out; F.ctl = (gu32*)(args.ws + WS_CTL);
    for (int u = F.tid; u < (LDS_BYTES - LDSCTL_OFF) / 4; u += NTHR) ((LAS unsigned*)(F.lds + LDSCTL_OFF))[u] = 0u;
    __syncthreads();
    const int lo = args.ph_lo, hi = args.ph_hi;
    const bool multi = (hi - lo) > 1;
    XcdBarrier bar; bar.bar = (unsigned*)(F.ctl + CW_BAR) + args.li * XCD_BAR_WORDS; bar.x = 0; bar.st = nullptr;
    if (multi) bar = xcd_barrier_post((unsigned*)(F.ctl + CW_BAR) + args.li * XCD_BAR_WORDS, F.MISC + 8);
#define IN(k) (lo <= (k) && (k) < hi)
#define SEAM(k) do { if (IN(k) && IN((k) + 1)) xcd_barrier(bar); } while (0)
    if (IN(0)) { p0_prologue(F); SEAM(0); }
    if (IN(1)) {
        SchedP1 S{(const char*)(F.ob + DO_HN), (const char*)(F.ws + WS_WIN), F.G, (int)blockIdx.x};
        EpiP1 E{F.ws, F.ob};
        pg8::gemm_phase<EpiP1, SchedP1>(F.lds, 1024, S, E);
        SEAM(1);
    }
    if (IN(2)) { p2_rows(F); SEAM(2); }
    if (IN(3)) { ssd_slow(F); __syncthreads(); SEAM(3); }
    if (IN(4)) { attn_slow(F); __syncthreads(); SEAM(4); }
    if (IN(5)) {
        SchedP5 S{(const char*)(F.ws + WS_XS), (const char*)(F.ob + DO_Q), (const char*)(F.ws + WS_WBS), (const char*)(F.ws + WS_WBA), F.G, (int)blockIdx.x};
        EpiP5 E{(const bf16_t*)(F.ws + WS_GS), (const bf16_t*)(F.ws + WS_GA), (const float*)(F.ws + WS_SSQ1), (bf16_t*)(F.ws + WS_MERGED)};
        pg8::gemm_phase<EpiP5, SchedP5>(F.lds, 1024, S, E);
        SEAM(5);
    }
    if (IN(6)) {
        SchedY S{(const char*)(F.ws + WS_MERGED), (const char*)(F.ws + WS_WOUT), 4, 1024, F.G, (int)blockIdx.x};
        EpiP6 E{F.in[0], F.in[1], F.in[23], F.out, (bf16_t*)(F.ws + WS_HB), (float*)(F.ws + WS_SSQ2)};
        pg8::gemm_phase<EpiP6, SchedY>(F.lds, 1024, S, E);
        SEAM(6);
    }
    if (IN(7)) {
        SchedY S{(const char*)(F.ws + WS_HB), (const char*)(F.ws + WS_WGU), NGU / 256, 1024, F.G, (int)blockIdx.x};
        EpiP7 E{(const float*)(F.ws + WS_SSQ2), (bf16_t*)(F.ws + WS_ACT)};
        pg8::gemm_phase<EpiP7, SchedY>(F.lds, 1024, S, E);
        SEAM(7);
    }
    if (IN(8)) {
        SchedY S{(const char*)(F.ws + WS_ACT), (const char*)(F.ws + WS_WDN), 4, DFF, F.G, (int)blockIdx.x};
        EpiP8 E{F.out};
        pg8::gemm_phase<EpiP8, SchedY>(F.lds, DFF, S, E);
    }
#undef IN
#undef SEAM
}

extern "C" void kernel_launch(void* const* d_in, const int* in_sizes, int n_in, void* d_out, int out_size, void* d_ws, size_t ws_size, hipStream_t stream) {
    static int grid = 0;
    if (grid == 0) {
        if (n_in != 27 || out_size != (int)O_END || ws_size < WS_END) { fprintf(stderr, "kernel_launch: unexpected shapes: n_in %d out %d ws %zu (need %zu)\n", n_in, out_size, ws_size, (size_t)WS_END); grid = -1; return; }
        int dev = 0, cus = 0;
        if (hipGetDevice(&dev) != hipSuccess || hipDeviceGetAttribute(&cus, hipDeviceAttributeMultiprocessorCount, dev) != hipSuccess) { grid = -1; return; }
        if (hipFuncSetAttribute((const void*)hybrid_fwd, hipFuncAttributeMaxDynamicSharedMemorySize, LDS_BYTES) != hipSuccess) { fprintf(stderr, "kernel_launch: hipFuncSetAttribute failed\n"); grid = -1; return; }
        (void)hipGetLastError();
        grid = cus;
    }
    if (grid < 0) return;
    (void)hipMemsetAsync((char*)d_ws + WS_CTL, 0, CTL_BYTES, stream);
    Args a{};
    for (int i = 0; i < 27; ++i) a.in[i] = (const float*)d_in[i];
    a.out = (float*)d_out; a.ws = (unsigned char*)d_ws;
#ifndef MK_SPLIT
#define MK_SPLIT 1
#endif
#if MK_SPLIT
    for (int p = 0; p < NPHASE; ++p) { a.ph_lo = p; a.ph_hi = p + 1; a.li = 0; hipLaunchKernelGGL(hybrid_fwd, dim3(grid), dim3(NTHR), LDS_BYTES, stream, a); }
#else
    a.ph_lo = 0; a.ph_hi = NPHASE; a.li = 0; hipLaunchKernelGGL(hybrid_fwd, dim3(grid), dim3(NTHR), LDS_BYTES, stream, a);
#endif
    const hipError_t le = hipPeekAtLastError();
    if (le != hipSuccess) fprintf(stderr, "kernel_launch: launch failed: %s\n", hipGetErrorName(le));
}
```

```cpp
#include <hip/hip_runtime.h>
#include <cstdio>
#include <cstdint>

constexpr int DM = 1024, NBATCH = 8, SEQ = 2048, NMETA = 16, TP = NMETA + SEQ  , DSEQ = 64, PAST = 4096, LS = PAST + DSEQ  ;
constexpr int RPR = NBATCH * TP  , RSR = NBATCH * DSEQ  , RR = RPR + RSR  , RPAD = 17152  ;
constexpr int YPR = NBATCH * SEQ  , YR = YPR + RSR  ;
constexpr int NIN = 7424  , DFF = 2816, NGU = 2 * DFF;
constexpr int SSD_H = 16, SSD_P = 64, SSD_G = 4, SSD_N = 128, CONV_DIM = 2048;
constexpr int NH = 8, NKV = 2, HD = 128, IDXH = 8, IDXD = 64, TOPK = 256;
constexpr float EPS = 1e-6f;
constexpr int SMLD = 96;

constexpr size_t O_YP = 0, O_YS = O_YP + (size_t)YPR * DM, O_KP = O_YS + (size_t)RSR * DM, O_VP = O_KP + (size_t)RPR * 256, O_KIP = O_VP + (size_t)RPR * 256,
                 O_SSMP = O_KIP + (size_t)RPR * 64, O_CVP = O_SSMP + (size_t)NBATCH * 16 * 64 * 128, O_KS = O_CVP + (size_t)NBATCH * 3 * CONV_DIM, O_VS = O_KS + (size_t)RSR * 256,
                 O_KIS = O_VS + (size_t)RSR * 256, O_SSMS = O_KIS + (size_t)RSR * 64, O_CVS = O_SSMS + (size_t)NBATCH * 16 * 64 * 128, O_END = O_CVS + (size_t)NBATCH * 3 * CONV_DIM;
static_assert(O_END == 29302784, "d_out size");
constexpr size_t DO_Q = 0, DO_QI = DO_Q + (size_t)RR * 1024 * 2, DO_CV = DO_QI + (size_t)RR * 512 * 2, DO_YEND = DO_CV + (size_t)NBATCH * PAST * 256 * 2;
static_assert(DO_YEND <= O_KP * 4, "y-region scratch");
constexpr size_t DO_HN = O_KP * 4;
static_assert(DO_HN + (size_t)RPAD * 1024 * 2 <= O_CVP * 4, "hn scratch in tail");

constexpr size_t al256(size_t x) { return (x + 255) / 256 * 256; }
constexpr size_t WS_CTL = 0, CTL_BYTES = 1u << 20;
constexpr size_t WS_WIN = CTL_BYTES, WS_WBS = WS_WIN + (size_t)NIN * 1024 * 2, WS_WBA = WS_WBS + 1024 * 1024 * 2, WS_WOUT = WS_WBA + 1024 * 1024 * 2, WS_WGU = WS_WOUT + 1024 * 1024 * 2,
                 WS_WDN = WS_WGU + (size_t)NGU * 1024 * 2, WS_Z = WS_WDN + (size_t)1024 * DFF * 2, WS_XS = WS_Z + (size_t)RR * 1024 * 2, WS_BC = WS_XS + (size_t)RR * 1024 * 2,
                 WS_GA = WS_BC + (size_t)RR * 1024 * 2, WS_GS = WS_GA + (size_t)RR * 1024 * 2, WS_K = WS_GS + (size_t)RR * 1024 * 2, WS_V = WS_K + (size_t)RR * 256 * 2,
                 WS_SM = WS_V + (size_t)RR * 256 * 2, WS_KI = WS_SM + (size_t)RR * SMLD * 4, WS_CK = WS_KI + (size_t)RR * 64 * 2, WS_MASK = WS_CK + (size_t)NBATCH * PAST * 256 * 2;
constexpr int MASK_LDP = 68, MASK_LDS = 132;
constexpr size_t WS_MASKS = WS_MASK + (size_t)RPR * MASK_LDP * 4, WS_SSQ1 = WS_MASKS + (size_t)RSR * MASK_LDS * 4, WS_SSQ2 = WS_SSQ1 + al256((size_t)RR * 4),
                 WS_PART = WS_SSQ2 + al256((size_t)YR * 4), WS_END = WS_PART + (size_t)32 * 256 * 132 * 4;
constexpr size_t WS_MERGED = WS_Z, WS_ACT = WS_XS, WS_HB = WS_GS, WS_HAL = WS_PART;
static_assert(WS_END <= 268435456, "d_ws map exceeds 256 MiB");
static_assert((size_t)YR * DFF * 2 <= WS_GS - WS_XS, "act overlay");
static_assert((size_t)NBATCH * 33 * 3 * CONV_DIM * 2 <= WS_END - WS_PART, "halo overlay");
constexpr int CW_TMO = 0, CW_BAR = 4096, CW_Q = 16384;

#define GAS __attribute__((address_space(1)))
#define LAS __attribute__((address_space(3)))
typedef unsigned short bf16_t;
typedef short bf16x8 __attribute__((ext_vector_type(8)));
typedef short s16x4 __attribute__((ext_vector_type(4)));
typedef float f32x4 __attribute__((ext_vector_type(4)));
typedef float f32x2 __attribute__((ext_vector_type(2)));
typedef float f32x16 __attribute__((ext_vector_type(16)));
typedef unsigned u32x4 __attribute__((ext_vector_type(4)));
typedef unsigned u32x2 __attribute__((ext_vector_type(2)));
typedef GAS unsigned gu32;
#define RLX_AGENT __ATOMIC_RELAXED, __HIP_MEMORY_SCOPE_AGENT
#define LDS_WAIT() asm volatile("s_waitcnt lgkmcnt(0)" ::: "memory")
#define VM_WAIT() asm volatile("s_waitcnt vmcnt(0)" ::: "memory")
__device__ __forceinline__ unsigned cvt_pk_bf16(float lo, float hi) { unsigned r; asm volatile("v_cvt_pk_bf16_f32 %0, %1, %2" : "=v"(r) : "v"(lo), "v"(hi)); return r; }
__device__ __forceinline__ float bf_lo(unsigned w) { return __uint_as_float(w << 16); }
__device__ __forceinline__ float bf_hi(unsigned w) { return __uint_as_float(w & 0xffff0000u); }
__device__ __forceinline__ float bf2f(bf16_t b) { return __uint_as_float((unsigned)b << 16); }
__device__ __forceinline__ bf16_t f2bf(float f) { return (bf16_t)(cvt_pk_bf16(f, 0.f) & 0xffffu); }
__device__ __forceinline__ float sigmoidf_(float x) { return __builtin_amdgcn_rcpf(1.f + __builtin_amdgcn_exp2f(-1.4426950408889634f * x)); }
__device__ __forceinline__ float siluf_(float x) { return x * sigmoidf_(x); }
__device__ __forceinline__ float wave_sum(float v) {
#pragma unroll
    for (int o = 1; o < 64; o <<= 1) v += __shfl_xor(v, o);
    return v;
}

#define XB_TMO      128
#define XB_XCNT(j)  (256  + 64 * (j))
#define XB_XSUB(j)  (1280 + 64 * (j))
#define XB_XGEN(j)  (2304 + 64 * (j))
#define XB_TOP      3328
#define XB_TOPGEN   3392
#define XCD_BAR_WORDS 3456
#define XB_SPIN_CAP (1u << 18)
__device__ __forceinline__ unsigned xb_ld(unsigned* p)              { return __hip_atomic_load(p, __ATOMIC_RELAXED, __HIP_MEMORY_SCOPE_AGENT); }
__device__ __forceinline__ unsigned xb_add(unsigned* p, unsigned v) { return __hip_atomic_fetch_add(p, v, __ATOMIC_RELAXED, __HIP_MEMORY_SCOPE_AGENT); }
__device__ __forceinline__ unsigned xb_xcc_id() { return (unsigned)__builtin_amdgcn_s_getreg((3 << 11) | 20) & 0xFu; }
#define XB_SPIN(cond, bar) do { unsigned _sp = 0; while (cond) { __builtin_amdgcn_s_sleep(1); \
    if ((++_sp & 255u) == 0u) { if (xb_ld(&(bar)[XB_TMO])) break; if (_sp > XB_SPIN_CAP) { atomicAdd(&(bar)[XB_TMO], 1u); break; } } } } while (0)
struct XcdBarrier { unsigned* bar; unsigned x; volatile LAS unsigned* st; };
__device__ __forceinline__ XcdBarrier xcd_barrier_post(unsigned* bar, volatile LAS unsigned* st) {
    XcdBarrier b; b.bar = bar; b.x = xb_xcc_id(); b.st = st;
    if (threadIdx.x == 0) (void)xb_add(&bar[XB_XCNT(b.x)], 1u);
    return b;
}
__device__ __forceinline__ void xcd_barrier_complete(unsigned* bar, unsigned x, unsigned& nloc, unsigned& nx) {
    const unsigned G = gridDim.x * gridDim.y * gridDim.z;
    unsigned sum, cnt, mine, sp = 0u;
    for (;;) {
        sum = 0u; cnt = 0u; mine = 0u;
#pragma unroll
        for (unsigned j = 0; j < 16; ++j) { const unsigned c = xb_ld(&bar[XB_XCNT(j)]); sum += c; cnt += (c > 0u) ? 1u : 0u; mine = (j == x) ? c : mine; }
        if (sum == G) break;
        __builtin_amdgcn_s_sleep(1);
        if ((++sp & 255u) == 0u) { if (xb_ld(&bar[XB_TMO])) break; if (sp > XB_SPIN_CAP) { atomicAdd(&bar[XB_TMO], 1u); break; } }
    }
    nloc = mine > 0u ? mine : 1u; nx = cnt > 0u ? cnt : 1u;
}
__device__ __forceinline__ void xcd_barrier(const XcdBarrier& b) {
    asm volatile("s_waitcnt vmcnt(0)" ::: "memory");
    __syncthreads();
    if (threadIdx.x == 0) {
        unsigned* bar = b.bar;
        __builtin_amdgcn_s_waitcnt(0);
        unsigned nloc = b.st[0], nx = b.st[1];
        if (nloc == 0u) { xcd_barrier_complete(bar, b.x, nloc, nx); b.st[0] = nloc; b.st[1] = nx; }
        const unsigned old = xb_add(&bar[XB_XSUB(b.x)], 1u);
        const unsigned gen = old / nloc;
        if (old + 1u == (gen + 1u) * nloc) {
            __builtin_amdgcn_fence(__ATOMIC_RELEASE, "agent");
            asm volatile("s_waitcnt vmcnt(0)" ::: "memory");
            const unsigned og = xb_add(&bar[XB_TOP], 1u);
            const unsigned tg = og / nx;
            if (og + 1u == (tg + 1u) * nx) xb_add(&bar[XB_TOPGEN], 1u);
            else XB_SPIN(xb_ld(&bar[XB_TOPGEN]) == tg, bar);
            __builtin_amdgcn_fence(__ATOMIC_ACQUIRE, "agent");
            xb_add(&bar[XB_XGEN(b.x)], 1u);
            asm volatile("s_waitcnt vmcnt(0)" ::: "memory");
        } else {
            XB_SPIN(xb_ld(&bar[XB_XGEN(b.x)]) == gen, bar);
            __builtin_amdgcn_fence(__ATOMIC_ACQUIRE, "agent");
            asm volatile("s_waitcnt vmcnt(0)" ::: "memory");
        }
    }
    __syncthreads();
}

namespace pg8 {
constexpr int BM = 256, BK = 64, HALF = 128, HTB = HALF * BK * 2, STAGE_BYTES = 8 * HTB, NXCD = 8, WGM = 8;
__host__ __device__ __forceinline__ int lds_byte(int r, int c) { const int st = (r >> 4) * 2 + (c >> 5), rr = r & 15, cc = c & 31, ob = rr * 64 + cc * 2; return st * 1024 + (ob ^ (((ob >> 9) & 1) << 5)); }
__host__ __device__ __forceinline__ void stage_rc(int b, int& R, int& C) { const int st = b / 1024, sb = b % 1024, swz = sb ^ (((sb >> 9) & 1) << 5); R = (st >> 1) * 16 + swz / 64; C = (st & 1) * 32 + (swz % 64) / 2; }
__host__ __device__ __forceinline__ int perm32(int rho) { const int n = rho >> 4, i = rho & 15; return 8 * (i >> 2) + 4 * n + (i & 3); }
struct Unit { int pm, pn, part; const char* A; const char* B; };
__device__ __forceinline__ void tile_of(int L, int nM, int nN, int& pm, int& pn) {
    const int nwg = nM * nN; int wgid = L; { const int q = nwg / NXCD, r = nwg % NXCD, xcd = wgid % NXCD, off = wgid / NXCD; wgid = (xcd < r ? xcd * (q + 1) : r * (q + 1) + (xcd - r) * q) + off; }
    const int nig = WGM * nN, gid = wgid / nig, fm = gid * WGM, gsz = (nM - fm) < WGM ? (nM - fm) : WGM;
    pm = fm + ((wgid % nig) % gsz); pn = (wgid % nig) / gsz;
}
typedef f32x4 Acc[2][2][4][2];
template <class Epi, class Sched>
__device__ __forceinline__ void gemm_phase(LAS unsigned char* lds, const int K, const Sched& S, const Epi& E) {
    const int tid = threadIdx.x, wid = __builtin_amdgcn_readfirstlane(tid >> 6), lane = tid & 63, wr = wid >> 2, wc = wid & 3, fr = lane & 15, fq = lane >> 4;
    const int nt = K / BK;
    unsigned voffA[2], voffB[2];
#pragma unroll
    for (int i = 0; i < 2; ++i) { int R, C; stage_rc(tid * 16 + i * 8192, R, C); const int Rb = Epi::PERM ? ((R & ~31) + perm32(R & 31)) : R;
        voffA[i] = (unsigned)(R * K + C) * 2u; voffB[i] = (unsigned)(Rb * K + C) * 2u; }
    const size_t kstep = (size_t)(BK * 2);
    const size_t hstep = (size_t)HALF * K * 2;
    const unsigned ldsw = (unsigned)wid * 1024u;
    const int aoff = lds_byte(wr * 64 + fr, fq * 8), boff = lds_byte(wc * 32 + fr, fq * 8);
#define PG8_SA(b, h) (((b) * 2 + (h)) * HTB)
#define PG8_SB(b, h) ((4 + (b) * 2 + (h)) * HTB)
#define PG8_STAGE(bufoff, gbase, voff) do { _Pragma("unroll") for (int _i = 0; _i < 2; ++_i) \
        __builtin_amdgcn_global_load_lds((const unsigned*)((const char*)(gbase) + (voff)[_i]), (LAS unsigned*)(lds + (bufoff) + ldsw + _i * 8192), 16, 0, 0); } while (0)
#define PG8_LDA(dst, b, h) do { _Pragma("unroll") for (int m = 0; m < 4; ++m) _Pragma("unroll") for (int k = 0; k < 2; ++k) dst[m][k] = *(const LAS bf16x8*)(lds + PG8_SA(b, h) + aoff + m * 2048 + k * 1024); } while (0)
#define PG8_LDB(dst, b, h) do { _Pragma("unroll") for (int n = 0; n < 2; ++n) _Pragma("unroll") for (int k = 0; k < 2; ++k) dst[n][k] = *(const LAS bf16x8*)(lds + PG8_SB(b, h) + boff + n * 2048 + k * 1024); } while (0)
#define PG8_MMA(ai, bj, At, Bt) do { __builtin_amdgcn_s_setprio(1); _Pragma("unroll") for (int m = 0; m < 4; ++m) _Pragma("unroll") for (int n = 0; n < 2; ++n) _Pragma("unroll") for (int k = 0; k < 2; ++k) \
        acc[ai][bj][m][n] = __builtin_amdgcn_mfma_f32_16x16x32_bf16(Bt[n][k], At[m][k], acc[ai][bj][m][n], 0, 0, 0); __builtin_amdgcn_s_setprio(0); } while (0)
#define PG8_WAIT_V(n) asm volatile("s_waitcnt vmcnt(" #n ")" ::: "memory")
#define PG8_WAIT_L(n) asm volatile("s_waitcnt lgkmcnt(" #n ")" ::: "memory")
#define PG8_BAR __builtin_amdgcn_s_barrier()
#define PG8_SCHED __builtin_amdgcn_sched_barrier(0)
    Unit cur, nxt; int ui = 0;
    if (!S.next(0, cur)) return;
    Acc acc;
#pragma unroll
    for (int a = 0; a < 2; ++a)
#pragma unroll
        for (int b = 0; b < 2; ++b)
#pragma unroll
            for (int m = 0; m < 4; ++m)
#pragma unroll
                for (int n = 0; n < 2; ++n) acc[a][b][m][n] = (f32x4){0.f, 0.f, 0.f, 0.f};
    bf16x8 At[4][2], B0[2][2], B1[2][2];
    const char* cA = cur.A; const char* cB = cur.B;
    PG8_STAGE(PG8_SB(0, 0), cB, voffB); PG8_STAGE(PG8_SB(0, 1), cB + hstep, voffB); PG8_STAGE(PG8_SA(0, 0), cA, voffA); PG8_STAGE(PG8_SA(0, 1), cA + hstep, voffA);
    if (wr == 1) PG8_BAR;
    PG8_WAIT_V(2); PG8_BAR;
    PG8_STAGE(PG8_SB(1, 0), cB + kstep, voffB); PG8_STAGE(PG8_SA(1, 0), cA + kstep, voffA); PG8_STAGE(PG8_SB(1, 1), cB + hstep + kstep, voffB);
    PG8_WAIT_V(6); PG8_BAR;
    for (;;) {
        const bool has_next = S.next(ui + 1, nxt);
        const char* nA = has_next ? nxt.A : cA; const char* nB = has_next ? nxt.B : cB;
        for (int t = 0; t < nt; t += 2) {
            const bool last = (t == nt - 2);
            const char* a1 = cA + (size_t)(t + 1) * kstep;
            const char* a2 = last ? nA : cA + (size_t)(t + 2) * kstep; const char* b2 = last ? nB : cB + (size_t)(t + 2) * kstep;
            const char* a3 = a2 + kstep; const char* b3 = b2 + kstep;
            PG8_LDB(B0, 0, 0); PG8_LDB(B1, 0, 1); PG8_SCHED; PG8_LDA(At, 0, 0); PG8_STAGE(PG8_SA(1, 1), a1 + hstep, voffA);
            PG8_WAIT_V(8); PG8_WAIT_L(0); PG8_BAR; PG8_MMA(0, 0, At, B0); PG8_MMA(0, 1, At, B1); PG8_BAR; PG8_SCHED;
            PG8_LDA(At, 0, 1); PG8_STAGE(PG8_SB(0, 0), b2, voffB); PG8_STAGE(PG8_SB(0, 1), b2 + hstep, voffB); PG8_STAGE(PG8_SA(0, 0), a2, voffA);
            PG8_WAIT_V(8); PG8_WAIT_L(0); PG8_BAR; PG8_MMA(1, 0, At, B0); PG8_MMA(1, 1, At, B1); PG8_BAR; PG8_SCHED;
            PG8_LDB(B0, 1, 0); PG8_LDB(B1, 1, 1); PG8_SCHED; PG8_LDA(At, 1, 0); PG8_STAGE(PG8_SA(0, 1), a2 + hstep, voffA);
            PG8_WAIT_V(8); PG8_WAIT_L(0); PG8_BAR; PG8_MMA(0, 0, At, B0); PG8_MMA(0, 1, At, B1); PG8_BAR; PG8_SCHED;
            PG8_LDA(At, 1, 1); PG8_STAGE(PG8_SB(1, 0), b3, voffB); PG8_STAGE(PG8_SB(1, 1), b3 + hstep, voffB); PG8_STAGE(PG8_SA(1, 0), a3, voffA);
            PG8_WAIT_V(8); PG8_WAIT_L(0); PG8_BAR; PG8_MMA(1, 0, At, B0); PG8_MMA(1, 1, At, B1); PG8_BAR; PG8_SCHED;
        }
        if (wr == 0) PG8_BAR;
        const bool keep = E(acc, cur, wr, wc, fr, fq);
        if (!has_next) break;
        if (!keep) {
#pragma unroll
            for (int a = 0; a < 2; ++a)
#pragma unroll
                for (int b = 0; b < 2; ++b)
#pragma unroll
                    for (int m = 0; m < 4; ++m)
#pragma unroll
                        for (int n = 0; n < 2; ++n) acc[a][b][m][n] = (f32x4){0.f, 0.f, 0.f, 0.f};
        }
        cur = nxt; cA = nA; cB = nB; ++ui;
        if (wr == 1) PG8_BAR;
    }
    PG8_WAIT_V(0);
    PG8_BAR;
#undef PG8_SA
#undef PG8_SB
#undef PG8_STAGE
#undef PG8_LDA
#undef PG8_LDB
#undef PG8_MMA
#undef PG8_WAIT_V
#undef PG8_WAIT_L
#undef PG8_BAR
#undef PG8_SCHED
}
}

struct Args { const float* in[27]; float* out; unsigned char* ws; int ph_lo, ph_hi, li, pad; };
constexpr int NWAVES = 8, NTHR = 512;
constexpr int RING_BYTES = 131072, LDSCTL_OFF = RING_BYTES, MISC_OFF = LDSCTL_OFF + 320, LDS_BYTES = 147456;

struct Frame {
    LAS unsigned char* lds; volatile LAS unsigned* MISC; gu32* ctl;
    int tid, lane, wave, vcu, G;
    const float* const* in; float* out; unsigned char* ws; unsigned char* ob;
};

__device__ __forceinline__ int win_src(int n) {
    if (n < 3072) return n;
    if (n < 4096) return 3088 + (n - 3072);
    if (n < 4352) return 4112 + (n - 4096);
    if (n < 4608) return 4368 + (n - 4352);
    if (n < 5120) return 4624 + (n - 4608);
    if (n < 6144) return 5208 + (n - 5120);
    if (n < 7168) return 6232 + (n - 6144);
    if (n < 7184) return 3072 + (n - 7168);
    if (n < 7248) return 5136 + (n - 7184);
    if (n < 7256) return 5200 + (n - 7248);
    return -1;
}
template <class SrcFn>
__device__ __forceinline__ void p0_transpose_item(SrcFn src, int ldw, int Kdim, bf16_t* WT, LAS float* scr, int kb, int nb, int lane) {
    const int k0 = 64 * kb, n0 = 32 * nb;
    const float* cp = src(n0 + (lane & 31));
#pragma unroll 8
    for (int i = 0; i < 32; ++i) { const int kk = 2 * i + (lane >> 5); scr[kk * 33 + (lane & 31)] = cp ? cp[(size_t)(k0 + kk) * ldw] : 0.f; }
    LDS_WAIT(); asm volatile("" ::: "memory");
    const int c = lane & 7;
#pragma unroll
    for (int j = 0; j < 4; ++j) { const int n = (lane >> 3) + 8 * j; const LAS float* s = scr + (8 * c) * 33 + n;
        u32x4 o; o.x = cvt_pk_bf16(s[0 * 33], s[1 * 33]); o.y = cvt_pk_bf16(s[2 * 33], s[3 * 33]); o.z = cvt_pk_bf16(s[4 * 33], s[5 * 33]); o.w = cvt_pk_bf16(s[6 * 33], s[7 * 33]);
        *(GAS u32x4*)(WT + (size_t)(n0 + n) * Kdim + k0 + 8 * c) = o; }
    LDS_WAIT(); asm volatile("" ::: "memory");
}
__device__ __forceinline__ void p0_prologue(Frame& F) {
    LAS float* scr = (LAS float*)(F.lds + F.wave * 16384);
    const int gw = F.vcu * NWAVES + F.wave, NGW = F.G * NWAVES, lane = F.lane;
    const float* w_in = F.in[10]; const float* w_bs = F.in[20]; const float* w_ba = F.in[21]; const float* w_out = F.in[22];
    const float* w_gate = F.in[24]; const float* w_up = F.in[25]; const float* w_dn = F.in[26];
    bf16_t* WIN = (bf16_t*)(F.ws + WS_WIN); bf16_t* WBS = (bf16_t*)(F.ws + WS_WBS); bf16_t* WBA = (bf16_t*)(F.ws + WS_WBA); bf16_t* WOUT = (bf16_t*)(F.ws + WS_WOUT);
    bf16_t* WGU = (bf16_t*)(F.ws + WS_WGU); bf16_t* WDN = (bf16_t*)(F.ws + WS_WDN);
    constexpr int I_IN = 16 * (NIN / 32), I_SQ = 16 * 32, I_GU = 16 * (NGU / 32), I_DN = (DFF / 64) * 32;
    constexpr int NITEMS = I_IN + 3 * I_SQ + I_GU + I_DN;
    for (int it = gw; it < NITEMS; it += NGW) {
        int r = it;
        if (r < I_IN) { const int nb = r % (NIN / 32), kb = r / (NIN / 32);
            p0_transpose_item([&](int n) -> const float* { const int s = win_src(n); return s >= 0 ? w_in + s : nullptr; }, 7256, 1024, WIN, scr, kb, nb, lane); continue; } r -= I_IN;
        if (r < I_SQ) { p0_transpose_item([&](int n) -> const float* { return w_bs + n; }, 1024, 1024, WBS, scr, r / 32, r % 32, lane); continue; } r -= I_SQ;
        if (r < I_SQ) { p0_transpose_item([&](int n) -> const float* { return w_ba + n; }, 1024, 1024, WBA, scr, r / 32, r % 32, lane); continue; } r -= I_SQ;
        if (r < I_SQ) { p0_transpose_item([&](int n) -> const float* { return w_out + n; }, 1024, 1024, WOUT, scr, r / 32, r % 32, lane); continue; } r -= I_SQ;
        if (r < I_GU) { const int nb = r % (NGU / 32), kb = r / (NGU / 32);
            p0_transpose_item([&](int n) -> const float* { const int t = n >> 8, j = n & 255, ch = t * 128 + (j >> 3) * 4 + (j & 3); return ((j & 4) ? w_up : w_gate) + ch; }, DFF, 1024, WGU, scr, kb, nb, lane); continue; } r -= I_GU;
        p0_transpose_item([&](int n) -> const float* { return w_dn + n; }, 1024, DFF, WDN, scr, r / 32, r % 32, lane);
    }
    const float* xp = F.in[0]; const float* xs = F.in[1]; const float* meta = F.in[7]; const float* n1w = F.in[9];
    bf16_t* HN = (bf16_t*)(F.ob + DO_HN);
    f32x4 wv[4];
#pragma unroll
    for (int j = 0; j < 4; ++j) wv[j] = *((const f32x4*)n1w + lane + 64 * j);
    for (int m = gw; m < RPAD; m += NGW) {
        GAS u32x2* o8 = (GAS u32x2*)(HN + (size_t)m * DM) + lane;
        if (m >= RR) {
#pragma unroll
            for (int j = 0; j < 4; ++j) o8[64 * j] = (u32x2){0u, 0u};
            continue; }
        const float* xrow;
        if (m < RPR) { const int b = m / TP, t = m - b * TP; xrow = t < NMETA ? meta + (size_t)t * DM : xp + ((size_t)b * SEQ + (t - NMETA)) * DM; }
        else xrow = xs + (size_t)(m - RPR) * DM;
        const f32x4* xr = (const f32x4*)xrow + lane;
        f32x4 v[4]; float s = 0.f;
#pragma unroll
        for (int j = 0; j < 4; ++j) { v[j] = xr[64 * j]; s += (v[j].x * v[j].x + v[j].y * v[j].y) + (v[j].z * v[j].z + v[j].w * v[j].w); }
        const float rs = __builtin_amdgcn_rsqf(wave_sum(s) * (1.f / DM) + EPS);
#pragma unroll
        for (int j = 0; j < 4; ++j) { const f32x4 y = v[j] * rs * wv[j]; o8[64 * j] = (u32x2){cvt_pk_bf16(y.x, y.y), cvt_pk_bf16(y.z, y.w)}; }
    }
    { const f32x4* ck = (const f32x4*)F.in[2]; const f32x4* cv = (const f32x4*)F.in[3]; GAS u32x4* ok = (GAS u32x4*)(F.ws + WS_CK); GAS u32x4* ov = (GAS u32x4*)(F.ob + DO_CV);
      const long n8 = (long)NBATCH * PAST * 256 / 8; const long gt = (long)F.vcu * NTHR + F.tid, GT = (long)F.G * NTHR;
      for (long i = gt; i < 2 * n8; i += GT) { const bool isk = i < n8; const long j = isk ? i : i - n8; const f32x4* s = (isk ? ck : cv) + 2 * j;
          const f32x4 a = s[0], b = s[1]; u32x4 o; o.x = cvt_pk_bf16(a.x, a.y); o.y = cvt_pk_bf16(a.z, a.w); o.z = cvt_pk_bf16(b.x, b.y); o.w = cvt_pk_bf16(b.z, b.w);
          (isk ? ok : ov)[j] = o; } }
    { float* s1 = (float*)(F.ws + WS_SSQ1); const int gt = F.vcu * NTHR + F.tid, GT = F.G * NTHR;
      for (int i = gt; i < (int)((WS_PART - WS_SSQ1) / 4); i += GT) s1[i] = 0.f; }
}

struct SchedP1 {
    const char* A; const char* B; int G, c;
    __device__ __forceinline__ bool next(int i, pg8::Unit& u) const {
        const int L = i * G + c; if (L >= 67 * 29) return false;
        pg8::tile_of(L, 67, 29, u.pm, u.pn); u.part = 0; u.A = A + (size_t)u.pm * 256 * 1024 * 2; u.B = B + (size_t)u.pn * 256 * 1024 * 2; return true; }
};
struct EpiP1 {
    static constexpr bool PERM = true;
    unsigned char* ws; unsigned char* ob;
    __device__ __forceinline__ bool operator()(pg8::Acc& acc, const pg8::Unit& u, int wr, int wc, int fr, int fq) const {
        const int pn = u.pn; const int row0 = u.pm * 256 + wr * 64 + fr, cw = wc * 32 + 8 * fq;
        if (pn == 28) {
            float* SM = (float*)(ws + WS_SM);
            if (cw < SMLD) {
#pragma unroll
                for (int ai = 0; ai < 2; ++ai)
#pragma unroll
                    for (int m = 0; m < 4; ++m) { const int r = row0 + ai * 128 + m * 16; if (r < RR) { float* p = SM + (size_t)r * SMLD + cw; *(f32x4*)p = acc[ai][0][m][0]; *(f32x4*)(p + 4) = acc[ai][0][m][1]; } }
            }
            return false;
        }
        bf16_t* base; int ld, c0;
        if (pn < 4) { base = (bf16_t*)(ws + WS_Z); ld = 1024; c0 = pn * 256; }
        else if (pn < 8) { base = (bf16_t*)(ws + WS_XS); ld = 1024; c0 = (pn - 4) * 256; }
        else if (pn < 12) { base = (bf16_t*)(ws + WS_BC); ld = 1024; c0 = (pn - 8) * 256; }
        else if (pn < 16) { base = (bf16_t*)(ob + DO_Q); ld = 1024; c0 = (pn - 12) * 256; }
        else if (pn == 16) { base = (bf16_t*)(ws + WS_K); ld = 256; c0 = 0; }
        else if (pn == 17) { base = (bf16_t*)(ws + WS_V); ld = 256; c0 = 0; }
        else if (pn < 20) { base = (bf16_t*)(ob + DO_QI); ld = 512; c0 = (pn - 18) * 256; }
        else if (pn < 24) { base = (bf16_t*)(ws + WS_GS); ld = 1024; c0 = (pn - 20) * 256; }
        else { base = (bf16_t*)(ws + WS_GA); ld = 1024; c0 = (pn - 24) * 256; }
#pragma unroll
        for (int ai = 0; ai < 2; ++ai)
#pragma unroll
            for (int m = 0; m < 4; ++m) { const int r = row0 + ai * 128 + m * 16;
                if (r < RR) { bf16_t* rowp = base + (size_t)r * ld + c0 + cw;
#pragma unroll
                    for (int bj = 0; bj < 2; ++bj) { const f32x4 v0 = acc[ai][bj][m][0], v1 = acc[ai][bj][m][1];
                        u32x4 w; w.x = cvt_pk_bf16(v0[0], v0[1]); w.y = cvt_pk_bf16(v0[2], v0[3]); w.z = cvt_pk_bf16(v1[0], v1[1]); w.w = cvt_pk_bf16(v1[2], v1[3]);
                        *(u32x4*)(rowp + bj * 128) = w; } } }
        return false;
    }
};

__device__ __forceinline__ void p2_rows(Frame& F) {
    const int gw = F.vcu * NWAVES + F.wave, NGW = F.G * NWAVES, lane = F.lane;
    bf16_t* Q = (bf16_t*)(F.ob + DO_Q); bf16_t* K = (bf16_t*)(F.ws + WS_K); const bf16_t* V = (const bf16_t*)(F.ws + WS_V);
    float* SM = (float*)(F.ws + WS_SM); bf16_t* KI = (bf16_t*)(F.ws + WS_KI);
    const float* qnw = F.in[17]; const float* knw = F.in[18]; const float* ikw = F.in[19]; const float* dtb = F.in[13];
    f32x4 qw[4];
#pragma unroll
    for (int j = 0; j < 4; ++j) qw[j] = *(const f32x4*)(qnw + (lane & 7) * 16 + 4 * j);
    const f32x4 kw = *(const f32x4*)(knw + (lane & 31) * 4);
    const float iw = ikw[lane]; const float dbias = lane < 16 ? dtb[lane] : 0.f;
    constexpr float QSC = 0.08838834764831845f * 1.4426950408889634f;
    for (int r = gw; r < RR; r += NGW) {
        const bool pr = r < RPR; const size_t orow = pr ? (size_t)r : (size_t)(r - RPR);
        float* k_out = F.out + (pr ? O_KP : O_KS) + orow * 256; float* v_out = F.out + (pr ? O_VP : O_VS) + orow * 256; float* ki_out = F.out + (pr ? O_KIP : O_KIS) + orow * 64;
        { u32x4* qp = (u32x4*)(Q + (size_t)r * 1024) + lane * 2; const u32x4 a = qp[0], b = qp[1];
          float x[16]; x[0] = bf_lo(a.x); x[1] = bf_hi(a.x); x[2] = bf_lo(a.y); x[3] = bf_hi(a.y); x[4] = bf_lo(a.z); x[5] = bf_hi(a.z); x[6] = bf_lo(a.w); x[7] = bf_hi(a.w);
          x[8] = bf_lo(b.x); x[9] = bf_hi(b.x); x[10] = bf_lo(b.y); x[11] = bf_hi(b.y); x[12] = bf_lo(b.z); x[13] = bf_hi(b.z); x[14] = bf_lo(b.w); x[15] = bf_hi(b.w);
          float s = 0.f;
#pragma unroll
          for (int j = 0; j < 16; ++j) s += x[j] * x[j];
          s += __shfl_xor(s, 1); s += __shfl_xor(s, 2); s += __shfl_xor(s, 4);
          const float rs = __builtin_amdgcn_rsqf(s * (1.f / HD) + EPS) * QSC;
#pragma unroll
          for (int j = 0; j < 16; ++j) x[j] = x[j] * rs * qw[j >> 2][j & 3];
          u32x4 oa, ob; oa.x = cvt_pk_bf16(x[0], x[1]); oa.y = cvt_pk_bf16(x[2], x[3]); oa.z = cvt_pk_bf16(x[4], x[5]); oa.w = cvt_pk_bf16(x[6], x[7]);
          ob.x = cvt_pk_bf16(x[8], x[9]); ob.y = cvt_pk_bf16(x[10], x[11]); ob.z = cvt_pk_bf16(x[12], x[13]); ob.w = cvt_pk_bf16(x[14], x[15]);
          qp[0] = oa; qp[1] = ob; }
        { u32x2* kp = (u32x2*)(K + (size_t)r * 256) + lane; const u32x2 a = *kp;
          f32x4 x = {bf_lo(a.x), bf_hi(a.x), bf_lo(a.y), bf_hi(a.y)};
          float s = (x.x * x.x + x.y * x.y) + (x.z * x.z + x.w * x.w);
          s += __shfl_xor(s, 1); s += __shfl_xor(s, 2); s += __shfl_xor(s, 4); s += __shfl_xor(s, 8); s += __shfl_xor(s, 16);
          const float rs = __builtin_amdgcn_rsqf(s * (1.f / HD) + EPS);
          x = x * rs * kw;
          *kp = (u32x2){cvt_pk_bf16(x.x, x.y), cvt_pk_bf16(x.z, x.w)};
          *((f32x4*)k_out + lane) = x;
          const u32x2 vv = *((const u32x2*)(V + (size_t)r * 256) + lane);
          *((f32x4*)v_out + lane) = (f32x4){bf_lo(vv.x), bf_hi(vv.x), bf_lo(vv.y), bf_hi(vv.y)}; }
        { float* sm = SM + (size_t)r * SMLD;
          const float kv = sm[16 + lane]; const float ss = wave_sum(kv * kv);
          const float kn = kv * __builtin_amdgcn_rsqf(ss * (1.f / IDXD) + EPS) * iw;
          KI[(size_t)r * 64 + lane] = f2bf(kn); ki_out[lane] = kn;
          if (lane < 16) { const float x = sm[lane] + dbias; sm[lane] = x > 20.f ? x : log1pf(expf(x)); }
          if (lane < 8) sm[80 + lane] *= 0.04419417382415922f; }
    }
    { const bf16_t* XS = (const bf16_t*)(F.ws + WS_XS); const bf16_t* BC = (const bf16_t*)(F.ws + WS_BC); bf16_t* HAL = (bf16_t*)(F.ws + WS_HAL);
      for (int it = gw; it < 48 + 768; it += NGW) {
          if (it < 48) { const int s = it / 3, i = it % 3; const int r = s < 8 ? s * TP + (TP - 3 + i) : RPR + (s - 8) * DSEQ + (DSEQ - 3 + i);
              float* o = F.out + (s < 8 ? O_CVP + (size_t)(s * 3 + i) * CONV_DIM : O_CVS + (size_t)((s - 8) * 3 + i) * CONV_DIM);
#pragma unroll
              for (int j = 0; j < 4; ++j) { const int c = j * 256 + lane * 4;
                  const u32x2 a = *(const u32x2*)(XS + (size_t)r * 1024 + c); *(f32x4*)(o + c) = (f32x4){bf_lo(a.x), bf_hi(a.x), bf_lo(a.y), bf_hi(a.y)};
                  const u32x2 b = *(const u32x2*)(BC + (size_t)r * 1024 + c); *(f32x4*)(o + 1024 + c) = (f32x4){bf_lo(b.x), bf_hi(b.x), bf_lo(b.y), bf_hi(b.y)}; } }
          else { const int h = it - 48, b = h / 96, jb = (h % 96) / 3, i = h % 3; const int r = b * TP + 64 * (jb + 1) - 3 + i;
              bf16_t* o = HAL + (size_t)((b * 33 + jb + 1) * 3 + i) * CONV_DIM;
#pragma unroll
              for (int j = 0; j < 2; ++j) { const int c = j * 512 + lane * 8;
                  *(u32x4*)(o + c) = *(const u32x4*)(XS + (size_t)r * 1024 + c); *(u32x4*)(o + 1024 + c) = *(const u32x4*)(BC + (size_t)r * 1024 + c); } }
      } }
}

__device__ __forceinline__ int t5_bucket(int rel) {
    const int n = rel < 0 ? -rel : rel; const int ret = rel > 0 ? 16 : 0;
    const int v = n < 8 ? n : (n < 12 ? 8 : n < 16 ? 9 : n < 23 ? 10 : n < 32 ? 11 : n < 46 ? 12 : n < 64 ? 13 : n < 91 ? 14 : 15);
    return ret + v;
}
__device__ __forceinline__ void ssd_slow(Frame& F) {
    if (F.wave != 0) return;
    const int lane = F.lane;
    bf16_t* XS = (bf16_t*)(F.ws + WS_XS); const bf16_t* BC = (const bf16_t*)(F.ws + WS_BC); const bf16_t* Z = (const bf16_t*)(F.ws + WS_Z);
    const float* SM = (const float*)(F.ws + WS_SM); float* SSQ1 = (float*)(F.ws + WS_SSQ1);
    const float* conv_w = F.in[11]; const float* conv_b = F.in[12]; const float* a_log = F.in[14]; const float* d_skip = F.in[15]; const float* snw = F.in[16];
    const float* st_ssm = F.in[5]; const float* st_conv = F.in[6];
    LAS float* sbc = (LAS float*)F.lds;
    for (int item = F.vcu; item < 256; item += F.G) {
        const bool pr = item < 128; const int bh = item & 127, b = bh >> 4, h = bh & 15, g = h >> 2;
        const int T = pr ? TP : DSEQ; const int row0 = pr ? b * TP : RPR + b * DSEQ;
        const int xch = h * 64 + lane;
        const int bcc = lane < 32 ? g * 128 + 4 * lane : 512 + g * 128 + 4 * (lane - 32);
        float wx[4], bx; f32x4 wb[4], bb;
#pragma unroll
        for (int i = 0; i < 4; ++i) { wx[i] = conv_w[i * CONV_DIM + xch]; wb[i] = *(const f32x4*)(conv_w + i * CONV_DIM + 1024 + bcc); }
        bx = conv_b[xch]; bb = *(const f32x4*)(conv_b + 1024 + bcc);
        float xp[3]; f32x4 bp[3];
#pragma unroll
        for (int i = 0; i < 3; ++i) { if (pr) { xp[i] = 0.f; bp[i] = (f32x4){0.f, 0.f, 0.f, 0.f}; } else { xp[i] = st_conv[(size_t)(b * 3 + i) * CONV_DIM + xch]; bp[i] = *(const f32x4*)(st_conv + (size_t)(b * 3 + i) * CONV_DIM + 1024 + bcc); } }
        float hs[128];
        float* sout = F.out + (pr ? O_SSMP : O_SSMS) + ((size_t)(b * 16 + h) * 64 + lane) * 128;
        if (pr) {
#pragma unroll
            for (int n = 0; n < 128; ++n) hs[n] = 0.f;
        } else { const float* sp = st_ssm + ((size_t)(b * 16 + h) * 64 + lane) * 128;
#pragma unroll
            for (int n = 0; n < 128; n += 4) { const f32x4 v = *(const f32x4*)(sp + n); hs[n] = v.x; hs[n + 1] = v.y; hs[n + 2] = v.z; hs[n + 3] = v.w; } }
        const float a_h = -expf(a_log[h]), dsk = d_skip[h], nw = snw[xch];
        for (int t = 0; t < T; ++t) {
            const size_t r = (size_t)(row0 + t);
            const float xr = bf2f(XS[r * 1024 + xch]);
            const u32x2 bcr = *(const u32x2*)(BC + r * 1024 + bcc);
            const f32x4 br = {bf_lo(bcr.x), bf_hi(bcr.x), bf_lo(bcr.y), bf_hi(bcr.y)};
            const float zv = bf2f(Z[r * 1024 + xch]);
            const float dt = SM[r * SMLD + h];
            float xc = bx + xp[0] * wx[0] + xp[1] * wx[1] + xp[2] * wx[2] + xr * wx[3];
            f32x4 bc = bb + bp[0] * wb[0] + bp[1] * wb[1] + bp[2] * wb[2] + br * wb[3];
            xp[0] = xp[1]; xp[1] = xp[2]; xp[2] = xr; bp[0] = bp[1]; bp[1] = bp[2]; bp[2] = br;
            xc = siluf_(xc); bc.x = siluf_(bc.x); bc.y = siluf_(bc.y); bc.z = siluf_(bc.z); bc.w = siluf_(bc.w);
            *(LAS f32x4*)(sbc + 4 * lane) = bc;
            LDS_WAIT(); asm volatile("" ::: "memory");
            const float dA = expf(dt * a_h), dx = dt * xc;
            float y = 0.f;
#pragma unroll
            for (int n = 0; n < 128; n += 4) { const f32x4 Bv = *(const LAS f32x4*)(sbc + n); const f32x4 Cv = *(const LAS f32x4*)(sbc + 128 + n);
                hs[n] = hs[n] * dA + dx * Bv.x; y += Cv.x * hs[n];
                hs[n + 1] = hs[n + 1] * dA + dx * Bv.y; y += Cv.y * hs[n + 1];
                hs[n + 2] = hs[n + 2] * dA + dx * Bv.z; y += Cv.z * hs[n + 2];
                hs[n + 3] = hs[n + 3] * dA + dx * Bv.w; y += Cv.w * hs[n + 3]; }
            LDS_WAIT(); asm volatile("" ::: "memory");
            y = (y + dsk * xc) * siluf_(zv);
            const float ss = wave_sum(y * y);
            if (lane == 0) atomicAdd(SSQ1 + r, ss);
            XS[r * 1024 + xch] = f2bf(y * nw);
        }
#pragma unroll
        for (int n = 0; n < 128; n += 4) *(f32x4*)(sout + n) = (f32x4){hs[n], hs[n + 1], hs[n + 2], hs[n + 3]};
    }
}

template <bool PR>
__device__ __forceinline__ void attn_slow_query(Frame& F, int r, LAS unsigned char* wl) {
    const int lane = F.lane;
    bf16_t* Q = (bf16_t*)(F.ob + DO_Q); const bf16_t* QI = (const bf16_t*)(F.ob + DO_QI); const bf16_t* KI = (const bf16_t*)(F.ws + WS_KI);
    const bf16_t* Kb = (const bf16_t*)(F.ws + WS_K); const bf16_t* Vb = (const bf16_t*)(F.ws + WS_V); const bf16_t* CK = (const bf16_t*)(F.ws + WS_CK); const bf16_t* CV = (const bf16_t*)(F.ob + DO_CV);
    const float* SM = (const float*)(F.ws + WS_SM); const float* ckidx = F.in[4]; const float* relb = F.in[8];
    int b, tq, L, qpos, krow0;
    if (PR) { b = r / TP; tq = r - b * TP; const int qc = (tq - NMETA) / 64 + 1; L = NMETA + 64 * qc; qpos = tq; krow0 = b * TP; }
    else { b = (r - RPR) / DSEQ; tq = (r - RPR) - b * DSEQ; L = LS; qpos = PAST + tq; krow0 = RPR + b * DSEQ; }
    LAS float* qf = (LAS float*)wl;
    LAS unsigned* list = (LAS unsigned*)(wl + 2048);
    LAS float* pl = (LAS float*)(wl + 3072);
    LAS unsigned* keys = (LAS unsigned*)(wl + 7168);
    const int ni = (L + 63) >> 6;
    { const u32x4 a = *((const u32x4*)(QI + (size_t)r * 512) + lane);
      LAS float* d = qf + lane * 8; d[0] = bf_lo(a.x); d[1] = bf_hi(a.x); d[2] = bf_lo(a.y); d[3] = bf_hi(a.y); d[4] = bf_lo(a.z); d[5] = bf_hi(a.z); d[6] = bf_lo(a.w); d[7] = bf_hi(a.w); }
    LDS_WAIT(); asm volatile("" ::: "memory");
    float wv[8];
#pragma unroll
    for (int h = 0; h < 8; ++h) wv[h] = SM[(size_t)r * SMLD + 80 + h];
#pragma unroll 1
    for (int i = 0; i < ni; ++i) {
        const int s = i * 64 + lane; const int sc_ = s < L ? s : L - 1;
        float d[8] = {0.f, 0.f, 0.f, 0.f, 0.f, 0.f, 0.f, 0.f};
        const bool cache = !PR && (i * 64 < PAST);
        const float* kpf = ckidx + ((size_t)b * PAST + (cache ? sc_ : 0)) * 64;
        const bf16_t* kpb = KI + (size_t)(PR ? krow0 + sc_ : (cache ? krow0 : krow0 + sc_ - PAST)) * 64;
#pragma unroll 1
        for (int c = 0; c < 8; ++c) {
            float k8[8];
            if (cache) { const f32x4 v0 = *((const f32x4*)kpf + 2 * c), v1 = *((const f32x4*)kpf + 2 * c + 1); k8[0] = v0.x; k8[1] = v0.y; k8[2] = v0.z; k8[3] = v0.w; k8[4] = v1.x; k8[5] = v1.y; k8[6] = v1.z; k8[7] = v1.w; }
            else { const u32x4 v = *((const u32x4*)kpb + c); k8[0] = bf_lo(v.x); k8[1] = bf_hi(v.x); k8[2] = bf_lo(v.y); k8[3] = bf_hi(v.y); k8[4] = bf_lo(v.z); k8[5] = bf_hi(v.z); k8[6] = bf_lo(v.w); k8[7] = bf_hi(v.w); }
#pragma unroll
            for (int h = 0; h < 8; ++h) { const f32x4 qa = *(const LAS f32x4*)(qf + h * 64 + c * 8), qb = *(const LAS f32x4*)(qf + h * 64 + c * 8 + 4);
                d[h] += qa.x * k8[0] + qa.y * k8[1] + qa.z * k8[2] + qa.w * k8[3] + qb.x * k8[4] + qb.y * k8[5] + qb.z * k8[6] + qb.w * k8[7]; }
        }
        float sc = 0.f;
#pragma unroll
        for (int h = 0; h < 8; ++h) sc += wv[h] * fmaxf(d[h], 0.f);
        if (sc == 0.f) sc = 0.f;
        const unsigned u = __float_as_uint(sc);
        keys[s] = s < L ? ((u & 0x80000000u) ? ~u : (u | 0x80000000u)) : 0u;
    }
    LDS_WAIT(); asm volatile("" ::: "memory");
    int nsel;
    const unsigned long long lt_mask = (1ull << lane) - 1ull;
    if (L <= TOPK) { nsel = L;
#pragma unroll
        for (int i = 0; i < 4; ++i) { const int s = i * 64 + lane; if (s < L) list[s] = (unsigned)s; } }
    else {
        unsigned prefix = 0u;
        for (int bit = 31; bit >= 0; --bit) { const unsigned cand = prefix | (1u << bit); int cnt = 0;
#pragma unroll 1
            for (int i = 0; i < ni; ++i) cnt += __popcll(__ballot(keys[i * 64 + lane] >= cand));
            if (cnt >= TOPK) prefix = cand; }
        int ngt = 0;
#pragma unroll 1
        for (int i = 0; i < ni; ++i) ngt += __popcll(__ballot(keys[i * 64 + lane] > prefix));
        const int need = TOPK - ngt; int eqseen = 0, pos = 0;
#pragma unroll 1
        for (int i = 0; i < ni; ++i) { const unsigned kv = keys[i * 64 + lane]; const bool gt = kv > prefix, eq = kv == prefix; const unsigned long long meq = __ballot(eq);
            const bool sel = gt || (eq && (eqseen + __popcll(meq & lt_mask)) < need); const unsigned long long ms = __ballot(sel);
            if (sel) list[pos + __popcll(ms & lt_mask)] = (unsigned)(i * 64 + lane);
            pos += __popcll(ms); eqseen += __popcll(meq); }
        nsel = TOPK; }
    LDS_WAIT(); asm volatile("" ::: "memory");
#pragma unroll 1
    for (int g = 0; g < 2; ++g) {
        { const u32x4 a = *((const u32x4*)(Q + (size_t)r * 1024 + g * 512) + lane);
          LAS float* d = qf + lane * 8; d[0] = bf_lo(a.x); d[1] = bf_hi(a.x); d[2] = bf_lo(a.y); d[3] = bf_hi(a.y); d[4] = bf_lo(a.z); d[5] = bf_hi(a.z); d[6] = bf_lo(a.w); d[7] = bf_hi(a.w); }
        LDS_WAIT(); asm volatile("" ::: "memory");
        float mx[4] = {-1e30f, -1e30f, -1e30f, -1e30f};
        const int njj = (nsel + 63) >> 6;
#pragma unroll 1
        for (int jj = 0; jj < njj; ++jj) { const int j = jj * 64 + lane;
            const int s = j < nsel ? (int)list[j] : (int)list[0];
            const bf16_t* kp = (!PR && s < PAST) ? CK + ((size_t)b * PAST + s) * 256 + g * 128 : Kb + (size_t)(PR ? krow0 + s : krow0 + s - PAST) * 256 + g * 128;
            float d0 = 0.f, d1 = 0.f, d2 = 0.f, d3 = 0.f;
#pragma unroll 1
            for (int c = 0; c < 16; ++c) { const u32x4 v = *((const u32x4*)kp + c);
                const float k0 = bf_lo(v.x), k1 = bf_hi(v.x), k2 = bf_lo(v.y), k3 = bf_hi(v.y), k4 = bf_lo(v.z), k5 = bf_hi(v.z), k6 = bf_lo(v.w), k7 = bf_hi(v.w);
#define DOT8(hh, acc) { const f32x4 qa = *(const LAS f32x4*)(qf + hh * 128 + c * 8), qb = *(const LAS f32x4*)(qf + hh * 128 + c * 8 + 4); \
                    acc += qa.x * k0 + qa.y * k1 + qa.z * k2 + qa.w * k3 + qb.x * k4 + qb.y * k5 + qb.z * k6 + qb.w * k7; }
                DOT8(0, d0) DOT8(1, d1) DOT8(2, d2) DOT8(3, d3)
#undef DOT8
            }
            const int bk = t5_bucket(s - qpos);
            const f32x4 bv = *(const f32x4*)(relb + bk * 8 + g * 4);
            constexpr float L2E = 1.4426950408889634f;
            const bool ok = j < nsel;
            f32x4 lgv; lgv.x = ok ? d0 + bv.x * L2E : -1e30f; lgv.y = ok ? d1 + bv.y * L2E : -1e30f; lgv.z = ok ? d2 + bv.z * L2E : -1e30f; lgv.w = ok ? d3 + bv.w * L2E : -1e30f;
            *(LAS f32x4*)(pl + j * 4) = lgv;
            mx[0] = fmaxf(mx[0], lgv.x); mx[1] = fmaxf(mx[1], lgv.y); mx[2] = fmaxf(mx[2], lgv.z); mx[3] = fmaxf(mx[3], lgv.w);
        }
        float sm[4] = {0.f, 0.f, 0.f, 0.f};
#pragma unroll
        for (int h = 0; h < 4; ++h) {
#pragma unroll
            for (int o = 1; o < 64; o <<= 1) mx[h] = fmaxf(mx[h], __shfl_xor(mx[h], o)); }
        LDS_WAIT(); asm volatile("" ::: "memory");
#pragma unroll 1
        for (int jj = 0; jj < njj; ++jj) { const int j = jj * 64 + lane;
            f32x4 lgv = *(const LAS f32x4*)(pl + j * 4);
            lgv.x = __builtin_amdgcn_exp2f(lgv.x - mx[0]); lgv.y = __builtin_amdgcn_exp2f(lgv.y - mx[1]); lgv.z = __builtin_amdgcn_exp2f(lgv.z - mx[2]); lgv.w = __builtin_amdgcn_exp2f(lgv.w - mx[3]);
            sm[0] += lgv.x; sm[1] += lgv.y; sm[2] += lgv.z; sm[3] += lgv.w;
            *(LAS f32x4*)(pl + j * 4) = lgv; }
#pragma unroll
        for (int h = 0; h < 4; ++h) sm[h] = __builtin_amdgcn_rcpf(wave_sum(sm[h]));
        LDS_WAIT(); asm volatile("" ::: "memory");
        float o[4][2] = {};
        for (int j = 0; j < nsel; ++j) {
            const int s = (int)list[j]; const f32x4 p = *(const LAS f32x4*)(pl + j * 4);
            const bf16_t* vp = (!PR && s < PAST) ? CV + ((size_t)b * PAST + s) * 256 + g * 128 : Vb + (size_t)(PR ? krow0 + s : krow0 + s - PAST) * 256 + g * 128;
            const unsigned vv = *((const unsigned*)vp + lane); const float v0 = bf_lo(vv), v1 = bf_hi(vv);
            o[0][0] += p.x * v0; o[0][1] += p.x * v1; o[1][0] += p.y * v0; o[1][1] += p.y * v1; o[2][0] += p.z * v0; o[2][1] += p.z * v1; o[3][0] += p.w * v0; o[3][1] += p.w * v1;
        }
#pragma unroll
        for (int h = 0; h < 4; ++h) *((unsigned*)(Q + (size_t)r * 1024 + g * 512 + h * 128) + lane) = cvt_pk_bf16(o[h][0] * sm[h], o[h][1] * sm[h]);
        LDS_WAIT(); asm volatile("" ::: "memory");
    }
}
__device__ __forceinline__ void attn_slow(Frame& F) {
    const int gw = F.vcu * NWAVES + F.wave, NGW = F.G * NWAVES;
    for (int q = gw; q < YPR; q += NGW) { const int b = q / SEQ, t = q - b * SEQ; attn_slow_query<true>(F, b * TP + NMETA + t, F.lds + F.wave * 16384); }
    __syncthreads();
    if (F.wave < 4) { const int gw4 = F.vcu * 4 + F.wave;
        for (int q = gw4; q < RSR; q += F.G * 4) attn_slow_query<false>(F, RPR + q, F.lds + F.wave * 32768); }
}
__device__ __forceinline__ int yrow_to_r(int pm) { return pm * 256 + (pm < 64 ? 16 * ((pm >> 3) + 1) : 128); }
struct SchedP5 {
    const char* A0; const char* A1; const char* B0; const char* B1; int G, c;
    __device__ __forceinline__ bool next(int i, pg8::Unit& u) const {
        const int L = (i >> 1) * G + c; if (L >= 66 * 4) return false;
        pg8::tile_of(L, 66, 4, u.pm, u.pn); u.part = i & 1;
        u.A = (u.part ? A1 : A0) + (size_t)yrow_to_r(u.pm) * 1024 * 2; u.B = (u.part ? B1 : B0) + (size_t)u.pn * 256 * 1024 * 2; return true; }
};
struct EpiP5 {
    static constexpr bool PERM = true;
    const bf16_t* GS; const bf16_t* GA; const float* SSQ1; bf16_t* MERGED;
    __device__ __forceinline__ bool operator()(pg8::Acc& acc, const pg8::Unit& u, int wr, int wc, int fr, int fq) const {
        const int rr0 = yrow_to_r(u.pm) + wr * 64 + fr, ry0 = u.pm * 256 + wr * 64 + fr, col = u.pn * 256 + wc * 32 + 8 * fq;
#pragma unroll
        for (int ai = 0; ai < 2; ++ai)
#pragma unroll
            for (int m = 0; m < 4; ++m) { const int rr = rr0 + ai * 128 + m * 16, ry = ry0 + ai * 128 + m * 16;
                float rstd = 0.f; if (u.part == 0) rstd = __builtin_amdgcn_rsqf(SSQ1[rr] * (1.f / 1024.f) + EPS);
#pragma unroll
                for (int bj = 0; bj < 2; ++bj) {
                    const u32x4 ga = *(const u32x4*)(GA + (size_t)rr * 1024 + col + bj * 128);
                    float sa[8] = {bf_lo(ga.x), bf_hi(ga.x), bf_lo(ga.y), bf_hi(ga.y), bf_lo(ga.z), bf_hi(ga.z), bf_lo(ga.w), bf_hi(ga.w)};
                    if (u.part == 0) {
                        const u32x4 gs = *(const u32x4*)(GS + (size_t)rr * 1024 + col + bj * 128);
                        const float ss[8] = {bf_lo(gs.x), bf_hi(gs.x), bf_lo(gs.y), bf_hi(gs.y), bf_lo(gs.z), bf_hi(gs.z), bf_lo(gs.w), bf_hi(gs.w)};
#pragma unroll
                        for (int e = 0; e < 8; ++e) {
                            const float f = rstd * (1.f + __builtin_amdgcn_exp2f(-1.4426950408889634f * sa[e])) * __builtin_amdgcn_rcpf(1.f + __builtin_amdgcn_exp2f(-1.4426950408889634f * ss[e]));
                            acc[ai][bj][m][e >> 2][e & 3] *= f; }
                    } else {
                        float o[8];
#pragma unroll
                        for (int e = 0; e < 8; ++e) o[e] = acc[ai][bj][m][e >> 2][e & 3] * sigmoidf_(sa[e]);
                        u32x4 w; w.x = cvt_pk_bf16(o[0], o[1]); w.y = cvt_pk_bf16(o[2], o[3]); w.z = cvt_pk_bf16(o[4], o[5]); w.w = cvt_pk_bf16(o[6], o[7]);
                        *(u32x4*)(MERGED + (size_t)ry * 1024 + col + bj * 128) = w; } } }
        return u.part == 0;
    }
};
struct SchedY {
    const char* A; const char* B; int nN, K, G, c;
    __device__ __forceinline__ bool next(int i, pg8::Unit& u) const {
        const int L = i * G + c; if (L >= 66 * nN) return false;
        pg8::tile_of(L, 66, nN, u.pm, u.pn); u.part = 0; u.A = A + (size_t)u.pm * 256 * K * 2; u.B = B + (size_t)u.pn * 256 * K * 2; return true; }
};
struct EpiP6 {
    static constexpr bool PERM = false;
    const float* xp; const float* xs; const float* n2w; float* H; bf16_t* HB; float* SSQ2;
    __device__ __forceinline__ bool operator()(pg8::Acc& acc, const pg8::Unit& u, int wr, int wc, int fr, int fq) const {
        const int ry0 = u.pm * 256 + wr * 64 + fr, col0 = u.pn * 256 + wc * 32 + 4 * fq;
        f32x4 nw[2][2];
#pragma unroll
        for (int bj = 0; bj < 2; ++bj)
#pragma unroll
            for (int n = 0; n < 2; ++n) nw[bj][n] = *(const f32x4*)(n2w + col0 + bj * 128 + n * 16);
#pragma unroll
        for (int ai = 0; ai < 2; ++ai)
#pragma unroll
            for (int m = 0; m < 4; ++m) { const int ry = ry0 + ai * 128 + m * 16;
                const float* xrow = ry < YPR ? xp + (size_t)ry * 1024 : xs + (size_t)(ry - YPR) * 1024; float ss = 0.f;
#pragma unroll
                for (int bj = 0; bj < 2; ++bj)
#pragma unroll
                    for (int n = 0; n < 2; ++n) { const int c = col0 + bj * 128 + n * 16; const f32x4 h = *(const f32x4*)(xrow + c) + acc[ai][bj][m][n];
                        *(f32x4*)(H + (size_t)ry * 1024 + c) = h; ss += (h.x * h.x + h.y * h.y) + (h.z * h.z + h.w * h.w);
                        const f32x4 hn = h * nw[bj][n]; *(u32x2*)(HB + (size_t)ry * 1024 + c) = (u32x2){cvt_pk_bf16(hn.x, hn.y), cvt_pk_bf16(hn.z, hn.w)}; }
                ss += __shfl_xor(ss, 16); ss += __shfl_xor(ss, 32);
                if (fq == 0) atomicAdd(SSQ2 + ry, ss); }
        return false;
    }
};
struct EpiP7 {
    static constexpr bool PERM = true;
    const float* SSQ2; bf16_t* ACT;
    __device__ __forceinline__ bool operator()(pg8::Acc& acc, const pg8::Unit& u, int wr, int wc, int fr, int fq) const {
        const int ry0 = u.pm * 256 + wr * 64 + fr, ch0 = u.pn * 128 + wc * 16 + 4 * fq;
#pragma unroll
        for (int ai = 0; ai < 2; ++ai)
#pragma unroll
            for (int m = 0; m < 4; ++m) { const int ry = ry0 + ai * 128 + m * 16; const float rs = __builtin_amdgcn_rsqf(SSQ2[ry] * (1.f / 1024.f) + EPS);
#pragma unroll
                for (int bj = 0; bj < 2; ++bj) { const f32x4 g = acc[ai][bj][m][0] * rs, up = acc[ai][bj][m][1] * rs;
                    const float a0 = siluf_(g.x) * up.x, a1 = siluf_(g.y) * up.y, a2 = siluf_(g.z) * up.z, a3 = siluf_(g.w) * up.w;
                    *(u32x2*)(ACT + (size_t)ry * DFF + ch0 + bj * 64) = (u32x2){cvt_pk_bf16(a0, a1), cvt_pk_bf16(a2, a3)}; } }
        return false;
    }
};
struct EpiP8 {
    static constexpr bool PERM = false;
    float* H;
    __device__ __forceinline__ bool operator()(pg8::Acc& acc, const pg8::Unit& u, int wr, int wc, int fr, int fq) const {
        const int ry0 = u.pm * 256 + wr * 64 + fr, col0 = u.pn * 256 + wc * 32 + 4 * fq;
#pragma unroll
        for (int ai = 0; ai < 2; ++ai)
#pragma unroll
            for (int m = 0; m < 4; ++m) { float* hrow = H + (size_t)(ry0 + ai * 128 + m * 16) * 1024 + col0;
#pragma unroll
                for (int bj = 0; bj < 2; ++bj)
#pragma unroll
                    for (int n = 0; n < 2; ++n) { f32x4* p = (f32x4*)(hrow + bj * 128 + n * 16); *p = *p + acc[ai][bj][m][n]; } }
        return false;
    }
};

constexpr int NPHASE = 9;
__global__ void __launch_bounds__(NTHR, 2) hybrid_fwd(Args args) {
    extern __shared__ __attribute__((aligned(16))) unsigned char lds[];
    Frame F;
    F.lds = (LAS unsigned char*)lds; F.MISC = (volatile LAS unsigned*)(F.lds + MISC_OFF);
    F.tid = threadIdx.x; F.lane = F.tid & 63; F.wave = __builtin_amdgcn_readfirstlane(F.tid >> 6);
    F.G = gridDim.x; { const int bx = blockIdx.x; F.vcu = (F.G % 8 == 0) ? (bx % 8) * (F.G / 8) + bx / 8 : bx; }
    F.in = args.in; F.out = args.out; F.ws = args.ws; F.ob = (unsigned char*)args.out; F.ctl = (gu32*)(args.ws + WS_CTL);
    for (int u = F.tid; u < (LDS_BYTES - LDSCTL_OFF) / 4; u += NTHR) ((LAS unsigned*)(F.lds + LDSCTL_OFF))[u] = 0u;
    __syncthreads();
    const int lo = args.ph_lo, hi = args.ph_hi;
    const bool multi = (hi - lo) > 1;
    XcdBarrier bar; bar.bar = (unsigned*)(F.ctl + CW_BAR) + args.li * XCD_BAR_WORDS; bar.x = 0; bar.st = nullptr;
    if (multi) bar = xcd_barrier_post((unsigned*)(F.ctl + CW_BAR) + args.li * XCD_BAR_WORDS, F.MISC + 8);
#define IN(k) (lo <= (k) && (k) < hi)
#define SEAM(k) do { if (IN(k) && IN((k) + 1)) xcd_barrier(bar); } while (0)
    if (IN(0)) { p0_prologue(F); SEAM(0); }
    if (IN(1)) {
        SchedP1 S{(const char*)(F.ob + DO_HN), (const char*)(F.ws + WS_WIN), F.G, (int)blockIdx.x};
        EpiP1 E{F.ws, F.ob};
        pg8::gemm_phase<EpiP1, SchedP1>(F.lds, 1024, S, E);
        SEAM(1);
    }
    if (IN(2)) { p2_rows(F); SEAM(2); }
    if (IN(3)) { ssd_slow(F); __syncthreads(); SEAM(3); }
    if (IN(4)) { attn_slow(F); __syncthreads(); SEAM(4); }
    if (IN(5)) {
        SchedP5 S{(const char*)(F.ws + WS_XS), (const char*)(F.ob + DO_Q), (const char*)(F.ws + WS_WBS), (const char*)(F.ws + WS_WBA), F.G, (int)blockIdx.x};
        EpiP5 E{(const bf16_t*)(F.ws + WS_GS), (const bf16_t*)(F.ws + WS_GA), (const float*)(F.ws + WS_SSQ1), (bf16_t*)(F.ws + WS_MERGED)};
        pg8::gemm_phase<EpiP5, SchedP5>(F.lds, 1024, S, E);
        SEAM(5);
    }
    if (IN(6)) {
        SchedY S{(const char*)(F.ws + WS_MERGED), (const char*)(F.ws + WS_WOUT), 4, 1024, F.G, (int)blockIdx.x};
        EpiP6 E{F.in[0], F.in[1], F.in[23], F.out, (bf16_t*)(F.ws + WS_HB), (float*)(F.ws + WS_SSQ2)};
        pg8::gemm_phase<EpiP6, SchedY>(F.lds, 1024, S, E);
        SEAM(6);
    }
    if (IN(7)) {
        SchedY S{(const char*)(F.ws + WS_HB), (const char*)(F.ws + WS_WGU), NGU / 256, 1024, F.G, (int)blockIdx.x};
        EpiP7 E{(const float*)(F.ws + WS_SSQ2), (bf16_t*)(F.ws + WS_ACT)};
        pg8::gemm_phase<EpiP7, SchedY>(F.lds, 1024, S, E);
        SEAM(7);
    }
    if (IN(8)) {
        SchedY S{(const char*)(F.ws + WS_ACT), (const char*)(F.ws + WS_WDN), 4, DFF, F.G, (int)blockIdx.x};
        EpiP8 E{F.out};
        pg8::gemm_phase<EpiP8, SchedY>(F.lds, DFF, S, E);
    }
#undef IN
#undef SEAM
}

extern "C" void kernel_launch(void* const* d_in, const int* in_sizes, int n_in, void* d_out, int out_size, void* d_ws, size_t ws_size, hipStream_t stream) {
    static int grid = 0;
    if (grid == 0) {
        if (n_in != 27 || out_size != (int)O_END || ws_size < WS_END) { fprintf(stderr, "kernel_launch: unexpected shapes: n_in %d out %d ws %zu (need %zu)\n", n_in, out_size, ws_size, (size_t)WS_END); grid = -1; return; }
        int dev = 0, cus = 0;
        if (hipGetDevice(&dev) != hipSuccess || hipDeviceGetAttribute(&cus, hipDeviceAttributeMultiprocessorCount, dev) != hipSuccess) { grid = -1; return; }
        if (hipFuncSetAttribute((const void*)hybrid_fwd, hipFuncAttributeMaxDynamicSharedMemorySize, LDS_BYTES) != hipSuccess) { fprintf(stderr, "kernel_launch: hipFuncSetAttribute failed\n"); grid = -1; return; }
        (void)hipGetLastError();
        grid = cus;
    }
    if (grid < 0) return;
    (void)hipMemsetAsync((char*)d_ws + WS_CTL, 0, CTL_BYTES, stream);
    Args a{};
    for (int i = 0; i < 27; ++i) a.in[i] = (const float*)d_in[i];
    a.out = (float*)d_out; a.ws = (unsigned char*)d_ws;
#ifndef MK_SPLIT
#define MK_SPLIT 0
#endif
#if MK_SPLIT
    for (int p = 0; p < NPHASE; ++p) { a.ph_lo = p; a.ph_hi = p + 1; a.li = 0; hipLaunchKernelGGL(hybrid_fwd, dim3(grid), dim3(NTHR), LDS_BYTES, stream, a); }
#else
    a.ph_lo = 0; a.ph_hi = NPHASE; a.li = 0; hipLaunchKernelGGL(hybrid_fwd, dim3(grid), dim3(NTHR), LDS_BYTES, stream, a);
#endif
    const hipError_t le = hipPeekAtLastError();
    if (le != hipSuccess) fprintf(stderr, "kernel_launch: launch failed: %s\n", hipGetErrorName(le));
}
```

```cpp
#include <hip/hip_runtime.h>
#include <cstdio>
#include <cstdint>

constexpr int DM = 1024, NBATCH = 8, SEQ = 2048, NMETA = 16, TP = NMETA + SEQ  , DSEQ = 64, PAST = 4096, LS = PAST + DSEQ  ;
constexpr int RPR = NBATCH * TP  , RSR = NBATCH * DSEQ  , RR = RPR + RSR  , RPAD = 17152  ;
constexpr int YPR = NBATCH * SEQ  , YR = YPR + RSR  ;
constexpr int NIN = 7424  , DFF = 2816, NGU = 2 * DFF;
constexpr int SSD_H = 16, SSD_P = 64, SSD_G = 4, SSD_N = 128, CONV_DIM = 2048;
constexpr int NH = 8, NKV = 2, HD = 128, IDXH = 8, IDXD = 64, TOPK = 256;
constexpr float EPS = 1e-6f;
constexpr int SMLD = 96;

constexpr size_t O_YP = 0, O_YS = O_YP + (size_t)YPR * DM, O_KP = O_YS + (size_t)RSR * DM, O_VP = O_KP + (size_t)RPR * 256, O_KIP = O_VP + (size_t)RPR * 256,
                 O_SSMP = O_KIP + (size_t)RPR * 64, O_CVP = O_SSMP + (size_t)NBATCH * 16 * 64 * 128, O_KS = O_CVP + (size_t)NBATCH * 3 * CONV_DIM, O_VS = O_KS + (size_t)RSR * 256,
                 O_KIS = O_VS + (size_t)RSR * 256, O_SSMS = O_KIS + (size_t)RSR * 64, O_CVS = O_SSMS + (size_t)NBATCH * 16 * 64 * 128, O_END = O_CVS + (size_t)NBATCH * 3 * CONV_DIM;
static_assert(O_END == 29302784, "d_out size");
constexpr size_t DO_Q = 0, DO_QI = DO_Q + (size_t)RR * 1024 * 2, DO_CV = DO_QI + (size_t)RR * 512 * 2, DO_YEND = DO_CV + (size_t)NBATCH * PAST * 256 * 2;
static_assert(DO_YEND <= O_KP * 4, "y-region scratch");
constexpr size_t DO_HN = O_KP * 4;
static_assert(DO_HN + (size_t)RPAD * 1024 * 2 <= O_CVP * 4, "hn scratch in tail");

constexpr size_t al256(size_t x) { return (x + 255) / 256 * 256; }
constexpr size_t WS_CTL = 0, CTL_BYTES = 1u << 20;
constexpr size_t WS_WIN = CTL_BYTES, WS_WBS = WS_WIN + (size_t)NIN * 1024 * 2, WS_WBA = WS_WBS + 1024 * 1024 * 2, WS_WOUT = WS_WBA + 1024 * 1024 * 2, WS_WGU = WS_WOUT + 1024 * 1024 * 2,
                 WS_WDN = WS_WGU + (size_t)NGU * 1024 * 2, WS_Z = WS_WDN + (size_t)1024 * DFF * 2, WS_XS = WS_Z + (size_t)RR * 1024 * 2, WS_BC = WS_XS + (size_t)RR * 1024 * 2,
                 WS_GA = WS_BC + (size_t)RR * 1024 * 2, WS_GS = WS_GA + (size_t)RR * 1024 * 2, WS_K = WS_GS + (size_t)RR * 1024 * 2, WS_V = WS_K + (size_t)RR * 256 * 2,
                 WS_SM = WS_V + (size_t)RR * 256 * 2, WS_KI = WS_SM + (size_t)RR * SMLD * 4, WS_CK = WS_KI + (size_t)RR * 64 * 2, WS_MASK = WS_CK + (size_t)NBATCH * PAST * 256 * 2;
constexpr int MASK_LDP = 68, MASK_LDS = 132;
constexpr size_t WS_MASKS = WS_MASK + (size_t)RPR * MASK_LDP * 4, WS_SSQ1 = WS_MASKS + (size_t)RSR * MASK_LDS * 4, WS_SSQ2 = WS_SSQ1 + al256((size_t)RR * 4),
                 WS_PART = WS_SSQ2 + al256((size_t)YR * 4), WS_END = WS_PART + (size_t)32 * 256 * 132 * 4;
constexpr size_t WS_MERGED = WS_Z, WS_ACT = WS_XS, WS_HB = WS_GS, WS_HAL = WS_PART;
static_assert(WS_END <= 268435456, "d_ws map exceeds 256 MiB");
static_assert((size_t)YR * DFF * 2 <= WS_GS - WS_XS, "act overlay");
static_assert((size_t)NBATCH * 33 * 3 * CONV_DIM * 2 <= WS_END - WS_PART, "halo overlay");
constexpr int CW_TMO = 0, CW_BAR = 4096, CW_Q = 16384;

#define GAS __attribute__((address_space(1)))
#define LAS __attribute__((address_space(3)))
typedef unsigned short bf16_t;
typedef short bf16x8 __attribute__((ext_vector_type(8)));
typedef short s16x4 __attribute__((ext_vector_type(4)));
typedef float f32x4 __attribute__((ext_vector_type(4)));
typedef float f32x2 __attribute__((ext_vector_type(2)));
typedef float f32x16 __attribute__((ext_vector_type(16)));
typedef unsigned u32x4 __attribute__((ext_vector_type(4)));
typedef unsigned u32x2 __attribute__((ext_vector_type(2)));
typedef GAS unsigned gu32;
#define RLX_AGENT __ATOMIC_RELAXED, __HIP_MEMORY_SCOPE_AGENT
#define LDS_WAIT() asm volatile("s_waitcnt lgkmcnt(0)" ::: "memory")
#define VM_WAIT() asm volatile("s_waitcnt vmcnt(0)" ::: "memory")
__device__ __forceinline__ unsigned cvt_pk_bf16(float lo, float hi) { unsigned r; asm volatile("v_cvt_pk_bf16_f32 %0, %1, %2" : "=v"(r) : "v"(lo), "v"(hi)); return r; }
__device__ __forceinline__ float bf_lo(unsigned w) { return __uint_as_float(w << 16); }
__device__ __forceinline__ float bf_hi(unsigned w) { return __uint_as_float(w & 0xffff0000u); }
__device__ __forceinline__ float bf2f(bf16_t b) { return __uint_as_float((unsigned)b << 16); }
__device__ __forceinline__ bf16_t f2bf(float f) { return (bf16_t)(cvt_pk_bf16(f, 0.f) & 0xffffu); }
__device__ __forceinline__ float sigmoidf_(float x) { return __builtin_amdgcn_rcpf(1.f + __builtin_amdgcn_exp2f(-1.4426950408889634f * x)); }
__device__ __forceinline__ float siluf_(float x) { return x * sigmoidf_(x); }
__device__ __forceinline__ float wave_sum(float v) {
#pragma unroll
    for (int o = 1; o < 64; o <<= 1) v += __shfl_xor(v, o);
    return v;
}

#define XB_TMO      128
#define XB_XCNT(j)  (256  + 64 * (j))
#define XB_XSUB(j)  (1280 + 64 * (j))
#define XB_XGEN(j)  (2304 + 64 * (j))
#define XB_TOP      3328
#define XB_TOPGEN   3392
#define XCD_BAR_WORDS 3456
#define XB_SPIN_CAP (1u << 18)
__device__ __forceinline__ unsigned xb_ld(unsigned* p)              { return __hip_atomic_load(p, __ATOMIC_RELAXED, __HIP_MEMORY_SCOPE_AGENT); }
__device__ __forceinline__ unsigned xb_add(unsigned* p, unsigned v) { return __hip_atomic_fetch_add(p, v, __ATOMIC_RELAXED, __HIP_MEMORY_SCOPE_AGENT); }
__device__ __forceinline__ unsigned xb_xcc_id() { return (unsigned)__builtin_amdgcn_s_getreg((3 << 11) | 20) & 0xFu; }
#define XB_SPIN(cond, bar) do { unsigned _sp = 0; while (cond) { __builtin_amdgcn_s_sleep(1); \
    if ((++_sp & 255u) == 0u) { if (xb_ld(&(bar)[XB_TMO])) break; if (_sp > XB_SPIN_CAP) { atomicAdd(&(bar)[XB_TMO], 1u); break; } } } } while (0)
struct XcdBarrier { unsigned* bar; unsigned x; volatile LAS unsigned* st; };
__device__ __forceinline__ XcdBarrier xcd_barrier_post(unsigned* bar, volatile LAS unsigned* st) {
    XcdBarrier b; b.bar = bar; b.x = xb_xcc_id(); b.st = st;
    if (threadIdx.x == 0) (void)xb_add(&bar[XB_XCNT(b.x)], 1u);
    return b;
}
__device__ __forceinline__ void xcd_barrier_complete(unsigned* bar, unsigned x, unsigned& nloc, unsigned& nx) {
    const unsigned G = gridDim.x * gridDim.y * gridDim.z;
    unsigned sum, cnt, mine, sp = 0u;
    for (;;) {
        sum = 0u; cnt = 0u; mine = 0u;
#pragma unroll
        for (unsigned j = 0; j < 16; ++j) { const unsigned c = xb_ld(&bar[XB_XCNT(j)]); sum += c; cnt += (c > 0u) ? 1u : 0u; mine = (j == x) ? c : mine; }
        if (sum == G) break;
        __builtin_amdgcn_s_sleep(1);
        if ((++sp & 255u) == 0u) { if (xb_ld(&bar[XB_TMO])) break; if (sp > XB_SPIN_CAP) { atomicAdd(&bar[XB_TMO], 1u); break; } }
    }
    nloc = mine > 0u ? mine : 1u; nx = cnt > 0u ? cnt : 1u;
}
__device__ __forceinline__ void xcd_barrier(const XcdBarrier& b) {
    asm volatile("s_waitcnt vmcnt(0)" ::: "memory");
    __syncthreads();
    if (threadIdx.x == 0) {
        unsigned* bar = b.bar;
        __builtin_amdgcn_s_waitcnt(0);
        unsigned nloc = b.st[0], nx = b.st[1];
        if (nloc == 0u) { xcd_barrier_complete(bar, b.x, nloc, nx); b.st[0] = nloc; b.st[1] = nx; }
        const unsigned old = xb_add(&bar[XB_XSUB(b.x)], 1u);
        const unsigned gen = old / nloc;
        if (old + 1u == (gen + 1u) * nloc) {
            __builtin_amdgcn_fence(__ATOMIC_RELEASE, "agent");
            asm volatile("s_waitcnt vmcnt(0)" ::: "memory");
            const unsigned og = xb_add(&bar[XB_TOP], 1u);
            const unsigned tg = og / nx;
            if (og + 1u == (tg + 1u) * nx) xb_add(&bar[XB_TOPGEN], 1u);
            else XB_SPIN(xb_ld(&bar[XB_TOPGEN]) == tg, bar);
            __builtin_amdgcn_fence(__ATOMIC_ACQUIRE, "agent");
            xb_add(&bar[XB_XGEN(b.x)], 1u);
            asm volatile("s_waitcnt vmcnt(0)" ::: "memory");
        } else {
            XB_SPIN(xb_ld(&bar[XB_XGEN(b.x)]) == gen, bar);
            __builtin_amdgcn_fence(__ATOMIC_ACQUIRE, "agent");
            asm volatile("s_waitcnt vmcnt(0)" ::: "memory");
        }
    }
    __syncthreads();
}

namespace pg8 {
constexpr int BM = 256, BK = 64, HALF = 128, HTB = HALF * BK * 2, STAGE_BYTES = 8 * HTB, NXCD = 8, WGM = 8;
__host__ __device__ __forceinline__ int lds_byte(int r, int c) { const int st = (r >> 4) * 2 + (c >> 5), rr = r & 15, cc = c & 31, ob = rr * 64 + cc * 2; return st * 1024 + (ob ^ (((ob >> 9) & 1) << 5)); }
__host__ __device__ __forceinline__ void stage_rc(int b, int& R, int& C) { const int st = b / 1024, sb = b % 1024, swz = sb ^ (((sb >> 9) & 1) << 5); R = (st >> 1) * 16 + swz / 64; C = (st & 1) * 32 + (swz % 64) / 2; }
__host__ __device__ __forceinline__ int perm32(int rho) { const int n = rho >> 4, i = rho & 15; return 8 * (i >> 2) + 4 * n + (i & 3); }
struct Unit { int pm, pn, part; const char* A; const char* B; };
__device__ __forceinline__ void tile_of(int L, int nM, int nN, int& pm, int& pn) {
    const int nwg = nM * nN; int wgid = L; { const int q = nwg / NXCD, r = nwg % NXCD, xcd = wgid % NXCD, off = wgid / NXCD; wgid = (xcd < r ? xcd * (q + 1) : r * (q + 1) + (xcd - r) * q) + off; }
    const int nig = WGM * nN, gid = wgid / nig, fm = gid * WGM, gsz = (nM - fm) < WGM ? (nM - fm) : WGM;
    pm = fm + ((wgid % nig) % gsz); pn = (wgid % nig) / gsz;
}
typedef f32x4 Acc[2][2][4][2];
template <class Epi, class Sched>
__device__ __forceinline__ void gemm_phase(LAS unsigned char* lds, const int K, const Sched& S, const Epi& E) {
    const int tid = threadIdx.x, wid = __builtin_amdgcn_readfirstlane(tid >> 6), lane = tid & 63, wr = wid >> 2, wc = wid & 3, fr = lane & 15, fq = lane >> 4;
    const int nt = K / BK;
    unsigned voffA[2], voffB[2];
#pragma unroll
    for (int i = 0; i < 2; ++i) { int R, C; stage_rc(tid * 16 + i * 8192, R, C); const int Rb = Epi::PERM ? ((R & ~31) + perm32(R & 31)) : R;
        voffA[i] = (unsigned)(R * K + C) * 2u; voffB[i] = (unsigned)(Rb * K + C) * 2u; }
    const size_t kstep = (size_t)(BK * 2);
    const size_t hstep = (size_t)HALF * K * 2;
    const unsigned ldsw = (unsigned)wid * 1024u;
    const int aoff = lds_byte(wr * 64 + fr, fq * 8), boff = lds_byte(wc * 32 + fr, fq * 8);
#define PG8_SA(b, h) (((b) * 2 + (h)) * HTB)
#define PG8_SB(b, h) ((4 + (b) * 2 + (h)) * HTB)
#define PG8_STAGE(bufoff, gbase, voff) do { _Pragma("unroll") for (int _i = 0; _i < 2; ++_i) \
        __builtin_amdgcn_global_load_lds((const unsigned*)((const char*)(gbase) + (voff)[_i]), (LAS unsigned*)(lds + (bufoff) + ldsw + _i * 8192), 16, 0, 0); } while (0)
#define PG8_LDA(dst, b, h) do { _Pragma("unroll") for (int m = 0; m < 4; ++m) _Pragma("unroll") for (int k = 0; k < 2; ++k) dst[m][k] = *(const LAS bf16x8*)(lds + PG8_SA(b, h) + aoff + m * 2048 + k * 1024); } while (0)
#define PG8_LDB(dst, b, h) do { _Pragma("unroll") for (int n = 0; n < 2; ++n) _Pragma("unroll") for (int k = 0; k < 2; ++k) dst[n][k] = *(const LAS bf16x8*)(lds + PG8_SB(b, h) + boff + n * 2048 + k * 1024); } while (0)
#define PG8_MMA(ai, bj, At, Bt) do { __builtin_amdgcn_s_setprio(1); _Pragma("unroll") for (int m = 0; m < 4; ++m) _Pragma("unroll") for (int n = 0; n < 2; ++n) _Pragma("unroll") for (int k = 0; k < 2; ++k) \
        acc[ai][bj][m][n] = __builtin_amdgcn_mfma_f32_16x16x32_bf16(Bt[n][k], At[m][k], acc[ai][bj][m][n], 0, 0, 0); __builtin_amdgcn_s_setprio(0); } while (0)
#define PG8_WAIT_V(n) asm volatile("s_waitcnt vmcnt(" #n ")" ::: "memory")
#define PG8_WAIT_L(n) asm volatile("s_waitcnt lgkmcnt(" #n ")" ::: "memory")
#define PG8_BAR __builtin_amdgcn_s_barrier()
#define PG8_SCHED __builtin_amdgcn_sched_barrier(0)
    Unit cur, nxt; int ui = 0;
    if (!S.next(0, cur)) return;
    Acc acc;
#pragma unroll
    for (int a = 0; a < 2; ++a)
#pragma unroll
        for (int b = 0; b < 2; ++b)
#pragma unroll
            for (int m = 0; m < 4; ++m)
#pragma unroll
                for (int n = 0; n < 2; ++n) acc[a][b][m][n] = (f32x4){0.f, 0.f, 0.f, 0.f};
    bf16x8 At[4][2], B0[2][2], B1[2][2];
    const char* cA = cur.A; const char* cB = cur.B;
    PG8_STAGE(PG8_SB(0, 0), cB, voffB); PG8_STAGE(PG8_SB(0, 1), cB + hstep, voffB); PG8_STAGE(PG8_SA(0, 0), cA, voffA); PG8_STAGE(PG8_SA(0, 1), cA + hstep, voffA);
    if (wr == 1) PG8_BAR;
    PG8_WAIT_V(2); PG8_BAR;
    PG8_STAGE(PG8_SB(1, 0), cB + kstep, voffB); PG8_STAGE(PG8_SA(1, 0), cA + kstep, voffA); PG8_STAGE(PG8_SB(1, 1), cB + hstep + kstep, voffB);
    PG8_WAIT_V(6); PG8_BAR;
    for (;;) {
        const bool has_next = S.next(ui + 1, nxt);
        const char* nA = has_next ? nxt.A : cA; const char* nB = has_next ? nxt.B : cB;
        for (int t = 0; t < nt; t += 2) {
            const bool last = (t == nt - 2);
            const char* a1 = cA + (size_t)(t + 1) * kstep;
            const char* a2 = last ? nA : cA + (size_t)(t + 2) * kstep; const char* b2 = last ? nB : cB + (size_t)(t + 2) * kstep;
            const char* a3 = a2 + kstep; const char* b3 = b2 + kstep;
            PG8_LDB(B0, 0, 0); PG8_LDB(B1, 0, 1); PG8_SCHED; PG8_LDA(At, 0, 0); PG8_STAGE(PG8_SA(1, 1), a1 + hstep, voffA);
            PG8_WAIT_V(8); PG8_WAIT_L(0); PG8_BAR; PG8_MMA(0, 0, At, B0); PG8_MMA(0, 1, At, B1); PG8_BAR; PG8_SCHED;
            PG8_LDA(At, 0, 1); PG8_STAGE(PG8_SB(0, 0), b2, voffB); PG8_STAGE(PG8_SB(0, 1), b2 + hstep, voffB); PG8_STAGE(PG8_SA(0, 0), a2, voffA);
            PG8_WAIT_V(8); PG8_WAIT_L(0); PG8_BAR; PG8_MMA(1, 0, At, B0); PG8_MMA(1, 1, At, B1); PG8_BAR; PG8_SCHED;
            PG8_LDB(B0, 1, 0); PG8_LDB(B1, 1, 1); PG8_SCHED; PG8_LDA(At, 1, 0); PG8_STAGE(PG8_SA(0, 1), a2 + hstep, voffA);
            PG8_WAIT_V(8); PG8_WAIT_L(0); PG8_BAR; PG8_MMA(0, 0, At, B0); PG8_MMA(0, 1, At, B1); PG8_BAR; PG8_SCHED;
            PG8_LDA(At, 1, 1); PG8_STAGE(PG8_SB(1, 0), b3, voffB); PG8_STAGE(PG8_SB(1, 1), b3 + hstep, voffB); PG8_STAGE(PG8_SA(1, 0), a3, voffA);
            PG8_WAIT_V(8); PG8_WAIT_L(0); PG8_BAR; PG8_MMA(1, 0, At, B0); PG8_MMA(1, 1, At, B1); PG8_BAR; PG8_SCHED;
        }
        if (wr == 0) PG8_BAR;
        const bool keep = E(acc, cur, wr, wc, fr, fq);
        if (!has_next) break;
        if (!keep) {
#pragma unroll
            for (int a = 0; a < 2; ++a)
#pragma unroll
                for (int b = 0; b < 2; ++b)
#pragma unroll
                    for (int m = 0; m < 4; ++m)
#pragma unroll
                        for (int n = 0; n < 2; ++n) acc[a][b][m][n] = (f32x4){0.f, 0.f, 0.f, 0.f};
        }
        cur = nxt; cA = nA; cB = nB; ++ui;
        if (wr == 1) PG8_BAR;
    }
    PG8_WAIT_V(0);
    PG8_BAR;
#undef PG8_SA
#undef PG8_SB
#undef PG8_STAGE
#undef PG8_LDA
#undef PG8_LDB
#undef PG8_MMA
#undef PG8_WAIT_V
#undef PG8_WAIT_L
#undef PG8_BAR
#undef PG8_SCHED
}
}

struct Args { const float* in[27]; float* out; unsigned char* ws; int ph_lo, ph_hi, li, pad; };
constexpr int NWAVES = 8, NTHR = 512;
constexpr int RING_BYTES = 131072, LDSCTL_OFF = RING_BYTES, MISC_OFF = LDSCTL_OFF + 320, LDS_BYTES = 147456;

struct Frame {
    LAS unsigned char* lds; volatile LAS unsigned* MISC; gu32* ctl;
    int tid, lane, wave, vcu, G;
    const float* const* in; float* out; unsigned char* ws; unsigned char* ob;
};

__device__ __forceinline__ int win_src(int n) {
    if (n < 3072) return n;
    if (n < 4096) return 3088 + (n - 3072);
    if (n < 4352) return 4112 + (n - 4096);
    if (n < 4608) return 4368 + (n - 4352);
    if (n < 5120) return 4624 + (n - 4608);
    if (n < 6144) return 5208 + (n - 5120);
    if (n < 7168) return 6232 + (n - 6144);
    if (n < 7184) return 3072 + (n - 7168);
    if (n < 7248) return 5136 + (n - 7184);
    if (n < 7256) return 5200 + (n - 7248);
    return -1;
}
template <class SrcFn>
__device__ __forceinline__ void p0_transpose_item(SrcFn src, int ldw, int Kdim, bf16_t* WT, LAS float* scr, int kb, int nb, int lane) {
    const int k0 = 64 * kb, n0 = 32 * nb;
    const float* cp = src(n0 + (lane & 31));
#pragma unroll 8
    for (int i = 0; i < 32; ++i) { const int kk = 2 * i + (lane >> 5); scr[kk * 33 + (lane & 31)] = cp ? cp[(size_t)(k0 + kk) * ldw] : 0.f; }
    LDS_WAIT(); asm volatile("" ::: "memory");
    const int c = lane & 7;
#pragma unroll
    for (int j = 0; j < 4; ++j) { const int n = (lane >> 3) + 8 * j; const LAS float* s = scr + (8 * c) * 33 + n;
        u32x4 o; o.x = cvt_pk_bf16(s[0 * 33], s[1 * 33]); o.y = cvt_pk_bf16(s[2 * 33], s[3 * 33]); o.z = cvt_pk_bf16(s[4 * 33], s[5 * 33]); o.w = cvt_pk_bf16(s[6 * 33], s[7 * 33]);
        *(GAS u32x4*)(WT + (size_t)(n0 + n) * Kdim + k0 + 8 * c) = o; }
    LDS_WAIT(); asm volatile("" ::: "memory");
}
__device__ __forceinline__ void p0_prologue(Frame& F) {
    LAS float* scr = (LAS float*)(F.lds + F.wave * 16384);
    const int gw = F.vcu * NWAVES + F.wave, NGW = F.G * NWAVES, lane = F.lane;
    const float* w_in = F.in[10]; const float* w_bs = F.in[20]; const float* w_ba = F.in[21]; const float* w_out = F.in[22];
    const float* w_gate = F.in[24]; const float* w_up = F.in[25]; const float* w_dn = F.in[26];
    bf16_t* WIN = (bf16_t*)(F.ws + WS_WIN); bf16_t* WBS = (bf16_t*)(F.ws + WS_WBS); bf16_t* WBA = (bf16_t*)(F.ws + WS_WBA); bf16_t* WOUT = (bf16_t*)(F.ws + WS_WOUT);
    bf16_t* WGU = (bf16_t*)(F.ws + WS_WGU); bf16_t* WDN = (bf16_t*)(F.ws + WS_WDN);
    constexpr int I_IN = 16 * (NIN / 32), I_SQ = 16 * 32, I_GU = 16 * (NGU / 32), I_DN = (DFF / 64) * 32;
    constexpr int NITEMS = I_IN + 3 * I_SQ + I_GU + I_DN;
    for (int it = gw; it < NITEMS; it += NGW) {
        int r = it;
        if (r < I_IN) { const int nb = r % (NIN / 32), kb = r / (NIN / 32);
            p0_transpose_item([&](int n) -> const float* { const int s = win_src(n); return s >= 0 ? w_in + s : nullptr; }, 7256, 1024, WIN, scr, kb, nb, lane); continue; } r -= I_IN;
        if (r < I_SQ) { p0_transpose_item([&](int n) -> const float* { return w_bs + n; }, 1024, 1024, WBS, scr, r / 32, r % 32, lane); continue; } r -= I_SQ;
        if (r < I_SQ) { p0_transpose_item([&](int n) -> const float* { return w_ba + n; }, 1024, 1024, WBA, scr, r / 32, r % 32, lane); continue; } r -= I_SQ;
        if (r < I_SQ) { p0_transpose_item([&](int n) -> const float* { return w_out + n; }, 1024, 1024, WOUT, scr, r / 32, r % 32, lane); continue; } r -= I_SQ;
        if (r < I_GU) { const int nb = r % (NGU / 32), kb = r / (NGU / 32);
            p0_transpose_item([&](int n) -> const float* { const int t = n >> 8, j = n & 255, ch = t * 128 + (j >> 3) * 4 + (j & 3); return ((j & 4) ? w_up : w_gate) + ch; }, DFF, 1024, WGU, scr, kb, nb, lane); continue; } r -= I_GU;
        p0_transpose_item([&](int n) -> const float* { return w_dn + n; }, 1024, DFF, WDN, scr, r / 32, r % 32, lane);
    }
    const float* xp = F.in[0]; const float* xs = F.in[1]; const float* meta = F.in[7]; const float* n1w = F.in[9];
    bf16_t* HN = (bf16_t*)(F.ob + DO_HN);
    f32x4 wv[4];
#pragma unroll
    for (int j = 0; j < 4; ++j) wv[j] = *((const f32x4*)n1w + lane + 64 * j);
    for (int m = gw; m < RPAD; m += NGW) {
        GAS u32x2* o8 = (GAS u32x2*)(HN + (size_t)m * DM) + lane;
        if (m >= RR) {
#pragma unroll
            for (int j = 0; j < 4; ++j) o8[64 * j] = (u32x2){0u, 0u};
            continue; }
        const float* xrow;
        if (m < RPR) { const int b = m / TP, t = m - b * TP; xrow = t < NMETA ? meta + (size_t)t * DM : xp + ((size_t)b * SEQ + (t - NMETA)) * DM; }
        else xrow = xs + (size_t)(m - RPR) * DM;
        const f32x4* xr = (const f32x4*)xrow + lane;
        f32x4 v[4]; float s = 0.f;
#pragma unroll
        for (int j = 0; j < 4; ++j) { v[j] = xr[64 * j]; s += (v[j].x * v[j].x + v[j].y * v[j].y) + (v[j].z * v[j].z + v[j].w * v[j].w); }
        const float rs = __builtin_amdgcn_rsqf(wave_sum(s) * (1.f / DM) + EPS);
#pragma unroll
        for (int j = 0; j < 4; ++j) { const f32x4 y = v[j] * rs * wv[j]; o8[64 * j] = (u32x2){cvt_pk_bf16(y.x, y.y), cvt_pk_bf16(y.z, y.w)}; }
    }
    { const f32x4* ck = (const f32x4*)F.in[2]; const f32x4* cv = (const f32x4*)F.in[3]; GAS u32x4* ok = (GAS u32x4*)(F.ws + WS_CK); GAS u32x4* ov = (GAS u32x4*)(F.ob + DO_CV);
      const long n8 = (long)NBATCH * PAST * 256 / 8; const long gt = (long)F.vcu * NTHR + F.tid, GT = (long)F.G * NTHR;
      for (long i = gt; i < 2 * n8; i += GT) { const bool isk = i < n8; const long j = isk ? i : i - n8; const f32x4* s = (isk ? ck : cv) + 2 * j;
          const f32x4 a = s[0], b = s[1]; u32x4 o; o.x = cvt_pk_bf16(a.x, a.y); o.y = cvt_pk_bf16(a.z, a.w); o.z = cvt_pk_bf16(b.x, b.y); o.w = cvt_pk_bf16(b.z, b.w);
          (isk ? ok : ov)[j] = o; } }
    { float* s1 = (float*)(F.ws + WS_SSQ1); const int gt = F.vcu * NTHR + F.tid, GT = F.G * NTHR;
      for (int i = gt; i < (int)((WS_PART - WS_SSQ1) / 4); i += GT) s1[i] = 0.f; }
}

struct SchedP1 {
    const char* A; const char* B; int G, c;
    __device__ __forceinline__ bool next(int i, pg8::Unit& u) const {
        const int L = i * G + c; if (L >= 67 * 29) return false;
        pg8::tile_of(L, 67, 29, u.pm, u.pn); u.part = 0; u.A = A + (size_t)u.pm * 256 * 1024 * 2; u.B = B + (size_t)u.pn * 256 * 1024 * 2; return true; }
};
struct EpiP1 {
    static constexpr bool PERM = true;
    unsigned char* ws; unsigned char* ob;
    __device__ __forceinline__ bool operator()(pg8::Acc& acc, const pg8::Unit& u, int wr, int wc, int fr, int fq) const {
        const int pn = u.pn; const int row0 = u.pm * 256 + wr * 64 + fr, cw = wc * 32 + 8 * fq;
        if (pn == 28) {
            float* SM = (float*)(ws + WS_SM);
            if (cw < SMLD) {
#pragma unroll
                for (int ai = 0; ai < 2; ++ai)
#pragma unroll
                    for (int m = 0; m < 4; ++m) { const int r = row0 + ai * 128 + m * 16; if (r < RR) { float* p = SM + (size_t)r * SMLD + cw; *(f32x4*)p = acc[ai][0][m][0]; *(f32x4*)(p + 4) = acc[ai][0][m][1]; } }
            }
            return false;
        }
        bf16_t* base; int ld, c0;
        if (pn < 4) { base = (bf16_t*)(ws + WS_Z); ld = 1024; c0 = pn * 256; }
        else if (pn < 8) { base = (bf16_t*)(ws + WS_XS); ld = 1024; c0 = (pn - 4) * 256; }
        else if (pn < 12) { base = (bf16_t*)(ws + WS_BC); ld = 1024; c0 = (pn - 8) * 256; }
        else if (pn < 16) { base = (bf16_t*)(ob + DO_Q); ld = 1024; c0 = (pn - 12) * 256; }
        else if (pn == 16) { base = (bf16_t*)(ws + WS_K); ld = 256; c0 = 0; }
        else if (pn == 17) { base = (bf16_t*)(ws + WS_V); ld = 256; c0 = 0; }
        else if (pn < 20) { base = (bf16_t*)(ob + DO_QI); ld = 512; c0 = (pn - 18) * 256; }
        else if (pn < 24) { base = (bf16_t*)(ws + WS_GS); ld = 1024; c0 = (pn - 20) * 256; }
        else { base = (bf16_t*)(ws + WS_GA); ld = 1024; c0 = (pn - 24) * 256; }
#pragma unroll
        for (int ai = 0; ai < 2; ++ai)
#pragma unroll
            for (int m = 0; m < 4; ++m) { const int r = row0 + ai * 128 + m * 16;
                if (r < RR) { bf16_t* rowp = base + (size_t)r * ld + c0 + cw;
#pragma unroll
                    for (int bj = 0; bj < 2; ++bj) { const f32x4 v0 = acc[ai][bj][m][0], v1 = acc[ai][bj][m][1];
                        u32x4 w; w.x = cvt_pk_bf16(v0[0], v0[1]); w.y = cvt_pk_bf16(v0[2], v0[3]); w.z = cvt_pk_bf16(v1[0], v1[1]); w.w = cvt_pk_bf16(v1[2], v1[3]);
                        *(u32x4*)(rowp + bj * 128) = w; } } }
        return false;
    }
};

__device__ __forceinline__ void p2_rows(Frame& F) {
    const int gw = F.vcu * NWAVES + F.wave, NGW = F.G * NWAVES, lane = F.lane;
    bf16_t* Q = (bf16_t*)(F.ob + DO_Q); bf16_t* K = (bf16_t*)(F.ws + WS_K); const bf16_t* V = (const bf16_t*)(F.ws + WS_V);
    float* SM = (float*)(F.ws + WS_SM); bf16_t* KI = (bf16_t*)(F.ws + WS_KI);
    const float* qnw = F.in[17]; const float* knw = F.in[18]; const float* ikw = F.in[19]; const float* dtb = F.in[13];
    f32x4 qw[4];
#pragma unroll
    for (int j = 0; j < 4; ++j) qw[j] = *(const f32x4*)(qnw + (lane & 7) * 16 + 4 * j);
    const f32x4 kw = *(const f32x4*)(knw + (lane & 31) * 4);
    const float iw = ikw[lane]; const float dbias = lane < 16 ? dtb[lane] : 0.f;
    constexpr float QSC = 0.08838834764831845f * 1.4426950408889634f;
    for (int r = gw; r < RR; r += NGW) {
        const bool pr = r < RPR; const size_t orow = pr ? (size_t)r : (size_t)(r - RPR);
        float* k_out = F.out + (pr ? O_KP : O_KS) + orow * 256; float* v_out = F.out + (pr ? O_VP : O_VS) + orow * 256; float* ki_out = F.out + (pr ? O_KIP : O_KIS) + orow * 64;
        { u32x4* qp = (u32x4*)(Q + (size_t)r * 1024) + lane * 2; const u32x4 a = qp[0], b = qp[1];
          float x[16]; x[0] = bf_lo(a.x); x[1] = bf_hi(a.x); x[2] = bf_lo(a.y); x[3] = bf_hi(a.y); x[4] = bf_lo(a.z); x[5] = bf_hi(a.z); x[6] = bf_lo(a.w); x[7] = bf_hi(a.w);
          x[8] = bf_lo(b.x); x[9] = bf_hi(b.x); x[10] = bf_lo(b.y); x[11] = bf_hi(b.y); x[12] = bf_lo(b.z); x[13] = bf_hi(b.z); x[14] = bf_lo(b.w); x[15] = bf_hi(b.w);
          float s = 0.f;
#pragma unroll
          for (int j = 0; j < 16; ++j) s += x[j] * x[j];
          s += __shfl_xor(s, 1); s += __shfl_xor(s, 2); s += __shfl_xor(s, 4);
          const float rs = __builtin_amdgcn_rsqf(s * (1.f / HD) + EPS) * QSC;
#pragma unroll
          for (int j = 0; j < 16; ++j) x[j] = x[j] * rs * qw[j >> 2][j & 3];
          u32x4 oa, ob; oa.x = cvt_pk_bf16(x[0], x[1]); oa.y = cvt_pk_bf16(x[2], x[3]); oa.z = cvt_pk_bf16(x[4], x[5]); oa.w = cvt_pk_bf16(x[6], x[7]);
          ob.x = cvt_pk_bf16(x[8], x[9]); ob.y = cvt_pk_bf16(x[10], x[11]); ob.z = cvt_pk_bf16(x[12], x[13]); ob.w = cvt_pk_bf16(x[14], x[15]);
          qp[0] = oa; qp[1] = ob; }
        { u32x2* kp = (u32x2*)(K + (size_t)r * 256) + lane; const u32x2 a = *kp;
          f32x4 x = {bf_lo(a.x), bf_hi(a.x), bf_lo(a.y), bf_hi(a.y)};
          float s = (x.x * x.x + x.y * x.y) + (x.z * x.z + x.w * x.w);
          s += __shfl_xor(s, 1); s += __shfl_xor(s, 2); s += __shfl_xor(s, 4); s += __shfl_xor(s, 8); s += __shfl_xor(s, 16);
          const float rs = __builtin_amdgcn_rsqf(s * (1.f / HD) + EPS);
          x = x * rs * kw;
          *kp = (u32x2){cvt_pk_bf16(x.x, x.y), cvt_pk_bf16(x.z, x.w)};
          *((f32x4*)k_out + lane) = x;
          const u32x2 vv = *((const u32x2*)(V + (size_t)r * 256) + lane);
          *((f32x4*)v_out + lane) = (f32x4){bf_lo(vv.x), bf_hi(vv.x), bf_lo(vv.y), bf_hi(vv.y)}; }
        { float* sm = SM + (size_t)r * SMLD;
          const float kv = sm[16 + lane]; const float ss = wave_sum(kv * kv);
          const float kn = kv * __builtin_amdgcn_rsqf(ss * (1.f / IDXD) + EPS) * iw;
          KI[(size_t)r * 64 + lane] = f2bf(kn); ki_out[lane] = kn;
          if (lane < 16) { const float x = sm[lane] + dbias; sm[lane] = x > 20.f ? x : log1pf(expf(x)); }
          if (lane < 8) sm[80 + lane] *= 0.04419417382415922f; }
    }
    { const bf16_t* XS = (const bf16_t*)(F.ws + WS_XS); const bf16_t* BC = (const bf16_t*)(F.ws + WS_BC); bf16_t* HAL = (bf16_t*)(F.ws + WS_HAL);
      for (int it = gw; it < 48 + 768; it += NGW) {
          if (it < 48) { const int s = it / 3, i = it % 3; const int r = s < 8 ? s * TP + (TP - 3 + i) : RPR + (s - 8) * DSEQ + (DSEQ - 3 + i);
              float* o = F.out + (s < 8 ? O_CVP + (size_t)(s * 3 + i) * CONV_DIM : O_CVS + (size_t)((s - 8) * 3 + i) * CONV_DIM);
#pragma unroll
              for (int j = 0; j < 4; ++j) { const int c = j * 256 + lane * 4;
                  const u32x2 a = *(const u32x2*)(XS + (size_t)r * 1024 + c); *(f32x4*)(o + c) = (f32x4){bf_lo(a.x), bf_hi(a.x), bf_lo(a.y), bf_hi(a.y)};
                  const u32x2 b = *(const u32x2*)(BC + (size_t)r * 1024 + c); *(f32x4*)(o + 1024 + c) = (f32x4){bf_lo(b.x), bf_hi(b.x), bf_lo(b.y), bf_hi(b.y)}; } }
          else { const int h = it - 48, b = h / 96, jb = (h % 96) / 3, i = h % 3; const int r = b * TP + 64 * (jb + 1) - 3 + i;
              bf16_t* o = HAL + (size_t)((b * 33 + jb + 1) * 3 + i) * CONV_DIM;
#pragma unroll
              for (int j = 0; j < 2; ++j) { const int c = j * 512 + lane * 8;
                  *(u32x4*)(o + c) = *(const u32x4*)(XS + (size_t)r * 1024 + c); *(u32x4*)(o + 1024 + c) = *(const u32x4*)(BC + (size_t)r * 1024 + c); } }
      } }
}

__device__ __forceinline__ int t5_bucket(int rel) {
    const int n = rel < 0 ? -rel : rel; const int ret = rel > 0 ? 16 : 0;
    const int v = n < 8 ? n : (n < 12 ? 8 : n < 16 ? 9 : n < 23 ? 10 : n < 32 ? 11 : n < 46 ? 12 : n < 64 ? 13 : n < 91 ? 14 : 15);
    return ret + v;
}
__device__ __forceinline__ void ssd_slow(Frame& F) {
    if (F.wave != 0) return;
    const int lane = F.lane;
    bf16_t* XS = (bf16_t*)(F.ws + WS_XS); const bf16_t* BC = (const bf16_t*)(F.ws + WS_BC); const bf16_t* Z = (const bf16_t*)(F.ws + WS_Z);
    const float* SM = (const float*)(F.ws + WS_SM); float* SSQ1 = (float*)(F.ws + WS_SSQ1);
    const float* conv_w = F.in[11]; const float* conv_b = F.in[12]; const float* a_log = F.in[14]; const float* d_skip = F.in[15]; const float* snw = F.in[16];
    const float* st_ssm = F.in[5]; const float* st_conv = F.in[6];
    LAS float* sbc = (LAS float*)F.lds;
    for (int item = F.vcu; item < 256; item += F.G) {
        const bool pr = item < 128; const int bh = item & 127, b = bh >> 4, h = bh & 15, g = h >> 2;
        const int T = pr ? TP : DSEQ; const int row0 = pr ? b * TP : RPR + b * DSEQ;
        const int xch = h * 64 + lane;
        const int bcc = lane < 32 ? g * 128 + 4 * lane : 512 + g * 128 + 4 * (lane - 32);
        float wx[4], bx; f32x4 wb[4], bb;
#pragma unroll
        for (int i = 0; i < 4; ++i) { wx[i] = conv_w[i * CONV_DIM + xch]; wb[i] = *(const f32x4*)(conv_w + i * CONV_DIM + 1024 + bcc); }
        bx = conv_b[xch]; bb = *(const f32x4*)(conv_b + 1024 + bcc);
        float xp[3]; f32x4 bp[3];
#pragma unroll
        for (int i = 0; i < 3; ++i) { if (pr) { xp[i] = 0.f; bp[i] = (f32x4){0.f, 0.f, 0.f, 0.f}; } else { xp[i] = st_conv[(size_t)(b * 3 + i) * CONV_DIM + xch]; bp[i] = *(const f32x4*)(st_conv + (size_t)(b * 3 + i) * CONV_DIM + 1024 + bcc); } }
        float hs[128];
        float* sout = F.out + (pr ? O_SSMP : O_SSMS) + ((size_t)(b * 16 + h) * 64 + lane) * 128;
        if (pr) {
#pragma unroll
            for (int n = 0; n < 128; ++n) hs[n] = 0.f;
        } else { const float* sp = st_ssm + ((size_t)(b * 16 + h) * 64 + lane) * 128;
#pragma unroll
            for (int n = 0; n < 128; n += 4) { const f32x4 v = *(const f32x4*)(sp + n); hs[n] = v.x; hs[n + 1] = v.y; hs[n + 2] = v.z; hs[n + 3] = v.w; } }
        const float a_h = -expf(a_log[h]), dsk = d_skip[h], nw = snw[xch];
        for (int t = 0; t < T; ++t) {
            const size_t r = (size_t)(row0 + t);
            const float xr = bf2f(XS[r * 1024 + xch]);
            const u32x2 bcr = *(const u32x2*)(BC + r * 1024 + bcc);
            const f32x4 br = {bf_lo(bcr.x), bf_hi(bcr.x), bf_lo(bcr.y), bf_hi(bcr.y)};
            const float zv = bf2f(Z[r * 1024 + xch]);
            const float dt = SM[r * SMLD + h];
            float xc = bx + xp[0] * wx[0] + xp[1] * wx[1] + xp[2] * wx[2] + xr * wx[3];
            f32x4 bc = bb + bp[0] * wb[0] + bp[1] * wb[1] + bp[2] * wb[2] + br * wb[3];
            xp[0] = xp[1]; xp[1] = xp[2]; xp[2] = xr; bp[0] = bp[1]; bp[1] = bp[2]; bp[2] = br;
            xc = siluf_(xc); bc.x = siluf_(bc.x); bc.y = siluf_(bc.y); bc.z = siluf_(bc.z); bc.w = siluf_(bc.w);
            *(LAS f32x4*)(sbc + 4 * lane) = bc;
            LDS_WAIT(); asm volatile("" ::: "memory");
            const float dA = expf(dt * a_h), dx = dt * xc;
            float y = 0.f;
#pragma unroll
            for (int n = 0; n < 128; n += 4) { const f32x4 Bv = *(const LAS f32x4*)(sbc + n); const f32x4 Cv = *(const LAS f32x4*)(sbc + 128 + n);
                hs[n] = hs[n] * dA + dx * Bv.x; y += Cv.x * hs[n];
                hs[n + 1] = hs[n + 1] * dA + dx * Bv.y; y += Cv.y * hs[n + 1];
                hs[n + 2] = hs[n + 2] * dA + dx * Bv.z; y += Cv.z * hs[n + 2];
                hs[n + 3] = hs[n + 3] * dA + dx * Bv.w; y += Cv.w * hs[n + 3]; }
            LDS_WAIT(); asm volatile("" ::: "memory");
            y = (y + dsk * xc) * siluf_(zv);
            const float ss = wave_sum(y * y);
            if (lane == 0) atomicAdd(SSQ1 + r, ss);
            XS[r * 1024 + xch] = f2bf(y * nw);
        }
#pragma unroll
        for (int n = 0; n < 128; n += 4) *(f32x4*)(sout + n) = (f32x4){hs[n], hs[n + 1], hs[n + 2], hs[n + 3]};
    }
}

template <bool PR>
__device__ __forceinline__ void attn_slow_query(Frame& F, int r, LAS unsigned char* wl) {
    const int lane = F.lane;
    bf16_t* Q = (bf16_t*)(F.ob + DO_Q); const bf16_t* QI = (const bf16_t*)(F.ob + DO_QI); const bf16_t* KI = (const bf16_t*)(F.ws + WS_KI);
    const bf16_t* Kb = (const bf16_t*)(F.ws + WS_K); const bf16_t* Vb = (const bf16_t*)(F.ws + WS_V); const bf16_t* CK = (const bf16_t*)(F.ws + WS_CK); const bf16_t* CV = (const bf16_t*)(F.ob + DO_CV);
    const float* SM = (const float*)(F.ws + WS_SM); const float* ckidx = F.in[4]; const float* relb = F.in[8];
    int b, tq, L, qpos, krow0;
    if (PR) { b = r / TP; tq = r - b * TP; const int qc = (tq - NMETA) / 64 + 1; L = NMETA + 64 * qc; qpos = tq; krow0 = b * TP; }
    else { b = (r - RPR) / DSEQ; tq = (r - RPR) - b * DSEQ; L = LS; qpos = PAST + tq; krow0 = RPR + b * DSEQ; }
    LAS float* qf = (LAS float*)wl;
    LAS unsigned* list = (LAS unsigned*)(wl + 2048);
    LAS float* pl = (LAS float*)(wl + 3072);
    LAS unsigned* keys = (LAS unsigned*)(wl + 7168);
    const int ni = (L + 63) >> 6;
    { const u32x4 a = *((const u32x4*)(QI + (size_t)r * 512) + lane);
      LAS float* d = qf + lane * 8; d[0] = bf_lo(a.x); d[1] = bf_hi(a.x); d[2] = bf_lo(a.y); d[3] = bf_hi(a.y); d[4] = bf_lo(a.z); d[5] = bf_hi(a.z); d[6] = bf_lo(a.w); d[7] = bf_hi(a.w); }
    LDS_WAIT(); asm volatile("" ::: "memory");
    float wv[8];
#pragma unroll
    for (int h = 0; h < 8; ++h) wv[h] = SM[(size_t)r * SMLD + 80 + h];
#pragma unroll 1
    for (int i = 0; i < ni; ++i) {
        const int s = i * 64 + lane; const int sc_ = s < L ? s : L - 1;
        float d[8] = {0.f, 0.f, 0.f, 0.f, 0.f, 0.f, 0.f, 0.f};
        const bool cache = !PR && (i * 64 < PAST);
        const float* kpf = ckidx + ((size_t)b * PAST + (cache ? sc_ : 0)) * 64;
        const bf16_t* kpb = KI + (size_t)(PR ? krow0 + sc_ : (cache ? krow0 : krow0 + sc_ - PAST)) * 64;
#pragma unroll 1
        for (int c = 0; c < 8; ++c) {
            float k8[8];
            if (cache) { const f32x4 v0 = *((const f32x4*)kpf + 2 * c), v1 = *((const f32x4*)kpf + 2 * c + 1); k8[0] = v0.x; k8[1] = v0.y; k8[2] = v0.z; k8[3] = v0.w; k8[4] = v1.x; k8[5] = v1.y; k8[6] = v1.z; k8[7] = v1.w; }
            else { const u32x4 v = *((const u32x4*)kpb + c); k8[0] = bf_lo(v.x); k8[1] = bf_hi(v.x); k8[2] = bf_lo(v.y); k8[3] = bf_hi(v.y); k8[4] = bf_lo(v.z); k8[5] = bf_hi(v.z); k8[6] = bf_lo(v.w); k8[7] = bf_hi(v.w); }
#pragma unroll
            for (int h = 0; h < 8; ++h) { const f32x4 qa = *(const LAS f32x4*)(qf + h * 64 + c * 8), qb = *(const LAS f32x4*)(qf + h * 64 + c * 8 + 4);
                d[h] += qa.x * k8[0] + qa.y * k8[1] + qa.z * k8[2] + qa.w * k8[3] + qb.x * k8[4] + qb.y * k8[5] + qb.z * k8[6] + qb.w * k8[7]; }
        }
        float sc = 0.f;
#pragma unroll
        for (int h = 0; h < 8; ++h) sc += wv[h] * fmaxf(d[h], 0.f);
        if (sc == 0.f) sc = 0.f;
        const unsigned u = __float_as_uint(sc);
        keys[s] = s < L ? ((u & 0x80000000u) ? ~u : (u | 0x80000000u)) : 0u;
    }
    LDS_WAIT(); asm volatile("" ::: "memory");
    int nsel;
    const unsigned long long lt_mask = (1ull << lane) - 1ull;
    if (L <= TOPK) { nsel = L;
#pragma unroll
        for (int i = 0; i < 4; ++i) { const int s = i * 64 + lane; if (s < L) list[s] = (unsigned)s; } }
    else {
        unsigned prefix = 0u;
        for (int bit = 31; bit >= 0; --bit) { const unsigned cand = prefix | (1u << bit); int cnt = 0;
#pragma unroll 1
            for (int i = 0; i < ni; ++i) cnt += __popcll(__ballot(keys[i * 64 + lane] >= cand));
            if (cnt >= TOPK) prefix = cand; }
        int ngt = 0;
#pragma unroll 1
        for (int i = 0; i < ni; ++i) ngt += __popcll(__ballot(keys[i * 64 + lane] > prefix));
        const int need = TOPK - ngt; int eqseen = 0, pos = 0;
#pragma unroll 1
        for (int i = 0; i < ni; ++i) { const unsigned kv = keys[i * 64 + lane]; const bool gt = kv > prefix, eq = kv == prefix; const unsigned long long meq = __ballot(eq);
            const bool sel = gt || (eq && (eqseen + __popcll(meq & lt_mask)) < need); const unsigned long long ms = __ballot(sel);
            if (sel) list[pos + __popcll(ms & lt_mask)] = (unsigned)(i * 64 + lane);
            pos += __popcll(ms); eqseen += __popcll(meq); }
        nsel = TOPK; }
    LDS_WAIT(); asm volatile("" ::: "memory");
#pragma unroll 1
    for (int g = 0; g < 2; ++g) {
        { const u32x4 a = *((const u32x4*)(Q + (size_t)r * 1024 + g * 512) + lane);
          LAS float* d = qf + lane * 8; d[0] = bf_lo(a.x); d[1] = bf_hi(a.x); d[2] = bf_lo(a.y); d[3] = bf_hi(a.y); d[4] = bf_lo(a.z); d[5] = bf_hi(a.z); d[6] = bf_lo(a.w); d[7] = bf_hi(a.w); }
        LDS_WAIT(); asm volatile("" ::: "memory");
        float mx[4] = {-1e30f, -1e30f, -1e30f, -1e30f};
        const int njj = (nsel + 63) >> 6;
#pragma unroll 1
        for (int jj = 0; jj < njj; ++jj) { const int j = jj * 64 + lane;
            const int s = j < nsel ? (int)list[j] : (int)list[0];
            const bf16_t* kp = (!PR && s < PAST) ? CK + ((size_t)b * PAST + s) * 256 + g * 128 : Kb + (size_t)(PR ? krow0 + s : krow0 + s - PAST) * 256 + g * 128;
            float d0 = 0.f, d1 = 0.f, d2 = 0.f, d3 = 0.f;
#pragma unroll 1
            for (int c = 0; c < 16; ++c) { const u32x4 v = *((const u32x4*)kp + c);
                const float k0 = bf_lo(v.x), k1 = bf_hi(v.x), k2 = bf_lo(v.y), k3 = bf_hi(v.y), k4 = bf_lo(v.z), k5 = bf_hi(v.z), k6 = bf_lo(v.w), k7 = bf_hi(v.w);
#define DOT8(hh, acc) { const f32x4 qa = *(const LAS f32x4*)(qf + hh * 128 + c * 8), qb = *(const LAS f32x4*)(qf + hh * 128 + c * 8 + 4); \
                    acc += qa.x * k0 + qa.y * k1 + qa.z * k2 + qa.w * k3 + qb.x * k4 + qb.y * k5 + qb.z * k6 + qb.w * k7; }
                DOT8(0, d0) DOT8(1, d1) DOT8(2, d2) DOT8(3, d3)
#undef DOT8
            }
            const int bk = t5_bucket(s - qpos);
            const f32x4 bv = *(const f32x4*)(relb + bk * 8 + g * 4);
            constexpr float L2E = 1.4426950408889634f;
            const bool ok = j < nsel;
            f32x4 lgv; lgv.x = ok ? d0 + bv.x * L2E : -1e30f; lgv.y = ok ? d1 + bv.y * L2E : -1e30f; lgv.z = ok ? d2 + bv.z * L2E : -1e30f; lgv.w = ok ? d3 + bv.w * L2E : -1e30f;
            *(LAS f32x4*)(pl + j * 4) = lgv;
            mx[0] = fmaxf(mx[0], lgv.x); mx[1] = fmaxf(mx[1], lgv.y); mx[2] = fmaxf(mx[2], lgv.z); mx[3] = fmaxf(mx[3], lgv.w);
        }
        float sm[4] = {0.f, 0.f, 0.f, 0.f};
#pragma unroll
        for (int h = 0; h < 4; ++h) {
#pragma unroll
            for (int o = 1; o < 64; o <<= 1) mx[h] = fmaxf(mx[h], __shfl_xor(mx[h], o)); }
        LDS_WAIT(); asm volatile("" ::: "memory");
#pragma unroll 1
        for (int jj = 0; jj < njj; ++jj) { const int j = jj * 64 + lane;
            f32x4 lgv = *(const LAS f32x4*)(pl + j * 4);
            lgv.x = __builtin_amdgcn_exp2f(lgv.x - mx[0]); lgv.y = __builtin_amdgcn_exp2f(lgv.y - mx[1]); lgv.z = __builtin_amdgcn_exp2f(lgv.z - mx[2]); lgv.w = __builtin_amdgcn_exp2f(lgv.w - mx[3]);
            sm[0] += lgv.x; sm[1] += lgv.y; sm[2] += lgv.z; sm[3] += lgv.w;
            *(LAS f32x4*)(pl + j * 4) = lgv; }
#pragma unroll
        for (int h = 0; h < 4; ++h) sm[h] = __builtin_amdgcn_rcpf(wave_sum(sm[h]));
        LDS_WAIT(); asm volatile("" ::: "memory");
        float o[4][2] = {};
        for (int j = 0; j < nsel; ++j) {
            const int s = (int)list[j]; const f32x4 p = *(const LAS f32x4*)(pl + j * 4);
            const bf16_t* vp = (!PR && s < PAST) ? CV + ((size_t)b * PAST + s) * 256 + g * 128 : Vb + (size_t)(PR ? krow0 + s : krow0 + s - PAST) * 256 + g * 128;
            const unsigned vv = *((const unsigned*)vp + lane); const float v0 = bf_lo(vv), v1 = bf_hi(vv);
            o[0][0] += p.x * v0; o[0][1] += p.x * v1; o[1][0] += p.y * v0; o[1][1] += p.y * v1; o[2][0] += p.z * v0; o[2][1] += p.z * v1; o[3][0] += p.w * v0; o[3][1] += p.w * v1;
        }
#pragma unroll
        for (int h = 0; h < 4; ++h) *((unsigned*)(Q + (size_t)r * 1024 + g * 512 + h * 128) + lane) = cvt_pk_bf16(o[h][0] * sm[h], o[h][1] * sm[h]);
        LDS_WAIT(); asm volatile("" ::: "memory");
    }
}
__device__ __forceinline__ void attn_slow(Frame& F) {
    const int gw = F.vcu * NWAVES + F.wave, NGW = F.G * NWAVES;
    for (int q = gw; q < YPR; q += NGW) { const int b = q / SEQ, t = q - b * SEQ; attn_slow_query<true>(F, b * TP + NMETA + t, F.lds + F.wave * 16384); }
    __syncthreads();
    if (F.wave < 4) { const int gw4 = F.vcu * 4 + F.wave;
        for (int q = gw4; q < RSR; q += F.G * 4) attn_slow_query<false>(F, RPR + q, F.lds + F.wave * 32768); }
}
__device__ __forceinline__ void conv_units(Frame& F) {
    bf16_t* XS = (bf16_t*)(F.ws + WS_XS); bf16_t* BC = (bf16_t*)(F.ws + WS_BC); const bf16_t* HAL = (const bf16_t*)(F.ws + WS_HAL);
    const float* conv_w = F.in[11]; const float* conv_b = F.in[12]; const float* st_conv = F.in[6];
    const int cg = F.tid & 63, rc = F.wave;
    constexpr int NU = (NBATCH * 33 + NBATCH) * 4;
    for (int u = F.vcu; u < NU; u += F.G) {
        const int cq = u & 3, sb = u >> 2; const bool pr = sb < NBATCH * 33;
        const int b = pr ? sb / 33 : sb - NBATCH * 33, j = pr ? sb % 33 : 0;
        const int T = pr ? TP : DSEQ, row0 = (pr ? b * TP : RPR + b * DSEQ) + 64 * j, nvalid = T - 64 * j;
        const int ch = 512 * cq + 8 * cg;
        bf16_t* colp = ch < 1024 ? XS + ch : BC + (ch - 1024);
        float w[4][8], bias[8];
#pragma unroll
        for (int i = 0; i < 4; ++i) { const f32x4 a = *(const f32x4*)(conv_w + i * CONV_DIM + ch), c = *(const f32x4*)(conv_w + i * CONV_DIM + ch + 4);
            w[i][0] = a.x; w[i][1] = a.y; w[i][2] = a.z; w[i][3] = a.w; w[i][4] = c.x; w[i][5] = c.y; w[i][6] = c.z; w[i][7] = c.w; }
        { const f32x4 a = *(const f32x4*)(conv_b + ch), c = *(const f32x4*)(conv_b + ch + 4); bias[0] = a.x; bias[1] = a.y; bias[2] = a.z; bias[3] = a.w; bias[4] = c.x; bias[5] = c.y; bias[6] = c.z; bias[7] = c.w; }
        float x[11][8];
        const int t0 = 8 * rc;
#pragma unroll
        for (int i = 0; i < 11; ++i) {
            const int t = t0 - 3 + i;
            u32x4 v = {0u, 0u, 0u, 0u}; bool have = false;
            if (t >= 0) { if (t < nvalid) { v = *(const u32x4*)(colp + (size_t)(row0 + t) * 1024); have = true; } }
            else if (j > 0) { v = *(const u32x4*)(HAL + (size_t)((b * 33 + j) * 3 + (t + 3)) * CONV_DIM + ch); have = true; }
            else if (!pr) { const float* sp = st_conv + (size_t)(b * 3 + (t + 3)) * CONV_DIM + ch; const f32x4 a = *(const f32x4*)sp, c = *(const f32x4*)(sp + 4);
                x[i][0] = a.x; x[i][1] = a.y; x[i][2] = a.z; x[i][3] = a.w; x[i][4] = c.x; x[i][5] = c.y; x[i][6] = c.z; x[i][7] = c.w; continue; }
            (void)have;
            x[i][0] = bf_lo(v.x); x[i][1] = bf_hi(v.x); x[i][2] = bf_lo(v.y); x[i][3] = bf_hi(v.y); x[i][4] = bf_lo(v.z); x[i][5] = bf_hi(v.z); x[i][6] = bf_lo(v.w); x[i][7] = bf_hi(v.w);
        }
        __syncthreads();
#pragma unroll
        for (int r = 0; r < 8; ++r) { const int t = t0 + r;
            if (t < nvalid) { float o[8];
#pragma unroll
                for (int e = 0; e < 8; ++e) o[e] = siluf_(bias[e] + x[r][e] * w[0][e] + x[r + 1][e] * w[1][e] + x[r + 2][e] * w[2][e] + x[r + 3][e] * w[3][e]);
                u32x4 ov; ov.x = cvt_pk_bf16(o[0], o[1]); ov.y = cvt_pk_bf16(o[2], o[3]); ov.z = cvt_pk_bf16(o[4], o[5]); ov.w = cvt_pk_bf16(o[6], o[7]);
                *(u32x4*)(colp + (size_t)(row0 + t) * 1024) = ov; } }
        __syncthreads();
    }
}

namespace ssd {
constexpr int CL = 0, BL = 17408, XR = 34816, XW = 39936, WM = 45056, SB = 54272, FA = 62976, LDS_TOT = 63744;
constexpr int LDC = 272, LDX = 80, LDW = 144;
typedef short v4i16 __attribute__((ext_vector_type(4)));
__device__ __forceinline__ s16x4 trd(LAS unsigned char* p) { return __builtin_bit_cast(s16x4, __builtin_amdgcn_ds_read_tr16_b64_v4i16((LAS v4i16*)p)); }
__device__ __forceinline__ bf16x8 frag_tr(LAS unsigned char* img, int stride, int m0, int kb0, int i, int g4) {
    LAS unsigned char* p = img + (kb0 + 8 * g4 + (i >> 2)) * stride + (m0 + 4 * (i & 3)) * 2;
    const s16x4 lo = trd(p), hi = trd(p + 4 * stride);
    return (bf16x8){lo[0], lo[1], lo[2], lo[3], hi[0], hi[1], hi[2], hi[3]};
}
__device__ __forceinline__ bf16x8 frag_row(LAS unsigned char* img, int stride, int r0, int kb0, int i, int g4) {
    return *(const LAS bf16x8*)(img + (r0 + i) * stride + (kb0 + 8 * g4) * 2);
}
}
__device__ __forceinline__ void ssd_chain_unit(Frame& F, int unit) {
    using namespace ssd;
    const int tid = F.tid, lane = F.lane, w = F.wave, i16 = lane & 15, g4 = lane >> 4;
    LAS unsigned char* L = F.lds;
    const bool pr = unit < 256; const int uu = unit & 255, b = uu >> 5, h = (uu >> 1) & 15, ph = uu & 1, g = h >> 2;
    const int T = pr ? TP : DSEQ, row0 = pr ? b * TP : RPR + b * DSEQ, nblk = (T + 63) >> 6;
    bf16_t* XS = (bf16_t*)(F.ws + WS_XS); const bf16_t* BC = (const bf16_t*)(F.ws + WS_BC); const bf16_t* Z = (const bf16_t*)(F.ws + WS_Z);
    const float* SM = (const float*)(F.ws + WS_SM); float* SSQ1 = (float*)(F.ws + WS_SSQ1);
    const int xcol = h * 64 + ph * 32;
    const float a_h = -expf(F.in[14][h]), dsk = F.in[15][h];
    const int cb_sb = w >> 1, cb_tb0 = 2 * (w & 1), y_pb = w & 1, y_tb = w >> 1;
    const int yp0 = 16 * y_pb + 4 * g4;
    const f32x4 nwv = *(const f32x4*)(F.in[16] + xcol + yp0);
    f32x4 st[2];
    float* sout = F.out + (pr ? O_SSMP : O_SSMS) + ((size_t)(b * 16 + h) * 64 + ph * 32) * 128;
    if (pr) { st[0] = (f32x4){0.f, 0.f, 0.f, 0.f}; st[1] = st[0]; }
    else { const float* sp = F.in[5] + ((size_t)(b * 16 + h) * 64 + ph * 32) * 128;
#pragma unroll
        for (int pb = 0; pb < 2; ++pb) st[pb] = *(const f32x4*)(sp + (size_t)(16 * pb + i16) * 128 + 16 * w + 4 * g4); }
    const int srow = tid >> 3, sch = tid & 7, xrow = tid >> 2, xch = tid & 3;
    u32x4 pB[2], pC[2], pX; u32x2 pZ; float pdt;
#define SSD_PREFETCH(jb) do { const int base_ = 64 * (jb); \
        { const bool ok_ = base_ + srow < T; const bf16_t* rp_ = BC + (size_t)(row0 + base_ + srow) * 1024 + g * 128 + 8 * sch; \
          pB[0] = ok_ ? *(const u32x4*)rp_ : (u32x4){0u, 0u, 0u, 0u}; pB[1] = ok_ ? *(const u32x4*)(rp_ + 64) : (u32x4){0u, 0u, 0u, 0u}; \
          pC[0] = ok_ ? *(const u32x4*)(rp_ + 512) : (u32x4){0u, 0u, 0u, 0u}; pC[1] = ok_ ? *(const u32x4*)(rp_ + 576) : (u32x4){0u, 0u, 0u, 0u}; } \
        if (tid < 256) { const bool ok_ = base_ + xrow < T; pX = ok_ ? *(const u32x4*)(XS + (size_t)(row0 + base_ + xrow) * 1024 + xcol + 8 * xch) : (u32x4){0u, 0u, 0u, 0u}; } \
        { const int t_ = base_ + 16 * y_tb + i16; pZ = t_ < T ? *(const u32x2*)(Z + (size_t)(row0 + t_) * 1024 + xcol + yp0) : (u32x2){0u, 0u}; } \
        { const int t_ = base_ + lane; pdt = t_ < T ? SM[(size_t)(row0 + t_) * SMLD + h] : 0.f; } } while (0)
    SSD_PREFETCH(0);
#pragma unroll 1
    for (int jb = 0; jb < nblk; ++jb) {
        float ac = pdt * a_h;
#pragma unroll
        for (int o = 1; o < 64; o <<= 1) { const float v = __shfl_up(ac, o); if (lane >= o) ac += v; }
        const float tot = __shfl(ac, 63);
        const float wsc = __builtin_amdgcn_exp2f((tot - ac) * 1.4426950408889634f) * pdt;
        if (w == 0) { LAS float* fa = (LAS float*)(L + FA); fa[lane] = ac; fa[64 + lane] = pdt; }
        *(LAS u32x4*)(L + BL + srow * LDC + 16 * sch) = pB[0]; *(LAS u32x4*)(L + BL + srow * LDC + 128 + 16 * sch) = pB[1];
        *(LAS u32x4*)(L + CL + srow * LDC + 16 * sch) = pC[0]; *(LAS u32x4*)(L + CL + srow * LDC + 128 + 16 * sch) = pC[1];
        if (tid < 256) { *(LAS u32x4*)(L + XR + xrow * LDX + 16 * xch) = pX;
            const float ws_ = __shfl(wsc, xrow & 63);
            u32x4 xw; xw.x = cvt_pk_bf16(bf_lo(pX.x) * ws_, bf_hi(pX.x) * ws_); xw.y = cvt_pk_bf16(bf_lo(pX.y) * ws_, bf_hi(pX.y) * ws_);
            xw.z = cvt_pk_bf16(bf_lo(pX.z) * ws_, bf_hi(pX.z) * ws_); xw.w = cvt_pk_bf16(bf_lo(pX.w) * ws_, bf_hi(pX.w) * ws_);
            *(LAS u32x4*)(L + XW + xrow * LDX + 16 * xch) = xw; }
#pragma unroll
        for (int pb = 0; pb < 2; ++pb)
            *(LAS u32x2*)(L + SB + (16 * pb + i16) * LDC + (16 * w + 4 * g4) * 2) = (u32x2){cvt_pk_bf16(st[pb].x, st[pb].y), cvt_pk_bf16(st[pb].z, st[pb].w)};
        const u32x2 zreg = pZ;
        __syncthreads();
        if (jb + 1 < nblk) SSD_PREFETCH(jb + 1);
        {
            f32x4 cb[2] = {{0.f, 0.f, 0.f, 0.f}, {0.f, 0.f, 0.f, 0.f}};
#pragma unroll
            for (int ks = 0; ks < 4; ++ks) { const bf16x8 af = frag_row(L + BL, LDC, 16 * cb_sb, 32 * ks, i16, g4);
#pragma unroll
                for (int q = 0; q < 2; ++q) { const bf16x8 bfv = frag_row(L + CL, LDC, 16 * (cb_tb0 + q), 32 * ks, i16, g4);
                    cb[q] = __builtin_amdgcn_mfma_f32_16x16x32_bf16(af, bfv, cb[q], 0, 0, 0); } }
            const LAS float* fa = (const LAS float*)(L + FA);
            const int s0 = 16 * cb_sb + 4 * g4;
            const f32x4 acs = *(const LAS f32x4*)(fa + s0), dts = *(const LAS f32x4*)(fa + 64 + s0);
#pragma unroll
            for (int q = 0; q < 2; ++q) { const int t = 16 * (cb_tb0 + q) + i16; const float act = fa[t];
                float o[4];
#pragma unroll
                for (int e = 0; e < 4; ++e) o[e] = (s0 + e <= t) ? cb[q][e] * __builtin_amdgcn_exp2f((act - acs[e]) * 1.4426950408889634f) * dts[e] : 0.f;
                *(LAS u32x2*)(L + WM + t * LDW + s0 * 2) = (u32x2){cvt_pk_bf16(o[0], o[1]), cvt_pk_bf16(o[2], o[3])}; }
            const float dtot = __builtin_amdgcn_exp2f(tot * 1.4426950408889634f);
            st[0] = st[0] * dtot; st[1] = st[1] * dtot;
#pragma unroll
            for (int ks = 0; ks < 2; ++ks) { const bf16x8 af = frag_tr(L + BL, LDC, 16 * w, 32 * ks, i16, g4);
#pragma unroll
                for (int pb = 0; pb < 2; ++pb) { const bf16x8 bfv = frag_tr(L + XW, LDX, 16 * pb, 32 * ks, i16, g4);
                    st[pb] = __builtin_amdgcn_mfma_f32_16x16x32_bf16(af, bfv, st[pb], 0, 0, 0); } }
        }
        __syncthreads();
        {
            f32x4 y = {0.f, 0.f, 0.f, 0.f};
#pragma unroll
            for (int ks = 0; ks < 4; ++ks) { const bf16x8 af = frag_row(L + SB, LDC, 16 * y_pb, 32 * ks, i16, g4), bfv = frag_row(L + CL, LDC, 16 * y_tb, 32 * ks, i16, g4);
                y = __builtin_amdgcn_mfma_f32_16x16x32_bf16(af, bfv, y, 0, 0, 0); }
            const LAS float* fa = (const LAS float*)(L + FA);
            const int t = 16 * y_tb + i16; const float eac = __builtin_amdgcn_exp2f(fa[t] * 1.4426950408889634f);
            y = y * eac;
#pragma unroll
            for (int ks = 0; ks < 2; ++ks) { const bf16x8 af = frag_tr(L + XR, LDX, 16 * y_pb, 32 * ks, i16, g4), bfv = frag_row(L + WM, LDW, 16 * y_tb, 32 * ks, i16, g4);
                y = __builtin_amdgcn_mfma_f32_16x16x32_bf16(af, bfv, y, 0, 0, 0); }
            const u32x2 xv = *(const LAS u32x2*)(L + XR + t * LDX + yp0 * 2);
            const f32x4 xf = {bf_lo(xv.x), bf_hi(xv.x), bf_lo(xv.y), bf_hi(xv.y)}, zf = {bf_lo(zreg.x), bf_hi(zreg.x), bf_lo(zreg.y), bf_hi(zreg.y)};
            f32x4 yo; yo.x = (y.x + dsk * xf.x) * siluf_(zf.x); yo.y = (y.y + dsk * xf.y) * siluf_(zf.y); yo.z = (y.z + dsk * xf.z) * siluf_(zf.z); yo.w = (y.w + dsk * xf.w) * siluf_(zf.w);
            float ss = (yo.x * yo.x + yo.y * yo.y) + (yo.z * yo.z + yo.w * yo.w);
            ss += __shfl_xor(ss, 16); ss += __shfl_xor(ss, 32);
            const int tg = 64 * jb + t;
            if (tg < T) { if (g4 == 0) atomicAdd(SSQ1 + row0 + tg, ss);
                yo = yo * nwv; *(u32x2*)(XS + (size_t)(row0 + tg) * 1024 + xcol + yp0) = (u32x2){cvt_pk_bf16(yo.x, yo.y), cvt_pk_bf16(yo.z, yo.w)}; }
        }
        __syncthreads();
    }
#undef SSD_PREFETCH
#pragma unroll
    for (int pb = 0; pb < 2; ++pb) *(f32x4*)(sout + (size_t)(16 * pb + i16) * 128 + 16 * w + 4 * g4) = st[pb];
}
__device__ __forceinline__ void ssd_chains(Frame& F) {
    for (int u = F.vcu; u < 512; u += F.G) ssd_chain_unit(F, u);
}
__device__ __forceinline__ int yrow_to_r(int pm) { return pm * 256 + (pm < 64 ? 16 * ((pm >> 3) + 1) : 128); }
struct SchedP5 {
    const char* A0; const char* A1; const char* B0; const char* B1; int G, c;
    __device__ __forceinline__ bool next(int i, pg8::Unit& u) const {
        const int L = (i >> 1) * G + c; if (L >= 66 * 4) return false;
        pg8::tile_of(L, 66, 4, u.pm, u.pn); u.part = i & 1;
        u.A = (u.part ? A1 : A0) + (size_t)yrow_to_r(u.pm) * 1024 * 2; u.B = (u.part ? B1 : B0) + (size_t)u.pn * 256 * 1024 * 2; return true; }
};
struct EpiP5 {
    static constexpr bool PERM = true;
    const bf16_t* GS; const bf16_t* GA; const float* SSQ1; bf16_t* MERGED;
    __device__ __forceinline__ bool operator()(pg8::Acc& acc, const pg8::Unit& u, int wr, int wc, int fr, int fq) const {
        const int rr0 = yrow_to_r(u.pm) + wr * 64 + fr, ry0 = u.pm * 256 + wr * 64 + fr, col = u.pn * 256 + wc * 32 + 8 * fq;
#pragma unroll
        for (int ai = 0; ai < 2; ++ai)
#pragma unroll
            for (int m = 0; m < 4; ++m) { const int rr = rr0 + ai * 128 + m * 16, ry = ry0 + ai * 128 + m * 16;
                float rstd = 0.f; if (u.part == 0) rstd = __builtin_amdgcn_rsqf(SSQ1[rr] * (1.f / 1024.f) + EPS);
#pragma unroll
                for (int bj = 0; bj < 2; ++bj) {
                    const u32x4 ga = *(const u32x4*)(GA + (size_t)rr * 1024 + col + bj * 128);
                    float sa[8] = {bf_lo(ga.x), bf_hi(ga.x), bf_lo(ga.y), bf_hi(ga.y), bf_lo(ga.z), bf_hi(ga.z), bf_lo(ga.w), bf_hi(ga.w)};
                    if (u.part == 0) {
                        const u32x4 gs = *(const u32x4*)(GS + (size_t)rr * 1024 + col + bj * 128);
                        const float ss[8] = {bf_lo(gs.x), bf_hi(gs.x), bf_lo(gs.y), bf_hi(gs.y), bf_lo(gs.z), bf_hi(gs.z), bf_lo(gs.w), bf_hi(gs.w)};
#pragma unroll
                        for (int e = 0; e < 8; ++e) {
                            const float f = rstd * (1.f + __builtin_amdgcn_exp2f(-1.4426950408889634f * sa[e])) * __builtin_amdgcn_rcpf(1.f + __builtin_amdgcn_exp2f(-1.4426950408889634f * ss[e]));
                            acc[ai][bj][m][e >> 2][e & 3] *= f; }
                    } else {
                        float o[8];
#pragma unroll
                        for (int e = 0; e < 8; ++e) o[e] = acc[ai][bj][m][e >> 2][e & 3] * sigmoidf_(sa[e]);
                        u32x4 w; w.x = cvt_pk_bf16(o[0], o[1]); w.y = cvt_pk_bf16(o[2], o[3]); w.z = cvt_pk_bf16(o[4], o[5]); w.w = cvt_pk_bf16(o[6], o[7]);
                        *(u32x4*)(MERGED + (size_t)ry * 1024 + col + bj * 128) = w; } } }
        return u.part == 0;
    }
};
struct SchedY {
    const char* A; const char* B; int nN, K, G, c;
    __device__ __forceinline__ bool next(int i, pg8::Unit& u) const {
        const int L = i * G + c; if (L >= 66 * nN) return false;
        pg8::tile_of(L, 66, nN, u.pm, u.pn); u.part = 0; u.A = A + (size_t)u.pm * 256 * K * 2; u.B = B + (size_t)u.pn * 256 * K * 2; return true; }
};
struct EpiP6 {
    static constexpr bool PERM = false;
    const float* xp; const float* xs; const float* n2w; float* H; bf16_t* HB; float* SSQ2;
    __device__ __forceinline__ bool operator()(pg8::Acc& acc, const pg8::Unit& u, int wr, int wc, int fr, int fq) const {
        const int ry0 = u.pm * 256 + wr * 64 + fr, col0 = u.pn * 256 + wc * 32 + 4 * fq;
        f32x4 nw[2][2];
#pragma unroll
        for (int bj = 0; bj < 2; ++bj)
#pragma unroll
            for (int n = 0; n < 2; ++n) nw[bj][n] = *(const f32x4*)(n2w + col0 + bj * 128 + n * 16);
#pragma unroll
        for (int ai = 0; ai < 2; ++ai)
#pragma unroll
            for (int m = 0; m < 4; ++m) { const int ry = ry0 + ai * 128 + m * 16;
                const float* xrow = ry < YPR ? xp + (size_t)ry * 1024 : xs + (size_t)(ry - YPR) * 1024; float ss = 0.f;
#pragma unroll
                for (int bj = 0; bj < 2; ++bj)
#pragma unroll
                    for (int n = 0; n < 2; ++n) { const int c = col0 + bj * 128 + n * 16; const f32x4 h = *(const f32x4*)(xrow + c) + acc[ai][bj][m][n];
                        *(f32x4*)(H + (size_t)ry * 1024 + c) = h; ss += (h.x * h.x + h.y * h.y) + (h.z * h.z + h.w * h.w);
                        const f32x4 hn = h * nw[bj][n]; *(u32x2*)(HB + (size_t)ry * 1024 + c) = (u32x2){cvt_pk_bf16(hn.x, hn.y), cvt_pk_bf16(hn.z, hn.w)}; }
                ss += __shfl_xor(ss, 16); ss += __shfl_xor(ss, 32);
                if (fq == 0) atomicAdd(SSQ2 + ry, ss); }
        return false;
    }
};
struct EpiP7 {
    static constexpr bool PERM = true;
    const float* SSQ2; bf16_t* ACT;
    __device__ __forceinline__ bool operator()(pg8::Acc& acc, const pg8::Unit& u, int wr, int wc, int fr, int fq) const {
        const int ry0 = u.pm * 256 + wr * 64 + fr, ch0 = u.pn * 128 + wc * 16 + 4 * fq;
#pragma unroll
        for (int ai = 0; ai < 2; ++ai)
#pragma unroll
            for (int m = 0; m < 4; ++m) { const int ry = ry0 + ai * 128 + m * 16; const float rs = __builtin_amdgcn_rsqf(SSQ2[ry] * (1.f / 1024.f) + EPS);
#pragma unroll
                for (int bj = 0; bj < 2; ++bj) { const f32x4 g = acc[ai][bj][m][0] * rs, up = acc[ai][bj][m][1] * rs;
                    const float a0 = siluf_(g.x) * up.x, a1 = siluf_(g.y) * up.y, a2 = siluf_(g.z) * up.z, a3 = siluf_(g.w) * up.w;
                    *(u32x2*)(ACT + (size_t)ry * DFF + ch0 + bj * 64) = (u32x2){cvt_pk_bf16(a0, a1), cvt_pk_bf16(a2, a3)}; } }
        return false;
    }
};
struct EpiP8 {
    static constexpr bool PERM = false;
    float* H;
    __device__ __forceinline__ bool operator()(pg8::Acc& acc, const pg8::Unit& u, int wr, int wc, int fr, int fq) const {
        const int ry0 = u.pm * 256 + wr * 64 + fr, col0 = u.pn * 256 + wc * 32 + 4 * fq;
#pragma unroll
        for (int ai = 0; ai < 2; ++ai)
#pragma unroll
            for (int m = 0; m < 4; ++m) { float* hrow = H + (size_t)(ry0 + ai * 128 + m * 16) * 1024 + col0;
#pragma unroll
                for (int bj = 0; bj < 2; ++bj)
#pragma unroll
                    for (int n = 0; n < 2; ++n) { f32x4* p = (f32x4*)(hrow + bj * 128 + n * 16); *p = *p + acc[ai][bj][m][n]; } }
        return false;
    }
};

constexpr int NPHASE = 10;
__global__ void __launch_bounds__(NTHR, 2) hybrid_fwd(Args args) {
    extern __shared__ __attribute__((aligned(16))) unsigned char lds[];
    Frame F;
    F.lds = (LAS unsigned char*)lds; F.MISC = (volatile LAS unsigned*)(F.lds + MISC_OFF);
    F.tid = threadIdx.x; F.lane = F.tid & 63; F.wave = __builtin_amdgcn_readfirstlane(F.tid >> 6);
    F.G = gridDim.x; { const int bx = blockIdx.x; F.vcu = (F.G % 8 == 0) ? (bx % 8) * (F.G / 8) + bx / 8 : bx; }
    F.in = args.in; F.out = args.out; F.ws = args.ws; F.ob = (unsigned char*)args.out; F.ctl = (gu32*)(args.ws + WS_CTL);
    for (int u = F.tid; u < (LDS_BYTES - LDSCTL_OFF) / 4; u += NTHR) ((LAS unsigned*)(F.lds + LDSCTL_OFF))[u] = 0u;
    __syncthreads();
    const int lo = args.ph_lo, hi = args.ph_hi;
    const bool multi = (hi - lo) > 1;
    XcdBarrier bar; bar.bar = (unsigned*)(F.ctl + CW_BAR) + args.li * XCD_BAR_WORDS; bar.x = 0; bar.st = nullptr;
    if (multi) bar = xcd_barrier_post((unsigned*)(F.ctl + CW_BAR) + args.li * XCD_BAR_WORDS, F.MISC + 8);
#define IN(k) (lo <= (k) && (k) < hi)
#define SEAM(k) do { if (IN(k) && IN((k) + 1)) xcd_barrier(bar); } while (0)
    if (IN(0)) { p0_prologue(F); SEAM(0); }
    if (IN(1)) {
        SchedP1 S{(const char*)(F.ob + DO_HN), (const char*)(F.ws + WS_WIN), F.G, (int)blockIdx.x};
        EpiP1 E{F.ws, F.ob};
        pg8::gemm_phase<EpiP1, SchedP1>(F.lds, 1024, S, E);
        SEAM(1);
    }
    if (IN(2)) { p2_rows(F); SEAM(2); }
    if (IN(3)) { conv_units(F); SEAM(3); }
    if (IN(4)) { ssd_chains(F); SEAM(4); }
    if (IN(5)) { attn_slow(F); __syncthreads(); SEAM(5); }
    if (IN(6)) {
        SchedP5 S{(const char*)(F.ws + WS_XS), (const char*)(F.ob + DO_Q), (const char*)(F.ws + WS_WBS), (const char*)(F.ws + WS_WBA), F.G, (int)blockIdx.x};
        EpiP5 E{(const bf16_t*)(F.ws + WS_GS), (const bf16_t*)(F.ws + WS_GA), (const float*)(F.ws + WS_SSQ1), (bf16_t*)(F.ws + WS_MERGED)};
        pg8::gemm_phase<EpiP5, SchedP5>(F.lds, 1024, S, E);
        SEAM(6);
    }
    if (IN(7)) {
        SchedY S{(const char*)(F.ws + WS_MERGED), (const char*)(F.ws + WS_WOUT), 4, 1024, F.G, (int)blockIdx.x};
        EpiP6 E{F.in[0], F.in[1], F.in[23], F.out, (bf16_t*)(F.ws + WS_HB), (float*)(F.ws + WS_SSQ2)};
        pg8::gemm_phase<EpiP6, SchedY>(F.lds, 1024, S, E);
        SEAM(7);
    }
    if (IN(8)) {
        SchedY S{(const char*)(F.ws + WS_HB), (const char*)(F.ws + WS_WGU), NGU / 256, 1024, F.G, (int)blockIdx.x};
        EpiP7 E{(const float*)(F.ws + WS_SSQ2), (bf16_t*)(F.ws + WS_ACT)};
        pg8::gemm_phase<EpiP7, SchedY>(F.lds, 1024, S, E);
        SEAM(8);
    }
    if (IN(9)) {
        SchedY S{(const char*)(F.ws + WS_ACT), (const char*)(F.ws + WS_WDN), 4, DFF, F.G, (int)blockIdx.x};
        EpiP8 E{F.out};
        pg8::gemm_phase<EpiP8, SchedY>(F.lds, DFF, S, E);
    }
#undef IN
#undef SEAM
}

extern "C" void kernel_launch(void* const* d_in, const int* in_sizes, int n_in, void* d_out, int out_size, void* d_ws, size_t ws_size, hipStream_t stream) {
    static int grid = 0;
    if (grid == 0) {
        if (n_in != 27 || out_size != (int)O_END || ws_size < WS_END) { fprintf(stderr, "kernel_launch: unexpected shapes: n_in %d out %d ws %zu (need %zu)\n", n_in, out_size, ws_size, (size_t)WS_END); grid = -1; return; }
        int dev = 0, cus = 0;
        if (hipGetDevice(&dev) != hipSuccess || hipDeviceGetAttribute(&cus, hipDeviceAttributeMultiprocessorCount, dev) != hipSuccess) { grid = -1; return; }
        if (hipFuncSetAttribute((const void*)hybrid_fwd, hipFuncAttributeMaxDynamicSharedMemorySize, LDS_BYTES) != hipSuccess) { fprintf(stderr, "kernel_launch: hipFuncSetAttribute failed\n"); grid = -1; return; }
        (void)hipGetLastError();
        grid = cus;
    }
    if (grid < 0) return;
    (void)hipMemsetAsync((char*)d_ws + WS_CTL, 0, CTL_BYTES, stream);
    Args a{};
    for (int i = 0; i < 27; ++i) a.in[i] = (const float*)d_in[i];
    a.out = (float*)d_out; a.ws = (unsigned char*)d_ws;
#ifndef MK_SPLIT
#define MK_SPLIT 0
#endif
#if MK_SPLIT
    for (int p = 0; p < NPHASE; ++p) { a.ph_lo = p; a.ph_hi = p + 1; a.li = 0; hipLaunchKernelGGL(hybrid_fwd, dim3(grid), dim3(NTHR), LDS_BYTES, stream, a); }
#else
    a.ph_lo = 0; a.ph_hi = NPHASE; a.li = 0; hipLaunchKernelGGL(hybrid_fwd, dim3(grid), dim3(NTHR), LDS_BYTES, stream, a);
#endif
    const hipError_t le = hipPeekAtLastError();
    if (le != hipSuccess) fprintf(stderr, "kernel_launch: launch failed: %s\n", hipGetErrorName(le));
}
```

```cpp
#include <hip/hip_runtime.h>
#include <cstdio>
#include <cstdint>

constexpr int DM = 1024, NBATCH = 8, SEQ = 2048, NMETA = 16, TP = NMETA + SEQ  , DSEQ = 64, PAST = 4096, LS = PAST + DSEQ  ;
constexpr int RPR = NBATCH * TP  , RSR = NBATCH * DSEQ  , RR = RPR + RSR  , RPAD = 17152  ;
constexpr int YPR = NBATCH * SEQ  , YR = YPR + RSR  ;
constexpr int NIN = 7424  , DFF = 2816, NGU = 2 * DFF;
constexpr int SSD_H = 16, SSD_P = 64, SSD_G = 4, SSD_N = 128, CONV_DIM = 2048;
constexpr int NH = 8, NKV = 2, HD = 128, IDXH = 8, IDXD = 64, TOPK = 256;
constexpr float EPS = 1e-6f;
constexpr int SMLD = 96;

constexpr size_t O_YP = 0, O_YS = O_YP + (size_t)YPR * DM, O_KP = O_YS + (size_t)RSR * DM, O_VP = O_KP + (size_t)RPR * 256, O_KIP = O_VP + (size_t)RPR * 256,
                 O_SSMP = O_KIP + (size_t)RPR * 64, O_CVP = O_SSMP + (size_t)NBATCH * 16 * 64 * 128, O_KS = O_CVP + (size_t)NBATCH * 3 * CONV_DIM, O_VS = O_KS + (size_t)RSR * 256,
                 O_KIS = O_VS + (size_t)RSR * 256, O_SSMS = O_KIS + (size_t)RSR * 64, O_CVS = O_SSMS + (size_t)NBATCH * 16 * 64 * 128, O_END = O_CVS + (size_t)NBATCH * 3 * CONV_DIM;
static_assert(O_END == 29302784, "d_out size");
constexpr size_t DO_Q = 0, DO_QI = DO_Q + (size_t)RR * 1024 * 2, DO_CV = DO_QI + (size_t)RR * 512 * 2, DO_YEND = DO_CV + (size_t)NBATCH * PAST * 256 * 2;
static_assert(DO_YEND <= O_KP * 4, "y-region scratch");
constexpr size_t DO_HN = O_KP * 4;
static_assert(DO_HN + (size_t)RPAD * 1024 * 2 <= O_CVP * 4, "hn scratch in tail");

constexpr size_t al256(size_t x) { return (x + 255) / 256 * 256; }
constexpr size_t WS_CTL = 0, CTL_BYTES = 1u << 20;
constexpr size_t WS_WIN = CTL_BYTES, WS_WBS = WS_WIN + (size_t)NIN * 1024 * 2, WS_WBA = WS_WBS + 1024 * 1024 * 2, WS_WOUT = WS_WBA + 1024 * 1024 * 2, WS_WGU = WS_WOUT + 1024 * 1024 * 2,
                 WS_WDN = WS_WGU + (size_t)NGU * 1024 * 2, WS_Z = WS_WDN + (size_t)1024 * DFF * 2, WS_XS = WS_Z + (size_t)RR * 1024 * 2, WS_BC = WS_XS + (size_t)RR * 1024 * 2,
                 WS_GA = WS_BC + (size_t)RR * 1024 * 2, WS_GS = WS_GA + (size_t)RR * 1024 * 2, WS_K = WS_GS + (size_t)RR * 1024 * 2, WS_V = WS_K + (size_t)RR * 256 * 2,
                 WS_SM = WS_V + (size_t)RR * 256 * 2, WS_KI = WS_SM + (size_t)RR * SMLD * 4, WS_CK = WS_KI + (size_t)RR * 64 * 2, WS_MASK = WS_CK + (size_t)NBATCH * PAST * 256 * 2;
constexpr int MASK_LDP = 68, MASK_LDS = 132;
constexpr size_t WS_MASKS = WS_MASK + (size_t)RPR * MASK_LDP * 4, WS_SSQ1 = WS_MASKS + (size_t)RSR * MASK_LDS * 4, WS_SSQ2 = WS_SSQ1 + al256((size_t)RR * 4),
                 WS_PART = WS_SSQ2 + al256((size_t)YR * 4), WS_END = WS_PART + (size_t)32 * 256 * 132 * 4;
constexpr size_t WS_MERGED = WS_Z, WS_ACT = WS_XS, WS_HB = WS_GS, WS_HAL = WS_PART;
static_assert(WS_END <= 268435456, "d_ws map exceeds 256 MiB");
static_assert((size_t)YR * DFF * 2 <= WS_GS - WS_XS, "act overlay");
static_assert((size_t)NBATCH * 33 * 3 * CONV_DIM * 2 <= WS_END - WS_PART, "halo overlay");
constexpr int CW_TMO = 0, CW_BAR = 4096, CW_Q = 16384;

#define GAS __attribute__((address_space(1)))
#define LAS __attribute__((address_space(3)))
typedef unsigned short bf16_t;
typedef short bf16x8 __attribute__((ext_vector_type(8)));
typedef short s16x4 __attribute__((ext_vector_type(4)));
typedef float f32x4 __attribute__((ext_vector_type(4)));
typedef float f32x2 __attribute__((ext_vector_type(2)));
typedef float f32x16 __attribute__((ext_vector_type(16)));
typedef unsigned u32x4 __attribute__((ext_vector_type(4)));
typedef unsigned u32x2 __attribute__((ext_vector_type(2)));
typedef GAS unsigned gu32;
#define RLX_AGENT __ATOMIC_RELAXED, __HIP_MEMORY_SCOPE_AGENT
#define LDS_WAIT() asm volatile("s_waitcnt lgkmcnt(0)" ::: "memory")
#define VM_WAIT() asm volatile("s_waitcnt vmcnt(0)" ::: "memory")
__device__ __forceinline__ unsigned cvt_pk_bf16(float lo, float hi) { unsigned r; asm volatile("v_cvt_pk_bf16_f32 %0, %1, %2" : "=v"(r) : "v"(lo), "v"(hi)); return r; }
__device__ __forceinline__ float bf_lo(unsigned w) { return __uint_as_float(w << 16); }
__device__ __forceinline__ float bf_hi(unsigned w) { return __uint_as_float(w & 0xffff0000u); }
__device__ __forceinline__ float bf2f(bf16_t b) { return __uint_as_float((unsigned)b << 16); }
__device__ __forceinline__ bf16_t f2bf(float f) { return (bf16_t)(cvt_pk_bf16(f, 0.f) & 0xffffu); }
__device__ __forceinline__ float sigmoidf_(float x) { return __builtin_amdgcn_rcpf(1.f + __builtin_amdgcn_exp2f(-1.4426950408889634f * x)); }
__device__ __forceinline__ float siluf_(float x) { return x * sigmoidf_(x); }
__device__ __forceinline__ float wave_sum(float v) {
#pragma unroll
    for (int o = 1; o < 64; o <<= 1) v += __shfl_xor(v, o);
    return v;
}

#define XB_TMO      128
#define XB_XCNT(j)  (256  + 64 * (j))
#define XB_XSUB(j)  (1280 + 64 * (j))
#define XB_XGEN(j)  (2304 + 64 * (j))
#define XB_TOP      3328
#define XB_TOPGEN   3392
#define XCD_BAR_WORDS 3456
#define XB_SPIN_CAP (1u << 18)
__device__ __forceinline__ unsigned xb_ld(unsigned* p)              { return __hip_atomic_load(p, __ATOMIC_RELAXED, __HIP_MEMORY_SCOPE_AGENT); }
__device__ __forceinline__ unsigned xb_add(unsigned* p, unsigned v) { return __hip_atomic_fetch_add(p, v, __ATOMIC_RELAXED, __HIP_MEMORY_SCOPE_AGENT); }
__device__ __forceinline__ unsigned xb_xcc_id() { return (unsigned)__builtin_amdgcn_s_getreg((3 << 11) | 20) & 0xFu; }
#define XB_SPIN(cond, bar) do { unsigned _sp = 0; while (cond) { __builtin_amdgcn_s_sleep(1); \
    if ((++_sp & 255u) == 0u) { if (xb_ld(&(bar)[XB_TMO])) break; if (_sp > XB_SPIN_CAP) { atomicAdd(&(bar)[XB_TMO], 1u); break; } } } } while (0)
struct XcdBarrier { unsigned* bar; unsigned x; volatile LAS unsigned* st; };
__device__ __forceinline__ XcdBarrier xcd_barrier_post(unsigned* bar, volatile LAS unsigned* st) {
    XcdBarrier b; b.bar = bar; b.x = xb_xcc_id(); b.st = st;
    if (threadIdx.x == 0) (void)xb_add(&bar[XB_XCNT(b.x)], 1u);
    return b;
}
__device__ __forceinline__ void xcd_barrier_complete(unsigned* bar, unsigned x, unsigned& nloc, unsigned& nx) {
    const unsigned G = gridDim.x * gridDim.y * gridDim.z;
    unsigned sum, cnt, mine, sp = 0u;
    for (;;) {
        sum = 0u; cnt = 0u; mine = 0u;
#pragma unroll
        for (unsigned j = 0; j < 16; ++j) { const unsigned c = xb_ld(&bar[XB_XCNT(j)]); sum += c; cnt += (c > 0u) ? 1u : 0u; mine = (j == x) ? c : mine; }
        if (sum == G) break;
        __builtin_amdgcn_s_sleep(1);
        if ((++sp & 255u) == 0u) { if (xb_ld(&bar[XB_TMO])) break; if (sp > XB_SPIN_CAP) { atomicAdd(&bar[XB_TMO], 1u); break; } }
    }
    nloc = mine > 0u ? mine : 1u; nx = cnt > 0u ? cnt : 1u;
}
__device__ __forceinline__ void xcd_barrier(const XcdBarrier& b) {
    asm volatile("s_waitcnt vmcnt(0)" ::: "memory");
    __syncthreads();
    if (threadIdx.x == 0) {
        unsigned* bar = b.bar;
        __builtin_amdgcn_s_waitcnt(0);
        unsigned nloc = b.st[0], nx = b.st[1];
        if (nloc == 0u) { xcd_barrier_complete(bar, b.x, nloc, nx); b.st[0] = nloc; b.st[1] = nx; }
        const unsigned old = xb_add(&bar[XB_XSUB(b.x)], 1u);
        const unsigned gen = old / nloc;
        if (old + 1u == (gen + 1u) * nloc) {
            __builtin_amdgcn_fence(__ATOMIC_RELEASE, "agent");
            asm volatile("s_waitcnt vmcnt(0)" ::: "memory");
            const unsigned og = xb_add(&bar[XB_TOP], 1u);
            const unsigned tg = og / nx;
            if (og + 1u == (tg + 1u) * nx) xb_add(&bar[XB_TOPGEN], 1u);
            else XB_SPIN(xb_ld(&bar[XB_TOPGEN]) == tg, bar);
            __builtin_amdgcn_fence(__ATOMIC_ACQUIRE, "agent");
            xb_add(&bar[XB_XGEN(b.x)], 1u);
            asm volatile("s_waitcnt vmcnt(0)" ::: "memory");
        } else {
            XB_SPIN(xb_ld(&bar[XB_XGEN(b.x)]) == gen, bar);
            __builtin_amdgcn_fence(__ATOMIC_ACQUIRE, "agent");
            asm volatile("s_waitcnt vmcnt(0)" ::: "memory");
        }
    }
    __syncthreads();
}

namespace pg8 {
constexpr int BM = 256, BK = 64, HALF = 128, HTB = HALF * BK * 2, STAGE_BYTES = 8 * HTB, NXCD = 8, WGM = 8;
__host__ __device__ __forceinline__ int lds_byte(int r, int c) { const int st = (r >> 4) * 2 + (c >> 5), rr = r & 15, cc = c & 31, ob = rr * 64 + cc * 2; return st * 1024 + (ob ^ (((ob >> 9) & 1) << 5)); }
__host__ __device__ __forceinline__ void stage_rc(int b, int& R, int& C) { const int st = b / 1024, sb = b % 1024, swz = sb ^ (((sb >> 9) & 1) << 5); R = (st >> 1) * 16 + swz / 64; C = (st & 1) * 32 + (swz % 64) / 2; }
__host__ __device__ __forceinline__ int perm32(int rho) { const int n = rho >> 4, i = rho & 15; return 8 * (i >> 2) + 4 * n + (i & 3); }
struct Unit { int pm, pn, part; const char* A; const char* B; };
__device__ __forceinline__ void tile_of(int L, int nM, int nN, int& pm, int& pn) {
    const int nwg = nM * nN; int wgid = L; { const int q = nwg / NXCD, r = nwg % NXCD, xcd = wgid % NXCD, off = wgid / NXCD; wgid = (xcd < r ? xcd * (q + 1) : r * (q + 1) + (xcd - r) * q) + off; }
    const int nig = WGM * nN, gid = wgid / nig, fm = gid * WGM, gsz = (nM - fm) < WGM ? (nM - fm) : WGM;
    pm = fm + ((wgid % nig) % gsz); pn = (wgid % nig) / gsz;
}
typedef f32x4 Acc[2][2][4][2];
template <class Epi, class Sched>
__device__ __forceinline__ void gemm_phase(LAS unsigned char* lds, const int K, const Sched& S, const Epi& E) {
    const int tid = threadIdx.x, wid = __builtin_amdgcn_readfirstlane(tid >> 6), lane = tid & 63, wr = wid >> 2, wc = wid & 3, fr = lane & 15, fq = lane >> 4;
    const int nt = K / BK;
    unsigned voffA[2], voffB[2];
#pragma unroll
    for (int i = 0; i < 2; ++i) { int R, C; stage_rc(tid * 16 + i * 8192, R, C); const int Rb = Epi::PERM ? ((R & ~31) + perm32(R & 31)) : R;
        voffA[i] = (unsigned)(R * K + C) * 2u; voffB[i] = (unsigned)(Rb * K + C) * 2u; }
    const size_t kstep = (size_t)(BK * 2);
    const size_t hstep = (size_t)HALF * K * 2;
    const unsigned ldsw = (unsigned)wid * 1024u;
    const int aoff = lds_byte(wr * 64 + fr, fq * 8), boff = lds_byte(wc * 32 + fr, fq * 8);
#define PG8_SA(b, h) (((b) * 2 + (h)) * HTB)
#define PG8_SB(b, h) ((4 + (b) * 2 + (h)) * HTB)
#define PG8_STAGE(bufoff, gbase, voff) do { _Pragma("unroll") for (int _i = 0; _i < 2; ++_i) \
        __builtin_amdgcn_global_load_lds((const unsigned*)((const char*)(gbase) + (voff)[_i]), (LAS unsigned*)(lds + (bufoff) + ldsw + _i * 8192), 16, 0, 0); } while (0)
#define PG8_LDA(dst, b, h) do { _Pragma("unroll") for (int m = 0; m < 4; ++m) _Pragma("unroll") for (int k = 0; k < 2; ++k) dst[m][k] = *(const LAS bf16x8*)(lds + PG8_SA(b, h) + aoff + m * 2048 + k * 1024); } while (0)
#define PG8_LDB(dst, b, h) do { _Pragma("unroll") for (int n = 0; n < 2; ++n) _Pragma("unroll") for (int k = 0; k < 2; ++k) dst[n][k] = *(const LAS bf16x8*)(lds + PG8_SB(b, h) + boff + n * 2048 + k * 1024); } while (0)
#define PG8_MMA(ai, bj, At, Bt) do { __builtin_amdgcn_s_setprio(1); _Pragma("unroll") for (int m = 0; m < 4; ++m) _Pragma("unroll") for (int n = 0; n < 2; ++n) _Pragma("unroll") for (int k = 0; k < 2; ++k) \
        acc[ai][bj][m][n] = __builtin_amdgcn_mfma_f32_16x16x32_bf16(Bt[n][k], At[m][k], acc[ai][bj][m][n], 0, 0, 0); __builtin_amdgcn_s_setprio(0); } while (0)
#define PG8_WAIT_V(n) asm volatile("s_waitcnt vmcnt(" #n ")" ::: "memory")
#define PG8_WAIT_L(n) asm volatile("s_waitcnt lgkmcnt(" #n ")" ::: "memory")
#define PG8_BAR __builtin_amdgcn_s_barrier()
#define PG8_SCHED __builtin_amdgcn_sched_barrier(0)
    Unit cur, nxt; int ui = 0;
    if (!S.next(0, cur)) return;
    Acc acc;
#pragma unroll
    for (int a = 0; a < 2; ++a)
#pragma unroll
        for (int b = 0; b < 2; ++b)
#pragma unroll
            for (int m = 0; m < 4; ++m)
#pragma unroll
                for (int n = 0; n < 2; ++n) acc[a][b][m][n] = (f32x4){0.f, 0.f, 0.f, 0.f};
    bf16x8 At[4][2], B0[2][2], B1[2][2];
    const char* cA = cur.A; const char* cB = cur.B;
    PG8_STAGE(PG8_SB(0, 0), cB, voffB); PG8_STAGE(PG8_SB(0, 1), cB + hstep, voffB); PG8_STAGE(PG8_SA(0, 0), cA, voffA); PG8_STAGE(PG8_SA(0, 1), cA + hstep, voffA);
    if (wr == 1) PG8_BAR;
    PG8_WAIT_V(2); PG8_BAR;
    PG8_STAGE(PG8_SB(1, 0), cB + kstep, voffB); PG8_STAGE(PG8_SA(1, 0), cA + kstep, voffA); PG8_STAGE(PG8_SB(1, 1), cB + hstep + kstep, voffB);
    PG8_WAIT_V(6); PG8_BAR;
    for (;;) {
        const bool has_next = S.next(ui + 1, nxt);
        const char* nA = has_next ? nxt.A : cA; const char* nB = has_next ? nxt.B : cB;
        for (int t = 0; t < nt; t += 2) {
            const bool last = (t == nt - 2);
            const char* a1 = cA + (size_t)(t + 1) * kstep;
            const char* a2 = last ? nA : cA + (size_t)(t + 2) * kstep; const char* b2 = last ? nB : cB + (size_t)(t + 2) * kstep;
            const char* a3 = a2 + kstep; const char* b3 = b2 + kstep;
            PG8_LDB(B0, 0, 0); PG8_LDB(B1, 0, 1); PG8_SCHED; PG8_LDA(At, 0, 0); PG8_STAGE(PG8_SA(1, 1), a1 + hstep, voffA);
            PG8_WAIT_V(8); PG8_WAIT_L(0); PG8_BAR; PG8_MMA(0, 0, At, B0); PG8_MMA(0, 1, At, B1); PG8_BAR; PG8_SCHED;
            PG8_LDA(At, 0, 1); PG8_STAGE(PG8_SB(0, 0), b2, voffB); PG8_STAGE(PG8_SB(0, 1), b2 + hstep, voffB); PG8_STAGE(PG8_SA(0, 0), a2, voffA);
            PG8_WAIT_V(8); PG8_WAIT_L(0); PG8_BAR; PG8_MMA(1, 0, At, B0); PG8_MMA(1, 1, At, B1); PG8_BAR; PG8_SCHED;
            PG8_LDB(B0, 1, 0); PG8_LDB(B1, 1, 1); PG8_SCHED; PG8_LDA(At, 1, 0); PG8_STAGE(PG8_SA(0, 1), a2 + hstep, voffA);
            PG8_WAIT_V(8); PG8_WAIT_L(0); PG8_BAR; PG8_MMA(0, 0, At, B0); PG8_MMA(0, 1, At, B1); PG8_BAR; PG8_SCHED;
            PG8_LDA(At, 1, 1); PG8_STAGE(PG8_SB(1, 0), b3, voffB); PG8_STAGE(PG8_SB(1, 1), b3 + hstep, voffB); PG8_STAGE(PG8_SA(1, 0), a3, voffA);
            PG8_WAIT_V(8); PG8_WAIT_L(0); PG8_BAR; PG8_MMA(1, 0, At, B0); PG8_MMA(1, 1, At, B1); PG8_BAR; PG8_SCHED;
        }
        if (wr == 0) PG8_BAR;
        const bool keep = E(acc, cur, wr, wc, fr, fq);
        if (!has_next) break;
        if (!keep) {
#pragma unroll
            for (int a = 0; a < 2; ++a)
#pragma unroll
                for (int b = 0; b < 2; ++b)
#pragma unroll
                    for (int m = 0; m < 4; ++m)
#pragma unroll
                        for (int n = 0; n < 2; ++n) acc[a][b][m][n] = (f32x4){0.f, 0.f, 0.f, 0.f};
        }
        cur = nxt; cA = nA; cB = nB; ++ui;
        if (wr == 1) PG8_BAR;
    }
    PG8_WAIT_V(0);
    PG8_BAR;
#undef PG8_SA
#undef PG8_SB
#undef PG8_STAGE
#undef PG8_LDA
#undef PG8_LDB
#undef PG8_MMA
#undef PG8_WAIT_V
#undef PG8_WAIT_L
#undef PG8_BAR
#undef PG8_SCHED
}
}

struct Args { const float* in[27]; float* out; unsigned char* ws; int ph_lo, ph_hi, li, pad; };
constexpr int NWAVES = 8, NTHR = 512;
constexpr int RING_BYTES = 131072, LDS_BYTES = 147456, MISC_OFF = LDS_BYTES - 256;

struct Frame {
    LAS unsigned char* lds; volatile LAS unsigned* MISC; gu32* ctl;
    int tid, lane, wave, vcu, G;
    const float* const* in; float* out; unsigned char* ws; unsigned char* ob;
};

__device__ __forceinline__ int win_src(int n) {
    if (n < 3072) return n;
    if (n < 4096) return 3088 + (n - 3072);
    if (n < 4352) return 4112 + (n - 4096);
    if (n < 4608) return 4368 + (n - 4352);
    if (n < 5120) return 4624 + (n - 4608);
    if (n < 6144) return 5208 + (n - 5120);
    if (n < 7168) return 6232 + (n - 6144);
    if (n < 7184) return 3072 + (n - 7168);
    if (n < 7248) return 5136 + (n - 7184);
    if (n < 7256) return 5200 + (n - 7248);
    return -1;
}
template <class SrcFn>
__device__ __forceinline__ void p0_transpose_item(SrcFn src, int ldw, int Kdim, bf16_t* WT, LAS float* scr, int kb, int nb, int lane) {
    const int k0 = 64 * kb, n0 = 32 * nb;
    const float* cp = src(n0 + (lane & 31));
#pragma unroll 8
    for (int i = 0; i < 32; ++i) { const int kk = 2 * i + (lane >> 5); scr[kk * 33 + (lane & 31)] = cp ? cp[(size_t)(k0 + kk) * ldw] : 0.f; }
    LDS_WAIT(); asm volatile("" ::: "memory");
    const int c = lane & 7;
#pragma unroll
    for (int j = 0; j < 4; ++j) { const int n = (lane >> 3) + 8 * j; const LAS float* s = scr + (8 * c) * 33 + n;
        u32x4 o; o.x = cvt_pk_bf16(s[0 * 33], s[1 * 33]); o.y = cvt_pk_bf16(s[2 * 33], s[3 * 33]); o.z = cvt_pk_bf16(s[4 * 33], s[5 * 33]); o.w = cvt_pk_bf16(s[6 * 33], s[7 * 33]);
        *(GAS u32x4*)(WT + (size_t)(n0 + n) * Kdim + k0 + 8 * c) = o; }
    LDS_WAIT(); asm volatile("" ::: "memory");
}
__device__ __forceinline__ void p0_prologue(Frame& F) {
    LAS float* scr = (LAS float*)(F.lds + F.wave * 16384);
    const int gw = F.vcu * NWAVES + F.wave, NGW = F.G * NWAVES, lane = F.lane;
    const float* w_in = F.in[10]; const float* w_bs = F.in[20]; const float* w_ba = F.in[21]; const float* w_out = F.in[22];
    const float* w_gate = F.in[24]; const float* w_up = F.in[25]; const float* w_dn = F.in[26];
    bf16_t* WIN = (bf16_t*)(F.ws + WS_WIN); bf16_t* WBS = (bf16_t*)(F.ws + WS_WBS); bf16_t* WBA = (bf16_t*)(F.ws + WS_WBA); bf16_t* WOUT = (bf16_t*)(F.ws + WS_WOUT);
    bf16_t* WGU = (bf16_t*)(F.ws + WS_WGU); bf16_t* WDN = (bf16_t*)(F.ws + WS_WDN);
    constexpr int I_IN = 16 * (NIN / 32), I_SQ = 16 * 32, I_GU = 16 * (NGU / 32), I_DN = (DFF / 64) * 32;
    constexpr int NITEMS = I_IN + 3 * I_SQ + I_GU + I_DN;
    for (int it = gw; it < NITEMS; it += NGW) {
        int r = it;
        if (r < I_IN) { const int nb = r % (NIN / 32), kb = r / (NIN / 32);
            p0_transpose_item([&](int n) -> const float* { const int s = win_src(n); return s >= 0 ? w_in + s : nullptr; }, 7256, 1024, WIN, scr, kb, nb, lane); continue; } r -= I_IN;
        if (r < I_SQ) { p0_transpose_item([&](int n) -> const float* { return w_bs + n; }, 1024, 1024, WBS, scr, r / 32, r % 32, lane); continue; } r -= I_SQ;
        if (r < I_SQ) { p0_transpose_item([&](int n) -> const float* { return w_ba + n; }, 1024, 1024, WBA, scr, r / 32, r % 32, lane); continue; } r -= I_SQ;
        if (r < I_SQ) { p0_transpose_item([&](int n) -> const float* { return w_out + n; }, 1024, 1024, WOUT, scr, r / 32, r % 32, lane); continue; } r -= I_SQ;
        if (r < I_GU) { const int nb = r % (NGU / 32), kb = r / (NGU / 32);
            p0_transpose_item([&](int n) -> const float* { const int t = n >> 8, j = n & 255, ch = t * 128 + (j >> 3) * 4 + (j & 3); return ((j & 4) ? w_up : w_gate) + ch; }, DFF, 1024, WGU, scr, kb, nb, lane); continue; } r -= I_GU;
        p0_transpose_item([&](int n) -> const float* { return w_dn + n; }, 1024, DFF, WDN, scr, r / 32, r % 32, lane);
    }
    const float* xp = F.in[0]; const float* xs = F.in[1]; const float* meta = F.in[7]; const float* n1w = F.in[9];
    bf16_t* HN = (bf16_t*)(F.ob + DO_HN);
    f32x4 wv[4];
#pragma unroll
    for (int j = 0; j < 4; ++j) wv[j] = *((const f32x4*)n1w + lane + 64 * j);
    for (int m = gw; m < RPAD; m += NGW) {
        GAS u32x2* o8 = (GAS u32x2*)(HN + (size_t)m * DM) + lane;
        if (m >= RR) {
#pragma unroll
            for (int j = 0; j < 4; ++j) o8[64 * j] = (u32x2){0u, 0u};
            continue; }
        const float* xrow;
        if (m < RPR) { const int b = m / TP, t = m - b * TP; xrow = t < NMETA ? meta + (size_t)t * DM : xp + ((size_t)b * SEQ + (t - NMETA)) * DM; }
        else xrow = xs + (size_t)(m - RPR) * DM;
        const f32x4* xr = (const f32x4*)xrow + lane;
        f32x4 v[4]; float s = 0.f;
#pragma unroll
        for (int j = 0; j < 4; ++j) { v[j] = xr[64 * j]; s += (v[j].x * v[j].x + v[j].y * v[j].y) + (v[j].z * v[j].z + v[j].w * v[j].w); }
        const float rs = __builtin_amdgcn_rsqf(wave_sum(s) * (1.f / DM) + EPS);
#pragma unroll
        for (int j = 0; j < 4; ++j) { const f32x4 y = v[j] * rs * wv[j]; o8[64 * j] = (u32x2){cvt_pk_bf16(y.x, y.y), cvt_pk_bf16(y.z, y.w)}; }
    }
    { const f32x4* ck = (const f32x4*)F.in[2]; const f32x4* cv = (const f32x4*)F.in[3]; GAS u32x4* ok = (GAS u32x4*)(F.ws + WS_CK); GAS u32x4* ov = (GAS u32x4*)(F.ob + DO_CV);
      const long n8 = (long)NBATCH * PAST * 256 / 8; const long gt = (long)F.vcu * NTHR + F.tid, GT = (long)F.G * NTHR;
      for (long i = gt; i < 2 * n8; i += GT) { const bool isk = i < n8; const long j = isk ? i : i - n8; const f32x4* s = (isk ? ck : cv) + 2 * j;
          const f32x4 a = s[0], b = s[1]; u32x4 o; o.x = cvt_pk_bf16(a.x, a.y); o.y = cvt_pk_bf16(a.z, a.w); o.z = cvt_pk_bf16(b.x, b.y); o.w = cvt_pk_bf16(b.z, b.w);
          (isk ? ok : ov)[j] = o; } }
    { float* s1 = (float*)(F.ws + WS_SSQ1); const int gt = F.vcu * NTHR + F.tid, GT = F.G * NTHR;
      for (int i = gt; i < (int)((WS_PART - WS_SSQ1) / 4); i += GT) s1[i] = 0.f; }
}

struct SchedP1 {
    const char* A; const char* B; int G, c;
    __device__ __forceinline__ bool next(int i, pg8::Unit& u) const {
        const int L = i * G + c; if (L >= 67 * 29) return false;
        pg8::tile_of(L, 67, 29, u.pm, u.pn); u.part = 0; u.A = A + (size_t)u.pm * 256 * 1024 * 2; u.B = B + (size_t)u.pn * 256 * 1024 * 2; return true; }
};
struct EpiP1 {
    static constexpr bool PERM = true;
    unsigned char* ws; unsigned char* ob;
    __device__ __forceinline__ bool operator()(pg8::Acc& acc, const pg8::Unit& u, int wr, int wc, int fr, int fq) const {
        const int pn = u.pn; const int row0 = u.pm * 256 + wr * 64 + fr, cw = wc * 32 + 8 * fq;
        if (pn == 28) {
            float* SM = (float*)(ws + WS_SM);
            if (cw < SMLD) {
#pragma unroll
                for (int ai = 0; ai < 2; ++ai)
#pragma unroll
                    for (int m = 0; m < 4; ++m) { const int r = row0 + ai * 128 + m * 16; if (r < RR) { float* p = SM + (size_t)r * SMLD + cw; *(f32x4*)p = acc[ai][0][m][0]; *(f32x4*)(p + 4) = acc[ai][0][m][1]; } }
            }
            return false;
        }
        bf16_t* base; int ld, c0;
        if (pn < 4) { base = (bf16_t*)(ws + WS_Z); ld = 1024; c0 = pn * 256; }
        else if (pn < 8) { base = (bf16_t*)(ws + WS_XS); ld = 1024; c0 = (pn - 4) * 256; }
        else if (pn < 12) { base = (bf16_t*)(ws + WS_BC); ld = 1024; c0 = (pn - 8) * 256; }
        else if (pn < 16) { base = (bf16_t*)(ob + DO_Q); ld = 1024; c0 = (pn - 12) * 256; }
        else if (pn == 16) { base = (bf16_t*)(ws + WS_K); ld = 256; c0 = 0; }
        else if (pn == 17) { base = (bf16_t*)(ws + WS_V); ld = 256; c0 = 0; }
        else if (pn < 20) { base = (bf16_t*)(ob + DO_QI); ld = 512; c0 = (pn - 18) * 256; }
        else if (pn < 24) { base = (bf16_t*)(ws + WS_GS); ld = 1024; c0 = (pn - 20) * 256; }
        else { base = (bf16_t*)(ws + WS_GA); ld = 1024; c0 = (pn - 24) * 256; }
#pragma unroll
        for (int ai = 0; ai < 2; ++ai)
#pragma unroll
            for (int m = 0; m < 4; ++m) { const int r = row0 + ai * 128 + m * 16;
                if (r < RR) { bf16_t* rowp = base + (size_t)r * ld + c0 + cw;
#pragma unroll
                    for (int bj = 0; bj < 2; ++bj) { const f32x4 v0 = acc[ai][bj][m][0], v1 = acc[ai][bj][m][1];
                        u32x4 w; w.x = cvt_pk_bf16(v0[0], v0[1]); w.y = cvt_pk_bf16(v0[2], v0[3]); w.z = cvt_pk_bf16(v1[0], v1[1]); w.w = cvt_pk_bf16(v1[2], v1[3]);
                        *(u32x4*)(rowp + bj * 128) = w; } } }
        return false;
    }
};

__device__ __forceinline__ void p2_rows(Frame& F) {
    const int gw = F.vcu * NWAVES + F.wave, NGW = F.G * NWAVES, lane = F.lane;
    bf16_t* Q = (bf16_t*)(F.ob + DO_Q); bf16_t* K = (bf16_t*)(F.ws + WS_K); const bf16_t* V = (const bf16_t*)(F.ws + WS_V);
    float* SM = (float*)(F.ws + WS_SM); bf16_t* KI = (bf16_t*)(F.ws + WS_KI);
    const float* qnw = F.in[17]; const float* knw = F.in[18]; const float* ikw = F.in[19]; const float* dtb = F.in[13];
    f32x4 qw[4];
#pragma unroll
    for (int j = 0; j < 4; ++j) qw[j] = *(const f32x4*)(qnw + (lane & 7) * 16 + 4 * j);
    const f32x4 kw = *(const f32x4*)(knw + (lane & 31) * 4);
    const float iw = ikw[lane]; const float dbias = lane < 16 ? dtb[lane] : 0.f;
    constexpr float QSC = 0.08838834764831845f * 1.4426950408889634f;
    for (int r = gw; r < RR; r += NGW) {
        const bool pr = r < RPR; const size_t orow = pr ? (size_t)r : (size_t)(r - RPR);
        float* k_out = F.out + (pr ? O_KP : O_KS) + orow * 256; float* v_out = F.out + (pr ? O_VP : O_VS) + orow * 256; float* ki_out = F.out + (pr ? O_KIP : O_KIS) + orow * 64;
        { u32x4* qp = (u32x4*)(Q + (size_t)r * 1024) + lane * 2; const u32x4 a = qp[0], b = qp[1];
          float x[16]; x[0] = bf_lo(a.x); x[1] = bf_hi(a.x); x[2] = bf_lo(a.y); x[3] = bf_hi(a.y); x[4] = bf_lo(a.z); x[5] = bf_hi(a.z); x[6] = bf_lo(a.w); x[7] = bf_hi(a.w);
          x[8] = bf_lo(b.x); x[9] = bf_hi(b.x); x[10] = bf_lo(b.y); x[11] = bf_hi(b.y); x[12] = bf_lo(b.z); x[13] = bf_hi(b.z); x[14] = bf_lo(b.w); x[15] = bf_hi(b.w);
          float s = 0.f;
#pragma unroll
          for (int j = 0; j < 16; ++j) s += x[j] * x[j];
          s += __shfl_xor(s, 1); s += __shfl_xor(s, 2); s += __shfl_xor(s, 4);
          const float rs = __builtin_amdgcn_rsqf(s * (1.f / HD) + EPS) * QSC;
#pragma unroll
          for (int j = 0; j < 16; ++j) x[j] = x[j] * rs * qw[j >> 2][j & 3];
          u32x4 oa, ob; oa.x = cvt_pk_bf16(x[0], x[1]); oa.y = cvt_pk_bf16(x[2], x[3]); oa.z = cvt_pk_bf16(x[4], x[5]); oa.w = cvt_pk_bf16(x[6], x[7]);
          ob.x = cvt_pk_bf16(x[8], x[9]); ob.y = cvt_pk_bf16(x[10], x[11]); ob.z = cvt_pk_bf16(x[12], x[13]); ob.w = cvt_pk_bf16(x[14], x[15]);
          qp[0] = oa; qp[1] = ob; }
        { u32x2* kp = (u32x2*)(K + (size_t)r * 256) + lane; const u32x2 a = *kp;
          f32x4 x = {bf_lo(a.x), bf_hi(a.x), bf_lo(a.y), bf_hi(a.y)};
          float s = (x.x * x.x + x.y * x.y) + (x.z * x.z + x.w * x.w);
          s += __shfl_xor(s, 1); s += __shfl_xor(s, 2); s += __shfl_xor(s, 4); s += __shfl_xor(s, 8); s += __shfl_xor(s, 16);
          const float rs = __builtin_amdgcn_rsqf(s * (1.f / HD) + EPS);
          x = x * rs * kw;
          *kp = (u32x2){cvt_pk_bf16(x.x, x.y), cvt_pk_bf16(x.z, x.w)};
          *((f32x4*)k_out + lane) = x;
          const u32x2 vv = *((const u32x2*)(V + (size_t)r * 256) + lane);
          *((f32x4*)v_out + lane) = (f32x4){bf_lo(vv.x), bf_hi(vv.x), bf_lo(vv.y), bf_hi(vv.y)}; }
        { float* sm = SM + (size_t)r * SMLD;
          const float kv = sm[16 + lane]; const float ss = wave_sum(kv * kv);
          const float kn = kv * __builtin_amdgcn_rsqf(ss * (1.f / IDXD) + EPS) * iw;
          KI[(size_t)r * 64 + lane] = f2bf(kn); ki_out[lane] = kn;
          if (lane < 16) { const float x = sm[lane] + dbias; sm[lane] = x > 20.f ? x : log1pf(expf(x)); }
          if (lane < 8) sm[80 + lane] *= 0.04419417382415922f; }
    }
    { const bf16_t* XS = (const bf16_t*)(F.ws + WS_XS); const bf16_t* BC = (const bf16_t*)(F.ws + WS_BC); bf16_t* HAL = (bf16_t*)(F.ws + WS_HAL);
      for (int it = gw; it < 48 + 768; it += NGW) {
          if (it < 48) { const int s = it / 3, i = it % 3; const int r = s < 8 ? s * TP + (TP - 3 + i) : RPR + (s - 8) * DSEQ + (DSEQ - 3 + i);
              float* o = F.out + (s < 8 ? O_CVP + (size_t)(s * 3 + i) * CONV_DIM : O_CVS + (size_t)((s - 8) * 3 + i) * CONV_DIM);
#pragma unroll
              for (int j = 0; j < 4; ++j) { const int c = j * 256 + lane * 4;
                  const u32x2 a = *(const u32x2*)(XS + (size_t)r * 1024 + c); *(f32x4*)(o + c) = (f32x4){bf_lo(a.x), bf_hi(a.x), bf_lo(a.y), bf_hi(a.y)};
                  const u32x2 b = *(const u32x2*)(BC + (size_t)r * 1024 + c); *(f32x4*)(o + 1024 + c) = (f32x4){bf_lo(b.x), bf_hi(b.x), bf_lo(b.y), bf_hi(b.y)}; } }
          else { const int h = it - 48, b = h / 96, jb = (h % 96) / 3, i = h % 3; const int r = b * TP + 64 * (jb + 1) - 3 + i;
              bf16_t* o = HAL + (size_t)((b * 33 + jb + 1) * 3 + i) * CONV_DIM;
#pragma unroll
              for (int j = 0; j < 2; ++j) { const int c = j * 512 + lane * 8;
                  *(u32x4*)(o + c) = *(const u32x4*)(XS + (size_t)r * 1024 + c); *(u32x4*)(o + 1024 + c) = *(const u32x4*)(BC + (size_t)r * 1024 + c); } }
      } }
}

__device__ __forceinline__ int t5_bucket(int rel) {
    const int n = rel < 0 ? -rel : rel; const int ret = rel > 0 ? 16 : 0;
    const int v = n < 8 ? n : (n < 12 ? 8 : n < 16 ? 9 : n < 23 ? 10 : n < 32 ? 11 : n < 46 ? 12 : n < 64 ? 13 : n < 91 ? 14 : 15);
    return ret + v;
}
__device__ __forceinline__ void ssd_slow(Frame& F) {
    if (F.wave != 0) return;
    const int lane = F.lane;
    bf16_t* XS = (bf16_t*)(F.ws + WS_XS); const bf16_t* BC = (const bf16_t*)(F.ws + WS_BC); const bf16_t* Z = (const bf16_t*)(F.ws + WS_Z);
    const float* SM = (const float*)(F.ws + WS_SM); float* SSQ1 = (float*)(F.ws + WS_SSQ1);
    const float* conv_w = F.in[11]; const float* conv_b = F.in[12]; const float* a_log = F.in[14]; const float* d_skip = F.in[15]; const float* snw = F.in[16];
    const float* st_ssm = F.in[5]; const float* st_conv = F.in[6];
    LAS float* sbc = (LAS float*)F.lds;
    for (int item = F.vcu; item < 256; item += F.G) {
        const bool pr = item < 128; const int bh = item & 127, b = bh >> 4, h = bh & 15, g = h >> 2;
        const int T = pr ? TP : DSEQ; const int row0 = pr ? b * TP : RPR + b * DSEQ;
        const int xch = h * 64 + lane;
        const int bcc = lane < 32 ? g * 128 + 4 * lane : 512 + g * 128 + 4 * (lane - 32);
        float wx[4], bx; f32x4 wb[4], bb;
#pragma unroll
        for (int i = 0; i < 4; ++i) { wx[i] = conv_w[i * CONV_DIM + xch]; wb[i] = *(const f32x4*)(conv_w + i * CONV_DIM + 1024 + bcc); }
        bx = conv_b[xch]; bb = *(const f32x4*)(conv_b + 1024 + bcc);
        float xp[3]; f32x4 bp[3];
#pragma unroll
        for (int i = 0; i < 3; ++i) { if (pr) { xp[i] = 0.f; bp[i] = (f32x4){0.f, 0.f, 0.f, 0.f}; } else { xp[i] = st_conv[(size_t)(b * 3 + i) * CONV_DIM + xch]; bp[i] = *(const f32x4*)(st_conv + (size_t)(b * 3 + i) * CONV_DIM + 1024 + bcc); } }
        float hs[128];
        float* sout = F.out + (pr ? O_SSMP : O_SSMS) + ((size_t)(b * 16 + h) * 64 + lane) * 128;
        if (pr) {
#pragma unroll
            for (int n = 0; n < 128; ++n) hs[n] = 0.f;
        } else { const float* sp = st_ssm + ((size_t)(b * 16 + h) * 64 + lane) * 128;
#pragma unroll
            for (int n = 0; n < 128; n += 4) { const f32x4 v = *(const f32x4*)(sp + n); hs[n] = v.x; hs[n + 1] = v.y; hs[n + 2] = v.z; hs[n + 3] = v.w; } }
        const float a_h = -expf(a_log[h]), dsk = d_skip[h], nw = snw[xch];
        for (int t = 0; t < T; ++t) {
            const size_t r = (size_t)(row0 + t);
            const float xr = bf2f(XS[r * 1024 + xch]);
            const u32x2 bcr = *(const u32x2*)(BC + r * 1024 + bcc);
            const f32x4 br = {bf_lo(bcr.x), bf_hi(bcr.x), bf_lo(bcr.y), bf_hi(bcr.y)};
            const float zv = bf2f(Z[r * 1024 + xch]);
            const float dt = SM[r * SMLD + h];
            float xc = bx + xp[0] * wx[0] + xp[1] * wx[1] + xp[2] * wx[2] + xr * wx[3];
            f32x4 bc = bb + bp[0] * wb[0] + bp[1] * wb[1] + bp[2] * wb[2] + br * wb[3];
            xp[0] = xp[1]; xp[1] = xp[2]; xp[2] = xr; bp[0] = bp[1]; bp[1] = bp[2]; bp[2] = br;
            xc = siluf_(xc); bc.x = siluf_(bc.x); bc.y = siluf_(bc.y); bc.z = siluf_(bc.z); bc.w = siluf_(bc.w);
            *(LAS f32x4*)(sbc + 4 * lane) = bc;
            LDS_WAIT(); asm volatile("" ::: "memory");
            const float dA = expf(dt * a_h), dx = dt * xc;
            float y = 0.f;
#pragma unroll
            for (int n = 0; n < 128; n += 4) { const f32x4 Bv = *(const LAS f32x4*)(sbc + n); const f32x4 Cv = *(const LAS f32x4*)(sbc + 128 + n);
                hs[n] = hs[n] * dA + dx * Bv.x; y += Cv.x * hs[n];
                hs[n + 1] = hs[n + 1] * dA + dx * Bv.y; y += Cv.y * hs[n + 1];
                hs[n + 2] = hs[n + 2] * dA + dx * Bv.z; y += Cv.z * hs[n + 2];
                hs[n + 3] = hs[n + 3] * dA + dx * Bv.w; y += Cv.w * hs[n + 3]; }
            LDS_WAIT(); asm volatile("" ::: "memory");
            y = (y + dsk * xc) * siluf_(zv);
            const float ss = wave_sum(y * y);
            if (lane == 0) atomicAdd(SSQ1 + r, ss);
            XS[r * 1024 + xch] = f2bf(y * nw);
        }
#pragma unroll
        for (int n = 0; n < 128; n += 4) *(f32x4*)(sout + n) = (f32x4){hs[n], hs[n + 1], hs[n + 2], hs[n + 3]};
    }
}

template <bool PR>
__device__ __forceinline__ void attn_slow_query(Frame& F, int r, LAS unsigned char* wl) {
    const int lane = F.lane;
    bf16_t* Q = (bf16_t*)(F.ob + DO_Q); const bf16_t* QI = (const bf16_t*)(F.ob + DO_QI); const bf16_t* KI = (const bf16_t*)(F.ws + WS_KI);
    const bf16_t* Kb = (const bf16_t*)(F.ws + WS_K); const bf16_t* Vb = (const bf16_t*)(F.ws + WS_V); const bf16_t* CK = (const bf16_t*)(F.ws + WS_CK); const bf16_t* CV = (const bf16_t*)(F.ob + DO_CV);
    const float* SM = (const float*)(F.ws + WS_SM); const float* ckidx = F.in[4]; const float* relb = F.in[8];
    int b, tq, L, qpos, krow0;
    if (PR) { b = r / TP; tq = r - b * TP; const int qc = (tq - NMETA) / 64 + 1; L = NMETA + 64 * qc; qpos = tq; krow0 = b * TP; }
    else { b = (r - RPR) / DSEQ; tq = (r - RPR) - b * DSEQ; L = LS; qpos = PAST + tq; krow0 = RPR + b * DSEQ; }
    LAS float* qf = (LAS float*)wl;
    LAS unsigned* list = (LAS unsigned*)(wl + 2048);
    LAS float* pl = (LAS float*)(wl + 3072);
    LAS unsigned* keys = (LAS unsigned*)(wl + 7168);
    const int ni = (L + 63) >> 6;
    int nsel = 0;
    { const unsigned* mrow = r < RPR ? (const unsigned*)(F.ws + WS_MASK) + (size_t)r * MASK_LDP : (const unsigned*)(F.ws + WS_MASKS) + (size_t)(r - RPR) * MASK_LDS;
      const unsigned long long lt_mask = (1ull << lane) - 1ull;
#pragma unroll 1
      for (int i = 0; i < ni; ++i) { const unsigned wd = mrow[2 * i + (lane >> 5)]; const bool sel = (wd >> (lane & 31)) & 1u; const unsigned long long ms = __ballot(sel);
          if (sel && nsel + __popcll(ms & lt_mask) < TOPK) list[nsel + __popcll(ms & lt_mask)] = (unsigned)(i * 64 + lane);
          nsel += __popcll(ms); }
      if (nsel > TOPK) nsel = TOPK; }
    (void)SM; (void)QI; (void)KI; (void)ckidx; (void)keys;
    LDS_WAIT(); asm volatile("" ::: "memory");
#pragma unroll 1
    for (int g = 0; g < 2; ++g) {
        { const u32x4 a = *((const u32x4*)(Q + (size_t)r * 1024 + g * 512) + lane);
          LAS float* d = qf + lane * 8; d[0] = bf_lo(a.x); d[1] = bf_hi(a.x); d[2] = bf_lo(a.y); d[3] = bf_hi(a.y); d[4] = bf_lo(a.z); d[5] = bf_hi(a.z); d[6] = bf_lo(a.w); d[7] = bf_hi(a.w); }
        LDS_WAIT(); asm volatile("" ::: "memory");
        float mx[4] = {-1e30f, -1e30f, -1e30f, -1e30f};
        const int njj = (nsel + 63) >> 6;
#pragma unroll 1
        for (int jj = 0; jj < njj; ++jj) { const int j = jj * 64 + lane;
            const int s = j < nsel ? (int)list[j] : (int)list[0];
            const bf16_t* kp = (!PR && s < PAST) ? CK + ((size_t)b * PAST + s) * 256 + g * 128 : Kb + (size_t)(PR ? krow0 + s : krow0 + s - PAST) * 256 + g * 128;
            float d0 = 0.f, d1 = 0.f, d2 = 0.f, d3 = 0.f;
#pragma unroll 1
            for (int c = 0; c < 16; ++c) { const u32x4 v = *((const u32x4*)kp + c);
                const float k0 = bf_lo(v.x), k1 = bf_hi(v.x), k2 = bf_lo(v.y), k3 = bf_hi(v.y), k4 = bf_lo(v.z), k5 = bf_hi(v.z), k6 = bf_lo(v.w), k7 = bf_hi(v.w);
#define DOT8(hh, acc) { const f32x4 qa = *(const LAS f32x4*)(qf + hh * 128 + c * 8), qb = *(const LAS f32x4*)(qf + hh * 128 + c * 8 + 4); \
                    acc += qa.x * k0 + qa.y * k1 + qa.z * k2 + qa.w * k3 + qb.x * k4 + qb.y * k5 + qb.z * k6 + qb.w * k7; }
                DOT8(0, d0) DOT8(1, d1) DOT8(2, d2) DOT8(3, d3)
#undef DOT8
            }
            const int bk = t5_bucket(s - qpos);
            const f32x4 bv = *(const f32x4*)(relb + bk * 8 + g * 4);
            constexpr float L2E = 1.4426950408889634f;
            const bool ok = j < nsel;
            f32x4 lgv; lgv.x = ok ? d0 + bv.x * L2E : -1e30f; lgv.y = ok ? d1 + bv.y * L2E : -1e30f; lgv.z = ok ? d2 + bv.z * L2E : -1e30f; lgv.w = ok ? d3 + bv.w * L2E : -1e30f;
            *(LAS f32x4*)(pl + j * 4) = lgv;
            mx[0] = fmaxf(mx[0], lgv.x); mx[1] = fmaxf(mx[1], lgv.y); mx[2] = fmaxf(mx[2], lgv.z); mx[3] = fmaxf(mx[3], lgv.w);
        }
        float sm[4] = {0.f, 0.f, 0.f, 0.f};
#pragma unroll
        for (int h = 0; h < 4; ++h) {
#pragma unroll
            for (int o = 1; o < 64; o <<= 1) mx[h] = fmaxf(mx[h], __shfl_xor(mx[h], o)); }
        LDS_WAIT(); asm volatile("" ::: "memory");
#pragma unroll 1
        for (int jj = 0; jj < njj; ++jj) { const int j = jj * 64 + lane;
            f32x4 lgv = *(const LAS f32x4*)(pl + j * 4);
            lgv.x = __builtin_amdgcn_exp2f(lgv.x - mx[0]); lgv.y = __builtin_amdgcn_exp2f(lgv.y - mx[1]); lgv.z = __builtin_amdgcn_exp2f(lgv.z - mx[2]); lgv.w = __builtin_amdgcn_exp2f(lgv.w - mx[3]);
            sm[0] += lgv.x; sm[1] += lgv.y; sm[2] += lgv.z; sm[3] += lgv.w;
            *(LAS f32x4*)(pl + j * 4) = lgv; }
#pragma unroll
        for (int h = 0; h < 4; ++h) sm[h] = __builtin_amdgcn_rcpf(wave_sum(sm[h]));
        LDS_WAIT(); asm volatile("" ::: "memory");
        float o[4][2] = {};
        for (int j = 0; j < nsel; ++j) {
            const int s = (int)list[j]; const f32x4 p = *(const LAS f32x4*)(pl + j * 4);
            const bf16_t* vp = (!PR && s < PAST) ? CV + ((size_t)b * PAST + s) * 256 + g * 128 : Vb + (size_t)(PR ? krow0 + s : krow0 + s - PAST) * 256 + g * 128;
            const unsigned vv = *((const unsigned*)vp + lane); const float v0 = bf_lo(vv), v1 = bf_hi(vv);
            o[0][0] += p.x * v0; o[0][1] += p.x * v1; o[1][0] += p.y * v0; o[1][1] += p.y * v1; o[2][0] += p.z * v0; o[2][1] += p.z * v1; o[3][0] += p.w * v0; o[3][1] += p.w * v1;
        }
#pragma unroll
        for (int h = 0; h < 4; ++h) *((unsigned*)(Q + (size_t)r * 1024 + g * 512 + h * 128) + lane) = cvt_pk_bf16(o[h][0] * sm[h], o[h][1] * sm[h]);
        LDS_WAIT(); asm volatile("" ::: "memory");
    }
}
__device__ __forceinline__ void attn_slow(Frame& F) {
    const int gw = F.vcu * NWAVES + F.wave, NGW = F.G * NWAVES;
    for (int q = gw; q < YPR; q += NGW) { const int b = q / SEQ, t = q - b * SEQ; attn_slow_query<true>(F, b * TP + NMETA + t, F.lds + F.wave * 16384); }
    __syncthreads();
    if (F.wave < 4) { const int gw4 = F.vcu * 4 + F.wave;
        for (int q = gw4; q < RSR; q += F.G * 4) attn_slow_query<false>(F, RPR + q, F.lds + F.wave * 32768); }
}
__device__ __forceinline__ void conv_units(Frame& F) {
    bf16_t* XS = (bf16_t*)(F.ws + WS_XS); bf16_t* BC = (bf16_t*)(F.ws + WS_BC); const bf16_t* HAL = (const bf16_t*)(F.ws + WS_HAL);
    const float* conv_w = F.in[11]; const float* conv_b = F.in[12]; const float* st_conv = F.in[6];
    const int cg = F.tid & 63, rc = F.wave;
    constexpr int NU = (NBATCH * 33 + NBATCH) * 4;
    for (int u = F.vcu; u < NU; u += F.G) {
        const int cq = u & 3, sb = u >> 2; const bool pr = sb < NBATCH * 33;
        const int b = pr ? sb / 33 : sb - NBATCH * 33, j = pr ? sb % 33 : 0;
        const int T = pr ? TP : DSEQ, row0 = (pr ? b * TP : RPR + b * DSEQ) + 64 * j, nvalid = T - 64 * j;
        const int ch = 512 * cq + 8 * cg;
        bf16_t* colp = ch < 1024 ? XS + ch : BC + (ch - 1024);
        float w[4][8], bias[8];
#pragma unroll
        for (int i = 0; i < 4; ++i) { const f32x4 a = *(const f32x4*)(conv_w + i * CONV_DIM + ch), c = *(const f32x4*)(conv_w + i * CONV_DIM + ch + 4);
            w[i][0] = a.x; w[i][1] = a.y; w[i][2] = a.z; w[i][3] = a.w; w[i][4] = c.x; w[i][5] = c.y; w[i][6] = c.z; w[i][7] = c.w; }
        { const f32x4 a = *(const f32x4*)(conv_b + ch), c = *(const f32x4*)(conv_b + ch + 4); bias[0] = a.x; bias[1] = a.y; bias[2] = a.z; bias[3] = a.w; bias[4] = c.x; bias[5] = c.y; bias[6] = c.z; bias[7] = c.w; }
        float x[11][8];
        const int t0 = 8 * rc;
#pragma unroll
        for (int i = 0; i < 11; ++i) {
            const int t = t0 - 3 + i;
            u32x4 v = {0u, 0u, 0u, 0u}; bool have = false;
            if (t >= 0) { if (t < nvalid) { v = *(const u32x4*)(colp + (size_t)(row0 + t) * 1024); have = true; } }
            else if (j > 0) { v = *(const u32x4*)(HAL + (size_t)((b * 33 + j) * 3 + (t + 3)) * CONV_DIM + ch); have = true; }
            else if (!pr) { const float* sp = st_conv + (size_t)(b * 3 + (t + 3)) * CONV_DIM + ch; const f32x4 a = *(const f32x4*)sp, c = *(const f32x4*)(sp + 4);
                x[i][0] = a.x; x[i][1] = a.y; x[i][2] = a.z; x[i][3] = a.w; x[i][4] = c.x; x[i][5] = c.y; x[i][6] = c.z; x[i][7] = c.w; continue; }
            (void)have;
            x[i][0] = bf_lo(v.x); x[i][1] = bf_hi(v.x); x[i][2] = bf_lo(v.y); x[i][3] = bf_hi(v.y); x[i][4] = bf_lo(v.z); x[i][5] = bf_hi(v.z); x[i][6] = bf_lo(v.w); x[i][7] = bf_hi(v.w);
        }
        __syncthreads();
#pragma unroll
        for (int r = 0; r < 8; ++r) { const int t = t0 + r;
            if (t < nvalid) { float o[8];
#pragma unroll
                for (int e = 0; e < 8; ++e) o[e] = siluf_(bias[e] + x[r][e] * w[0][e] + x[r + 1][e] * w[1][e] + x[r + 2][e] * w[2][e] + x[r + 3][e] * w[3][e]);
                u32x4 ov; ov.x = cvt_pk_bf16(o[0], o[1]); ov.y = cvt_pk_bf16(o[2], o[3]); ov.z = cvt_pk_bf16(o[4], o[5]); ov.w = cvt_pk_bf16(o[6], o[7]);
                *(u32x4*)(colp + (size_t)(row0 + t) * 1024) = ov; } }
        __syncthreads();
    }
}

namespace ssd {
constexpr int CL = 0, BL = 17408, XR = 34816, XW = 39936, WM = 45056, SB = 54272, FA = 62976, LDS_TOT = 63744;
constexpr int LDC = 272, LDX = 80, LDW = 144;
typedef short v4i16 __attribute__((ext_vector_type(4)));
__device__ __forceinline__ s16x4 trd(LAS unsigned char* p) { return __builtin_bit_cast(s16x4, __builtin_amdgcn_ds_read_tr16_b64_v4i16((LAS v4i16*)p)); }
__device__ __forceinline__ bf16x8 frag_tr(LAS unsigned char* img, int stride, int m0, int kb0, int i, int g4) {
    LAS unsigned char* p = img + (kb0 + 8 * g4 + (i >> 2)) * stride + (m0 + 4 * (i & 3)) * 2;
    const s16x4 lo = trd(p), hi = trd(p + 4 * stride);
    return (bf16x8){lo[0], lo[1], lo[2], lo[3], hi[0], hi[1], hi[2], hi[3]};
}
__device__ __forceinline__ bf16x8 frag_row(LAS unsigned char* img, int stride, int r0, int kb0, int i, int g4) {
    return *(const LAS bf16x8*)(img + (r0 + i) * stride + (kb0 + 8 * g4) * 2);
}
}
__device__ __forceinline__ void ssd_chain_unit(Frame& F, int unit) {
    using namespace ssd;
    const int tid = F.tid, lane = F.lane, w = F.wave, i16 = lane & 15, g4 = lane >> 4;
    LAS unsigned char* L = F.lds;
    const bool pr = unit < 256; const int uu = unit & 255, b = uu >> 5, h = (uu >> 1) & 15, ph = uu & 1, g = h >> 2;
    const int T = pr ? TP : DSEQ, row0 = pr ? b * TP : RPR + b * DSEQ, nblk = (T + 63) >> 6;
    bf16_t* XS = (bf16_t*)(F.ws + WS_XS); const bf16_t* BC = (const bf16_t*)(F.ws + WS_BC); const bf16_t* Z = (const bf16_t*)(F.ws + WS_Z);
    const float* SM = (const float*)(F.ws + WS_SM); float* SSQ1 = (float*)(F.ws + WS_SSQ1);
    const int xcol = h * 64 + ph * 32;
    const float a_h = -expf(F.in[14][h]), dsk = F.in[15][h];
    const int cb_sb = w >> 1, cb_tb0 = 2 * (w & 1), y_pb = w & 1, y_tb = w >> 1;
    const int yp0 = 16 * y_pb + 4 * g4;
    const f32x4 nwv = *(const f32x4*)(F.in[16] + xcol + yp0);
    f32x4 st[2];
    float* sout = F.out + (pr ? O_SSMP : O_SSMS) + ((size_t)(b * 16 + h) * 64 + ph * 32) * 128;
    if (pr) { st[0] = (f32x4){0.f, 0.f, 0.f, 0.f}; st[1] = st[0]; }
    else { const float* sp = F.in[5] + ((size_t)(b * 16 + h) * 64 + ph * 32) * 128;
#pragma unroll
        for (int pb = 0; pb < 2; ++pb) st[pb] = *(const f32x4*)(sp + (size_t)(16 * pb + i16) * 128 + 16 * w + 4 * g4); }
    const int srow = tid >> 3, sch = tid & 7, xrow = tid >> 2, xch = tid & 3;
    u32x4 pB[2], pC[2], pX; u32x2 pZ; float pdt;
#define SSD_PREFETCH(jb) do { const int base_ = 64 * (jb); \
        { const bool ok_ = base_ + srow < T; const bf16_t* rp_ = BC + (size_t)(row0 + base_ + srow) * 1024 + g * 128 + 8 * sch; \
          pB[0] = ok_ ? *(const u32x4*)rp_ : (u32x4){0u, 0u, 0u, 0u}; pB[1] = ok_ ? *(const u32x4*)(rp_ + 64) : (u32x4){0u, 0u, 0u, 0u}; \
          pC[0] = ok_ ? *(const u32x4*)(rp_ + 512) : (u32x4){0u, 0u, 0u, 0u}; pC[1] = ok_ ? *(const u32x4*)(rp_ + 576) : (u32x4){0u, 0u, 0u, 0u}; } \
        if (tid < 256) { const bool ok_ = base_ + xrow < T; pX = ok_ ? *(const u32x4*)(XS + (size_t)(row0 + base_ + xrow) * 1024 + xcol + 8 * xch) : (u32x4){0u, 0u, 0u, 0u}; } \
        { const int t_ = base_ + 16 * y_tb + i16; pZ = t_ < T ? *(const u32x2*)(Z + (size_t)(row0 + t_) * 1024 + xcol + yp0) : (u32x2){0u, 0u}; } \
        { const int t_ = base_ + lane; pdt = t_ < T ? SM[(size_t)(row0 + t_) * SMLD + h] : 0.f; } } while (0)
    SSD_PREFETCH(0);
#pragma unroll 1
    for (int jb = 0; jb < nblk; ++jb) {
        float ac = pdt * a_h;
#pragma unroll
        for (int o = 1; o < 64; o <<= 1) { const float v = __shfl_up(ac, o); if (lane >= o) ac += v; }
        const float tot = __shfl(ac, 63);
        const float wsc = __builtin_amdgcn_exp2f((tot - ac) * 1.4426950408889634f) * pdt;
        if (w == 0) { LAS float* fa = (LAS float*)(L + FA); fa[lane] = ac; fa[64 + lane] = pdt; }
        *(LAS u32x4*)(L + BL + srow * LDC + 16 * sch) = pB[0]; *(LAS u32x4*)(L + BL + srow * LDC + 128 + 16 * sch) = pB[1];
        *(LAS u32x4*)(L + CL + srow * LDC + 16 * sch) = pC[0]; *(LAS u32x4*)(L + CL + srow * LDC + 128 + 16 * sch) = pC[1];
        if (tid < 256) { *(LAS u32x4*)(L + XR + xrow * LDX + 16 * xch) = pX;
            const float ws_ = __shfl(wsc, xrow & 63);
            u32x4 xw; xw.x = cvt_pk_bf16(bf_lo(pX.x) * ws_, bf_hi(pX.x) * ws_); xw.y = cvt_pk_bf16(bf_lo(pX.y) * ws_, bf_hi(pX.y) * ws_);
            xw.z = cvt_pk_bf16(bf_lo(pX.z) * ws_, bf_hi(pX.z) * ws_); xw.w = cvt_pk_bf16(bf_lo(pX.w) * ws_, bf_hi(pX.w) * ws_);
            *(LAS u32x4*)(L + XW + xrow * LDX + 16 * xch) = xw; }
#pragma unroll
        for (int pb = 0; pb < 2; ++pb)
            *(LAS u32x2*)(L + SB + (16 * pb + i16) * LDC + (16 * w + 4 * g4) * 2) = (u32x2){cvt_pk_bf16(st[pb].x, st[pb].y), cvt_pk_bf16(st[pb].z, st[pb].w)};
        const u32x2 zreg = pZ;
        __syncthreads();
        if (jb + 1 < nblk) SSD_PREFETCH(jb + 1);
        {
            f32x4 cb[2] = {{0.f, 0.f, 0.f, 0.f}, {0.f, 0.f, 0.f, 0.f}};
#pragma unroll
            for (int ks = 0; ks < 4; ++ks) { const bf16x8 af = frag_row(L + BL, LDC, 16 * cb_sb, 32 * ks, i16, g4);
#pragma unroll
                for (int q = 0; q < 2; ++q) { const bf16x8 bfv = frag_row(L + CL, LDC, 16 * (cb_tb0 + q), 32 * ks, i16, g4);
                    cb[q] = __builtin_amdgcn_mfma_f32_16x16x32_bf16(af, bfv, cb[q], 0, 0, 0); } }
            const LAS float* fa = (const LAS float*)(L + FA);
            const int s0 = 16 * cb_sb + 4 * g4;
            const f32x4 acs = *(const LAS f32x4*)(fa + s0), dts = *(const LAS f32x4*)(fa + 64 + s0);
#pragma unroll
            for (int q = 0; q < 2; ++q) { const int t = 16 * (cb_tb0 + q) + i16; const float act = fa[t];
                float o[4];
#pragma unroll
                for (int e = 0; e < 4; ++e) o[e] = (s0 + e <= t) ? cb[q][e] * __builtin_amdgcn_exp2f((act - acs[e]) * 1.4426950408889634f) * dts[e] : 0.f;
                *(LAS u32x2*)(L + WM + t * LDW + s0 * 2) = (u32x2){cvt_pk_bf16(o[0], o[1]), cvt_pk_bf16(o[2], o[3])}; }
            const float dtot = __builtin_amdgcn_exp2f(tot * 1.4426950408889634f);
            st[0] = st[0] * dtot; st[1] = st[1] * dtot;
#pragma unroll
            for (int ks = 0; ks < 2; ++ks) { const bf16x8 af = frag_tr(L + BL, LDC, 16 * w, 32 * ks, i16, g4);
#pragma unroll
                for (int pb = 0; pb < 2; ++pb) { const bf16x8 bfv = frag_tr(L + XW, LDX, 16 * pb, 32 * ks, i16, g4);
                    st[pb] = __builtin_amdgcn_mfma_f32_16x16x32_bf16(af, bfv, st[pb], 0, 0, 0); } }
        }
        __syncthreads();
        {
            f32x4 y = {0.f, 0.f, 0.f, 0.f};
#pragma unroll
            for (int ks = 0; ks < 4; ++ks) { const bf16x8 af = frag_row(L + SB, LDC, 16 * y_pb, 32 * ks, i16, g4), bfv = frag_row(L + CL, LDC, 16 * y_tb, 32 * ks, i16, g4);
                y = __builtin_amdgcn_mfma_f32_16x16x32_bf16(af, bfv, y, 0, 0, 0); }
            const LAS float* fa = (const LAS float*)(L + FA);
            const int t = 16 * y_tb + i16; const float eac = __builtin_amdgcn_exp2f(fa[t] * 1.4426950408889634f);
            y = y * eac;
#pragma unroll
            for (int ks = 0; ks < 2; ++ks) { const bf16x8 af = frag_tr(L + XR, LDX, 16 * y_pb, 32 * ks, i16, g4), bfv = frag_row(L + WM, LDW, 16 * y_tb, 32 * ks, i16, g4);
                y = __builtin_amdgcn_mfma_f32_16x16x32_bf16(af, bfv, y, 0, 0, 0); }
            const u32x2 xv = *(const LAS u32x2*)(L + XR + t * LDX + yp0 * 2);
            const f32x4 xf = {bf_lo(xv.x), bf_hi(xv.x), bf_lo(xv.y), bf_hi(xv.y)}, zf = {bf_lo(zreg.x), bf_hi(zreg.x), bf_lo(zreg.y), bf_hi(zreg.y)};
            f32x4 yo; yo.x = (y.x + dsk * xf.x) * siluf_(zf.x); yo.y = (y.y + dsk * xf.y) * siluf_(zf.y); yo.z = (y.z + dsk * xf.z) * siluf_(zf.z); yo.w = (y.w + dsk * xf.w) * siluf_(zf.w);
            float ss = (yo.x * yo.x + yo.y * yo.y) + (yo.z * yo.z + yo.w * yo.w);
            ss += __shfl_xor(ss, 16); ss += __shfl_xor(ss, 32);
            const int tg = 64 * jb + t;
            if (tg < T) { if (g4 == 0) atomicAdd(SSQ1 + row0 + tg, ss);
                yo = yo * nwv; *(u32x2*)(XS + (size_t)(row0 + tg) * 1024 + xcol + yp0) = (u32x2){cvt_pk_bf16(yo.x, yo.y), cvt_pk_bf16(yo.z, yo.w)}; }
        }
        __syncthreads();
    }
#undef SSD_PREFETCH
#pragma unroll
    for (int pb = 0; pb < 2; ++pb) *(f32x4*)(sout + (size_t)(16 * pb + i16) * 128 + 16 * w + 4 * g4) = st[pb];
}
__device__ __forceinline__ void ssd_chains(Frame& F) {
    for (int u = F.vcu; u < 512; u += F.G) ssd_chain_unit(F, u);
}
namespace idx {
constexpr int WTAB = 0, SCORES = 512;
}
__device__ __forceinline__ unsigned* mask_row(Frame& F, int r) {
    return r < RPR ? (unsigned*)(F.ws + WS_MASK) + (size_t)r * MASK_LDP : (unsigned*)(F.ws + WS_MASKS) + (size_t)(r - RPR) * MASK_LDS;
}
template <bool PR>
__device__ __forceinline__ void idx_unit(Frame& F, int b, int c, int qg) {
    constexpr int NQ = PR ? 16 : 8, NRB = NQ / 4;
    const int tid = F.tid, lane = F.lane, w = F.wave, r32 = lane & 31, hh = lane >> 5;
    LAS unsigned char* L_ = F.lds;
    const int Lk = PR ? NMETA + 64 * c : LS, LP = (Lk + 63) & ~63, nkb = LP >> 5;
    const int r0 = PR ? b * TP + NMETA + 64 * (c - 1) + NQ * qg : RPR + b * DSEQ + NQ * qg;
    const int krow0 = PR ? b * TP : RPR + b * DSEQ;
    const bf16_t* QI = (const bf16_t*)(F.ob + DO_QI); const bf16_t* KI = (const bf16_t*)(F.ws + WS_KI); const float* SM = (const float*)(F.ws + WS_SM); const float* ckidx = F.in[4];
    LAS float* wtab = (LAS float*)(L_ + idx::WTAB); LAS unsigned* sc = (LAS unsigned*)(L_ + idx::SCORES);
    if (tid < NQ * 8) wtab[tid] = SM[(size_t)(r0 + (tid >> 3)) * SMLD + 80 + (tid & 7)];
    bf16x8 af[NRB][4];
#pragma unroll
    for (int rb = 0; rb < NRB; ++rb)
#pragma unroll
        for (int ks = 0; ks < 4; ++ks) af[rb][ks] = *(const bf16x8*)(QI + (size_t)(r0 + 4 * rb) * 512 + r32 * 64 + 16 * ks + 8 * hh);
    __syncthreads();
#pragma unroll 1
    for (int kb = w; kb < nkb; kb += 8) {
        const int s = kb * 32 + r32; const int sc_ = s < Lk ? s : Lk - 1;
        bf16x8 bfr[4];
        if (!PR && kb * 32 < PAST) { const float* kp = ckidx + ((size_t)b * PAST + sc_) * 64 + 8 * hh;
#pragma unroll
            for (int ks = 0; ks < 4; ++ks) { const f32x4 x0 = *(const f32x4*)(kp + 16 * ks), x1 = *(const f32x4*)(kp + 16 * ks + 4);
                u32x4 t; t.x = cvt_pk_bf16(x0.x, x0.y); t.y = cvt_pk_bf16(x0.z, x0.w); t.z = cvt_pk_bf16(x1.x, x1.y); t.w = cvt_pk_bf16(x1.z, x1.w); bfr[ks] = __builtin_bit_cast(bf16x8, t); } }
        else { const bf16_t* kp = KI + (size_t)(PR ? krow0 + sc_ : krow0 + sc_ - PAST) * 64 + 8 * hh;
#pragma unroll
            for (int ks = 0; ks < 4; ++ks) bfr[ks] = *(const bf16x8*)(kp + 16 * ks); }
#pragma unroll
        for (int rb = 0; rb < NRB; ++rb) {
            f32x16 d = {};
#pragma unroll
            for (int ks = 0; ks < 4; ++ks) d = __builtin_amdgcn_mfma_f32_32x32x16_bf16(af[rb][ks], bfr[ks], d, 0, 0, 0);
            float tot[4];
#pragma unroll
            for (int tl = 0; tl < 4; ++tl) { const f32x4 wv = *(const LAS f32x4*)(wtab + (4 * rb + tl) * 8 + 4 * hh);
                float sacc = wv.x * fmaxf(d[4 * tl], 0.f) + wv.y * fmaxf(d[4 * tl + 1], 0.f) + wv.z * fmaxf(d[4 * tl + 2], 0.f) + wv.w * fmaxf(d[4 * tl + 3], 0.f);
                const auto rr = __builtin_amdgcn_permlane32_swap(__float_as_uint(sacc), __float_as_uint(sacc), false, false);
                tot[tl] = __uint_as_float(rr[0]) + __uint_as_float(rr[1]); }
#pragma unroll
            for (int q = 0; q < 2; ++q) { const int tl = 2 * hh + q; float v = hh ? (q ? tot[3] : tot[2]) : (q ? tot[1] : tot[0]);
                if (v == 0.f) v = 0.f;
                const unsigned u = __float_as_uint(v); const unsigned key = s < Lk ? ((u & 0x80000000u) ? ~u : (u | 0x80000000u)) : 0u;
                sc[(4 * rb + tl) * LP + s] = key; }
        }
    }
    __syncthreads();
    const unsigned long long lt_mask = (1ull << lane) - 1ull; const int ni = LP >> 6;
#pragma unroll 1
    for (int q = w; q < NQ; q += 8) {
        const LAS unsigned* row = sc + q * LP; unsigned* mrow = mask_row(F, r0 + q);
        unsigned prefix = 0u;
        for (int bit = 31; bit >= 0; --bit) { const unsigned cand = prefix | (1u << bit); int cnt = 0;
#pragma unroll 4
            for (int i = 0; i < ni; ++i) cnt += __popcll(__ballot(row[i * 64 + lane] >= cand));
            if (cnt >= TOPK) prefix = cand; }
        int ngt = 0;
#pragma unroll 4
        for (int i = 0; i < ni; ++i) ngt += __popcll(__ballot(row[i * 64 + lane] > prefix));
        const int need = TOPK - ngt; int eqseen = 0;
#pragma unroll 1
        for (int i = 0; i < ni; ++i) { const unsigned kv = row[i * 64 + lane]; const bool gt = kv > prefix, eq = kv == prefix; const unsigned long long meq = __ballot(eq);
            const bool sel = gt || (eq && (eqseen + __popcll(meq & lt_mask)) < need); const unsigned long long ms = __ballot(sel);
            if (lane == 0) *(u32x2*)(mrow + 2 * i) = (u32x2){(unsigned)ms, (unsigned)(ms >> 32)};
            eqseen += __popcll(meq); }
    }
    __syncthreads();
}
__device__ __forceinline__ void idx_allones(Frame& F, int b, int c) {
    const int Lk = NMETA + 64 * c, nw = ((Lk + 63) & ~63) >> 5;
    for (int e = F.tid; e < 64 * nw; e += NTHR) { const int q = e / nw, wd = e - q * nw; const int lo = 32 * wd;
        const unsigned m = lo + 32 <= Lk ? 0xffffffffu : (lo >= Lk ? 0u : ((1u << (Lk - lo)) - 1u));
        mask_row(F, b * TP + NMETA + 64 * (c - 1) + q)[wd] = m; }
}
__device__ __forceinline__ void idx_units(Frame& F) {
    constexpr int NPU = NBATCH * 29 * 4, NSU = NBATCH * 8, NAU = NBATCH * 3;
    for (int u = F.vcu; u < NPU + NSU + NAU; u += F.G) {
        if (u < NSU) { idx_unit<false>(F, u >> 3, 0, u & 7); }
        else if (u < NSU + NPU) { const int v = u - NSU; const int qg = v & 3, bc = v >> 2, b = bc & 7, c = 32 - (bc >> 3); idx_unit<true>(F, b, c, qg); }
        else { const int v = u - NSU - NPU; idx_allones(F, v & 7, 1 + (v >> 3)); }
    }
}
__device__ __forceinline__ int yrow_to_r(int pm) { return pm * 256 + (pm < 64 ? 16 * ((pm >> 3) + 1) : 128); }
struct SchedP5 {
    const char* A0; const char* A1; const char* B0; const char* B1; int G, c;
    __device__ __forceinline__ bool next(int i, pg8::Unit& u) const {
        const int L = (i >> 1) * G + c; if (L >= 66 * 4) return false;
        pg8::tile_of(L, 66, 4, u.pm, u.pn); u.part = i & 1;
        u.A = (u.part ? A1 : A0) + (size_t)yrow_to_r(u.pm) * 1024 * 2; u.B = (u.part ? B1 : B0) + (size_t)u.pn * 256 * 1024 * 2; return true; }
};
struct EpiP5 {
    static constexpr bool PERM = true;
    const bf16_t* GS; const bf16_t* GA; const float* SSQ1; bf16_t* MERGED;
    __device__ __forceinline__ bool operator()(pg8::Acc& acc, const pg8::Unit& u, int wr, int wc, int fr, int fq) const {
        const int rr0 = yrow_to_r(u.pm) + wr * 64 + fr, ry0 = u.pm * 256 + wr * 64 + fr, col = u.pn * 256 + wc * 32 + 8 * fq;
#pragma unroll
        for (int ai = 0; ai < 2; ++ai)
#pragma unroll
            for (int m = 0; m < 4; ++m) { const int rr = rr0 + ai * 128 + m * 16, ry = ry0 + ai * 128 + m * 16;
                float rstd = 0.f; if (u.part == 0) rstd = __builtin_amdgcn_rsqf(SSQ1[rr] * (1.f / 1024.f) + EPS);
#pragma unroll
                for (int bj = 0; bj < 2; ++bj) {
                    const u32x4 ga = *(const u32x4*)(GA + (size_t)rr * 1024 + col + bj * 128);
                    float sa[8] = {bf_lo(ga.x), bf_hi(ga.x), bf_lo(ga.y), bf_hi(ga.y), bf_lo(ga.z), bf_hi(ga.z), bf_lo(ga.w), bf_hi(ga.w)};
                    if (u.part == 0) {
                        const u32x4 gs = *(const u32x4*)(GS + (size_t)rr * 1024 + col + bj * 128);
                        const float ss[8] = {bf_lo(gs.x), bf_hi(gs.x), bf_lo(gs.y), bf_hi(gs.y), bf_lo(gs.z), bf_hi(gs.z), bf_lo(gs.w), bf_hi(gs.w)};
#pragma unroll
                        for (int e = 0; e < 8; ++e) {
                            const float f = rstd * (1.f + __builtin_amdgcn_exp2f(-1.4426950408889634f * sa[e])) * __builtin_amdgcn_rcpf(1.f + __builtin_amdgcn_exp2f(-1.4426950408889634f * ss[e]));
                            acc[ai][bj][m][e >> 2][e & 3] *= f; }
                    } else {
                        float o[8];
#pragma unroll
                        for (int e = 0; e < 8; ++e) o[e] = acc[ai][bj][m][e >> 2][e & 3] * sigmoidf_(sa[e]);
                        u32x4 w; w.x = cvt_pk_bf16(o[0], o[1]); w.y = cvt_pk_bf16(o[2], o[3]); w.z = cvt_pk_bf16(o[4], o[5]); w.w = cvt_pk_bf16(o[6], o[7]);
                        *(u32x4*)(MERGED + (size_t)ry * 1024 + col + bj * 128) = w; } } }
        return u.part == 0;
    }
};
struct SchedY {
    const char* A; const char* B; int nN, K, G, c;
    __device__ __forceinline__ bool next(int i, pg8::Unit& u) const {
        const int L = i * G + c; if (L >= 66 * nN) return false;
        pg8::tile_of(L, 66, nN, u.pm, u.pn); u.part = 0; u.A = A + (size_t)u.pm * 256 * K * 2; u.B = B + (size_t)u.pn * 256 * K * 2; return true; }
};
struct EpiP6 {
    static constexpr bool PERM = false;
    const float* xp; const float* xs; const float* n2w; float* H; bf16_t* HB; float* SSQ2;
    __device__ __forceinline__ bool operator()(pg8::Acc& acc, const pg8::Unit& u, int wr, int wc, int fr, int fq) const {
        const int ry0 = u.pm * 256 + wr * 64 + fr, col0 = u.pn * 256 + wc * 32 + 4 * fq;
        f32x4 nw[2][2];
#pragma unroll
        for (int bj = 0; bj < 2; ++bj)
#pragma unroll
            for (int n = 0; n < 2; ++n) nw[bj][n] = *(const f32x4*)(n2w + col0 + bj * 128 + n * 16);
#pragma unroll
        for (int ai = 0; ai < 2; ++ai)
#pragma unroll
            for (int m = 0; m < 4; ++m) { const int ry = ry0 + ai * 128 + m * 16;
                const float* xrow = ry < YPR ? xp + (size_t)ry * 1024 : xs + (size_t)(ry - YPR) * 1024; float ss = 0.f;
#pragma unroll
                for (int bj = 0; bj < 2; ++bj)
#pragma unroll
                    for (int n = 0; n < 2; ++n) { const int c = col0 + bj * 128 + n * 16; const f32x4 h = *(const f32x4*)(xrow + c) + acc[ai][bj][m][n];
                        *(f32x4*)(H + (size_t)ry * 1024 + c) = h; ss += (h.x * h.x + h.y * h.y) + (h.z * h.z + h.w * h.w);
                        const f32x4 hn = h * nw[bj][n]; *(u32x2*)(HB + (size_t)ry * 1024 + c) = (u32x2){cvt_pk_bf16(hn.x, hn.y), cvt_pk_bf16(hn.z, hn.w)}; }
                ss += __shfl_xor(ss, 16); ss += __shfl_xor(ss, 32);
                if (fq == 0) atomicAdd(SSQ2 + ry, ss); }
        return false;
    }
};
struct EpiP7 {
    static constexpr bool PERM = true;
    const float* SSQ2; bf16_t* ACT;
    __device__ __forceinline__ bool operator()(pg8::Acc& acc, const pg8::Unit& u, int wr, int wc, int fr, int fq) const {
        const int ry0 = u.pm * 256 + wr * 64 + fr, ch0 = u.pn * 128 + wc * 16 + 4 * fq;
#pragma unroll
        for (int ai = 0; ai < 2; ++ai)
#pragma unroll
            for (int m = 0; m < 4; ++m) { const int ry = ry0 + ai * 128 + m * 16; const float rs = __builtin_amdgcn_rsqf(SSQ2[ry] * (1.f / 1024.f) + EPS);
#pragma unroll
                for (int bj = 0; bj < 2; ++bj) { const f32x4 g = acc[ai][bj][m][0] * rs, up = acc[ai][bj][m][1] * rs;
                    const float a0 = siluf_(g.x) * up.x, a1 = siluf_(g.y) * up.y, a2 = siluf_(g.z) * up.z, a3 = siluf_(g.w) * up.w;
                    *(u32x2*)(ACT + (size_t)ry * DFF + ch0 + bj * 64) = (u32x2){cvt_pk_bf16(a0, a1), cvt_pk_bf16(a2, a3)}; } }
        return false;
    }
};
struct EpiP8 {
    static constexpr bool PERM = false;
    float* H;
    __device__ __forceinline__ bool operator()(pg8::Acc& acc, const pg8::Unit& u, int wr, int wc, int fr, int fq) const {
        const int ry0 = u.pm * 256 + wr * 64 + fr, col0 = u.pn * 256 + wc * 32 + 4 * fq;
#pragma unroll
        for (int ai = 0; ai < 2; ++ai)
#pragma unroll
            for (int m = 0; m < 4; ++m) { float* hrow = H + (size_t)(ry0 + ai * 128 + m * 16) * 1024 + col0;
#pragma unroll
                for (int bj = 0; bj < 2; ++bj)
#pragma unroll
                    for (int n = 0; n < 2; ++n) { f32x4* p = (f32x4*)(hrow + bj * 128 + n * 16); *p = *p + acc[ai][bj][m][n]; } }
        return false;
    }
};

constexpr int NPHASE = 10;
__global__ void __launch_bounds__(NTHR, 2) hybrid_fwd(Args args) {
    extern __shared__ __attribute__((aligned(16))) unsigned char lds[];
    Frame F;
    F.lds = (LAS unsigned char*)lds; F.MISC = (volatile LAS unsigned*)(F.lds + MISC_OFF);
    F.tid = threadIdx.x; F.lane = F.tid & 63; F.wave = __builtin_amdgcn_readfirstlane(F.tid >> 6);
    F.G = gridDim.x; { const int bx = blockIdx.x; F.vcu = (F.G % 8 == 0) ? (bx % 8) * (F.G / 8) + bx / 8 : bx; }
    F.in = args.in; F.out = args.out; F.ws = args.ws; F.ob = (unsigned char*)args.out; F.ctl = (gu32*)(args.ws + WS_CTL);
    if (F.tid < 64) ((LAS unsigned*)(F.lds + MISC_OFF))[F.tid] = 0u;
    __syncthreads();
    const int lo = args.ph_lo, hi = args.ph_hi;
    const bool multi = (hi - lo) > 1;
    XcdBarrier bar; bar.bar = (unsigned*)(F.ctl + CW_BAR) + args.li * XCD_BAR_WORDS; bar.x = 0; bar.st = nullptr;
    if (multi) bar = xcd_barrier_post((unsigned*)(F.ctl + CW_BAR) + args.li * XCD_BAR_WORDS, F.MISC + 8);
#define IN(k) (lo <= (k) && (k) < hi)
#define SEAM(k) do { if (IN(k) && IN((k) + 1)) xcd_barrier(bar); } while (0)
    if (IN(0)) { p0_prologue(F); SEAM(0); }
    if (IN(1)) {
        SchedP1 S{(const char*)(F.ob + DO_HN), (const char*)(F.ws + WS_WIN), F.G, (int)blockIdx.x};
        EpiP1 E{F.ws, F.ob};
        pg8::gemm_phase<EpiP1, SchedP1>(F.lds, 1024, S, E);
        SEAM(1);
    }
    if (IN(2)) { p2_rows(F); SEAM(2); }
    if (IN(3)) { conv_units(F); idx_units(F); SEAM(3); }
    if (IN(4)) { ssd_chains(F); SEAM(4); }
    if (IN(5)) { attn_slow(F); __syncthreads(); SEAM(5); }
    if (IN(6)) {
        SchedP5 S{(const char*)(F.ws + WS_XS), (const char*)(F.ob + DO_Q), (const char*)(F.ws + WS_WBS), (const char*)(F.ws + WS_WBA), F.G, (int)blockIdx.x};
        EpiP5 E{(const bf16_t*)(F.ws + WS_GS), (const bf16_t*)(F.ws + WS_GA), (const float*)(F.ws + WS_SSQ1), (bf16_t*)(F.ws + WS_MERGED)};
        pg8::gemm_phase<EpiP5, SchedP5>(F.lds, 1024, S, E);
        SEAM(6);
    }
    if (IN(7)) {
        SchedY S{(const char*)(F.ws + WS_MERGED), (const char*)(F.ws + WS_WOUT), 4, 1024, F.G, (int)blockIdx.x};
        EpiP6 E{F.in[0], F.in[1], F.in[23], F.out, (bf16_t*)(F.ws + WS_HB), (float*)(F.ws + WS_SSQ2)};
        pg8::gemm_phase<EpiP6, SchedY>(F.lds, 1024, S, E);
        SEAM(7);
    }
    if (IN(8)) {
        SchedY S{(const char*)(F.ws + WS_HB), (const char*)(F.ws + WS_WGU), NGU / 256, 1024, F.G, (int)blockIdx.x};
        EpiP7 E{(const float*)(F.ws + WS_SSQ2), (bf16_t*)(F.ws + WS_ACT)};
        pg8::gemm_phase<EpiP7, SchedY>(F.lds, 1024, S, E);
        SEAM(8);
    }
    if (IN(9)) {
        SchedY S{(const char*)(F.ws + WS_ACT), (const char*)(F.ws + WS_WDN), 4, DFF, F.G, (int)blockIdx.x};
        EpiP8 E{F.out};
        pg8::gemm_phase<EpiP8, SchedY>(F.lds, DFF, S, E);
    }
#undef IN
#undef SEAM
}

extern "C" void kernel_launch(void* const* d_in, const int* in_sizes, int n_in, void* d_out, int out_size, void* d_ws, size_t ws_size, hipStream_t stream) {
    static int grid = 0;
    if (grid == 0) {
        if (n_in != 27 || out_size != (int)O_END || ws_size < WS_END) { fprintf(stderr, "kernel_launch: unexpected shapes: n_in %d out %d ws %zu (need %zu)\n", n_in, out_size, ws_size, (size_t)WS_END); grid = -1; return; }
        int dev = 0, cus = 0;
        if (hipGetDevice(&dev) != hipSuccess || hipDeviceGetAttribute(&cus, hipDeviceAttributeMultiprocessorCount, dev) != hipSuccess) { grid = -1; return; }
        if (hipFuncSetAttribute((const void*)hybrid_fwd, hipFuncAttributeMaxDynamicSharedMemorySize, LDS_BYTES) != hipSuccess) { fprintf(stderr, "kernel_launch: hipFuncSetAttribute failed\n"); grid = -1; return; }
        (void)hipGetLastError();
        grid = cus;
    }
    if (grid < 0) return;
    (void)hipMemsetAsync((char*)d_ws + WS_CTL, 0, CTL_BYTES, stream);
    Args a{};
    for (int i = 0; i < 27; ++i) a.in[i] = (const float*)d_in[i];
    a.out = (float*)d_out; a.ws = (unsigned char*)d_ws;
#ifndef MK_SPLIT
#define MK_SPLIT 0
#endif
#if MK_SPLIT
    for (int p = 0; p < NPHASE; ++p) { a.ph_lo = p; a.ph_hi = p + 1; a.li = 0; hipLaunchKernelGGL(hybrid_fwd, dim3(grid), dim3(NTHR), LDS_BYTES, stream, a); }
#else
    a.ph_lo = 0; a.ph_hi = NPHASE; a.li = 0; hipLaunchKernelGGL(hybrid_fwd, dim3(grid), dim3(NTHR), LDS_BYTES, stream, a);
#endif
    const hipError_t le = hipPeekAtLastError();
    if (le != hipSuccess) fprintf(stderr, "kernel_launch: launch failed: %s\n", hipGetErrorName(le));
}
```

```cpp
#include <hip/hip_runtime.h>
#include <cstdio>
#include <cstdint>

constexpr int DM = 1024, NBATCH = 8, SEQ = 2048, NMETA = 16, TP = NMETA + SEQ  , DSEQ = 64, PAST = 4096, LS = PAST + DSEQ  ;
constexpr int RPR = NBATCH * TP  , RSR = NBATCH * DSEQ  , RR = RPR + RSR  , RPAD = 17152  ;
constexpr int YPR = NBATCH * SEQ  , YR = YPR + RSR  ;
constexpr int NIN = 7424  , DFF = 2816, NGU = 2 * DFF;
constexpr int SSD_H = 16, SSD_P = 64, SSD_G = 4, SSD_N = 128, CONV_DIM = 2048;
constexpr int NH = 8, NKV = 2, HD = 128, IDXH = 8, IDXD = 64, TOPK = 256;
constexpr float EPS = 1e-6f;
constexpr int SMLD = 96;

constexpr size_t O_YP = 0, O_YS = O_YP + (size_t)YPR * DM, O_KP = O_YS + (size_t)RSR * DM, O_VP = O_KP + (size_t)RPR * 256, O_KIP = O_VP + (size_t)RPR * 256,
                 O_SSMP = O_KIP + (size_t)RPR * 64, O_CVP = O_SSMP + (size_t)NBATCH * 16 * 64 * 128, O_KS = O_CVP + (size_t)NBATCH * 3 * CONV_DIM, O_VS = O_KS + (size_t)RSR * 256,
                 O_KIS = O_VS + (size_t)RSR * 256, O_SSMS = O_KIS + (size_t)RSR * 64, O_CVS = O_SSMS + (size_t)NBATCH * 16 * 64 * 128, O_END = O_CVS + (size_t)NBATCH * 3 * CONV_DIM;
static_assert(O_END == 29302784, "d_out size");
constexpr size_t DO_Q = 0, DO_QI = DO_Q + (size_t)RR * 1024 * 2, DO_CV = DO_QI + (size_t)RR * 512 * 2, DO_YEND = DO_CV + (size_t)NBATCH * PAST * 256 * 2;
static_assert(DO_YEND <= O_KP * 4, "y-region scratch");
constexpr size_t DO_HN = O_KP * 4;
static_assert(DO_HN + (size_t)RPAD * 1024 * 2 <= O_CVP * 4, "hn scratch in tail");

constexpr size_t al256(size_t x) { return (x + 255) / 256 * 256; }
constexpr size_t WS_CTL = 0, CTL_BYTES = 1u << 20;
constexpr size_t WS_WIN = CTL_BYTES, WS_WBS = WS_WIN + (size_t)NIN * 1024 * 2, WS_WBA = WS_WBS + 1024 * 1024 * 2, WS_WOUT = WS_WBA + 1024 * 1024 * 2, WS_WGU = WS_WOUT + 1024 * 1024 * 2,
                 WS_WDN = WS_WGU + (size_t)NGU * 1024 * 2, WS_Z = WS_WDN + (size_t)1024 * DFF * 2, WS_XS = WS_Z + (size_t)RR * 1024 * 2, WS_BC = WS_XS + (size_t)RR * 1024 * 2,
                 WS_GA = WS_BC + (size_t)RR * 1024 * 2, WS_GS = WS_GA + (size_t)RR * 1024 * 2, WS_K = WS_GS + (size_t)RR * 1024 * 2, WS_V = WS_K + (size_t)RR * 256 * 2,
                 WS_SM = WS_V + (size_t)RR * 256 * 2, WS_KI = WS_SM + (size_t)RR * SMLD * 4, WS_CK = WS_KI + (size_t)RR * 64 * 2, WS_MASK = WS_CK + (size_t)NBATCH * PAST * 256 * 2;
constexpr int MASK_LDP = 68, MASK_LDS = 132;
constexpr size_t WS_MASKS = WS_MASK + (size_t)RPR * MASK_LDP * 4, WS_SSQ1 = WS_MASKS + (size_t)RSR * MASK_LDS * 4, WS_SSQ2 = WS_SSQ1 + al256((size_t)RR * 4),
                 WS_PART = WS_SSQ2 + al256((size_t)YR * 4), WS_END = WS_PART + (size_t)32 * 256 * 132 * 4;
constexpr size_t WS_MERGED = WS_Z, WS_ACT = WS_XS, WS_HB = WS_GS, WS_HAL = WS_PART;
static_assert(WS_END <= 268435456, "d_ws map exceeds 256 MiB");
static_assert((size_t)YR * DFF * 2 <= WS_GS - WS_XS, "act overlay");
static_assert((size_t)NBATCH * 33 * 3 * CONV_DIM * 2 <= WS_END - WS_PART, "halo overlay");
constexpr int CW_TMO = 0, CW_BAR = 4096, CW_Q = 16384;

#define GAS __attribute__((address_space(1)))
#define LAS __attribute__((address_space(3)))
typedef unsigned short bf16_t;
typedef short bf16x8 __attribute__((ext_vector_type(8)));
typedef short s16x4 __attribute__((ext_vector_type(4)));
typedef float f32x4 __attribute__((ext_vector_type(4)));
typedef float f32x2 __attribute__((ext_vector_type(2)));
typedef float f32x16 __attribute__((ext_vector_type(16)));
typedef unsigned u32x4 __attribute__((ext_vector_type(4)));
typedef unsigned u32x2 __attribute__((ext_vector_type(2)));
typedef GAS unsigned gu32;
#define RLX_AGENT __ATOMIC_RELAXED, __HIP_MEMORY_SCOPE_AGENT
#define LDS_WAIT() asm volatile("s_waitcnt lgkmcnt(0)" ::: "memory")
#define VM_WAIT() asm volatile("s_waitcnt vmcnt(0)" ::: "memory")
__device__ __forceinline__ unsigned cvt_pk_bf16(float lo, float hi) { unsigned r; asm volatile("v_cvt_pk_bf16_f32 %0, %1, %2" : "=v"(r) : "v"(lo), "v"(hi)); return r; }
__device__ __forceinline__ float bf_lo(unsigned w) { return __uint_as_float(w << 16); }
__device__ __forceinline__ float bf_hi(unsigned w) { return __uint_as_float(w & 0xffff0000u); }
__device__ __forceinline__ float bf2f(bf16_t b) { return __uint_as_float((unsigned)b << 16); }
__device__ __forceinline__ bf16_t f2bf(float f) { return (bf16_t)(cvt_pk_bf16(f, 0.f) & 0xffffu); }
__device__ __forceinline__ float sigmoidf_(float x) { return __builtin_amdgcn_rcpf(1.f + __builtin_amdgcn_exp2f(-1.4426950408889634f * x)); }
__device__ __forceinline__ float siluf_(float x) { return x * sigmoidf_(x); }
__device__ __forceinline__ float wave_sum(float v) {
#pragma unroll
    for (int o = 1; o < 64; o <<= 1) v += __shfl_xor(v, o);
    return v;
}

#define XB_TMO      128
#define XB_XCNT(j)  (256  + 64 * (j))
#define XB_XSUB(j)  (1280 + 64 * (j))
#define XB_XGEN(j)  (2304 + 64 * (j))
#define XB_TOP      3328
#define XB_TOPGEN   3392
#define XCD_BAR_WORDS 3456
#define XB_SPIN_CAP (1u << 18)
__device__ __forceinline__ unsigned xb_ld(unsigned* p)              { return __hip_atomic_load(p, __ATOMIC_RELAXED, __HIP_MEMORY_SCOPE_AGENT); }
__device__ __forceinline__ unsigned xb_add(unsigned* p, unsigned v) { return __hip_atomic_fetch_add(p, v, __ATOMIC_RELAXED, __HIP_MEMORY_SCOPE_AGENT); }
__device__ __forceinline__ unsigned xb_xcc_id() { return (unsigned)__builtin_amdgcn_s_getreg((3 << 11) | 20) & 0xFu; }
#define XB_SPIN(cond, bar) do { unsigned _sp = 0; while (cond) { __builtin_amdgcn_s_sleep(1); \
    if ((++_sp & 255u) == 0u) { if (xb_ld(&(bar)[XB_TMO])) break; if (_sp > XB_SPIN_CAP) { atomicAdd(&(bar)[XB_TMO], 1u); break; } } } } while (0)
struct XcdBarrier { unsigned* bar; unsigned x; volatile LAS unsigned* st; };
__device__ __forceinline__ XcdBarrier xcd_barrier_post(unsigned* bar, volatile LAS unsigned* st) {
    XcdBarrier b; b.bar = bar; b.x = xb_xcc_id(); b.st = st;
    if (threadIdx.x == 0) (void)xb_add(&bar[XB_XCNT(b.x)], 1u);
    return b;
}
__device__ __forceinline__ void xcd_barrier_complete(unsigned* bar, unsigned x, unsigned& nloc, unsigned& nx) {
    const unsigned G = gridDim.x * gridDim.y * gridDim.z;
    unsigned sum, cnt, mine, sp = 0u;
    for (;;) {
        sum = 0u; cnt = 0u; mine = 0u;
#pragma unroll
        for (unsigned j = 0; j < 16; ++j) { const unsigned c = xb_ld(&bar[XB_XCNT(j)]); sum += c; cnt += (c > 0u) ? 1u : 0u; mine = (j == x) ? c : mine; }
        if (sum == G) break;
        __builtin_amdgcn_s_sleep(1);
        if ((++sp & 255u) == 0u) { if (xb_ld(&bar[XB_TMO])) break; if (sp > XB_SPIN_CAP) { atomicAdd(&bar[XB_TMO], 1u); break; } }
    }
    nloc = mine > 0u ? mine : 1u; nx = cnt > 0u ? cnt : 1u;
}
__device__ __forceinline__ void xcd_barrier(const XcdBarrier& b) {
    asm volatile("s_waitcnt vmcnt(0)" ::: "memory");
    __syncthreads();
    if (threadIdx.x == 0) {
        unsigned* bar = b.bar;
        __builtin_amdgcn_s_waitcnt(0);
        unsigned nloc = b.st[0], nx = b.st[1];
        if (nloc == 0u) { xcd_barrier_complete(bar, b.x, nloc, nx); b.st[0] = nloc; b.st[1] = nx; }
        const unsigned old = xb_add(&bar[XB_XSUB(b.x)], 1u);
        const unsigned gen = old / nloc;
        if (old + 1u == (gen + 1u) * nloc) {
            __builtin_amdgcn_fence(__ATOMIC_RELEASE, "agent");
            asm volatile("s_waitcnt vmcnt(0)" ::: "memory");
            const unsigned og = xb_add(&bar[XB_TOP], 1u);
            const unsigned tg = og / nx;
            if (og + 1u == (tg + 1u) * nx) xb_add(&bar[XB_TOPGEN], 1u);
            else XB_SPIN(xb_ld(&bar[XB_TOPGEN]) == tg, bar);
            __builtin_amdgcn_fence(__ATOMIC_ACQUIRE, "agent");
            xb_add(&bar[XB_XGEN(b.x)], 1u);
            asm volatile("s_waitcnt vmcnt(0)" ::: "memory");
        } else {
            XB_SPIN(xb_ld(&bar[XB_XGEN(b.x)]) == gen, bar);
            __builtin_amdgcn_fence(__ATOMIC_ACQUIRE, "agent");
            asm volatile("s_waitcnt vmcnt(0)" ::: "memory");
        }
    }
    __syncthreads();
}

namespace pg8 {
constexpr int BM = 256, BK = 64, HALF = 128, HTB = HALF * BK * 2, STAGE_BYTES = 8 * HTB, NXCD = 8, WGM = 8;
__host__ __device__ __forceinline__ int lds_byte(int r, int c) { const int st = (r >> 4) * 2 + (c >> 5), rr = r & 15, cc = c & 31, ob = rr * 64 + cc * 2; return st * 1024 + (ob ^ (((ob >> 9) & 1) << 5)); }
__host__ __device__ __forceinline__ void stage_rc(int b, int& R, int& C) { const int st = b / 1024, sb = b % 1024, swz = sb ^ (((sb >> 9) & 1) << 5); R = (st >> 1) * 16 + swz / 64; C = (st & 1) * 32 + (swz % 64) / 2; }
__host__ __device__ __forceinline__ int perm32(int rho) { const int n = rho >> 4, i = rho & 15; return 8 * (i >> 2) + 4 * n + (i & 3); }
struct Unit { int pm, pn, part; const char* A; const char* B; };
__device__ __forceinline__ void tile_of(int L, int nM, int nN, int& pm, int& pn) {
    const int nwg = nM * nN; int wgid = L; { const int q = nwg / NXCD, r = nwg % NXCD, xcd = wgid % NXCD, off = wgid / NXCD; wgid = (xcd < r ? xcd * (q + 1) : r * (q + 1) + (xcd - r) * q) + off; }
    const int nig = WGM * nN, gid = wgid / nig, fm = gid * WGM, gsz = (nM - fm) < WGM ? (nM - fm) : WGM;
    pm = fm + ((wgid % nig) % gsz); pn = (wgid % nig) / gsz;
}
typedef f32x4 Acc[2][2][4][2];
template <class Epi, class Sched>
__device__ __forceinline__ void gemm_phase(LAS unsigned char* lds, const int K, const Sched& S, const Epi& E) {
    const int tid = threadIdx.x, wid = __builtin_amdgcn_readfirstlane(tid >> 6), lane = tid & 63, wr = wid >> 2, wc = wid & 3, fr = lane & 15, fq = lane >> 4;
    const int nt = K / BK;
    unsigned voffA[2], voffB[2];
#pragma unroll
    for (int i = 0; i < 2; ++i) { int R, C; stage_rc(tid * 16 + i * 8192, R, C); const int Rb = Epi::PERM ? ((R & ~31) + perm32(R & 31)) : R;
        voffA[i] = (unsigned)(R * K + C) * 2u; voffB[i] = (unsigned)(Rb * K + C) * 2u; }
    const size_t kstep = (size_t)(BK * 2);
    const size_t hstep = (size_t)HALF * K * 2;
    const unsigned ldsw = (unsigned)wid * 1024u;
    const int aoff = lds_byte(wr * 64 + fr, fq * 8), boff = lds_byte(wc * 32 + fr, fq * 8);
#define PG8_SA(b, h) (((b) * 2 + (h)) * HTB)
#define PG8_SB(b, h) ((4 + (b) * 2 + (h)) * HTB)
#define PG8_STAGE(bufoff, gbase, voff) do { _Pragma("unroll") for (int _i = 0; _i < 2; ++_i) \
        __builtin_amdgcn_global_load_lds((const unsigned*)((const char*)(gbase) + (voff)[_i]), (LAS unsigned*)(lds + (bufoff) + ldsw + _i * 8192), 16, 0, 0); } while (0)
#define PG8_LDA(dst, b, h) do { _Pragma("unroll") for (int m = 0; m < 4; ++m) _Pragma("unroll") for (int k = 0; k < 2; ++k) dst[m][k] = *(const LAS bf16x8*)(lds + PG8_SA(b, h) + aoff + m * 2048 + k * 1024); } while (0)
#define PG8_LDB(dst, b, h) do { _Pragma("unroll") for (int n = 0; n < 2; ++n) _Pragma("unroll") for (int k = 0; k < 2; ++k) dst[n][k] = *(const LAS bf16x8*)(lds + PG8_SB(b, h) + boff + n * 2048 + k * 1024); } while (0)
#define PG8_MMA(ai, bj, At, Bt) do { __builtin_amdgcn_s_setprio(1); _Pragma("unroll") for (int m = 0; m < 4; ++m) _Pragma("unroll") for (int n = 0; n < 2; ++n) _Pragma("unroll") for (int k = 0; k < 2; ++k) \
        acc[ai][bj][m][n] = __builtin_amdgcn_mfma_f32_16x16x32_bf16(Bt[n][k], At[m][k], acc[ai][bj][m][n], 0, 0, 0); __builtin_amdgcn_s_setprio(0); } while (0)
#define PG8_WAIT_V(n) asm volatile("s_waitcnt vmcnt(" #n ")" ::: "memory")
#define PG8_WAIT_L(n) asm volatile("s_waitcnt lgkmcnt(" #n ")" ::: "memory")
#define PG8_BAR __builtin_amdgcn_s_barrier()
#define PG8_SCHED __builtin_amdgcn_sched_barrier(0)
    Unit cur, nxt; int ui = 0;
    if (!S.next(0, cur)) return;
    Acc acc;
#pragma unroll
    for (int a = 0; a < 2; ++a)
#pragma unroll
        for (int b = 0; b < 2; ++b)
#pragma unroll
            for (int m = 0; m < 4; ++m)
#pragma unroll
                for (int n = 0; n < 2; ++n) acc[a][b][m][n] = (f32x4){0.f, 0.f, 0.f, 0.f};
    bf16x8 At[4][2], B0[2][2], B1[2][2];
    const char* cA = cur.A; const char* cB = cur.B;
    PG8_STAGE(PG8_SB(0, 0), cB, voffB); PG8_STAGE(PG8_SB(0, 1), cB + hstep, voffB); PG8_STAGE(PG8_SA(0, 0), cA, voffA); PG8_STAGE(PG8_SA(0, 1), cA + hstep, voffA);
    if (wr == 1) PG8_BAR;
    PG8_WAIT_V(2); PG8_BAR;
    PG8_STAGE(PG8_SB(1, 0), cB + kstep, voffB); PG8_STAGE(PG8_SA(1, 0), cA + kstep, voffA); PG8_STAGE(PG8_SB(1, 1), cB + hstep + kstep, voffB);
    PG8_WAIT_V(6); PG8_BAR;
    for (;;) {
        const bool has_next = S.next(ui + 1, nxt);
        const char* nA = has_next ? nxt.A : cA; const char* nB = has_next ? nxt.B : cB;
        for (int t = 0; t < nt; t += 2) {
            const bool last = (t == nt - 2);
            const char* a1 = cA + (size_t)(t + 1) * kstep;
            const char* a2 = last ? nA : cA + (size_t)(t + 2) * kstep; const char* b2 = last ? nB : cB + (size_t)(t + 2) * kstep;
            const char* a3 = a2 + kstep; const char* b3 = b2 + kstep;
            PG8_LDB(B0, 0, 0); PG8_LDB(B1, 0, 1); PG8_SCHED; PG8_LDA(At, 0, 0); PG8_STAGE(PG8_SA(1, 1), a1 + hstep, voffA);
            PG8_WAIT_V(8); PG8_WAIT_L(0); PG8_BAR; PG8_MMA(0, 0, At, B0); PG8_MMA(0, 1, At, B1); PG8_BAR; PG8_SCHED;
            PG8_LDA(At, 0, 1); PG8_STAGE(PG8_SB(0, 0), b2, voffB); PG8_STAGE(PG8_SB(0, 1), b2 + hstep, voffB); PG8_STAGE(PG8_SA(0, 0), a2, voffA);
            PG8_WAIT_V(8); PG8_WAIT_L(0); PG8_BAR; PG8_MMA(1, 0, At, B0); PG8_MMA(1, 1, At, B1); PG8_BAR; PG8_SCHED;
            PG8_LDB(B0, 1, 0); PG8_LDB(B1, 1, 1); PG8_SCHED; PG8_LDA(At, 1, 0); PG8_STAGE(PG8_SA(0, 1), a2 + hstep, voffA);
            PG8_WAIT_V(8); PG8_WAIT_L(0); PG8_BAR; PG8_MMA(0, 0, At, B0); PG8_MMA(0, 1, At, B1); PG8_BAR; PG8_SCHED;
            PG8_LDA(At, 1, 1); PG8_STAGE(PG8_SB(1, 0), b3, voffB); PG8_STAGE(PG8_SB(1, 1), b3 + hstep, voffB); PG8_STAGE(PG8_SA(1, 0), a3, voffA);
            PG8_WAIT_V(8); PG8_WAIT_L(0); PG8_BAR; PG8_MMA(1, 0, At, B0); PG8_MMA(1, 1, At, B1); PG8_BAR; PG8_SCHED;
        }
        if (wr == 0) PG8_BAR;
        const bool keep = E(acc, cur, wr, wc, fr, fq);
        if (!has_next) break;
        if (!keep) {
#pragma unroll
            for (int a = 0; a < 2; ++a)
#pragma unroll
                for (int b = 0; b < 2; ++b)
#pragma unroll
                    for (int m = 0; m < 4; ++m)
#pragma unroll
                        for (int n = 0; n < 2; ++n) acc[a][b][m][n] = (f32x4){0.f, 0.f, 0.f, 0.f};
        }
        cur = nxt; cA = nA; cB = nB; ++ui;
        if (wr == 1) PG8_BAR;
    }
    PG8_WAIT_V(0);
    PG8_BAR;
#undef PG8_SA
#undef PG8_SB
#undef PG8_STAGE
#undef PG8_LDA
#undef PG8_LDB
#undef PG8_MMA
#undef PG8_WAIT_V
#undef PG8_WAIT_L
#undef PG8_BAR
#undef PG8_SCHED
}
}

struct Args { const float* in[27]; float* out; unsigned char* ws; int ph_lo, ph_hi, li, pad; };
constexpr int NWAVES = 8, NTHR = 512;
constexpr int RING_BYTES = 131072, LDS_BYTES = 147456, MISC_OFF = LDS_BYTES - 256;

struct Frame {
    LAS unsigned char* lds; volatile LAS unsigned* MISC; gu32* ctl;
    int tid, lane, wave, vcu, G;
    const float* const* in; float* out; unsigned char* ws; unsigned char* ob;
};

__device__ __forceinline__ int win_src(int n) {
    if (n < 3072) return n;
    if (n < 4096) return 3088 + (n - 3072);
    if (n < 4352) return 4112 + (n - 4096);
    if (n < 4608) return 4368 + (n - 4352);
    if (n < 5120) return 4624 + (n - 4608);
    if (n < 6144) return 5208 + (n - 5120);
    if (n < 7168) return 6232 + (n - 6144);
    if (n < 7184) return 3072 + (n - 7168);
    if (n < 7248) return 5136 + (n - 7184);
    if (n < 7256) return 5200 + (n - 7248);
    return -1;
}
template <class SrcFn>
__device__ __forceinline__ void p0_transpose_item(SrcFn src, int ldw, int Kdim, bf16_t* WT, LAS float* scr, int kb, int nb, int lane) {
    const int k0 = 64 * kb, n0 = 32 * nb;
    const float* cp = src(n0 + (lane & 31));
#pragma unroll 8
    for (int i = 0; i < 32; ++i) { const int kk = 2 * i + (lane >> 5); scr[kk * 33 + (lane & 31)] = cp ? cp[(size_t)(k0 + kk) * ldw] : 0.f; }
    LDS_WAIT(); asm volatile("" ::: "memory");
    const int c = lane & 7;
#pragma unroll
    for (int j = 0; j < 4; ++j) { const int n = (lane >> 3) + 8 * j; const LAS float* s = scr + (8 * c) * 33 + n;
        u32x4 o; o.x = cvt_pk_bf16(s[0 * 33], s[1 * 33]); o.y = cvt_pk_bf16(s[2 * 33], s[3 * 33]); o.z = cvt_pk_bf16(s[4 * 33], s[5 * 33]); o.w = cvt_pk_bf16(s[6 * 33], s[7 * 33]);
        *(GAS u32x4*)(WT + (size_t)(n0 + n) * Kdim + k0 + 8 * c) = o; }
    LDS_WAIT(); asm volatile("" ::: "memory");
}
__device__ __forceinline__ void p0_prologue(Frame& F) {
    LAS float* scr = (LAS float*)(F.lds + F.wave * 16384);
    const int gw = F.vcu * NWAVES + F.wave, NGW = F.G * NWAVES, lane = F.lane;
    const float* w_in = F.in[10]; const float* w_bs = F.in[20]; const float* w_ba = F.in[21]; const float* w_out = F.in[22];
    const float* w_gate = F.in[24]; const float* w_up = F.in[25]; const float* w_dn = F.in[26];
    bf16_t* WIN = (bf16_t*)(F.ws + WS_WIN); bf16_t* WBS = (bf16_t*)(F.ws + WS_WBS); bf16_t* WBA = (bf16_t*)(F.ws + WS_WBA); bf16_t* WOUT = (bf16_t*)(F.ws + WS_WOUT);
    bf16_t* WGU = (bf16_t*)(F.ws + WS_WGU); bf16_t* WDN = (bf16_t*)(F.ws + WS_WDN);
    constexpr int I_IN = 16 * (NIN / 32), I_SQ = 16 * 32, I_GU = 16 * (NGU / 32), I_DN = (DFF / 64) * 32;
    constexpr int NITEMS = I_IN + 3 * I_SQ + I_GU + I_DN;
    for (int it = gw; it < NITEMS; it += NGW) {
        int r = it;
        if (r < I_IN) { const int nb = r % (NIN / 32), kb = r / (NIN / 32);
            p0_transpose_item([&](int n) -> const float* { const int s = win_src(n); return s >= 0 ? w_in + s : nullptr; }, 7256, 1024, WIN, scr, kb, nb, lane); continue; } r -= I_IN;
        if (r < I_SQ) { p0_transpose_item([&](int n) -> const float* { return w_bs + n; }, 1024, 1024, WBS, scr, r / 32, r % 32, lane); continue; } r -= I_SQ;
        if (r < I_SQ) { p0_transpose_item([&](int n) -> const float* { return w_ba + n; }, 1024, 1024, WBA, scr, r / 32, r % 32, lane); continue; } r -= I_SQ;
        if (r < I_SQ) { p0_transpose_item([&](int n) -> const float* { return w_out + n; }, 1024, 1024, WOUT, scr, r / 32, r % 32, lane); continue; } r -= I_SQ;
        if (r < I_GU) { const int nb = r % (NGU / 32), kb = r / (NGU / 32);
            p0_transpose_item([&](int n) -> const float* { const int t = n >> 8, j = n & 255, ch = t * 128 + (j >> 3) * 4 + (j & 3); return ((j & 4) ? w_up : w_gate) + ch; }, DFF, 1024, WGU, scr, kb, nb, lane); continue; } r -= I_GU;
        p0_transpose_item([&](int n) -> const float* { return w_dn + n; }, 1024, DFF, WDN, scr, r / 32, r % 32, lane);
    }
    const float* xp = F.in[0]; const float* xs = F.in[1]; const float* meta = F.in[7]; const float* n1w = F.in[9];
    bf16_t* HN = (bf16_t*)(F.ob + DO_HN);
    f32x4 wv[4];
#pragma unroll
    for (int j = 0; j < 4; ++j) wv[j] = *((const f32x4*)n1w + lane + 64 * j);
    for (int m = gw; m < RPAD; m += NGW) {
        GAS u32x2* o8 = (GAS u32x2*)(HN + (size_t)m * DM) + lane;
        if (m >= RR) {
#pragma unroll
            for (int j = 0; j < 4; ++j) o8[64 * j] = (u32x2){0u, 0u};
            continue; }
        const float* xrow;
        if (m < RPR) { const int b = m / TP, t = m - b * TP; xrow = t < NMETA ? meta + (size_t)t * DM : xp + ((size_t)b * SEQ + (t - NMETA)) * DM; }
        else xrow = xs + (size_t)(m - RPR) * DM;
        const f32x4* xr = (const f32x4*)xrow + lane;
        f32x4 v[4]; float s = 0.f;
#pragma unroll
        for (int j = 0; j < 4; ++j) { v[j] = xr[64 * j]; s += (v[j].x * v[j].x + v[j].y * v[j].y) + (v[j].z * v[j].z + v[j].w * v[j].w); }
        const float rs = __builtin_amdgcn_rsqf(wave_sum(s) * (1.f / DM) + EPS);
#pragma unroll
        for (int j = 0; j < 4; ++j) { const f32x4 y = v[j] * rs * wv[j]; o8[64 * j] = (u32x2){cvt_pk_bf16(y.x, y.y), cvt_pk_bf16(y.z, y.w)}; }
    }
    { const f32x4* ck = (const f32x4*)F.in[2]; const f32x4* cv = (const f32x4*)F.in[3]; GAS u32x4* ok = (GAS u32x4*)(F.ws + WS_CK); GAS u32x4* ov = (GAS u32x4*)(F.ob + DO_CV);
      const long n8 = (long)NBATCH * PAST * 256 / 8; const long gt = (long)F.vcu * NTHR + F.tid, GT = (long)F.G * NTHR;
      for (long i = gt; i < 2 * n8; i += GT) { const bool isk = i < n8; const long j = isk ? i : i - n8; const f32x4* s = (isk ? ck : cv) + 2 * j;
          const f32x4 a = s[0], b = s[1]; u32x4 o; o.x = cvt_pk_bf16(a.x, a.y); o.y = cvt_pk_bf16(a.z, a.w); o.z = cvt_pk_bf16(b.x, b.y); o.w = cvt_pk_bf16(b.z, b.w);
          (isk ? ok : ov)[j] = o; } }
    { float* s1 = (float*)(F.ws + WS_SSQ1); const int gt = F.vcu * NTHR + F.tid, GT = F.G * NTHR;
      for (int i = gt; i < (int)((WS_PART - WS_SSQ1) / 4); i += GT) s1[i] = 0.f; }
}

struct SchedP1 {
    const char* A; const char* B; int G, c;
    __device__ __forceinline__ bool next(int i, pg8::Unit& u) const {
        const int L = i * G + c; if (L >= 67 * 29) return false;
        pg8::tile_of(L, 67, 29, u.pm, u.pn); u.part = 0; u.A = A + (size_t)u.pm * 256 * 1024 * 2; u.B = B + (size_t)u.pn * 256 * 1024 * 2; return true; }
};
struct EpiP1 {
    static constexpr bool PERM = true;
    unsigned char* ws; unsigned char* ob;
    __device__ __forceinline__ bool operator()(pg8::Acc& acc, const pg8::Unit& u, int wr, int wc, int fr, int fq) const {
        const int pn = u.pn; const int row0 = u.pm * 256 + wr * 64 + fr, cw = wc * 32 + 8 * fq;
        if (pn == 28) {
            float* SM = (float*)(ws + WS_SM);
            if (cw < SMLD) {
#pragma unroll
                for (int ai = 0; ai < 2; ++ai)
#pragma unroll
                    for (int m = 0; m < 4; ++m) { const int r = row0 + ai * 128 + m * 16; if (r < RR) { float* p = SM + (size_t)r * SMLD + cw; *(f32x4*)p = acc[ai][0][m][0]; *(f32x4*)(p + 4) = acc[ai][0][m][1]; } }
            }
            return false;
        }
        bf16_t* base; int ld, c0;
        if (pn < 4) { base = (bf16_t*)(ws + WS_Z); ld = 1024; c0 = pn * 256; }
        else if (pn < 8) { base = (bf16_t*)(ws + WS_XS); ld = 1024; c0 = (pn - 4) * 256; }
        else if (pn < 12) { base = (bf16_t*)(ws + WS_BC); ld = 1024; c0 = (pn - 8) * 256; }
        else if (pn < 16) { base = (bf16_t*)(ob + DO_Q); ld = 1024; c0 = (pn - 12) * 256; }
        else if (pn == 16) { base = (bf16_t*)(ws + WS_K); ld = 256; c0 = 0; }
        else if (pn == 17) { base = (bf16_t*)(ws + WS_V); ld = 256; c0 = 0; }
        else if (pn < 20) { base = (bf16_t*)(ob + DO_QI); ld = 512; c0 = (pn - 18) * 256; }
        else if (pn < 24) { base = (bf16_t*)(ws + WS_GS); ld = 1024; c0 = (pn - 20) * 256; }
        else { base = (bf16_t*)(ws + WS_GA); ld = 1024; c0 = (pn - 24) * 256; }
#pragma unroll
        for (int ai = 0; ai < 2; ++ai)
#pragma unroll
            for (int m = 0; m < 4; ++m) { const int r = row0 + ai * 128 + m * 16;
                if (r < RR) { bf16_t* rowp = base + (size_t)r * ld + c0 + cw;
#pragma unroll
                    for (int bj = 0; bj < 2; ++bj) { const f32x4 v0 = acc[ai][bj][m][0], v1 = acc[ai][bj][m][1];
                        u32x4 w; w.x = cvt_pk_bf16(v0[0], v0[1]); w.y = cvt_pk_bf16(v0[2], v0[3]); w.z = cvt_pk_bf16(v1[0], v1[1]); w.w = cvt_pk_bf16(v1[2], v1[3]);
                        *(u32x4*)(rowp + bj * 128) = w; } } }
        return false;
    }
};

__device__ __forceinline__ void p2_rows(Frame& F) {
    const int gw = F.vcu * NWAVES + F.wave, NGW = F.G * NWAVES, lane = F.lane;
    bf16_t* Q = (bf16_t*)(F.ob + DO_Q); bf16_t* K = (bf16_t*)(F.ws + WS_K); const bf16_t* V = (const bf16_t*)(F.ws + WS_V);
    float* SM = (float*)(F.ws + WS_SM); bf16_t* KI = (bf16_t*)(F.ws + WS_KI);
    const float* qnw = F.in[17]; const float* knw = F.in[18]; const float* ikw = F.in[19]; const float* dtb = F.in[13];
    f32x4 qw[4];
#pragma unroll
    for (int j = 0; j < 4; ++j) qw[j] = *(const f32x4*)(qnw + (lane & 7) * 16 + 4 * j);
    const f32x4 kw = *(const f32x4*)(knw + (lane & 31) * 4);
    const float iw = ikw[lane]; const float dbias = lane < 16 ? dtb[lane] : 0.f;
    constexpr float QSC = 0.08838834764831845f * 1.4426950408889634f;
    for (int r = gw; r < RR; r += NGW) {
        const bool pr = r < RPR; const size_t orow = pr ? (size_t)r : (size_t)(r - RPR);
        float* k_out = F.out + (pr ? O_KP : O_KS) + orow * 256; float* v_out = F.out + (pr ? O_VP : O_VS) + orow * 256; float* ki_out = F.out + (pr ? O_KIP : O_KIS) + orow * 64;
        { u32x4* qp = (u32x4*)(Q + (size_t)r * 1024) + lane * 2; const u32x4 a = qp[0], b = qp[1];
          float x[16]; x[0] = bf_lo(a.x); x[1] = bf_hi(a.x); x[2] = bf_lo(a.y); x[3] = bf_hi(a.y); x[4] = bf_lo(a.z); x[5] = bf_hi(a.z); x[6] = bf_lo(a.w); x[7] = bf_hi(a.w);
          x[8] = bf_lo(b.x); x[9] = bf_hi(b.x); x[10] = bf_lo(b.y); x[11] = bf_hi(b.y); x[12] = bf_lo(b.z); x[13] = bf_hi(b.z); x[14] = bf_lo(b.w); x[15] = bf_hi(b.w);
          float s = 0.f;
#pragma unroll
          for (int j = 0; j < 16; ++j) s += x[j] * x[j];
          s += __shfl_xor(s, 1); s += __shfl_xor(s, 2); s += __shfl_xor(s, 4);
          const float rs = __builtin_amdgcn_rsqf(s * (1.f / HD) + EPS) * QSC;
#pragma unroll
          for (int j = 0; j < 16; ++j) x[j] = x[j] * rs * qw[j >> 2][j & 3];
          u32x4 oa, ob; oa.x = cvt_pk_bf16(x[0], x[1]); oa.y = cvt_pk_bf16(x[2], x[3]); oa.z = cvt_pk_bf16(x[4], x[5]); oa.w = cvt_pk_bf16(x[6], x[7]);
          ob.x = cvt_pk_bf16(x[8], x[9]); ob.y = cvt_pk_bf16(x[10], x[11]); ob.z = cvt_pk_bf16(x[12], x[13]); ob.w = cvt_pk_bf16(x[14], x[15]);
          qp[0] = oa; qp[1] = ob; }
        { u32x2* kp = (u32x2*)(K + (size_t)r * 256) + lane; const u32x2 a = *kp;
          f32x4 x = {bf_lo(a.x), bf_hi(a.x), bf_lo(a.y), bf_hi(a.y)};
          float s = (x.x * x.x + x.y * x.y) + (x.z * x.z + x.w * x.w);
          s += __shfl_xor(s, 1); s += __shfl_xor(s, 2); s += __shfl_xor(s, 4); s += __shfl_xor(s, 8); s += __shfl_xor(s, 16);
          const float rs = __builtin_amdgcn_rsqf(s * (1.f / HD) + EPS);
          x = x * rs * kw;
          *kp = (u32x2){cvt_pk_bf16(x.x, x.y), cvt_pk_bf16(x.z, x.w)};
          *((f32x4*)k_out + lane) = x;
          const u32x2 vv = *((const u32x2*)(V + (size_t)r * 256) + lane);
          *((f32x4*)v_out + lane) = (f32x4){bf_lo(vv.x), bf_hi(vv.x), bf_lo(vv.y), bf_hi(vv.y)}; }
        { float* sm = SM + (size_t)r * SMLD;
          const float kv = sm[16 + lane]; const float ss = wave_sum(kv * kv);
          const float kn = kv * __builtin_amdgcn_rsqf(ss * (1.f / IDXD) + EPS) * iw;
          KI[(size_t)r * 64 + lane] = f2bf(kn); ki_out[lane] = kn;
          if (lane < 16) { const float x = sm[lane] + dbias; sm[lane] = x > 20.f ? x : log1pf(expf(x)); }
          if (lane < 8) sm[80 + lane] *= 0.04419417382415922f; }
    }
    { const bf16_t* XS = (const bf16_t*)(F.ws + WS_XS); const bf16_t* BC = (const bf16_t*)(F.ws + WS_BC); bf16_t* HAL = (bf16_t*)(F.ws + WS_HAL);
      for (int it = gw; it < 48 + 768; it += NGW) {
          if (it < 48) { const int s = it / 3, i = it % 3; const int r = s < 8 ? s * TP + (TP - 3 + i) : RPR + (s - 8) * DSEQ + (DSEQ - 3 + i);
              float* o = F.out + (s < 8 ? O_CVP + (size_t)(s * 3 + i) * CONV_DIM : O_CVS + (size_t)((s - 8) * 3 + i) * CONV_DIM);
#pragma unroll
              for (int j = 0; j < 4; ++j) { const int c = j * 256 + lane * 4;
                  const u32x2 a = *(const u32x2*)(XS + (size_t)r * 1024 + c); *(f32x4*)(o + c) = (f32x4){bf_lo(a.x), bf_hi(a.x), bf_lo(a.y), bf_hi(a.y)};
                  const u32x2 b = *(const u32x2*)(BC + (size_t)r * 1024 + c); *(f32x4*)(o + 1024 + c) = (f32x4){bf_lo(b.x), bf_hi(b.x), bf_lo(b.y), bf_hi(b.y)}; } }
          else { const int h = it - 48, b = h / 96, jb = (h % 96) / 3, i = h % 3; const int r = b * TP + 64 * (jb + 1) - 3 + i;
              bf16_t* o = HAL + (size_t)((b * 33 + jb + 1) * 3 + i) * CONV_DIM;
#pragma unroll
              for (int j = 0; j < 2; ++j) { const int c = j * 512 + lane * 8;
                  *(u32x4*)(o + c) = *(const u32x4*)(XS + (size_t)r * 1024 + c); *(u32x4*)(o + 1024 + c) = *(const u32x4*)(BC + (size_t)r * 1024 + c); } }
      } }
}

__device__ __forceinline__ int t5_bucket(int rel) {
    const int n = rel < 0 ? -rel : rel; const int ret = rel > 0 ? 16 : 0;
    const int v = n < 8 ? n : (n < 12 ? 8 : n < 16 ? 9 : n < 23 ? 10 : n < 32 ? 11 : n < 46 ? 12 : n < 64 ? 13 : n < 91 ? 14 : 15);
    return ret + v;
}
__device__ __forceinline__ void ssd_slow(Frame& F) {
    if (F.wave != 0) return;
    const int lane = F.lane;
    bf16_t* XS = (bf16_t*)(F.ws + WS_XS); const bf16_t* BC = (const bf16_t*)(F.ws + WS_BC); const bf16_t* Z = (const bf16_t*)(F.ws + WS_Z);
    const float* SM = (const float*)(F.ws + WS_SM); float* SSQ1 = (float*)(F.ws + WS_SSQ1);
    const float* conv_w = F.in[11]; const float* conv_b = F.in[12]; const float* a_log = F.in[14]; const float* d_skip = F.in[15]; const float* snw = F.in[16];
    const float* st_ssm = F.in[5]; const float* st_conv = F.in[6];
    LAS float* sbc = (LAS float*)F.lds;
    for (int item = F.vcu; item < 256; item += F.G) {
        const bool pr = item < 128; const int bh = item & 127, b = bh >> 4, h = bh & 15, g = h >> 2;
        const int T = pr ? TP : DSEQ; const int row0 = pr ? b * TP : RPR + b * DSEQ;
        const int xch = h * 64 + lane;
        const int bcc = lane < 32 ? g * 128 + 4 * lane : 512 + g * 128 + 4 * (lane - 32);
        float wx[4], bx; f32x4 wb[4], bb;
#pragma unroll
        for (int i = 0; i < 4; ++i) { wx[i] = conv_w[i * CONV_DIM + xch]; wb[i] = *(const f32x4*)(conv_w + i * CONV_DIM + 1024 + bcc); }
        bx = conv_b[xch]; bb = *(const f32x4*)(conv_b + 1024 + bcc);
        float xp[3]; f32x4 bp[3];
#pragma unroll
        for (int i = 0; i < 3; ++i) { if (pr) { xp[i] = 0.f; bp[i] = (f32x4){0.f, 0.f, 0.f, 0.f}; } else { xp[i] = st_conv[(size_t)(b * 3 + i) * CONV_DIM + xch]; bp[i] = *(const f32x4*)(st_conv + (size_t)(b * 3 + i) * CONV_DIM + 1024 + bcc); } }
        float hs[128];
        float* sout = F.out + (pr ? O_SSMP : O_SSMS) + ((size_t)(b * 16 + h) * 64 + lane) * 128;
        if (pr) {
#pragma unroll
            for (int n = 0; n < 128; ++n) hs[n] = 0.f;
        } else { const float* sp = st_ssm + ((size_t)(b * 16 + h) * 64 + lane) * 128;
#pragma unroll
            for (int n = 0; n < 128; n += 4) { const f32x4 v = *(const f32x4*)(sp + n); hs[n] = v.x; hs[n + 1] = v.y; hs[n + 2] = v.z; hs[n + 3] = v.w; } }
        const float a_h = -expf(a_log[h]), dsk = d_skip[h], nw = snw[xch];
        for (int t = 0; t < T; ++t) {
            const size_t r = (size_t)(row0 + t);
            const float xr = bf2f(XS[r * 1024 + xch]);
            const u32x2 bcr = *(const u32x2*)(BC + r * 1024 + bcc);
            const f32x4 br = {bf_lo(bcr.x), bf_hi(bcr.x), bf_lo(bcr.y), bf_hi(bcr.y)};
            const float zv = bf2f(Z[r * 1024 + xch]);
            const float dt = SM[r * SMLD + h];
            float xc = bx + xp[0] * wx[0] + xp[1] * wx[1] + xp[2] * wx[2] + xr * wx[3];
            f32x4 bc = bb + bp[0] * wb[0] + bp[1] * wb[1] + bp[2] * wb[2] + br * wb[3];
            xp[0] = xp[1]; xp[1] = xp[2]; xp[2] = xr; bp[0] = bp[1]; bp[1] = bp[2]; bp[2] = br;
            xc = siluf_(xc); bc.x = siluf_(bc.x); bc.y = siluf_(bc.y); bc.z = siluf_(bc.z); bc.w = siluf_(bc.w);
            *(LAS f32x4*)(sbc + 4 * lane) = bc;
            LDS_WAIT(); asm volatile("" ::: "memory");
            const float dA = expf(dt * a_h), dx = dt * xc;
            float y = 0.f;
#pragma unroll
            for (int n = 0; n < 128; n += 4) { const f32x4 Bv = *(const LAS f32x4*)(sbc + n); const f32x4 Cv = *(const LAS f32x4*)(sbc + 128 + n);
                hs[n] = hs[n] * dA + dx * Bv.x; y += Cv.x * hs[n];
                hs[n + 1] = hs[n + 1] * dA + dx * Bv.y; y += Cv.y * hs[n + 1];
                hs[n + 2] = hs[n + 2] * dA + dx * Bv.z; y += Cv.z * hs[n + 2];
                hs[n + 3] = hs[n + 3] * dA + dx * Bv.w; y += Cv.w * hs[n + 3]; }
            LDS_WAIT(); asm volatile("" ::: "memory");
            y = (y + dsk * xc) * siluf_(zv);
            const float ss = wave_sum(y * y);
            if (lane == 0) atomicAdd(SSQ1 + r, ss);
            XS[r * 1024 + xch] = f2bf(y * nw);
        }
#pragma unroll
        for (int n = 0; n < 128; n += 4) *(f32x4*)(sout + n) = (f32x4){hs[n], hs[n + 1], hs[n + 2], hs[n + 3]};
    }
}

template <bool PR>
__device__ __forceinline__ void attn_slow_query(Frame& F, int r, LAS unsigned char* wl) {
    const int lane = F.lane;
    bf16_t* Q = (bf16_t*)(F.ob + DO_Q); const bf16_t* QI = (const bf16_t*)(F.ob + DO_QI); const bf16_t* KI = (const bf16_t*)(F.ws + WS_KI);
    const bf16_t* Kb = (const bf16_t*)(F.ws + WS_K); const bf16_t* Vb = (const bf16_t*)(F.ws + WS_V); const bf16_t* CK = (const bf16_t*)(F.ws + WS_CK); const bf16_t* CV = (const bf16_t*)(F.ob + DO_CV);
    const float* SM = (const float*)(F.ws + WS_SM); const float* ckidx = F.in[4]; const float* relb = F.in[8];
    int b, tq, L, qpos, krow0;
    if (PR) { b = r / TP; tq = r - b * TP; const int qc = (tq - NMETA) / 64 + 1; L = NMETA + 64 * qc; qpos = tq; krow0 = b * TP; }
    else { b = (r - RPR) / DSEQ; tq = (r - RPR) - b * DSEQ; L = LS; qpos = PAST + tq; krow0 = RPR + b * DSEQ; }
    LAS float* qf = (LAS float*)wl;
    LAS unsigned* list = (LAS unsigned*)(wl + 2048);
    LAS float* pl = (LAS float*)(wl + 3072);
    LAS unsigned* keys = (LAS unsigned*)(wl + 7168);
    const int ni = (L + 63) >> 6;
    int nsel = 0;
    { const unsigned* mrow = r < RPR ? (const unsigned*)(F.ws + WS_MASK) + (size_t)r * MASK_LDP : (const unsigned*)(F.ws + WS_MASKS) + (size_t)(r - RPR) * MASK_LDS;
      const unsigned long long lt_mask = (1ull << lane) - 1ull;
#pragma unroll 1
      for (int i = 0; i < ni; ++i) { const unsigned wd = mrow[2 * i + (lane >> 5)]; const bool sel = (wd >> (lane & 31)) & 1u; const unsigned long long ms = __ballot(sel);
          if (sel && nsel + __popcll(ms & lt_mask) < TOPK) list[nsel + __popcll(ms & lt_mask)] = (unsigned)(i * 64 + lane);
          nsel += __popcll(ms); }
      if (nsel > TOPK) nsel = TOPK; }
    (void)SM; (void)QI; (void)KI; (void)ckidx; (void)keys;
    LDS_WAIT(); asm volatile("" ::: "memory");
#pragma unroll 1
    for (int g = 0; g < 2; ++g) {
        { const u32x4 a = *((const u32x4*)(Q + (size_t)r * 1024 + g * 512) + lane);
          LAS float* d = qf + lane * 8; d[0] = bf_lo(a.x); d[1] = bf_hi(a.x); d[2] = bf_lo(a.y); d[3] = bf_hi(a.y); d[4] = bf_lo(a.z); d[5] = bf_hi(a.z); d[6] = bf_lo(a.w); d[7] = bf_hi(a.w); }
        LDS_WAIT(); asm volatile("" ::: "memory");
        float mx[4] = {-1e30f, -1e30f, -1e30f, -1e30f};
        const int njj = (nsel + 63) >> 6;
#pragma unroll 1
        for (int jj = 0; jj < njj; ++jj) { const int j = jj * 64 + lane;
            const int s = j < nsel ? (int)list[j] : (int)list[0];
            const bf16_t* kp = (!PR && s < PAST) ? CK + ((size_t)b * PAST + s) * 256 + g * 128 : Kb + (size_t)(PR ? krow0 + s : krow0 + s - PAST) * 256 + g * 128;
            float d0 = 0.f, d1 = 0.f, d2 = 0.f, d3 = 0.f;
#pragma unroll 1
            for (int c = 0; c < 16; ++c) { const u32x4 v = *((const u32x4*)kp + c);
                const float k0 = bf_lo(v.x), k1 = bf_hi(v.x), k2 = bf_lo(v.y), k3 = bf_hi(v.y), k4 = bf_lo(v.z), k5 = bf_hi(v.z), k6 = bf_lo(v.w), k7 = bf_hi(v.w);
#define DOT8(hh, acc) { const f32x4 qa = *(const LAS f32x4*)(qf + hh * 128 + c * 8), qb = *(const LAS f32x4*)(qf + hh * 128 + c * 8 + 4); \
                    acc += qa.x * k0 + qa.y * k1 + qa.z * k2 + qa.w * k3 + qb.x * k4 + qb.y * k5 + qb.z * k6 + qb.w * k7; }
                DOT8(0, d0) DOT8(1, d1) DOT8(2, d2) DOT8(3, d3)
#undef DOT8
            }
            const int bk = t5_bucket(s - qpos);
            const f32x4 bv = *(const f32x4*)(relb + bk * 8 + g * 4);
            constexpr float L2E = 1.4426950408889634f;
            const bool ok = j < nsel;
            f32x4 lgv; lgv.x = ok ? d0 + bv.x * L2E : -1e30f; lgv.y = ok ? d1 + bv.y * L2E : -1e30f; lgv.z = ok ? d2 + bv.z * L2E : -1e30f; lgv.w = ok ? d3 + bv.w * L2E : -1e30f;
            *(LAS f32x4*)(pl + j * 4) = lgv;
            mx[0] = fmaxf(mx[0], lgv.x); mx[1] = fmaxf(mx[1], lgv.y); mx[2] = fmaxf(mx[2], lgv.z); mx[3] = fmaxf(mx[3], lgv.w);
        }
        float sm[4] = {0.f, 0.f, 0.f, 0.f};
#pragma unroll
        for (int h = 0; h < 4; ++h) {
#pragma unroll
            for (int o = 1; o < 64; o <<= 1) mx[h] = fmaxf(mx[h], __shfl_xor(mx[h], o)); }
        LDS_WAIT(); asm volatile("" ::: "memory");
#pragma unroll 1
        for (int jj = 0; jj < njj; ++jj) { const int j = jj * 64 + lane;
            f32x4 lgv = *(const LAS f32x4*)(pl + j * 4);
            lgv.x = __builtin_amdgcn_exp2f(lgv.x - mx[0]); lgv.y = __builtin_amdgcn_exp2f(lgv.y - mx[1]); lgv.z = __builtin_amdgcn_exp2f(lgv.z - mx[2]); lgv.w = __builtin_amdgcn_exp2f(lgv.w - mx[3]);
            sm[0] += lgv.x; sm[1] += lgv.y; sm[2] += lgv.z; sm[3] += lgv.w;
            *(LAS f32x4*)(pl + j * 4) = lgv; }
#pragma unroll
        for (int h = 0; h < 4; ++h) sm[h] = __builtin_amdgcn_rcpf(wave_sum(sm[h]));
        LDS_WAIT(); asm volatile("" ::: "memory");
        float o[4][2] = {};
        for (int j = 0; j < nsel; ++j) {
            const int s = (int)list[j]; const f32x4 p = *(const LAS f32x4*)(pl + j * 4);
            const bf16_t* vp = (!PR && s < PAST) ? CV + ((size_t)b * PAST + s) * 256 + g * 128 : Vb + (size_t)(PR ? krow0 + s : krow0 + s - PAST) * 256 + g * 128;
            const unsigned vv = *((const unsigned*)vp + lane); const float v0 = bf_lo(vv), v1 = bf_hi(vv);
            o[0][0] += p.x * v0; o[0][1] += p.x * v1; o[1][0] += p.y * v0; o[1][1] += p.y * v1; o[2][0] += p.z * v0; o[2][1] += p.z * v1; o[3][0] += p.w * v0; o[3][1] += p.w * v1;
        }
#pragma unroll
        for (int h = 0; h < 4; ++h) *((unsigned*)(Q + (size_t)r * 1024 + g * 512 + h * 128) + lane) = cvt_pk_bf16(o[h][0] * sm[h], o[h][1] * sm[h]);
        LDS_WAIT(); asm volatile("" ::: "memory");
    }
}
__device__ __forceinline__ void attn_slow(Frame& F) {
    const int gw = F.vcu * NWAVES + F.wave, NGW = F.G * NWAVES;
    for (int q = gw; q < YPR; q += NGW) { const int b = q / SEQ, t = q - b * SEQ; attn_slow_query<true>(F, b * TP + NMETA + t, F.lds + F.wave * 16384); }
    __syncthreads();
    if (F.wave < 4) { const int gw4 = F.vcu * 4 + F.wave;
        for (int q = gw4; q < RSR; q += F.G * 4) attn_slow_query<false>(F, RPR + q, F.lds + F.wave * 32768); }
}
__device__ __forceinline__ void conv_units(Frame& F) {
    bf16_t* XS = (bf16_t*)(F.ws + WS_XS); bf16_t* BC = (bf16_t*)(F.ws + WS_BC); const bf16_t* HAL = (const bf16_t*)(F.ws + WS_HAL);
    const float* conv_w = F.in[11]; const float* conv_b = F.in[12]; const float* st_conv = F.in[6];
    const int cg = F.tid & 63, rc = F.wave;
    constexpr int NU = (NBATCH * 33 + NBATCH) * 4;
    for (int u = F.vcu; u < NU; u += F.G) {
        const int cq = u & 3, sb = u >> 2; const bool pr = sb < NBATCH * 33;
        const int b = pr ? sb / 33 : sb - NBATCH * 33, j = pr ? sb % 33 : 0;
        const int T = pr ? TP : DSEQ, row0 = (pr ? b * TP : RPR + b * DSEQ) + 64 * j, nvalid = T - 64 * j;
        const int ch = 512 * cq + 8 * cg;
        bf16_t* colp = ch < 1024 ? XS + ch : BC + (ch - 1024);
        float w[4][8], bias[8];
#pragma unroll
        for (int i = 0; i < 4; ++i) { const f32x4 a = *(const f32x4*)(conv_w + i * CONV_DIM + ch), c = *(const f32x4*)(conv_w + i * CONV_DIM + ch + 4);
            w[i][0] = a.x; w[i][1] = a.y; w[i][2] = a.z; w[i][3] = a.w; w[i][4] = c.x; w[i][5] = c.y; w[i][6] = c.z; w[i][7] = c.w; }
        { const f32x4 a = *(const f32x4*)(conv_b + ch), c = *(const f32x4*)(conv_b + ch + 4); bias[0] = a.x; bias[1] = a.y; bias[2] = a.z; bias[3] = a.w; bias[4] = c.x; bias[5] = c.y; bias[6] = c.z; bias[7] = c.w; }
        float x[11][8];
        const int t0 = 8 * rc;
#pragma unroll
        for (int i = 0; i < 11; ++i) {
            const int t = t0 - 3 + i;
            u32x4 v = {0u, 0u, 0u, 0u}; bool have = false;
            if (t >= 0) { if (t < nvalid) { v = *(const u32x4*)(colp + (size_t)(row0 + t) * 1024); have = true; } }
            else if (j > 0) { v = *(const u32x4*)(HAL + (size_t)((b * 33 + j) * 3 + (t + 3)) * CONV_DIM + ch); have = true; }
            else if (!pr) { const float* sp = st_conv + (size_t)(b * 3 + (t + 3)) * CONV_DIM + ch; const f32x4 a = *(const f32x4*)sp, c = *(const f32x4*)(sp + 4);
                x[i][0] = a.x; x[i][1] = a.y; x[i][2] = a.z; x[i][3] = a.w; x[i][4] = c.x; x[i][5] = c.y; x[i][6] = c.z; x[i][7] = c.w; continue; }
            (void)have;
            x[i][0] = bf_lo(v.x); x[i][1] = bf_hi(v.x); x[i][2] = bf_lo(v.y); x[i][3] = bf_hi(v.y); x[i][4] = bf_lo(v.z); x[i][5] = bf_hi(v.z); x[i][6] = bf_lo(v.w); x[i][7] = bf_hi(v.w);
        }
        __syncthreads();
#pragma unroll
        for (int r = 0; r < 8; ++r) { const int t = t0 + r;
            if (t < nvalid) { float o[8];
#pragma unroll
                for (int e = 0; e < 8; ++e) o[e] = siluf_(bias[e] + x[r][e] * w[0][e] + x[r + 1][e] * w[1][e] + x[r + 2][e] * w[2][e] + x[r + 3][e] * w[3][e]);
                u32x4 ov; ov.x = cvt_pk_bf16(o[0], o[1]); ov.y = cvt_pk_bf16(o[2], o[3]); ov.z = cvt_pk_bf16(o[4], o[5]); ov.w = cvt_pk_bf16(o[6], o[7]);
                *(u32x4*)(colp + (size_t)(row0 + t) * 1024) = ov; } }
        __syncthreads();
    }
}

namespace ssd {
constexpr int CL = 0, BL = 17408, XR = 34816, XW = 39936, WM = 45056, SB = 54272, FA = 62976, LDS_TOT = 63744;
constexpr int LDC = 272, LDX = 80, LDW = 144;
typedef short v4i16 __attribute__((ext_vector_type(4)));
__device__ __forceinline__ s16x4 trd(LAS unsigned char* p) { return __builtin_bit_cast(s16x4, __builtin_amdgcn_ds_read_tr16_b64_v4i16((LAS v4i16*)p)); }
__device__ __forceinline__ bf16x8 frag_tr(LAS unsigned char* img, int stride, int m0, int kb0, int i, int g4) {
    LAS unsigned char* p = img + (kb0 + 8 * g4 + (i >> 2)) * stride + (m0 + 4 * (i & 3)) * 2;
    const s16x4 lo = trd(p), hi = trd(p + 4 * stride);
    return (bf16x8){lo[0], lo[1], lo[2], lo[3], hi[0], hi[1], hi[2], hi[3]};
}
__device__ __forceinline__ bf16x8 frag_row(LAS unsigned char* img, int stride, int r0, int kb0, int i, int g4) {
    return *(const LAS bf16x8*)(img + (r0 + i) * stride + (kb0 + 8 * g4) * 2);
}
}
__device__ __forceinline__ void ssd_chain_unit(Frame& F, int unit) {
    using namespace ssd;
    const int tid = F.tid, lane = F.lane, w = F.wave, i16 = lane & 15, g4 = lane >> 4;
    LAS unsigned char* L = F.lds;
    const bool pr = unit < 256; const int uu = unit & 255, b = uu >> 5, h = (uu >> 1) & 15, ph = uu & 1, g = h >> 2;
    const int T = pr ? TP : DSEQ, row0 = pr ? b * TP : RPR + b * DSEQ, nblk = (T + 63) >> 6;
    bf16_t* XS = (bf16_t*)(F.ws + WS_XS); const bf16_t* BC = (const bf16_t*)(F.ws + WS_BC); const bf16_t* Z = (const bf16_t*)(F.ws + WS_Z);
    const float* SM = (const float*)(F.ws + WS_SM); float* SSQ1 = (float*)(F.ws + WS_SSQ1);
    const int xcol = h * 64 + ph * 32;
    const float a_h = -expf(F.in[14][h]), dsk = F.in[15][h];
    const int cb_sb = w >> 1, cb_tb0 = 2 * (w & 1), y_pb = w & 1, y_tb = w >> 1;
    const int yp0 = 16 * y_pb + 4 * g4;
    const f32x4 nwv = *(const f32x4*)(F.in[16] + xcol + yp0);
    f32x4 st[2];
    float* sout = F.out + (pr ? O_SSMP : O_SSMS) + ((size_t)(b * 16 + h) * 64 + ph * 32) * 128;
    if (pr) { st[0] = (f32x4){0.f, 0.f, 0.f, 0.f}; st[1] = st[0]; }
    else { const float* sp = F.in[5] + ((size_t)(b * 16 + h) * 64 + ph * 32) * 128;
#pragma unroll
        for (int pb = 0; pb < 2; ++pb) st[pb] = *(const f32x4*)(sp + (size_t)(16 * pb + i16) * 128 + 16 * w + 4 * g4); }
    const int srow = tid >> 3, sch = tid & 7, xrow = tid >> 2, xch = tid & 3;
    u32x4 pB[2], pC[2], pX; u32x2 pZ; float pdt;
#define SSD_PREFETCH(jb) do { const int base_ = 64 * (jb); \
        { const bool ok_ = base_ + srow < T; const bf16_t* rp_ = BC + (size_t)(row0 + base_ + srow) * 1024 + g * 128 + 8 * sch; \
          pB[0] = ok_ ? *(const u32x4*)rp_ : (u32x4){0u, 0u, 0u, 0u}; pB[1] = ok_ ? *(const u32x4*)(rp_ + 64) : (u32x4){0u, 0u, 0u, 0u}; \
          pC[0] = ok_ ? *(const u32x4*)(rp_ + 512) : (u32x4){0u, 0u, 0u, 0u}; pC[1] = ok_ ? *(const u32x4*)(rp_ + 576) : (u32x4){0u, 0u, 0u, 0u}; } \
        if (tid < 256) { const bool ok_ = base_ + xrow < T; pX = ok_ ? *(const u32x4*)(XS + (size_t)(row0 + base_ + xrow) * 1024 + xcol + 8 * xch) : (u32x4){0u, 0u, 0u, 0u}; } \
        { const int t_ = base_ + 16 * y_tb + i16; pZ = t_ < T ? *(const u32x2*)(Z + (size_t)(row0 + t_) * 1024 + xcol + yp0) : (u32x2){0u, 0u}; } \
        { const int t_ = base_ + lane; pdt = t_ < T ? SM[(size_t)(row0 + t_) * SMLD + h] : 0.f; } } while (0)
    SSD_PREFETCH(0);
#pragma unroll 1
    for (int jb = 0; jb < nblk; ++jb) {
        float ac = pdt * a_h;
#pragma unroll
        for (int o = 1; o < 64; o <<= 1) { const float v = __shfl_up(ac, o); if (lane >= o) ac += v; }
        const float tot = __shfl(ac, 63);
        const float wsc = __builtin_amdgcn_exp2f((tot - ac) * 1.4426950408889634f) * pdt;
        if (w == 0) { LAS float* fa = (LAS float*)(L + FA); fa[lane] = ac; fa[64 + lane] = pdt; }
        *(LAS u32x4*)(L + BL + srow * LDC + 16 * sch) = pB[0]; *(LAS u32x4*)(L + BL + srow * LDC + 128 + 16 * sch) = pB[1];
        *(LAS u32x4*)(L + CL + srow * LDC + 16 * sch) = pC[0]; *(LAS u32x4*)(L + CL + srow * LDC + 128 + 16 * sch) = pC[1];
        if (tid < 256) { *(LAS u32x4*)(L + XR + xrow * LDX + 16 * xch) = pX;
            const float ws_ = __shfl(wsc, xrow & 63);
            u32x4 xw; xw.x = cvt_pk_bf16(bf_lo(pX.x) * ws_, bf_hi(pX.x) * ws_); xw.y = cvt_pk_bf16(bf_lo(pX.y) * ws_, bf_hi(pX.y) * ws_);
            xw.z = cvt_pk_bf16(bf_lo(pX.z) * ws_, bf_hi(pX.z) * ws_); xw.w = cvt_pk_bf16(bf_lo(pX.w) * ws_, bf_hi(pX.w) * ws_);
            *(LAS u32x4*)(L + XW + xrow * LDX + 16 * xch) = xw; }
#pragma unroll
        for (int pb = 0; pb < 2; ++pb)
            *(LAS u32x2*)(L + SB + (16 * pb + i16) * LDC + (16 * w + 4 * g4) * 2) = (u32x2){cvt_pk_bf16(st[pb].x, st[pb].y), cvt_pk_bf16(st[pb].z, st[pb].w)};
        const u32x2 zreg = pZ;
        __syncthreads();
        if (jb + 1 < nblk) SSD_PREFETCH(jb + 1);
        {
            f32x4 cb[2] = {{0.f, 0.f, 0.f, 0.f}, {0.f, 0.f, 0.f, 0.f}};
#pragma unroll
            for (int ks = 0; ks < 4; ++ks) { const bf16x8 af = frag_row(L + BL, LDC, 16 * cb_sb, 32 * ks, i16, g4);
#pragma unroll
                for (int q = 0; q < 2; ++q) { const bf16x8 bfv = frag_row(L + CL, LDC, 16 * (cb_tb0 + q), 32 * ks, i16, g4);
                    cb[q] = __builtin_amdgcn_mfma_f32_16x16x32_bf16(af, bfv, cb[q], 0, 0, 0); } }
            const LAS float* fa = (const LAS float*)(L + FA);
            const int s0 = 16 * cb_sb + 4 * g4;
            const f32x4 acs = *(const LAS f32x4*)(fa + s0), dts = *(const LAS f32x4*)(fa + 64 + s0);
#pragma unroll
            for (int q = 0; q < 2; ++q) { const int t = 16 * (cb_tb0 + q) + i16; const float act = fa[t];
                float o[4];
#pragma unroll
                for (int e = 0; e < 4; ++e) o[e] = (s0 + e <= t) ? cb[q][e] * __builtin_amdgcn_exp2f((act - acs[e]) * 1.4426950408889634f) * dts[e] : 0.f;
                *(LAS u32x2*)(L + WM + t * LDW + s0 * 2) = (u32x2){cvt_pk_bf16(o[0], o[1]), cvt_pk_bf16(o[2], o[3])}; }
            const float dtot = __builtin_amdgcn_exp2f(tot * 1.4426950408889634f);
            st[0] = st[0] * dtot; st[1] = st[1] * dtot;
#pragma unroll
            for (int ks = 0; ks < 2; ++ks) { const bf16x8 af = frag_tr(L + BL, LDC, 16 * w, 32 * ks, i16, g4);
#pragma unroll
                for (int pb = 0; pb < 2; ++pb) { const bf16x8 bfv = frag_tr(L + XW, LDX, 16 * pb, 32 * ks, i16, g4);
                    st[pb] = __builtin_amdgcn_mfma_f32_16x16x32_bf16(af, bfv, st[pb], 0, 0, 0); } }
        }
        __syncthreads();
        {
            f32x4 y = {0.f, 0.f, 0.f, 0.f};
#pragma unroll
            for (int ks = 0; ks < 4; ++ks) { const bf16x8 af = frag_row(L + SB, LDC, 16 * y_pb, 32 * ks, i16, g4), bfv = frag_row(L + CL, LDC, 16 * y_tb, 32 * ks, i16, g4);
                y = __builtin_amdgcn_mfma_f32_16x16x32_bf16(af, bfv, y, 0, 0, 0); }
            const LAS float* fa = (const LAS float*)(L + FA);
            const int t = 16 * y_tb + i16; const float eac = __builtin_amdgcn_exp2f(fa[t] * 1.4426950408889634f);
            y = y * eac;
#pragma unroll
            for (int ks = 0; ks < 2; ++ks) { const bf16x8 af = frag_tr(L + XR, LDX, 16 * y_pb, 32 * ks, i16, g4), bfv = frag_row(L + WM, LDW, 16 * y_tb, 32 * ks, i16, g4);
                y = __builtin_amdgcn_mfma_f32_16x16x32_bf16(af, bfv, y, 0, 0, 0); }
            const u32x2 xv = *(const LAS u32x2*)(L + XR + t * LDX + yp0 * 2);
            const f32x4 xf = {bf_lo(xv.x), bf_hi(xv.x), bf_lo(xv.y), bf_hi(xv.y)}, zf = {bf_lo(zreg.x), bf_hi(zreg.x), bf_lo(zreg.y), bf_hi(zreg.y)};
            f32x4 yo; yo.x = (y.x + dsk * xf.x) * siluf_(zf.x); yo.y = (y.y + dsk * xf.y) * siluf_(zf.y); yo.z = (y.z + dsk * xf.z) * siluf_(zf.z); yo.w = (y.w + dsk * xf.w) * siluf_(zf.w);
            float ss = (yo.x * yo.x + yo.y * yo.y) + (yo.z * yo.z + yo.w * yo.w);
            ss += __shfl_xor(ss, 16); ss += __shfl_xor(ss, 32);
            const int tg = 64 * jb + t;
            if (tg < T) { if (g4 == 0) atomicAdd(SSQ1 + row0 + tg, ss);
                yo = yo * nwv; *(u32x2*)(XS + (size_t)(row0 + tg) * 1024 + xcol + yp0) = (u32x2){cvt_pk_bf16(yo.x, yo.y), cvt_pk_bf16(yo.z, yo.w)}; }
        }
        __syncthreads();
    }
#undef SSD_PREFETCH
#pragma unroll
    for (int pb = 0; pb < 2; ++pb) *(f32x4*)(sout + (size_t)(16 * pb + i16) * 128 + 16 * w + 4 * g4) = st[pb];
}
__device__ __forceinline__ void ssd_chains(Frame& F) {
    for (int u = F.vcu; u < 512; u += F.G) ssd_chain_unit(F, u);
}
namespace idx {
constexpr int WTAB = 0, SCORES = 512;
}
__device__ __forceinline__ unsigned* mask_row(Frame& F, int r) {
    return r < RPR ? (unsigned*)(F.ws + WS_MASK) + (size_t)r * MASK_LDP : (unsigned*)(F.ws + WS_MASKS) + (size_t)(r - RPR) * MASK_LDS;
}
template <bool PR>
__device__ __forceinline__ void idx_unit(Frame& F, int b, int c, int qg) {
    constexpr int NQ = PR ? 16 : 8, NRB = NQ / 4;
    const int tid = F.tid, lane = F.lane, w = F.wave, r32 = lane & 31, hh = lane >> 5;
    LAS unsigned char* L_ = F.lds;
    const int Lk = PR ? NMETA + 64 * c : LS, LP = (Lk + 63) & ~63, nkb = LP >> 5;
    const int r0 = PR ? b * TP + NMETA + 64 * (c - 1) + NQ * qg : RPR + b * DSEQ + NQ * qg;
    const int krow0 = PR ? b * TP : RPR + b * DSEQ;
    const bf16_t* QI = (const bf16_t*)(F.ob + DO_QI); const bf16_t* KI = (const bf16_t*)(F.ws + WS_KI); const float* SM = (const float*)(F.ws + WS_SM); const float* ckidx = F.in[4];
    LAS float* wtab = (LAS float*)(L_ + idx::WTAB); LAS unsigned* sc = (LAS unsigned*)(L_ + idx::SCORES);
    if (tid < NQ * 8) wtab[tid] = SM[(size_t)(r0 + (tid >> 3)) * SMLD + 80 + (tid & 7)];
    bf16x8 af[NRB][4];
#pragma unroll
    for (int rb = 0; rb < NRB; ++rb)
#pragma unroll
        for (int ks = 0; ks < 4; ++ks) af[rb][ks] = *(const bf16x8*)(QI + (size_t)(r0 + 4 * rb) * 512 + r32 * 64 + 16 * ks + 8 * hh);
    __syncthreads();
#pragma unroll 1
    for (int kb = w; kb < nkb; kb += 8) {
        const int s = kb * 32 + r32; const int sc_ = s < Lk ? s : Lk - 1;
        bf16x8 bfr[4];
        if (!PR && kb * 32 < PAST) { const float* kp = ckidx + ((size_t)b * PAST + sc_) * 64 + 8 * hh;
#pragma unroll
            for (int ks = 0; ks < 4; ++ks) { const f32x4 x0 = *(const f32x4*)(kp + 16 * ks), x1 = *(const f32x4*)(kp + 16 * ks + 4);
                u32x4 t; t.x = cvt_pk_bf16(x0.x, x0.y); t.y = cvt_pk_bf16(x0.z, x0.w); t.z = cvt_pk_bf16(x1.x, x1.y); t.w = cvt_pk_bf16(x1.z, x1.w); bfr[ks] = __builtin_bit_cast(bf16x8, t); } }
        else { const bf16_t* kp = KI + (size_t)(PR ? krow0 + sc_ : krow0 + sc_ - PAST) * 64 + 8 * hh;
#pragma unroll
            for (int ks = 0; ks < 4; ++ks) bfr[ks] = *(const bf16x8*)(kp + 16 * ks); }
#pragma unroll
        for (int rb = 0; rb < NRB; ++rb) {
            f32x16 d = {};
#pragma unroll
            for (int ks = 0; ks < 4; ++ks) d = __builtin_amdgcn_mfma_f32_32x32x16_bf16(af[rb][ks], bfr[ks], d, 0, 0, 0);
            float tot[4];
#pragma unroll
            for (int tl = 0; tl < 4; ++tl) { const f32x4 wv = *(const LAS f32x4*)(wtab + (4 * rb + tl) * 8 + 4 * hh);
                float sacc = wv.x * fmaxf(d[4 * tl], 0.f) + wv.y * fmaxf(d[4 * tl + 1], 0.f) + wv.z * fmaxf(d[4 * tl + 2], 0.f) + wv.w * fmaxf(d[4 * tl + 3], 0.f);
                const auto rr = __builtin_amdgcn_permlane32_swap(__float_as_uint(sacc), __float_as_uint(sacc), false, false);
                tot[tl] = __uint_as_float(rr[0]) + __uint_as_float(rr[1]); }
#pragma unroll
            for (int q = 0; q < 2; ++q) { const int tl = 2 * hh + q; float v = hh ? (q ? tot[3] : tot[2]) : (q ? tot[1] : tot[0]);
                if (v == 0.f) v = 0.f;
                const unsigned u = __float_as_uint(v); const unsigned key = s < Lk ? ((u & 0x80000000u) ? ~u : (u | 0x80000000u)) : 0u;
                sc[(4 * rb + tl) * LP + s] = key; }
        }
    }
    __syncthreads();
    const unsigned long long lt_mask = (1ull << lane) - 1ull; const int ni = LP >> 6;
#pragma unroll 1
    for (int q = w; q < NQ; q += 8) {
        const LAS unsigned* row = sc + q * LP; unsigned* mrow = mask_row(F, r0 + q);
        unsigned prefix = 0u;
        for (int bit = 31; bit >= 0; --bit) { const unsigned cand = prefix | (1u << bit); int cnt = 0;
#pragma unroll 4
            for (int i = 0; i < ni; ++i) cnt += __popcll(__ballot(row[i * 64 + lane] >= cand));
            if (cnt >= TOPK) prefix = cand; }
        int ngt = 0;
#pragma unroll 4
        for (int i = 0; i < ni; ++i) ngt += __popcll(__ballot(row[i * 64 + lane] > prefix));
        const int need = TOPK - ngt; int eqseen = 0;
#pragma unroll 1
        for (int i = 0; i < ni; ++i) { const unsigned kv = row[i * 64 + lane]; const bool gt = kv > prefix, eq = kv == prefix; const unsigned long long meq = __ballot(eq);
            const bool sel = gt || (eq && (eqseen + __popcll(meq & lt_mask)) < need); const unsigned long long ms = __ballot(sel);
            if (lane == 0) *(u32x2*)(mrow + 2 * i) = (u32x2){(unsigned)ms, (unsigned)(ms >> 32)};
            eqseen += __popcll(meq); }
    }
    __syncthreads();
}
__device__ __forceinline__ void idx_allones(Frame& F, int b, int c) {
    const int Lk = NMETA + 64 * c, nw = ((Lk + 63) & ~63) >> 5;
    for (int e = F.tid; e < 64 * nw; e += NTHR) { const int q = e / nw, wd = e - q * nw; const int lo = 32 * wd;
        const unsigned m = lo + 32 <= Lk ? 0xffffffffu : (lo >= Lk ? 0u : ((1u << (Lk - lo)) - 1u));
        mask_row(F, b * TP + NMETA + 64 * (c - 1) + q)[wd] = m; }
}
__device__ __forceinline__ void idx_units(Frame& F) {
    constexpr int NPU = NBATCH * 29 * 4, NSU = NBATCH * 8, NAU = NBATCH * 3;
    for (int u = F.vcu; u < NPU + NSU + NAU; u += F.G) {
        if (u < NSU) { idx_unit<false>(F, u >> 3, 0, u & 7); }
        else if (u < NSU + NPU) { const int v = u - NSU; const int qg = v & 3, bc = v >> 2, b = bc & 7, c = 32 - (bc >> 3); idx_unit<true>(F, b, c, qg); }
        else { const int v = u - NSU - NPU; idx_allones(F, v & 7, 1 + (v >> 3)); }
    }
}
namespace att {
constexpr int SHM_V = 16384, SHM_K = 16384, OFF_V = 0, OFF_K = 2 * SHM_V, OFF_WS = OFF_K + 2 * SHM_K, OFF_TAB = OFF_WS + 8 * 256, OFF_OST = OFF_TAB + 4 * 320 * 4, OST_LD = 272, LDS_TOT = OFF_OST + 8 * 32 * OST_LD;
static_assert(LDS_TOT <= MISC_OFF, "attention LDS");
constexpr float NEG = -1e30f, MINIT = -1e20f, THR2 = 8.f, L2E = 1.4426950408889634f;
#define KSWZ(row, colB) ((row) * 256 + ((colB) ^ (((row) & 7) << 4)))
#define SBAR() __builtin_amdgcn_sched_barrier(0)
__device__ __forceinline__ int crow(int r, int hi) { return (r & 3) + 8 * (r >> 2) + 4 * hi; }
__device__ __forceinline__ int v_st(int k, int c) { const int kk = (k & ~0xC) | ((k & 4) << 1) | ((k & 8) >> 1); return ((kk >> 3) * 4 + (c >> 5)) * 512 + ((kk & 7) * 32 + (c & 31)) * 2; }
__device__ __forceinline__ int v_rd_base(int lane) { return ((lane & 3) << 3) | (((lane >> 2) & 3) << 6) | (((lane >> 4) & 1) << 5) | (((lane >> 5) & 1) << 8); }
constexpr int v_rd_off(int d0, int ks, int half) { return d0 * 512 + ks * 4096 + half * 2048; }
template <int OFF> __device__ __forceinline__ s16x4 tr_read(int vb) { s16x4 r; asm volatile("ds_read_b64_tr_b16 %0, %1 offset:%2" : "=&v"(r) : "v"(vb), "i"(OFF) : "memory"); return r; }
template <int D0> __device__ __forceinline__ void pv_one(f32x16& od, int vb, bf16x8 pa0, bf16x8 pa1, bf16x8 pa2, bf16x8 pa3) {
    const s16x4 l0 = tr_read<v_rd_off(D0, 0, 0)>(vb), h0 = tr_read<v_rd_off(D0, 0, 1)>(vb), l1 = tr_read<v_rd_off(D0, 1, 0)>(vb), h1 = tr_read<v_rd_off(D0, 1, 1)>(vb);
    const s16x4 l2 = tr_read<v_rd_off(D0, 2, 0)>(vb), h2 = tr_read<v_rd_off(D0, 2, 1)>(vb), l3 = tr_read<v_rd_off(D0, 3, 0)>(vb), h3 = tr_read<v_rd_off(D0, 3, 1)>(vb);
    asm volatile("s_waitcnt lgkmcnt(0)" ::: "memory"); SBAR();
#define PK(L, H) (bf16x8){L[0], L[1], L[2], L[3], H[0], H[1], H[2], H[3]}
    od = __builtin_amdgcn_mfma_f32_32x32x16_bf16(pa0, PK(l0, h0), od, 0, 0, 0);
    od = __builtin_amdgcn_mfma_f32_32x32x16_bf16(pa1, PK(l1, h1), od, 0, 0, 0);
    od = __builtin_amdgcn_mfma_f32_32x32x16_bf16(pa2, PK(l2, h2), od, 0, 0, 0);
    od = __builtin_amdgcn_mfma_f32_32x32x16_bf16(pa3, PK(l3, h3), od, 0, 0, 0);
#undef PK
}
__device__ __forceinline__ void qkt(f32x16& p0, f32x16& p1, const LAS unsigned char* Ks, const bf16x8* qr, float init, int r32, int hi) {
#pragma unroll
    for (int r = 0; r < 16; ++r) { p0[r] = init; p1[r] = init; }
#pragma unroll
    for (int d0 = 0; d0 < 8; ++d0) { const int cb = (d0 * 16 + hi * 8) * 2;
        const bf16x8 b0 = *(const LAS bf16x8*)(Ks + KSWZ(r32, cb)), b1 = *(const LAS bf16x8*)(Ks + KSWZ(32 + r32, cb));
        p0 = __builtin_amdgcn_mfma_f32_32x32x16_bf16(b0, qr[d0], p0, 0, 0, 0);
        p1 = __builtin_amdgcn_mfma_f32_32x32x16_bf16(b1, qr[d0], p1, 0, 0, 0); }
}
}

template <bool PR>
__device__ __forceinline__ void attn_unit(Frame& F, int b, int c, int g) {
    using namespace att;
    const int tid = F.tid, lane = F.lane, w = F.wave, r32 = lane & 31, hi = lane >> 5, hd = w >> 1, th = w & 1;
    LAS unsigned char* L = F.lds;
    const int qrow0 = PR ? b * TP + NMETA + 64 * (c - 1) : RPR + b * DSEQ, qpos0 = PR ? NMETA + 64 * (c - 1) : PAST;
    const int NT = PR ? c + 1 : LS / 64;
    bf16_t* Q = (bf16_t*)(F.ob + DO_Q);
    const bf16_t* Kb = (const bf16_t*)(F.ws + WS_K); const bf16_t* Vb = (const bf16_t*)(F.ws + WS_V); const bf16_t* CK = (const bf16_t*)(F.ws + WS_CK); const bf16_t* CV = (const bf16_t*)(F.ob + DO_CV);
    const float* relb = F.in[8];
    { LAS float* tab = (LAS float*)(L + OFF_TAB);
      for (int e = tid; e < 4 * 320; e += NTHR) { const int h4 = e / 320, rel = e - h4 * 320 - 192; tab[e] = relb[t5_bucket(rel) * 8 + g * 4 + h4] * L2E; } }
    const float cfar = relb[15 * 8 + g * 4 + hd] * L2E;
    bf16x8 qr[8];
    { const bf16_t* qp = Q + (size_t)(qrow0 + 32 * th + r32) * 1024 + g * 512 + hd * 128 + hi * 8;
#pragma unroll
      for (int d0 = 0; d0 < 8; ++d0) qr[d0] = *(const bf16x8*)(qp + d0 * 16); }
    const unsigned* mrow = PR ? (const unsigned*)(F.ws + WS_MASK) + (size_t)(qrow0 + 32 * th + r32) * MASK_LDP : (const unsigned*)(F.ws + WS_MASKS) + (size_t)(qrow0 - RPR + 32 * th + r32) * MASK_LDS;
    LAS float* wsf = (LAS float*)(L + OFF_WS) + w * 64;
    const int sr = tid >> 4, scol = (tid & 15) * 8, vst0 = v_st(sr, scol), vst1 = v_st(32 + sr, scol);
    const int vb0 = (int)(uintptr_t)(L + OFF_V) + v_rd_base(lane);
    float m_reg = MINIT, l_reg = 0.f; f32x16 o[4] = {};
    u32x4 sv0, sv1, sk0, sk1;
#define ATT_SRC(j, kt, vt) const bf16_t* kt; const bf16_t* vt; { if (PR) { kt = Kb + (size_t)(b * TP + 64 * (j)) * 256 + g * 128; vt = Vb + (size_t)(b * TP + 64 * (j)) * 256 + g * 128; } \
        else if ((j) < PAST / 64) { kt = CK + ((size_t)b * PAST + 64 * (j)) * 256 + g * 128; vt = CV + ((size_t)b * PAST + 64 * (j)) * 256 + g * 128; } \
        else { kt = Kb + (size_t)(RPR + b * DSEQ) * 256 + g * 128; vt = Vb + (size_t)(RPR + b * DSEQ) * 256 + g * 128; } }
#define ATT_SLOAD(j) do { ATT_SRC(j, kt_, vt_); sv0 = *(const u32x4*)(vt_ + (size_t)sr * 256 + scol); sv1 = *(const u32x4*)(vt_ + (size_t)(32 + sr) * 256 + scol); \
        sk0 = *(const u32x4*)(kt_ + (size_t)sr * 256 + scol); sk1 = *(const u32x4*)(kt_ + (size_t)(32 + sr) * 256 + scol); } while (0)
#define ATT_SWRITE(bf) do { *(LAS u32x4*)(L + OFF_V + (bf) * SHM_V + vst0) = sv0; *(LAS u32x4*)(L + OFF_V + (bf) * SHM_V + vst1) = sv1; const int kc_ = scol * 2; \
        *(LAS u32x4*)(L + OFF_K + (bf) * SHM_K + KSWZ(sr, kc_)) = sk0; *(LAS u32x4*)(L + OFF_K + (bf) * SHM_K + KSWZ(32 + sr, kc_)) = sk1; } while (0)
    ATT_SLOAD(0); ATT_SWRITE(0);
    __syncthreads();
    const int qlo = qpos0 + 32 * th;
    const LAS float* tabh = (const LAS float*)(L + OFF_TAB) + hd * 320;
#pragma unroll 1
    for (int j = 0; j < NT; ++j) {
        const int bf = j & 1;
        if (j + 1 < NT) ATT_SLOAD(j + 1);
        const u32x2 mw = *(const u32x2*)(mrow + 2 * j);
        const bool far = (64 * j + 63 - qlo) <= -91;
        f32x16 p0, p1;
        qkt(p0, p1, L + OFF_K + bf * SHM_K, qr, far ? cfar : 0.f, r32, hi);
        if (!far) { const LAS float* tp = tabh + (64 * j - qlo - r32 + 4 * hi + 192);
#pragma unroll
            for (int r = 0; r < 16; ++r) { const int o_ = (r & 3) + 8 * (r >> 2); p0[r] += tp[o_]; p1[r] += tp[o_ + 32]; } }
        { const unsigned m0 = mw.x >> (4 * hi), m1 = mw.y >> (4 * hi);
#pragma unroll
          for (int r = 0; r < 16; ++r) { const int o_ = (r & 3) + 8 * (r >> 2); if (!((m0 >> o_) & 1u)) p0[r] = NEG; if (!((m1 >> o_) & 1u)) p1[r] = NEG; } }
        float pmax = p0[0];
#pragma unroll
        for (int r = 1; r < 16; ++r) pmax = fmaxf(pmax, p0[r]);
#pragma unroll
        for (int r = 0; r < 16; ++r) pmax = fmaxf(pmax, p1[r]);
        { const auto rr = __builtin_amdgcn_permlane32_swap(__float_as_uint(pmax), __float_as_uint(pmax), false, false); pmax = fmaxf(__uint_as_float(rr[0]), __uint_as_float(rr[1])); }
        float alpha = 1.f;
        if (!__all(pmax - m_reg <= THR2)) { const float mn = fmaxf(m_reg, pmax); alpha = __builtin_amdgcn_exp2f(m_reg - mn); m_reg = mn;
            if (hi == 0) wsf[r32] = alpha; asm volatile("s_waitcnt lgkmcnt(0)" ::: "memory");
#pragma unroll
            for (int d = 0; d < 4; ++d)
#pragma unroll
                for (int r = 0; r < 16; ++r) o[d][r] *= wsf[crow(r, hi)]; }
        float ps = 0.f;
#pragma unroll
        for (int r = 0; r < 16; ++r) { p0[r] = __builtin_amdgcn_exp2f(p0[r] - m_reg); p1[r] = __builtin_amdgcn_exp2f(p1[r] - m_reg); ps += p0[r] + p1[r]; }
        { const auto rr = __builtin_amdgcn_permlane32_swap(__float_as_uint(ps), __float_as_uint(ps), false, false); ps = __uint_as_float(rr[0]) + __uint_as_float(rr[1]); }
        l_reg = l_reg * alpha + ps;
        bf16x8 pa0, pa1, pa2, pa3;
#define PK4(P, BASE, OUT) do { const unsigned a0 = cvt_pk_bf16(P[BASE + 0], P[BASE + 1]), a1 = cvt_pk_bf16(P[BASE + 2], P[BASE + 3]); \
        const unsigned b0 = cvt_pk_bf16(P[BASE + 4], P[BASE + 5]), b1 = cvt_pk_bf16(P[BASE + 6], P[BASE + 7]); \
        const auto r0_ = __builtin_amdgcn_permlane32_swap(a0, b0, false, false); const auto r1_ = __builtin_amdgcn_permlane32_swap(a1, b1, false, false); \
        const u32x4 w_ = {r0_[0], r1_[0], r0_[1], r1_[1]}; OUT = __builtin_bit_cast(bf16x8, w_); } while (0)
        PK4(p0, 0, pa0); PK4(p0, 8, pa1); PK4(p1, 0, pa2); PK4(p1, 8, pa3);
#undef PK4
        SBAR();
        { const int vb = vb0 + bf * SHM_V;
          pv_one<0>(o[0], vb, pa0, pa1, pa2, pa3); pv_one<1>(o[1], vb, pa0, pa1, pa2, pa3); pv_one<2>(o[2], vb, pa0, pa1, pa2, pa3); pv_one<3>(o[3], vb, pa0, pa1, pa2, pa3); }
        if (j + 1 < NT) ATT_SWRITE(bf ^ 1);
        __syncthreads();
    }
#undef ATT_SRC
#undef ATT_SLOAD
#undef ATT_SWRITE
    if (hi == 0) wsf[r32] = l_reg; asm volatile("s_waitcnt lgkmcnt(0)" ::: "memory");
    float rli[16];
#pragma unroll
    for (int r = 0; r < 16; ++r) rli[r] = __builtin_amdgcn_rcpf(wsf[crow(r, hi)]);
    LAS unsigned char* stg = L + OFF_OST + w * 32 * OST_LD;
#pragma unroll
    for (int r = 0; r < 16; ++r) { const int orow = crow(r, hi);
#pragma unroll
        for (int d0 = 0; d0 < 4; ++d0) *(LAS bf16_t*)(stg + orow * OST_LD + (d0 * 32 + r32) * 2) = f2bf(o[d0][r] * rli[r]); }
    asm volatile("s_waitcnt lgkmcnt(0)" ::: "memory");
    bf16_t* ob = Q + (size_t)(qrow0 + 32 * th) * 1024 + g * 512 + hd * 128;
#pragma unroll
    for (int i = 0; i < 8; ++i) { const int row = i * 4 + (lane >> 4), ch = lane & 15; const u32x4 v = *(const LAS u32x4*)(stg + row * OST_LD + ch * 16);
        *(u32x4*)(ob + (size_t)row * 1024 + ch * 8) = v; }
    __syncthreads();
}
__device__ __forceinline__ void attn_units(Frame& F) {
    constexpr int NSU = NBATCH * 2, NPU = NBATCH * 2 * 32;
    LAS int* qslot = (LAS int*)(F.lds + MISC_OFF) + 16;
    for (;;) {
        if (F.tid == 0) *qslot = (int)__hip_atomic_fetch_add((unsigned*)(F.ctl + CW_Q), 1u, __ATOMIC_RELAXED, __HIP_MEMORY_SCOPE_AGENT);
        __syncthreads();
        const int u = *qslot;
        __syncthreads();
        if (u >= NSU + NPU) break;
        if (u < NSU) attn_unit<false>(F, u >> 1, 0, u & 1);
        else { const int v = u - NSU; const int bg = v & 15, c = 32 - (v >> 4); attn_unit<true>(F, bg >> 1, c, bg & 1); }
    }
}
__device__ __forceinline__ int yrow_to_r(int pm) { return pm * 256 + (pm < 64 ? 16 * ((pm >> 3) + 1) : 128); }
struct SchedP5 {
    const char* A0; const char* A1; const char* B0; const char* B1; int G, c;
    __device__ __forceinline__ bool next(int i, pg8::Unit& u) const {
        const int L = (i >> 1) * G + c; if (L >= 66 * 4) return false;
        pg8::tile_of(L, 66, 4, u.pm, u.pn); u.part = i & 1;
        u.A = (u.part ? A1 : A0) + (size_t)yrow_to_r(u.pm) * 1024 * 2; u.B = (u.part ? B1 : B0) + (size_t)u.pn * 256 * 1024 * 2; return true; }
};
struct EpiP5 {
    static constexpr bool PERM = true;
    const bf16_t* GS; const bf16_t* GA; const float* SSQ1; bf16_t* MERGED;
    __device__ __forceinline__ bool operator()(pg8::Acc& acc, const pg8::Unit& u, int wr, int wc, int fr, int fq) const {
        const int rr0 = yrow_to_r(u.pm) + wr * 64 + fr, ry0 = u.pm * 256 + wr * 64 + fr, col = u.pn * 256 + wc * 32 + 8 * fq;
#pragma unroll
        for (int ai = 0; ai < 2; ++ai)
#pragma unroll
            for (int m = 0; m < 4; ++m) { const int rr = rr0 + ai * 128 + m * 16, ry = ry0 + ai * 128 + m * 16;
                float rstd = 0.f; if (u.part == 0) rstd = __builtin_amdgcn_rsqf(SSQ1[rr] * (1.f / 1024.f) + EPS);
#pragma unroll
                for (int bj = 0; bj < 2; ++bj) {
                    const u32x4 ga = *(const u32x4*)(GA + (size_t)rr * 1024 + col + bj * 128);
                    float sa[8] = {bf_lo(ga.x), bf_hi(ga.x), bf_lo(ga.y), bf_hi(ga.y), bf_lo(ga.z), bf_hi(ga.z), bf_lo(ga.w), bf_hi(ga.w)};
                    if (u.part == 0) {
                        const u32x4 gs = *(const u32x4*)(GS + (size_t)rr * 1024 + col + bj * 128);
                        const float ss[8] = {bf_lo(gs.x), bf_hi(gs.x), bf_lo(gs.y), bf_hi(gs.y), bf_lo(gs.z), bf_hi(gs.z), bf_lo(gs.w), bf_hi(gs.w)};
#pragma unroll
                        for (int e = 0; e < 8; ++e) {
                            const float f = rstd * (1.f + __builtin_amdgcn_exp2f(-1.4426950408889634f * sa[e])) * __builtin_amdgcn_rcpf(1.f + __builtin_amdgcn_exp2f(-1.4426950408889634f * ss[e]));
                            acc[ai][bj][m][e >> 2][e & 3] *= f; }
                    } else {
                        float o[8];
#pragma unroll
                        for (int e = 0; e < 8; ++e) o[e] = acc[ai][bj][m][e >> 2][e & 3] * sigmoidf_(sa[e]);
                        u32x4 w; w.x = cvt_pk_bf16(o[0], o[1]); w.y = cvt_pk_bf16(o[2], o[3]); w.z = cvt_pk_bf16(o[4], o[5]); w.w = cvt_pk_bf16(o[6], o[7]);
                        *(u32x4*)(MERGED + (size_t)ry * 1024 + col + bj * 128) = w; } } }
        return u.part == 0;
    }
};
struct SchedY {
    const char* A; const char* B; int nN, K, G, c;
    __device__ __forceinline__ bool next(int i, pg8::Unit& u) const {
        const int L = i * G + c; if (L >= 66 * nN) return false;
        pg8::tile_of(L, 66, nN, u.pm, u.pn); u.part = 0; u.A = A + (size_t)u.pm * 256 * K * 2; u.B = B + (size_t)u.pn * 256 * K * 2; return true; }
};
struct EpiP6 {
    static constexpr bool PERM = false;
    const float* xp; const float* xs; const float* n2w; float* H; bf16_t* HB; float* SSQ2;
    __device__ __forceinline__ bool operator()(pg8::Acc& acc, const pg8::Unit& u, int wr, int wc, int fr, int fq) const {
        const int ry0 = u.pm * 256 + wr * 64 + fr, col0 = u.pn * 256 + wc * 32 + 4 * fq;
        f32x4 nw[2][2];
#pragma unroll
        for (int bj = 0; bj < 2; ++bj)
#pragma unroll
            for (int n = 0; n < 2; ++n) nw[bj][n] = *(const f32x4*)(n2w + col0 + bj * 128 + n * 16);
#pragma unroll
        for (int ai = 0; ai < 2; ++ai)
#pragma unroll
            for (int m = 0; m < 4; ++m) { const int ry = ry0 + ai * 128 + m * 16;
                const float* xrow = ry < YPR ? xp + (size_t)ry * 1024 : xs + (size_t)(ry - YPR) * 1024; float ss = 0.f;
#pragma unroll
                for (int bj = 0; bj < 2; ++bj)
#pragma unroll
                    for (int n = 0; n < 2; ++n) { const int c = col0 + bj * 128 + n * 16; const f32x4 h = *(const f32x4*)(xrow + c) + acc[ai][bj][m][n];
                        *(f32x4*)(H + (size_t)ry * 1024 + c) = h; ss += (h.x * h.x + h.y * h.y) + (h.z * h.z + h.w * h.w);
                        const f32x4 hn = h * nw[bj][n]; *(u32x2*)(HB + (size_t)ry * 1024 + c) = (u32x2){cvt_pk_bf16(hn.x, hn.y), cvt_pk_bf16(hn.z, hn.w)}; }
                ss += __shfl_xor(ss, 16); ss += __shfl_xor(ss, 32);
                if (fq == 0) atomicAdd(SSQ2 + ry, ss); }
        return false;
    }
};
struct EpiP7 {
    static constexpr bool PERM = true;
    const float* SSQ2; bf16_t* ACT;
    __device__ __forceinline__ bool operator()(pg8::Acc& acc, const pg8::Unit& u, int wr, int wc, int fr, int fq) const {
        const int ry0 = u.pm * 256 + wr * 64 + fr, ch0 = u.pn * 128 + wc * 16 + 4 * fq;
#pragma unroll
        for (int ai = 0; ai < 2; ++ai)
#pragma unroll
            for (int m = 0; m < 4; ++m) { const int ry = ry0 + ai * 128 + m * 16; const float rs = __builtin_amdgcn_rsqf(SSQ2[ry] * (1.f / 1024.f) + EPS);
#pragma unroll
                for (int bj = 0; bj < 2; ++bj) { const f32x4 g = acc[ai][bj][m][0] * rs, up = acc[ai][bj][m][1] * rs;
                    const float a0 = siluf_(g.x) * up.x, a1 = siluf_(g.y) * up.y, a2 = siluf_(g.z) * up.z, a3 = siluf_(g.w) * up.w;
                    *(u32x2*)(ACT + (size_t)ry * DFF + ch0 + bj * 64) = (u32x2){cvt_pk_bf16(a0, a1), cvt_pk_bf16(a2, a3)}; } }
        return false;
    }
};
struct EpiP8 {
    static constexpr bool PERM = false;
    float* H;
    __device__ __forceinline__ bool operator()(pg8::Acc& acc, const pg8::Unit& u, int wr, int wc, int fr, int fq) const {
        const int ry0 = u.pm * 256 + wr * 64 + fr, col0 = u.pn * 256 + wc * 32 + 4 * fq;
#pragma unroll
        for (int ai = 0; ai < 2; ++ai)
#pragma unroll
            for (int m = 0; m < 4; ++m) { float* hrow = H + (size_t)(ry0 + ai * 128 + m * 16) * 1024 + col0;
#pragma unroll
                for (int bj = 0; bj < 2; ++bj)
#pragma unroll
                    for (int n = 0; n < 2; ++n) { f32x4* p = (f32x4*)(hrow + bj * 128 + n * 16); *p = *p + acc[ai][bj][m][n]; } }
        return false;
    }
};

constexpr int NPHASE = 10;
__global__ void __launch_bounds__(NTHR, 2) hybrid_fwd(Args args) {
    extern __shared__ __attribute__((aligned(16))) unsigned char lds[];
    Frame F;
    F.lds = (LAS unsigned char*)lds; F.MISC = (volatile LAS unsigned*)(F.lds + MISC_OFF);
    F.tid = threadIdx.x; F.lane = F.tid & 63; F.wave = __builtin_amdgcn_readfirstlane(F.tid >> 6);
    F.G = gridDim.x; { const int bx = blockIdx.x; F.vcu = (F.G % 8 == 0) ? (bx % 8) * (F.G / 8) + bx / 8 : bx; }
    F.in = args.in; F.out = args.out; F.ws = args.ws; F.ob = (unsigned char*)args.out; F.ctl = (gu32*)(args.ws + WS_CTL);
    if (F.tid < 64) ((LAS unsigned*)(F.lds + MISC_OFF))[F.tid] = 0u;
    __syncthreads();
    const int lo = args.ph_lo, hi = args.ph_hi;
    const bool multi = (hi - lo) > 1;
    XcdBarrier bar; bar.bar = (unsigned*)(F.ctl + CW_BAR) + args.li * XCD_BAR_WORDS; bar.x = 0; bar.st = nullptr;
    if (multi) bar = xcd_barrier_post((unsigned*)(F.ctl + CW_BAR) + args.li * XCD_BAR_WORDS, F.MISC + 8);
#define IN(k) (lo <= (k) && (k) < hi)
#define SEAM(k) do { if (IN(k) && IN((k) + 1)) xcd_barrier(bar); } while (0)
    if (IN(0)) { p0_prologue(F); SEAM(0); }
    if (IN(1)) {
        SchedP1 S{(const char*)(F.ob + DO_HN), (const char*)(F.ws + WS_WIN), F.G, (int)blockIdx.x};
        EpiP1 E{F.ws, F.ob};
        pg8::gemm_phase<EpiP1, SchedP1>(F.lds, 1024, S, E);
        SEAM(1);
    }
    if (IN(2)) { p2_rows(F); SEAM(2); }
    if (IN(3)) { conv_units(F); idx_units(F); SEAM(3); }
    if (IN(4)) { ssd_chains(F); SEAM(4); }
    if (IN(5)) { attn_units(F); SEAM(5); }
    if (IN(6)) {
        SchedP5 S{(const char*)(F.ws + WS_XS), (const char*)(F.ob + DO_Q), (const char*)(F.ws + WS_WBS), (const char*)(F.ws + WS_WBA), F.G, (int)blockIdx.x};
        EpiP5 E{(const bf16_t*)(F.ws + WS_GS), (const bf16_t*)(F.ws + WS_GA), (const float*)(F.ws + WS_SSQ1), (bf16_t*)(F.ws + WS_MERGED)};
        pg8::gemm_phase<EpiP5, SchedP5>(F.lds, 1024, S, E);
        SEAM(6);
    }
    if (IN(7)) {
        SchedY S{(const char*)(F.ws + WS_MERGED), (const char*)(F.ws + WS_WOUT), 4, 1024, F.G, (int)blockIdx.x};
        EpiP6 E{F.in[0], F.in[1], F.in[23], F.out, (bf16_t*)(F.ws + WS_HB), (float*)(F.ws + WS_SSQ2)};
        pg8::gemm_phase<EpiP6, SchedY>(F.lds, 1024, S, E);
        SEAM(7);
    }
    if (IN(8)) {
        SchedY S{(const char*)(F.ws + WS_HB), (const char*)(F.ws + WS_WGU), NGU / 256, 1024, F.G, (int)blockIdx.x};
        EpiP7 E{(const float*)(F.ws + WS_SSQ2), (bf16_t*)(F.ws + WS_ACT)};
        pg8::gemm_phase<EpiP7, SchedY>(F.lds, 1024, S, E);
        SEAM(8);
    }
    if (IN(9)) {
        SchedY S{(const char*)(F.ws + WS_ACT), (const char*)(F.ws + WS_WDN), 4, DFF, F.G, (int)blockIdx.x};
        EpiP8 E{F.out};
        pg8::gemm_phase<EpiP8, SchedY>(F.lds, DFF, S, E);
    }
#undef IN
#undef SEAM
}

extern "C" void kernel_launch(void* const* d_in, const int* in_sizes, int n_in, void* d_out, int out_size, void* d_ws, size_t ws_size, hipStream_t stream) {
    static int grid = 0;
    if (grid == 0) {
        if (n_in != 27 || out_size != (int)O_END || ws_size < WS_END) { fprintf(stderr, "kernel_launch: unexpected shapes: n_in %d out %d ws %zu (need %zu)\n", n_in, out_size, ws_size, (size_t)WS_END); grid = -1; return; }
        int dev = 0, cus = 0;
        if (hipGetDevice(&dev) != hipSuccess || hipDeviceGetAttribute(&cus, hipDeviceAttributeMultiprocessorCount, dev) != hipSuccess) { grid = -1; return; }
        if (hipFuncSetAttribute((const void*)hybrid_fwd, hipFuncAttributeMaxDynamicSharedMemorySize, LDS_BYTES) != hipSuccess) { fprintf(stderr, "kernel_launch: hipFuncSetAttribute failed\n"); grid = -1; return; }
        (void)hipGetLastError();
        grid = cus;
    }
    if (grid < 0) return;
    (void)hipMemsetAsync((char*)d_ws + WS_CTL, 0, CTL_BYTES, stream);
    Args a{};
    for (int i = 0; i < 27; ++i) a.in[i] = (const float*)d_in[i];
    a.out = (float*)d_out; a.ws = (unsigned char*)d_ws;
#ifndef MK_SPLIT
#define MK_SPLIT 0
#endif
#if MK_SPLIT
    for (int p = 0; p < NPHASE; ++p) { a.ph_lo = p; a.ph_hi = p + 1; a.li = 0; hipLaunchKernelGGL(hybrid_fwd, dim3(grid), dim3(NTHR), LDS_BYTES, stream, a); }
#else
    a.ph_lo = 0; a.ph_hi = NPHASE; a.li = 0; hipLaunchKernelGGL(hybrid_fwd, dim3(grid), dim3(NTHR), LDS_BYTES, stream, a);
#endif
    const hipError_t le = hipPeekAtLastError();
    if (le != hipSuccess) fprintf(stderr, "kernel_launch: launch failed: %s\n", hipGetErrorName(le));
}
```

```cpp
#include <hip/hip_runtime.h>
#include <cstdio>
#include <cstdint>

constexpr int DM = 1024, NBATCH = 8, SEQ = 2048, NMETA = 16, TP = NMETA + SEQ  , DSEQ = 64, PAST = 4096, LS = PAST + DSEQ  ;
constexpr int RPR = NBATCH * TP  , RSR = NBATCH * DSEQ  , RR = RPR + RSR  , RPAD = 17152  ;
constexpr int YPR = NBATCH * SEQ  , YR = YPR + RSR  ;
constexpr int NIN = 7424  , DFF = 2816, NGU = 2 * DFF;
constexpr int SSD_H = 16, SSD_P = 64, SSD_G = 4, SSD_N = 128, CONV_DIM = 2048;
constexpr int NH = 8, NKV = 2, HD = 128, IDXH = 8, IDXD = 64, TOPK = 256;
constexpr float EPS = 1e-6f;
constexpr int SMLD = 96;

constexpr size_t O_YP = 0, O_YS = O_YP + (size_t)YPR * DM, O_KP = O_YS + (size_t)RSR * DM, O_VP = O_KP + (size_t)RPR * 256, O_KIP = O_VP + (size_t)RPR * 256,
                 O_SSMP = O_KIP + (size_t)RPR * 64, O_CVP = O_SSMP + (size_t)NBATCH * 16 * 64 * 128, O_KS = O_CVP + (size_t)NBATCH * 3 * CONV_DIM, O_VS = O_KS + (size_t)RSR * 256,
                 O_KIS = O_VS + (size_t)RSR * 256, O_SSMS = O_KIS + (size_t)RSR * 64, O_CVS = O_SSMS + (size_t)NBATCH * 16 * 64 * 128, O_END = O_CVS + (size_t)NBATCH * 3 * CONV_DIM;
static_assert(O_END == 29302784, "d_out size");
constexpr size_t DO_Q = 0, DO_QI = DO_Q + (size_t)RR * 1024 * 2, DO_CV = DO_QI + (size_t)RR * 512 * 2, DO_YEND = DO_CV + (size_t)NBATCH * PAST * 256 * 2;
static_assert(DO_YEND <= O_KP * 4, "y-region scratch");
constexpr size_t DO_HN = O_KP * 4;
static_assert(DO_HN + (size_t)RPAD * 1024 * 2 <= O_CVP * 4, "hn scratch in tail");

constexpr size_t al256(size_t x) { return (x + 255) / 256 * 256; }
constexpr size_t WS_CTL = 0, CTL_BYTES = 1u << 20, CTL_ZERO_BYTES = 128u << 10;
constexpr size_t WS_WIN = CTL_BYTES, WS_WBS = WS_WIN + (size_t)NIN * 1024 * 2, WS_WBA = WS_WBS + 1024 * 1024 * 2, WS_WOUT = WS_WBA + 1024 * 1024 * 2, WS_WGU = WS_WOUT + 1024 * 1024 * 2,
                 WS_WDN = WS_WGU + (size_t)NGU * 1024 * 2, WS_Z = WS_WDN + (size_t)1024 * DFF * 2, WS_XS = WS_Z + (size_t)RR * 1024 * 2, WS_BC = WS_XS + (size_t)RR * 1024 * 2,
                 WS_GA = WS_BC + (size_t)RR * 1024 * 2, WS_GS = WS_GA + (size_t)RR * 1024 * 2, WS_K = WS_GS + (size_t)RR * 1024 * 2, WS_V = WS_K + (size_t)RR * 256 * 2,
                 WS_SM = WS_V + (size_t)RR * 256 * 2, WS_KI = WS_SM + (size_t)RR * SMLD * 4, WS_CK = WS_KI + (size_t)RR * 64 * 2, WS_MASK = WS_CK + (size_t)NBATCH * PAST * 256 * 2;
constexpr int MASK_LDP = 68, MASK_LDS = 132;
constexpr size_t WS_MASKS = WS_MASK + (size_t)RPR * MASK_LDP * 4, WS_SSQ1 = WS_MASKS + (size_t)RSR * MASK_LDS * 4, WS_SSQ2 = WS_SSQ1 + al256((size_t)RR * 4),
                 WS_PART = WS_SSQ2 + al256((size_t)YR * 4), WS_END = WS_PART + (size_t)32 * 256 * 132 * 4;
constexpr size_t WS_MERGED = WS_Z, WS_ACT = WS_XS, WS_HB = WS_GS, WS_HAL = WS_PART;
static_assert(WS_END <= 268435456, "d_ws map exceeds 256 MiB");
static_assert((size_t)YR * DFF * 2 <= WS_GS - WS_XS, "act overlay");
static_assert((size_t)NBATCH * 33 * 3 * CONV_DIM * 2 <= WS_END - WS_PART, "halo overlay");
constexpr int CW_TMO = 0, CW_BAR = 4096, CW_Q = 16384;
constexpr int CW_DEP = CW_Q + 64 * 32;

#define GAS __attribute__((address_space(1)))
#define LAS __attribute__((address_space(3)))
typedef unsigned short bf16_t;
typedef short bf16x8 __attribute__((ext_vector_type(8)));
typedef short s16x4 __attribute__((ext_vector_type(4)));
typedef float f32x4 __attribute__((ext_vector_type(4)));
typedef float f32x2 __attribute__((ext_vector_type(2)));
typedef float f32x16 __attribute__((ext_vector_type(16)));
typedef unsigned u32x4 __attribute__((ext_vector_type(4)));
typedef unsigned u32x2 __attribute__((ext_vector_type(2)));
typedef GAS unsigned gu32;
#define RLX_AGENT __ATOMIC_RELAXED, __HIP_MEMORY_SCOPE_AGENT
#define LDS_WAIT() asm volatile("s_waitcnt lgkmcnt(0)" ::: "memory")
#define VM_WAIT() asm volatile("s_waitcnt vmcnt(0)" ::: "memory")
__device__ __forceinline__ unsigned cvt_pk_bf16(float lo, float hi) { unsigned r; asm volatile("v_cvt_pk_bf16_f32 %0, %1, %2" : "=v"(r) : "v"(lo), "v"(hi)); return r; }
__device__ __forceinline__ float bf_lo(unsigned w) { return __uint_as_float(w << 16); }
__device__ __forceinline__ float bf_hi(unsigned w) { return __uint_as_float(w & 0xffff0000u); }
__device__ __forceinline__ float bf2f(bf16_t b) { return __uint_as_float((unsigned)b << 16); }
__device__ __forceinline__ bf16_t f2bf(float f) { return (bf16_t)(cvt_pk_bf16(f, 0.f) & 0xffffu); }
__device__ __forceinline__ float sigmoidf_(float x) { return __builtin_amdgcn_rcpf(1.f + __builtin_amdgcn_exp2f(-1.4426950408889634f * x)); }
__device__ __forceinline__ float siluf_(float x) { return x * sigmoidf_(x); }
__device__ __forceinline__ float wave_sum(float v) {
#pragma unroll
    for (int o = 1; o < 64; o <<= 1) v += __shfl_xor(v, o);
    return v;
}

#define XB_TMO      128
#define XB_XCNT(j)  (256  + 64 * (j))
#define XB_XSUB(j)  (1280 + 64 * (j))
#define XB_XGEN(j)  (2304 + 64 * (j))
#define XB_TOP      3328
#define XB_TOPGEN   3392
#define XCD_BAR_WORDS 3456
#define XB_SPIN_CAP (1u << 18)
__device__ __forceinline__ unsigned xb_ld(unsigned* p)              { return __hip_atomic_load(p, __ATOMIC_RELAXED, __HIP_MEMORY_SCOPE_AGENT); }
__device__ __forceinline__ unsigned xb_add(unsigned* p, unsigned v) { return __hip_atomic_fetch_add(p, v, __ATOMIC_RELAXED, __HIP_MEMORY_SCOPE_AGENT); }
__device__ __forceinline__ unsigned xb_xcc_id() { return (unsigned)__builtin_amdgcn_s_getreg((3 << 11) | 20) & 0xFu; }
#define XB_SPIN(cond, bar) do { unsigned _sp = 0; while (cond) { __builtin_amdgcn_s_sleep(1); \
    if ((++_sp & 255u) == 0u) { if (xb_ld(&(bar)[XB_TMO])) break; if (_sp > XB_SPIN_CAP) { atomicAdd(&(bar)[XB_TMO], 1u); break; } } } } while (0)
struct XcdBarrier { unsigned* bar; unsigned x; volatile LAS unsigned* st; };
__device__ __forceinline__ XcdBarrier xcd_barrier_post(unsigned* bar, volatile LAS unsigned* st, const int tid) {
    XcdBarrier b; b.bar = bar; b.x = xb_xcc_id(); b.st = st;
    if (tid == 0) (void)xb_add(&bar[XB_XCNT(b.x)], 1u);
    return b;
}
__device__ __forceinline__ void xcd_barrier_complete(unsigned* bar, unsigned x, unsigned& nloc, unsigned& nx) {
    const unsigned G = gridDim.x * gridDim.y * gridDim.z;
    unsigned sum, cnt, mine, sp = 0u;
    for (;;) {
        sum = 0u; cnt = 0u; mine = 0u;
#pragma unroll
        for (unsigned j = 0; j < 16; ++j) { const unsigned c = xb_ld(&bar[XB_XCNT(j)]); sum += c; cnt += (c > 0u) ? 1u : 0u; mine = (j == x) ? c : mine; }
        if (sum == G) break;
        __builtin_amdgcn_s_sleep(1);
        if ((++sp & 255u) == 0u) { if (xb_ld(&bar[XB_TMO])) break; if (sp > XB_SPIN_CAP) { atomicAdd(&bar[XB_TMO], 1u); break; } }
    }
    nloc = mine > 0u ? mine : 1u; nx = cnt > 0u ? cnt : 1u;
}
__device__ __forceinline__ void xcd_barrier(const XcdBarrier& b, const int tid) {
    asm volatile("s_waitcnt vmcnt(0)" ::: "memory");
    __syncthreads();
    if (tid == 0) {
        unsigned* bar = b.bar;
        __builtin_amdgcn_s_waitcnt(0);
        unsigned nloc = b.st[0], nx = b.st[1];
        if (nloc == 0u) { xcd_barrier_complete(bar, b.x, nloc, nx); b.st[0] = nloc; b.st[1] = nx; }
        const unsigned old = xb_add(&bar[XB_XSUB(b.x)], 1u);
        const unsigned gen = old / nloc;
        if (old + 1u == (gen + 1u) * nloc) {
            __builtin_amdgcn_fence(__ATOMIC_RELEASE, "agent");
            asm volatile("s_waitcnt vmcnt(0)" ::: "memory");
            const unsigned og = xb_add(&bar[XB_TOP], 1u);
            const unsigned tg = og / nx;
            if (og + 1u == (tg + 1u) * nx) xb_add(&bar[XB_TOPGEN], 1u);
            else XB_SPIN(xb_ld(&bar[XB_TOPGEN]) == tg, bar);
            __builtin_amdgcn_fence(__ATOMIC_ACQUIRE, "agent");
            xb_add(&bar[XB_XGEN(b.x)], 1u);
            asm volatile("s_waitcnt vmcnt(0)" ::: "memory");
        } else {
            XB_SPIN(xb_ld(&bar[XB_XGEN(b.x)]) == gen, bar);
            __builtin_amdgcn_fence(__ATOMIC_ACQUIRE, "agent");
            asm volatile("s_waitcnt vmcnt(0)" ::: "memory");
        }
    }
    __syncthreads();
}

namespace pg8 {
constexpr int BM = 256, BK = 64, HALF = 128, HTB = HALF * BK * 2, STAGE_BYTES = 8 * HTB, NXCD = 8, WGM = 8;
__host__ __device__ __forceinline__ int lds_byte(int r, int c) { const int st = (r >> 4) * 2 + (c >> 5), rr = r & 15, cc = c & 31, ob = rr * 64 + cc * 2; return st * 1024 + (ob ^ (((ob >> 9) & 1) << 5)); }
__host__ __device__ __forceinline__ void stage_rc(int b, int& R, int& C) { const int st = b / 1024, sb = b % 1024, swz = sb ^ (((sb >> 9) & 1) << 5); R = (st >> 1) * 16 + swz / 64; C = (st & 1) * 32 + (swz % 64) / 2; }
__host__ __device__ __forceinline__ int perm32(int rho) { const int n = rho >> 4, i = rho & 15; return 8 * (i >> 2) + 4 * n + (i & 3); }
struct Unit { int pm, pn, part; const char* A; const char* B; };
__device__ __forceinline__ void tile_of(int L, int nM, int nN, int& pm, int& pn) {
    const int nwg = nM * nN; int wgid = L; { const int q = nwg / NXCD, r = nwg % NXCD, xcd = wgid % NXCD, off = wgid / NXCD; wgid = (xcd < r ? xcd * (q + 1) : r * (q + 1) + (xcd - r) * q) + off; }
    const int nig = WGM * nN, gid = wgid / nig, fm = gid * WGM, gsz = (nM - fm) < WGM ? (nM - fm) : WGM;
    pm = fm + ((wgid % nig) % gsz); pn = (wgid % nig) / gsz;
}
typedef f32x4 Acc[2][2][4][2];
template <class Epi, class Sched>
__device__ __forceinline__ void gemm_phase(LAS unsigned char* lds, const int K, const Sched& S, const Epi& E, const int wave_id) {
    int tid_; asm volatile("v_mbcnt_lo_u32_b32 %0, -1, 0\n\tv_mbcnt_hi_u32_b32 %0, -1, %0" : "=v"(tid_)); tid_ += 64 * wave_id;
    const int tid = tid_, wid = __builtin_amdgcn_readfirstlane(tid >> 6), lane = tid & 63, wr = wid >> 2, wc = wid & 3, fr = lane & 15, fq = lane >> 4;
    const int nt = K / BK;
    unsigned voffA[2], voffB[2];
#pragma unroll
    for (int i = 0; i < 2; ++i) { int R, C; stage_rc(tid * 16 + i * 8192, R, C); const int Rb = Epi::PERM ? ((R & ~31) + perm32(R & 31)) : R;
        voffA[i] = (unsigned)(R * K + C) * 2u; voffB[i] = (unsigned)(Rb * K + C) * 2u; }
    const size_t kstep = (size_t)(BK * 2);
    const size_t hstep = (size_t)HALF * K * 2;
    const unsigned ldsw = (unsigned)wid * 1024u;
    const int aoff = lds_byte(wr * 64 + fr, fq * 8), boff = lds_byte(wc * 32 + fr, fq * 8);
#define PG8_SA(b, h) (((b) * 2 + (h)) * HTB)
#define PG8_SB(b, h) ((4 + (b) * 2 + (h)) * HTB)
#define PG8_STAGE(bufoff, gbase, voff) do { _Pragma("unroll") for (int _i = 0; _i < 2; ++_i) \
        __builtin_amdgcn_global_load_lds((const unsigned*)((const char*)(gbase) + (voff)[_i]), (LAS unsigned*)(lds + (bufoff) + ldsw + _i * 8192), 16, 0, 0); } while (0)
#define PG8_LDA(dst, b, h) do { _Pragma("unroll") for (int m = 0; m < 4; ++m) _Pragma("unroll") for (int k = 0; k < 2; ++k) dst[m][k] = *(const LAS bf16x8*)(lds + PG8_SA(b, h) + aoff + m * 2048 + k * 1024); } while (0)
#define PG8_LDB(dst, b, h) do { _Pragma("unroll") for (int n = 0; n < 2; ++n) _Pragma("unroll") for (int k = 0; k < 2; ++k) dst[n][k] = *(const LAS bf16x8*)(lds + PG8_SB(b, h) + boff + n * 2048 + k * 1024); } while (0)
#define PG8_MMA(ai, bj, At, Bt) do { __builtin_amdgcn_s_setprio(1); _Pragma("unroll") for (int m = 0; m < 4; ++m) _Pragma("unroll") for (int n = 0; n < 2; ++n) _Pragma("unroll") for (int k = 0; k < 2; ++k) \
        acc[ai][bj][m][n] = __builtin_amdgcn_mfma_f32_16x16x32_bf16(Bt[n][k], At[m][k], acc[ai][bj][m][n], 0, 0, 0); __builtin_amdgcn_s_setprio(0); } while (0)
#define PG8_WAIT_V(n) asm volatile("s_waitcnt vmcnt(" #n ")" ::: "memory")
#define PG8_WAIT_L(n) asm volatile("s_waitcnt lgkmcnt(" #n ")" ::: "memory")
#define PG8_BAR __builtin_amdgcn_s_barrier()
#define PG8_SCHED __builtin_amdgcn_sched_barrier(0)
    Unit cur, nxt; int ui = 0;
    if (!S.next(0, cur)) return;
    Acc acc;
#pragma unroll
    for (int a = 0; a < 2; ++a)
#pragma unroll
        for (int b = 0; b < 2; ++b)
#pragma unroll
            for (int m = 0; m < 4; ++m)
#pragma unroll
                for (int n = 0; n < 2; ++n) acc[a][b][m][n] = (f32x4){0.f, 0.f, 0.f, 0.f};
    bf16x8 At[4][2], B0[2][2], B1[2][2];
    const char* cA = cur.A; const char* cB = cur.B;
    PG8_STAGE(PG8_SB(0, 0), cB, voffB); PG8_STAGE(PG8_SB(0, 1), cB + hstep, voffB); PG8_STAGE(PG8_SA(0, 0), cA, voffA); PG8_STAGE(PG8_SA(0, 1), cA + hstep, voffA);
    if (wr == 1) PG8_BAR;
    PG8_WAIT_V(2); PG8_BAR;
    PG8_STAGE(PG8_SB(1, 0), cB + kstep, voffB); PG8_STAGE(PG8_SA(1, 0), cA + kstep, voffA); PG8_STAGE(PG8_SB(1, 1), cB + hstep + kstep, voffB);
    PG8_WAIT_V(6); PG8_BAR;
    for (;;) {
        const bool has_next = S.next(ui + 1, nxt);
        const char* nA = has_next ? nxt.A : cA; const char* nB = has_next ? nxt.B : cB;
        for (int t = 0; t < nt; t += 2) {
            const bool last = (t == nt - 2);
            const char* a1 = cA + (size_t)(t + 1) * kstep;
            const char* a2 = last ? nA : cA + (size_t)(t + 2) * kstep; const char* b2 = last ? nB : cB + (size_t)(t + 2) * kstep;
            const char* a3 = a2 + kstep; const char* b3 = b2 + kstep;
            PG8_LDB(B0, 0, 0); PG8_LDB(B1, 0, 1); PG8_SCHED; PG8_LDA(At, 0, 0); PG8_STAGE(PG8_SA(1, 1), a1 + hstep, voffA);
            PG8_WAIT_V(8); PG8_WAIT_L(0); PG8_BAR; PG8_MMA(0, 0, At, B0); PG8_MMA(0, 1, At, B1); PG8_BAR; PG8_SCHED;
            PG8_LDA(At, 0, 1); PG8_STAGE(PG8_SB(0, 0), b2, voffB); PG8_STAGE(PG8_SB(0, 1), b2 + hstep, voffB); PG8_STAGE(PG8_SA(0, 0), a2, voffA);
            PG8_WAIT_V(8); PG8_WAIT_L(0); PG8_BAR; PG8_MMA(1, 0, At, B0); PG8_MMA(1, 1, At, B1); PG8_BAR; PG8_SCHED;
            PG8_LDB(B0, 1, 0); PG8_LDB(B1, 1, 1); PG8_SCHED; PG8_LDA(At, 1, 0); PG8_STAGE(PG8_SA(0, 1), a2 + hstep, voffA);
            PG8_WAIT_V(8); PG8_WAIT_L(0); PG8_BAR; PG8_MMA(0, 0, At, B0); PG8_MMA(0, 1, At, B1); PG8_BAR; PG8_SCHED;
            PG8_LDA(At, 1, 1); PG8_STAGE(PG8_SB(1, 0), b3, voffB); PG8_STAGE(PG8_SB(1, 1), b3 + hstep, voffB); PG8_STAGE(PG8_SA(1, 0), a3, voffA);
            PG8_WAIT_V(8); PG8_WAIT_L(0); PG8_BAR; PG8_MMA(1, 0, At, B0); PG8_MMA(1, 1, At, B1); PG8_BAR; PG8_SCHED;
        }
        if (wr == 0) PG8_BAR;
        const bool keep = E(acc, cur, wr, wc, fr, fq);
        if (!has_next) break;
        if (!keep) {
#pragma unroll
            for (int a = 0; a < 2; ++a)
#pragma unroll
                for (int b = 0; b < 2; ++b)
#pragma unroll
                    for (int m = 0; m < 4; ++m)
#pragma unroll
                        for (int n = 0; n < 2; ++n) acc[a][b][m][n] = (f32x4){0.f, 0.f, 0.f, 0.f};
        }
        cur = nxt; cA = nA; cB = nB; ++ui;
        if (wr == 1) PG8_BAR;
    }
    PG8_WAIT_V(0);
    PG8_BAR;
#undef PG8_SA
#undef PG8_SB
#undef PG8_STAGE
#undef PG8_LDA
#undef PG8_LDB
#undef PG8_MMA
#undef PG8_WAIT_V
#undef PG8_WAIT_L
#undef PG8_BAR
#undef PG8_SCHED
}
}

struct Args { const float* in[27]; float* out; unsigned char* ws; int ph_lo, ph_hi, li, pad; };
constexpr int NWAVES = 8, NTHR = 512;
constexpr int RING_BYTES = 131072, LDS_BYTES = 147456, MISC_OFF = LDS_BYTES - 256;

struct Frame {
    LAS unsigned char* lds; volatile LAS unsigned* MISC; gu32* ctl;
    int tid, lane, wave, vcu, G;
    const float* const* in; float* out; unsigned char* ws; unsigned char* ob;
};

__device__ __forceinline__ void refresh_ids(Frame& F) { int l; asm volatile("v_mbcnt_lo_u32_b32 %0, -1, 0\n\tv_mbcnt_hi_u32_b32 %0, -1, %0" : "=v"(l)); F.lane = l; F.tid = F.wave * 64 + l; }

__device__ __forceinline__ void unit_publish(Frame& F, int ctr_word) {
    asm volatile("s_waitcnt vmcnt(0)" ::: "memory"); __syncthreads();
    if (F.tid == 0) { __builtin_amdgcn_fence(__ATOMIC_RELEASE, "agent"); asm volatile("s_waitcnt vmcnt(0)" ::: "memory");
        const unsigned o_ = __hip_atomic_fetch_add((unsigned*)(F.ctl + ctr_word), 1u, __ATOMIC_RELAXED, __HIP_MEMORY_SCOPE_AGENT); asm volatile("" :: "v"(o_)); }
    __syncthreads();
}
__device__ __forceinline__ void unit_wait(Frame& F, int ctr_word, unsigned need) {
    if (F.tid == 0) { unsigned sp = 0u; while (__hip_atomic_load((unsigned*)(F.ctl + ctr_word), __ATOMIC_RELAXED, __HIP_MEMORY_SCOPE_AGENT) < need) { __builtin_amdgcn_s_sleep(16); if (++sp > (1u << 18)) break; }
        __builtin_amdgcn_fence(__ATOMIC_ACQUIRE, "agent"); asm volatile("s_waitcnt vmcnt(0)" ::: "memory"); }
    __syncthreads();
}

typedef __attribute__((address_space(8))) void* rsrc_t;
__device__ __forceinline__ void wt_store16(void* p, u32x4 v) {
    asm volatile("global_store_dwordx4 %0, %1, off sc1\n\ts_nop 1" :: "v"(p), "v"(v) : "memory"); }
__device__ __forceinline__ void wt_store8(void* p, u32x2 v) { __hip_atomic_store((unsigned long long*)p, ((unsigned long long)v.y << 32) | v.x, __ATOMIC_RELAXED, __HIP_MEMORY_SCOPE_AGENT); }
__device__ __forceinline__ void unit_publish_wt(Frame& F, int ctr_word) {
    asm volatile("s_waitcnt vmcnt(0)" ::: "memory"); __syncthreads();
    if (F.tid == 0) { const unsigned o_ = __hip_atomic_fetch_add((unsigned*)(F.ctl + ctr_word), 1u, __ATOMIC_RELAXED, __HIP_MEMORY_SCOPE_AGENT); asm volatile("" :: "v"(o_)); }
    __syncthreads();
}

__device__ __forceinline__ int win_src(int n) {
    if (n < 3072) return n;
    if (n < 4096) return 3088 + (n - 3072);
    if (n < 4352) return 4112 + (n - 4096);
    if (n < 4608) return 4368 + (n - 4352);
    if (n < 5120) return 4624 + (n - 4608);
    if (n < 6144) return 5208 + (n - 5120);
    if (n < 7168) return 6232 + (n - 6144);
    if (n < 7184) return 3072 + (n - 7168);
    if (n < 7248) return 5136 + (n - 7184);
    if (n < 7256) return 5200 + (n - 7248);
    return -1;
}
template <bool VEC, class SrcFn>
__device__ __forceinline__ void p0_transpose_item(SrcFn src, int ldw, int Kdim, bf16_t* WT, LAS float* scr, int kb, int nb, int lane, const float* ksc = nullptr) {
    const int k0 = 64 * kb, n0 = 32 * nb;
    if (VEC) {
        const float* cp = src(n0 + 4 * (lane & 7)) + (size_t)(k0 + (lane >> 3)) * ldw;
#pragma unroll
        for (int i = 0; i < 8; ++i) { const f32x4 v = *(const f32x4*)(cp + (size_t)(8 * i) * ldw); LAS float* d = scr + (8 * i + (lane >> 3)) * 33 + 4 * (lane & 7); d[0] = v.x; d[1] = v.y; d[2] = v.z; d[3] = v.w; }
    } else {
        const float* cp = src(n0 + (lane & 31));
#pragma unroll 8
        for (int i = 0; i < 32; ++i) { const int kk = 2 * i + (lane >> 5); scr[kk * 33 + (lane & 31)] = cp ? cp[(size_t)(k0 + kk) * ldw] : 0.f; }
    }
    LDS_WAIT(); asm volatile("" ::: "memory");
    const int c = lane & 7;
    f32x4 k0s = {1.f, 1.f, 1.f, 1.f}, k1s = k0s;
    if (ksc) { k0s = *(const f32x4*)(ksc + k0 + 8 * c); k1s = *(const f32x4*)(ksc + k0 + 8 * c + 4); }
#pragma unroll
    for (int j = 0; j < 4; ++j) { const int n = (lane >> 3) + 8 * j; const LAS float* s = scr + (8 * c) * 33 + n;
        u32x4 o; o.x = cvt_pk_bf16(s[0 * 33] * k0s.x, s[1 * 33] * k0s.y); o.y = cvt_pk_bf16(s[2 * 33] * k0s.z, s[3 * 33] * k0s.w); o.z = cvt_pk_bf16(s[4 * 33] * k1s.x, s[5 * 33] * k1s.y); o.w = cvt_pk_bf16(s[6 * 33] * k1s.z, s[7 * 33] * k1s.w);
        *(GAS u32x4*)(WT + (size_t)(n0 + n) * Kdim + k0 + 8 * c) = o; }
    LDS_WAIT(); asm volatile("" ::: "memory");
}
__device__ __forceinline__ void cache_to_bf16(Frame& F, int wi, int nw) {
    const f32x4* ck = (const f32x4*)F.in[2]; const f32x4* cv = (const f32x4*)F.in[3]; GAS u32x4* ok = (GAS u32x4*)(F.ws + WS_CK); GAS u32x4* ov = (GAS u32x4*)(F.ob + DO_CV);
    const long n8 = (long)NBATCH * PAST * 256 / 8; const long gt = (long)wi * NTHR + F.tid, GT = (long)nw * NTHR;
    for (long i = gt; i < 2 * n8; i += 8 * GT) {
        f32x4 a[8], b[8];
#pragma unroll
        for (int u = 0; u < 8; ++u) { const long iu = i + u * GT; if (iu < 2 * n8) { const bool isk = iu < n8; const long j = isk ? iu : iu - n8; const f32x4* s = (isk ? ck : cv) + 2 * j; a[u] = s[0]; b[u] = s[1]; } }
#pragma unroll
        for (int u = 0; u < 8; ++u) { const long iu = i + u * GT; if (iu < 2 * n8) { const bool isk = iu < n8; const long j = isk ? iu : iu - n8;
            u32x4 o; o.x = cvt_pk_bf16(a[u].x, a[u].y); o.y = cvt_pk_bf16(a[u].z, a[u].w); o.z = cvt_pk_bf16(b[u].x, b[u].y); o.w = cvt_pk_bf16(b[u].z, b[u].w);
            (isk ? ok : ov)[j] = o; } }
    }
}
__device__ __forceinline__ void p0_prologue(Frame& F) {
    LAS float* scr = (LAS float*)(F.lds + F.wave * 16384);
    const int gw = F.vcu * NWAVES + F.wave, NGW = F.G * NWAVES, lane = F.lane;
    const float* w_in = F.in[10]; const float* w_bs = F.in[20]; const float* w_ba = F.in[21]; const float* w_out = F.in[22];
    const float* w_gate = F.in[24]; const float* w_up = F.in[25]; const float* w_dn = F.in[26];
    bf16_t* WIN = (bf16_t*)(F.ws + WS_WIN); bf16_t* WBS = (bf16_t*)(F.ws + WS_WBS); bf16_t* WBA = (bf16_t*)(F.ws + WS_WBA); bf16_t* WOUT = (bf16_t*)(F.ws + WS_WOUT);
    bf16_t* WGU = (bf16_t*)(F.ws + WS_WGU); bf16_t* WDN = (bf16_t*)(F.ws + WS_WDN);
    constexpr int I_IN = 16 * (NIN / 32), I_SQ = 16 * 32, I_GU = 16 * (NGU / 32), I_DN = (DFF / 64) * 32;
    constexpr int NITEMS = I_IN + 3 * I_SQ + I_GU + I_DN;
    for (int it = gw; it < NITEMS; it += NGW) {
        int r = it;
        if (r < I_IN) { const int nb = r % (NIN / 32), kb = r / (NIN / 32);
            if (nb < 224) p0_transpose_item<true>([&](int n) -> const float* { return w_in + win_src(n); }, 7256, 1024, WIN, scr, kb, nb, lane);
            else p0_transpose_item<false>([&](int n) -> const float* { const int s = win_src(n); return s >= 0 ? w_in + s : nullptr; }, 7256, 1024, WIN, scr, kb, nb, lane); continue; } r -= I_IN;
        if (r < I_SQ) { p0_transpose_item<true>([&](int n) -> const float* { return w_bs + n; }, 1024, 1024, WBS, scr, r / 32, r % 32, lane); continue; } r -= I_SQ;
        if (r < I_SQ) { p0_transpose_item<true>([&](int n) -> const float* { return w_ba + n; }, 1024, 1024, WBA, scr, r / 32, r % 32, lane); continue; } r -= I_SQ;
        if (r < I_SQ) { p0_transpose_item<true>([&](int n) -> const float* { return w_out + n; }, 1024, 1024, WOUT, scr, r / 32, r % 32, lane); continue; } r -= I_SQ;
        if (r < I_GU) { const int nb = r % (NGU / 32), kb = r / (NGU / 32);
            p0_transpose_item<true>([&](int n) -> const float* { const int t = n >> 8, j = n & 255, ch = t * 128 + (j >> 3) * 4 + (j & 3); return ((j & 4) ? w_up : w_gate) + ch; }, DFF, 1024, WGU, scr, kb, nb, lane, F.in[23]); continue; } r -= I_GU;
        p0_transpose_item<true>([&](int n) -> const float* { return w_dn + n; }, 1024, DFF, WDN, scr, r / 32, r % 32, lane);
    }
    const float* xp = F.in[0]; const float* xs = F.in[1]; const float* meta = F.in[7]; const float* n1w = F.in[9];
    bf16_t* HN = (bf16_t*)(F.ob + DO_HN);
    f32x4 wv[4];
#pragma unroll
    for (int j = 0; j < 4; ++j) wv[j] = *((const f32x4*)n1w + lane + 64 * j);
    for (int m = gw; m < RPAD; m += NGW) {
        GAS u32x2* o8 = (GAS u32x2*)(HN + (size_t)m * DM) + lane;
        if (m >= RR) {
#pragma unroll
            for (int j = 0; j < 4; ++j) o8[64 * j] = (u32x2){0u, 0u};
            continue; }
        const float* xrow;
        if (m < RPR) { const int b = m / TP, t = m - b * TP; xrow = t < NMETA ? meta + (size_t)t * DM : xp + ((size_t)b * SEQ + (t - NMETA)) * DM; }
        else xrow = xs + (size_t)(m - RPR) * DM;
        const f32x4* xr = (const f32x4*)xrow + lane;
        f32x4 v[4]; float s = 0.f;
#pragma unroll
        for (int j = 0; j < 4; ++j) { v[j] = xr[64 * j]; s += (v[j].x * v[j].x + v[j].y * v[j].y) + (v[j].z * v[j].z + v[j].w * v[j].w); }
        const float rs = __builtin_amdgcn_rsqf(wave_sum(s) * (1.f / DM) + EPS);
#pragma unroll
        for (int j = 0; j < 4; ++j) { const f32x4 y = v[j] * rs * wv[j]; o8[64 * j] = (u32x2){cvt_pk_bf16(y.x, y.y), cvt_pk_bf16(y.z, y.w)}; }
    }
    { float* s1 = (float*)(F.ws + WS_SSQ1); const int gt = F.vcu * NTHR + F.tid, GT = F.G * NTHR;
      for (int i = gt; i < (int)((WS_PART - WS_SSQ1) / 4); i += GT) s1[i] = 0.f; }
}

struct SchedP1 {
    const char* A; const char* B; int G, c;
    __device__ __forceinline__ bool next(int i, pg8::Unit& u) const {
        const int L = i * G + c; if (L >= 67 * 29) return false;
        pg8::tile_of(L, 67, 29, u.pm, u.pn); u.part = 0; u.A = A + (size_t)u.pm * 256 * 1024 * 2; u.B = B + (size_t)u.pn * 256 * 1024 * 2; return true; }
};
struct EpiP1 {
    static constexpr bool PERM = true;
    unsigned char* ws; unsigned char* ob;
    __device__ __forceinline__ bool operator()(pg8::Acc& acc, const pg8::Unit& u, int wr, int wc, int fr, int fq) const {
        const int pn = u.pn; const int row0 = u.pm * 256 + wr * 64 + fr, cw = wc * 32 + 8 * fq;
        if (pn == 28) {
            float* SM = (float*)(ws + WS_SM);
            if (cw < SMLD) {
#pragma unroll
                for (int ai = 0; ai < 2; ++ai)
#pragma unroll
                    for (int m = 0; m < 4; ++m) { const int r = row0 + ai * 128 + m * 16; if (r < RR) { float* p = SM + (size_t)r * SMLD + cw; *(f32x4*)p = acc[ai][0][m][0]; *(f32x4*)(p + 4) = acc[ai][0][m][1]; } }
            }
            return false;
        }
        bf16_t* base; int ld, c0;
        if (pn < 4) { base = (bf16_t*)(ws + WS_Z); ld = 1024; c0 = pn * 256; }
        else if (pn < 8) { base = (bf16_t*)(ws + WS_XS); ld = 1024; c0 = (pn - 4) * 256; }
        else if (pn < 12) { base = (bf16_t*)(ws + WS_BC); ld = 1024; c0 = (pn - 8) * 256; }
        else if (pn < 16) { base = (bf16_t*)(ob + DO_Q); ld = 1024; c0 = (pn - 12) * 256; }
        else if (pn == 16) { base = (bf16_t*)(ws + WS_K); ld = 256; c0 = 0; }
        else if (pn == 17) { base = (bf16_t*)(ws + WS_V); ld = 256; c0 = 0; }
        else if (pn < 20) { base = (bf16_t*)(ob + DO_QI); ld = 512; c0 = (pn - 18) * 256; }
        else if (pn < 24) { base = (bf16_t*)(ws + WS_GS); ld = 1024; c0 = (pn - 20) * 256; }
        else { base = (bf16_t*)(ws + WS_GA); ld = 1024; c0 = (pn - 24) * 256; }
#pragma unroll
        for (int ai = 0; ai < 2; ++ai)
#pragma unroll
            for (int m = 0; m < 4; ++m) { const int r = row0 + ai * 128 + m * 16;
                if (r < RR) { bf16_t* rowp = base + (size_t)r * ld + c0 + cw;
#pragma unroll
                    for (int bj = 0; bj < 2; ++bj) { const f32x4 v0 = acc[ai][bj][m][0], v1 = acc[ai][bj][m][1];
                        u32x4 w; w.x = cvt_pk_bf16(v0[0], v0[1]); w.y = cvt_pk_bf16(v0[2], v0[3]); w.z = cvt_pk_bf16(v1[0], v1[1]); w.w = cvt_pk_bf16(v1[2], v1[3]);
                        *(u32x4*)(rowp + bj * 128) = w; } } }
        return false;
    }
};

__device__ __forceinline__ void p2_rows(Frame& F) {
    const int gw = F.vcu * NWAVES + F.wave, NGW = F.G * NWAVES, lane = F.lane;
    bf16_t* K = (bf16_t*)(F.ws + WS_K); const bf16_t* V = (const bf16_t*)(F.ws + WS_V);
    float* SM = (float*)(F.ws + WS_SM); bf16_t* KI = (bf16_t*)(F.ws + WS_KI);
    const float* knw = F.in[18]; const float* ikw = F.in[19]; const float* dtb = F.in[13];
    const f32x4 kw = *(const f32x4*)(knw + (lane & 31) * 4);
    const float iw = ikw[lane]; const float dbias = lane < 16 ? dtb[lane] : 0.f;
    const int item = gw; u32x4 ixs[2] = {{0u, 0u, 0u, 0u}, {0u, 0u, 0u, 0u}}, ibc[2] = {{0u, 0u, 0u, 0u}, {0u, 0u, 0u, 0u}};
    if (item < 48 + 768) { int r;
        if (item < 48) { const int s = item / 3, i = item % 3; r = s < 8 ? s * TP + (TP - 3 + i) : RPR + (s - 8) * DSEQ + (DSEQ - 3 + i); }
        else { const int h = item - 48, b = h / 96, jb = (h % 96) / 3, i = h % 3; r = b * TP + 64 * (jb + 1) - 3 + i; }
#pragma unroll
        for (int j = 0; j < 2; ++j) { const int c = j * 512 + lane * 8; ixs[j] = *(const u32x4*)((const bf16_t*)(F.ws + WS_XS) + (size_t)r * 1024 + c); ibc[j] = *(const u32x4*)((const bf16_t*)(F.ws + WS_BC) + (size_t)r * 1024 + c); } }
    u32x2 nk, nv; float nki, ndt, nwi;
#define P2_LOAD(rr) do { nk = *((const u32x2*)(K + (size_t)(rr) * 256) + lane); nv = *((const u32x2*)(V + (size_t)(rr) * 256) + lane); \
        const float* sm_ = SM + (size_t)(rr) * SMLD; nki = sm_[16 + lane]; ndt = sm_[lane & 15]; nwi = sm_[80 + (lane & 7)]; } while (0)
    if (gw < RR) P2_LOAD(gw);
    for (int r = gw; r < RR; r += NGW) {
        const u32x2 kin = nk, vv = nv; const float kv = nki, dtv = ndt, wiv = nwi;
        if (r + NGW < RR) P2_LOAD(r + NGW);
        const bool pr = r < RPR; const size_t orow = pr ? (size_t)r : (size_t)(r - RPR);
        float* k_out = F.out + (pr ? O_KP : O_KS) + orow * 256; float* v_out = F.out + (pr ? O_VP : O_VS) + orow * 256; float* ki_out = F.out + (pr ? O_KIP : O_KIS) + orow * 64;
        { u32x2* kp = (u32x2*)(K + (size_t)r * 256) + lane;
          f32x4 x = {bf_lo(kin.x), bf_hi(kin.x), bf_lo(kin.y), bf_hi(kin.y)};
          float s = (x.x * x.x + x.y * x.y) + (x.z * x.z + x.w * x.w);
          s += __shfl_xor(s, 1); s += __shfl_xor(s, 2); s += __shfl_xor(s, 4); s += __shfl_xor(s, 8); s += __shfl_xor(s, 16);
          const float rs = __builtin_amdgcn_rsqf(s * (1.f / HD) + EPS);
          x = x * rs * kw;
          *kp = (u32x2){cvt_pk_bf16(x.x, x.y), cvt_pk_bf16(x.z, x.w)};
          *((f32x4*)k_out + lane) = x;
          *((f32x4*)v_out + lane) = (f32x4){bf_lo(vv.x), bf_hi(vv.x), bf_lo(vv.y), bf_hi(vv.y)}; }
        { float* sm = SM + (size_t)r * SMLD;
          const float ss = wave_sum(kv * kv);
          const float kn = kv * __builtin_amdgcn_rsqf(ss * (1.f / IDXD) + EPS) * iw;
          KI[(size_t)r * 64 + lane] = f2bf(kn); ki_out[lane] = kn;
          if (lane < 16) { const float x = dtv + dbias; sm[lane] = x > 20.f ? x : log1pf(expf(x)); }
          if (lane < 8) sm[80 + lane] = wiv * 0.04419417382415922f; }
    }
#undef P2_LOAD
    if (item < 48) { const int s = item / 3, i = item % 3; float* o = F.out + (s < 8 ? O_CVP + (size_t)(s * 3 + i) * CONV_DIM : O_CVS + (size_t)((s - 8) * 3 + i) * CONV_DIM);
#pragma unroll
        for (int j = 0; j < 2; ++j) { const int c = j * 512 + lane * 8; const u32x4 xa = ixs[j], xb = ibc[j];
            *(f32x4*)(o + c) = (f32x4){bf_lo(xa.x), bf_hi(xa.x), bf_lo(xa.y), bf_hi(xa.y)}; *(f32x4*)(o + c + 4) = (f32x4){bf_lo(xa.z), bf_hi(xa.z), bf_lo(xa.w), bf_hi(xa.w)};
            *(f32x4*)(o + 1024 + c) = (f32x4){bf_lo(xb.x), bf_hi(xb.x), bf_lo(xb.y), bf_hi(xb.y)}; *(f32x4*)(o + 1024 + c + 4) = (f32x4){bf_lo(xb.z), bf_hi(xb.z), bf_lo(xb.w), bf_hi(xb.w)}; } }
    else if (item < 48 + 768) { const int h = item - 48, b = h / 96, jb = (h % 96) / 3, i = h % 3; bf16_t* o = (bf16_t*)(F.ws + WS_HAL) + (size_t)((b * 33 + jb + 1) * 3 + i) * CONV_DIM;
#pragma unroll
        for (int j = 0; j < 2; ++j) { const int c = j * 512 + lane * 8; *(u32x4*)(o + c) = ixs[j]; *(u32x4*)(o + 1024 + c) = ibc[j]; } }
}

__device__ __forceinline__ int t5_bucket(int rel) {
    const int n = rel < 0 ? -rel : rel; const int ret = rel > 0 ? 16 : 0;
    const int v = n < 8 ? n : (n < 12 ? 8 : n < 16 ? 9 : n < 23 ? 10 : n < 32 ? 11 : n < 46 ? 12 : n < 64 ? 13 : n < 91 ? 14 : 15);
    return ret + v;
}
__device__ __forceinline__ void conv_unit(Frame& F, int u) {
    bf16_t* XS = (bf16_t*)(F.ws + WS_XS); bf16_t* BC = (bf16_t*)(F.ws + WS_BC); const bf16_t* HAL = (const bf16_t*)(F.ws + WS_HAL);
    const float* conv_w = F.in[11]; const float* conv_b = F.in[12]; const float* st_conv = F.in[6];
    const int cg = F.tid & 63, rc = F.wave;
    const int cq = u & 1, sb = u >> 1; const bool pr = sb < NBATCH * 33;
    const int b = pr ? sb / 33 : sb - NBATCH * 33, j = pr ? sb % 33 : 0;
    const int T = pr ? TP : DSEQ, row0 = (pr ? b * TP : RPR + b * DSEQ) + 64 * j, nvalid = T - 64 * j;
    const int t0 = 8 * rc;
    u32x4 raw[2][11];
#pragma unroll
    for (int h = 0; h < 2; ++h) { const int ch = 1024 * cq + 512 * h + 8 * cg; const bf16_t* colp = ch < 1024 ? XS + ch : BC + (ch - 1024);
#pragma unroll
        for (int i = 0; i < 11; ++i) { const int t = t0 - 3 + i;
            u32x4 v = {0u, 0u, 0u, 0u};
            if (t >= 0) { if (t < nvalid) v = __builtin_nontemporal_load((const u32x4*)(colp + (size_t)(row0 + t) * 1024)); }
            else if (j > 0) v = *(const u32x4*)(HAL + (size_t)((b * 33 + j) * 3 + (t + 3)) * CONV_DIM + ch);
            raw[h][i] = v; } }
    __syncthreads();
#pragma unroll
    for (int h = 0; h < 2; ++h) { const int ch = 1024 * cq + 512 * h + 8 * cg; bf16_t* colp = ch < 1024 ? XS + ch : BC + (ch - 1024);
        float w[4][8], bias[8];
#pragma unroll
        for (int i = 0; i < 4; ++i) { const f32x4 a = *(const f32x4*)(conv_w + i * CONV_DIM + ch), c = *(const f32x4*)(conv_w + i * CONV_DIM + ch + 4);
            w[i][0] = a.x; w[i][1] = a.y; w[i][2] = a.z; w[i][3] = a.w; w[i][4] = c.x; w[i][5] = c.y; w[i][6] = c.z; w[i][7] = c.w; }
        { const f32x4 a = *(const f32x4*)(conv_b + ch), c = *(const f32x4*)(conv_b + ch + 4); bias[0] = a.x; bias[1] = a.y; bias[2] = a.z; bias[3] = a.w; bias[4] = c.x; bias[5] = c.y; bias[6] = c.z; bias[7] = c.w; }
        float x[4][8];
#define CONV_ROW(dst, i) do { const int t_ = t0 - 3 + (i); \
            if (!pr && t_ < 0) { const float* sp = st_conv + (size_t)(b * 3 + (t_ + 3)) * CONV_DIM + ch; const f32x4 a_ = *(const f32x4*)sp, c_ = *(const f32x4*)(sp + 4); \
                dst[0] = a_.x; dst[1] = a_.y; dst[2] = a_.z; dst[3] = a_.w; dst[4] = c_.x; dst[5] = c_.y; dst[6] = c_.z; dst[7] = c_.w; } \
            else { const u32x4 v_ = raw[h][i]; dst[0] = bf_lo(v_.x); dst[1] = bf_hi(v_.x); dst[2] = bf_lo(v_.y); dst[3] = bf_hi(v_.y); dst[4] = bf_lo(v_.z); dst[5] = bf_hi(v_.z); dst[6] = bf_lo(v_.w); dst[7] = bf_hi(v_.w); } } while (0)
        CONV_ROW(x[0], 0); CONV_ROW(x[1], 1); CONV_ROW(x[2], 2);
#pragma unroll
        for (int r = 0; r < 8; ++r) { const int t = t0 + r;
            CONV_ROW(x[(r + 3) & 3], r + 3);
            if (t < nvalid) { float o[8];
#pragma unroll
                for (int e = 0; e < 8; ++e) o[e] = siluf_(bias[e] + x[r & 3][e] * w[0][e] + x[(r + 1) & 3][e] * w[1][e] + x[(r + 2) & 3][e] * w[2][e] + x[(r + 3) & 3][e] * w[3][e]);
                u32x4 ov; ov.x = cvt_pk_bf16(o[0], o[1]); ov.y = cvt_pk_bf16(o[2], o[3]); ov.z = cvt_pk_bf16(o[4], o[5]); ov.w = cvt_pk_bf16(o[6], o[7]);
                __builtin_nontemporal_store(ov, (u32x4*)(colp + (size_t)(row0 + t) * 1024)); } }
#undef CONV_ROW
    }
    __syncthreads();
}

namespace ssd {
constexpr int CL = 0, BL = 17408, XR = 34816, XW = 44032, WM = 53248, SB = 62464, FA = 79872, LDS_TOT = 80640;
constexpr int LDC = 272, LDX = 144, LDW = 144;
typedef short v4i16 __attribute__((ext_vector_type(4)));
__device__ __forceinline__ s16x4 trd(LAS unsigned char* p) { return __builtin_bit_cast(s16x4, __builtin_amdgcn_ds_read_tr16_b64_v4i16((LAS v4i16*)p)); }
__device__ __forceinline__ bf16x8 frag_tr(LAS unsigned char* img, int stride, int m0, int kb0, int i, int g4) {
    LAS unsigned char* p = img + (kb0 + 8 * g4 + (i >> 2)) * stride + (m0 + 4 * (i & 3)) * 2;
    const s16x4 lo = trd(p), hi = trd(p + 4 * stride);
    return (bf16x8){lo[0], lo[1], lo[2], lo[3], hi[0], hi[1], hi[2], hi[3]};
}
__device__ __forceinline__ bf16x8 frag_row(LAS unsigned char* img, int stride, int r0, int kb0, int i, int g4) {
    return *(const LAS bf16x8*)(img + (r0 + i) * stride + (kb0 + 8 * g4) * 2);
}
}
__device__ __forceinline__ void ssd_chain_unit(Frame& F, int unit) {
    using namespace ssd;
    int tid_ = F.tid; asm volatile("" : "+v"(tid_));
    const int tid = tid_, lane = tid & 63, w = F.wave, i16 = lane & 15, g4 = lane >> 4;
    LAS unsigned char* L = F.lds;
    const bool pr = unit < 128; const int uu = unit & 127, b = uu >> 4, h = uu & 15, g = h >> 2;
    const int T = pr ? TP : DSEQ, row0 = pr ? b * TP : RPR + b * DSEQ, nblk = (T + 63) >> 6;
    bf16_t* XS = (bf16_t*)(F.ws + WS_XS); const bf16_t* BC = (const bf16_t*)(F.ws + WS_BC); const bf16_t* Z = (const bf16_t*)(F.ws + WS_Z);
    const float* SM = (const float*)(F.ws + WS_SM); float* SSQ1 = (float*)(F.ws + WS_SSQ1);
    const int xcol = h * 64;
    const float a_h = -expf(F.in[14][h]), dsk = F.in[15][h];
    const int cb_sb = w >> 1, cb_tb0 = 2 * (w & 1), y_pb0 = 2 * (w & 1), y_tb = w >> 1;
    const int yp0 = 16 * y_pb0 + 4 * g4;
    f32x4 nwv[2];
#pragma unroll
    for (int q = 0; q < 2; ++q) nwv[q] = *(const f32x4*)(F.in[16] + xcol + yp0 + 16 * q);
    f32x4 st[4];
    float* sout = F.out + (pr ? O_SSMP : O_SSMS) + ((size_t)(b * 16 + h) * 64) * 128;
    if (pr) {
#pragma unroll
        for (int pb = 0; pb < 4; ++pb) st[pb] = (f32x4){0.f, 0.f, 0.f, 0.f}; }
    else { const float* sp = F.in[5] + ((size_t)(b * 16 + h) * 64) * 128;
#pragma unroll
        for (int pb = 0; pb < 4; ++pb) st[pb] = *(const f32x4*)(sp + (size_t)(16 * pb + i16) * 128 + 16 * w + 4 * g4); }
    const int srow = tid >> 3, sch = tid & 7;
    u32x4 pB[2], pC[2], pX; u32x2 pZ[2]; float pdt;
#define SSD_PREFETCH(jb) do { const int base_ = 64 * (jb); \
        { const bool ok_ = base_ + srow < T; const bf16_t* rp_ = BC + (size_t)(row0 + base_ + srow) * 1024 + g * 128 + 8 * sch; \
          pB[0] = ok_ ? *(const u32x4*)rp_ : (u32x4){0u, 0u, 0u, 0u}; pB[1] = ok_ ? *(const u32x4*)(rp_ + 64) : (u32x4){0u, 0u, 0u, 0u}; \
          pC[0] = ok_ ? *(const u32x4*)(rp_ + 512) : (u32x4){0u, 0u, 0u, 0u}; pC[1] = ok_ ? *(const u32x4*)(rp_ + 576) : (u32x4){0u, 0u, 0u, 0u}; \
          pX = ok_ ? *(const u32x4*)(XS + (size_t)(row0 + base_ + srow) * 1024 + xcol + 8 * sch) : (u32x4){0u, 0u, 0u, 0u}; } \
        { const int t_ = base_ + 16 * y_tb + i16; const bf16_t* zp_ = Z + (size_t)(row0 + t_) * 1024 + xcol + yp0; \
          pZ[0] = t_ < T ? *(const u32x2*)zp_ : (u32x2){0u, 0u}; pZ[1] = t_ < T ? *(const u32x2*)(zp_ + 16) : (u32x2){0u, 0u}; } \
        { const int t_ = base_ + lane; pdt = t_ < T ? SM[(size_t)(row0 + t_) * SMLD + h] : 0.f; } } while (0)
    SSD_PREFETCH(0);
#pragma unroll 1
    for (int jb = 0; jb < nblk; ++jb) {
        float ac = pdt * a_h;
#pragma unroll
        for (int o = 1; o < 64; o <<= 1) { const float v = __shfl_up(ac, o); if (lane >= o) ac += v; }
        const float tot = __shfl(ac, 63);
        const float wsc = __builtin_amdgcn_exp2f((tot - ac) * 1.4426950408889634f) * pdt;
        if (w == 0) { LAS float* fa = (LAS float*)(L + FA); fa[lane] = ac; fa[64 + lane] = pdt; }
        *(LAS u32x4*)(L + BL + srow * LDC + 16 * sch) = pB[0]; *(LAS u32x4*)(L + BL + srow * LDC + 128 + 16 * sch) = pB[1];
        *(LAS u32x4*)(L + CL + srow * LDC + 16 * sch) = pC[0]; *(LAS u32x4*)(L + CL + srow * LDC + 128 + 16 * sch) = pC[1];
        { *(LAS u32x4*)(L + XR + srow * LDX + 16 * sch) = pX;
            const float ws_ = __shfl(wsc, srow);
            u32x4 xw; xw.x = cvt_pk_bf16(bf_lo(pX.x) * ws_, bf_hi(pX.x) * ws_); xw.y = cvt_pk_bf16(bf_lo(pX.y) * ws_, bf_hi(pX.y) * ws_);
            xw.z = cvt_pk_bf16(bf_lo(pX.z) * ws_, bf_hi(pX.z) * ws_); xw.w = cvt_pk_bf16(bf_lo(pX.w) * ws_, bf_hi(pX.w) * ws_);
            *(LAS u32x4*)(L + XW + srow * LDX + 16 * sch) = xw; }
#pragma unroll
        for (int pb = 0; pb < 4; ++pb)
            *(LAS u32x2*)(L + SB + (16 * pb + i16) * LDC + (16 * w + 4 * g4) * 2) = (u32x2){cvt_pk_bf16(st[pb].x, st[pb].y), cvt_pk_bf16(st[pb].z, st[pb].w)};
        const u32x2 zreg0 = pZ[0], zreg1 = pZ[1];
        __syncthreads();
        if (jb + 1 < nblk) SSD_PREFETCH(jb + 1);
        {
            f32x4 cb[2] = {{0.f, 0.f, 0.f, 0.f}, {0.f, 0.f, 0.f, 0.f}};
#pragma unroll
            for (int ks = 0; ks < 4; ++ks) { const bf16x8 af = frag_row(L + BL, LDC, 16 * cb_sb, 32 * ks, i16, g4);
#pragma unroll
                for (int q = 0; q < 2; ++q) { const bf16x8 bfv = frag_row(L + CL, LDC, 16 * (cb_tb0 + q), 32 * ks, i16, g4);
                    cb[q] = __builtin_amdgcn_mfma_f32_16x16x32_bf16(af, bfv, cb[q], 0, 0, 0); } }
            const LAS float* fa = (const LAS float*)(L + FA);
            const int s0 = 16 * cb_sb + 4 * g4;
            const f32x4 acs = *(const LAS f32x4*)(fa + s0), dts = *(const LAS f32x4*)(fa + 64 + s0);
#pragma unroll
            for (int q = 0; q < 2; ++q) { const int t = 16 * (cb_tb0 + q) + i16; const float act = fa[t];
                float o[4];
#pragma unroll
                for (int e = 0; e < 4; ++e) o[e] = (s0 + e <= t) ? cb[q][e] * __builtin_amdgcn_exp2f((act - acs[e]) * 1.4426950408889634f) * dts[e] : 0.f;
                *(LAS u32x2*)(L + WM + t * LDW + s0 * 2) = (u32x2){cvt_pk_bf16(o[0], o[1]), cvt_pk_bf16(o[2], o[3])}; }
            const float dtot = __builtin_amdgcn_exp2f(tot * 1.4426950408889634f);
#pragma unroll
            for (int pb = 0; pb < 4; ++pb) st[pb] = st[pb] * dtot;
#pragma unroll
            for (int ks = 0; ks < 2; ++ks) { const bf16x8 af = frag_tr(L + BL, LDC, 16 * w, 32 * ks, i16, g4);
#pragma unroll
                for (int pb = 0; pb < 4; ++pb) { const bf16x8 bfv = frag_tr(L + XW, LDX, 16 * pb, 32 * ks, i16, g4);
                    st[pb] = __builtin_amdgcn_mfma_f32_16x16x32_bf16(af, bfv, st[pb], 0, 0, 0); } }
        }
        __syncthreads();
        {
            f32x4 y[2] = {{0.f, 0.f, 0.f, 0.f}, {0.f, 0.f, 0.f, 0.f}};
#pragma unroll
            for (int ks = 0; ks < 4; ++ks) { const bf16x8 bfv = frag_row(L + CL, LDC, 16 * y_tb, 32 * ks, i16, g4);
#pragma unroll
                for (int q = 0; q < 2; ++q) { const bf16x8 af = frag_row(L + SB, LDC, 16 * (y_pb0 + q), 32 * ks, i16, g4); y[q] = __builtin_amdgcn_mfma_f32_16x16x32_bf16(af, bfv, y[q], 0, 0, 0); } }
            const LAS float* fa = (const LAS float*)(L + FA);
            const int t = 16 * y_tb + i16; const float eac = __builtin_amdgcn_exp2f(fa[t] * 1.4426950408889634f);
            y[0] = y[0] * eac; y[1] = y[1] * eac;
#pragma unroll
            for (int ks = 0; ks < 2; ++ks) { const bf16x8 bfv = frag_row(L + WM, LDW, 16 * y_tb, 32 * ks, i16, g4);
#pragma unroll
                for (int q = 0; q < 2; ++q) { const bf16x8 af = frag_tr(L + XR, LDX, 16 * (y_pb0 + q), 32 * ks, i16, g4); y[q] = __builtin_amdgcn_mfma_f32_16x16x32_bf16(af, bfv, y[q], 0, 0, 0); } }
            const int tg = 64 * jb + t; float ss = 0.f; f32x4 yo[2];
#pragma unroll
            for (int q = 0; q < 2; ++q) { const u32x2 xv = *(const LAS u32x2*)(L + XR + t * LDX + (yp0 + 16 * q) * 2); const u32x2 zr = q ? zreg1 : zreg0;
                const f32x4 xf = {bf_lo(xv.x), bf_hi(xv.x), bf_lo(xv.y), bf_hi(xv.y)}, zf = {bf_lo(zr.x), bf_hi(zr.x), bf_lo(zr.y), bf_hi(zr.y)};
                yo[q].x = (y[q].x + dsk * xf.x) * siluf_(zf.x); yo[q].y = (y[q].y + dsk * xf.y) * siluf_(zf.y); yo[q].z = (y[q].z + dsk * xf.z) * siluf_(zf.z); yo[q].w = (y[q].w + dsk * xf.w) * siluf_(zf.w);
                ss += (yo[q].x * yo[q].x + yo[q].y * yo[q].y) + (yo[q].z * yo[q].z + yo[q].w * yo[q].w); }
            ss += __shfl_xor(ss, 16); ss += __shfl_xor(ss, 32);
            if (tg < T) { if (g4 == 0) atomicAdd(SSQ1 + row0 + tg, ss);
#pragma unroll
                for (int q = 0; q < 2; ++q) { const f32x4 yn = yo[q] * nwv[q]; const u32x2 yv = {cvt_pk_bf16(yn.x, yn.y), cvt_pk_bf16(yn.z, yn.w)}; bf16_t* yp = XS + (size_t)(row0 + tg) * 1024 + xcol + yp0 + 16 * q;
                    if (pr) *(u32x2*)yp = yv; else wt_store8(yp, yv); } }
        }
        __syncthreads();
    }
#undef SSD_PREFETCH
#pragma unroll
    for (int pb = 0; pb < 4; ++pb) *(f32x4*)(sout + (size_t)(16 * pb + i16) * 128 + 16 * w + 4 * g4) = st[pb];
    if (!pr) unit_publish_wt(F, CW_DEP + 192);
}
__device__ __forceinline__ float relu1(float a) { const int b = __float_as_int(a); return __int_as_float(b > 0 ? b : 0); }
__device__ __forceinline__ f32x2 pk_relu(f32x2 a) { return (f32x2){relu1(a.x), relu1(a.y)}; }
__device__ __forceinline__ f32x2 pk_fma(f32x2 a, f32x2 b, f32x2 c) { f32x2 r; asm volatile("v_pk_fma_f32 %0, %1, %2, %3" : "=v"(r) : "v"(a), "v"(b), "v"(c)); return r; }
namespace idx {
constexpr int WTAB = 0, SCORES = 512;
}
__device__ __forceinline__ unsigned* mask_row(Frame& F, int r) {
    return r < RPR ? (unsigned*)(F.ws + WS_MASK) + (size_t)r * MASK_LDP : (unsigned*)(F.ws + WS_MASKS) + (size_t)(r - RPR) * MASK_LDS;
}
__device__ __forceinline__ unsigned f2key(float f) { const unsigned u = __float_as_uint(f); return (u & 0x80000000u) ? ~u : (u | 0x80000000u); }
__device__ __forceinline__ float key2f(unsigned k) { return __uint_as_float((k & 0x80000000u) ? (k & 0x7fffffffu) : ~k); }
template <int NI>
__device__ __forceinline__ void idx_select(Frame& F, const LAS float* sc, int LP, int Lk, int NQ, int r0) {
    const int lane = F.lane, w = F.wave, ni = LP >> 6; const unsigned long long lt_mask = (1ull << lane) - 1ull;
    float zq, dfac;
    { const float qq = 0.5f - (float)TOPK / (float)Lk, r = qq * qq;
      zq = (((((-3.969683028665376e+01f * r + 2.209460984245205e+02f) * r - 2.759285104469687e+02f) * r + 1.383577518672690e+02f) * r - 3.066479806614716e+01f) * r + 2.506628277459239e+00f) * qq /
           (((((-5.447609879822406e+01f * r + 1.615858368580409e+02f) * r - 1.556989798598866e+02f) * r + 6.680131188771972e+01f) * r - 1.328068155288572e+01f) * r + 1.f);
      dfac = (float)Lk * 0.3989422804f * __builtin_amdgcn_exp2f(-0.7213475204f * zq * zq); }
    constexpr int NMIN = NI == 9 ? 5 : (NI == 65 ? 65 : NI - 7);
    const float NINF = -__builtin_inff(), PINF = __builtin_inff();
#pragma unroll 1
    for (int q = w; q < NQ; q += 8) {
        const LAS float* row = sc + q * LP + lane; unsigned* mrow = mask_row(F, r0 + q);
        float kreg[NI];
        kreg[0] = row[(ni - 1) * 64];
#pragma unroll
        for (int j = 1; j < NI; ++j) { if (j < NMIN) kreg[j] = row[(j - 1) * 64]; else kreg[j] = j < ni ? row[(j - 1) * 64] : NINF; }
        float mx = kreg[0], mn = kreg[0] == NINF ? PINF : kreg[0], sm = 0.f, sq = 0.f;
#pragma unroll
        for (int j = 1; j < NI; ++j) { const float x = kreg[j]; mx = fmaxf(mx, x);
            if (j < NMIN) { mn = fminf(mn, x); sm += x; sq = fmaf(x, x, sq); } else mn = fminf(mn, x == NINF ? PINF : x); }
#pragma unroll
        for (int o = 1; o < 64; o <<= 1) { mx = fmaxf(mx, __shfl_xor(mx, o)); mn = fminf(mn, __shfl_xor(mn, o)); sm += __shfl_xor(sm, o); sq += __shfl_xor(sq, o); }
        mx = __int_as_float(__builtin_amdgcn_readfirstlane(__float_as_int(mx))); mn = __int_as_float(__builtin_amdgcn_readfirstlane(__float_as_int(mn)));
        sm = __int_as_float(__builtin_amdgcn_readfirstlane(__float_as_int(sm))); sq = __int_as_float(__builtin_amdgcn_readfirstlane(__float_as_int(sq)));
        constexpr float RN = 1.f / (64.f * (NMIN - 1));
        const float mu = sm * RN, sd = __builtin_sqrtf(fmaxf(sq * RN - mu * mu, 0.f));
        const float idens = sd / dfac;
        float lo = mn, hi = __uint_as_float(__float_as_uint(mx) + (mx >= 0.f ? 1u : 0xffffffffu)); if (mx == 0.f) hi = 1e-38f;
        float thr = 0.f; bool exact = false; float flo = 0.f, fhi = 0.f; bool lo_set = false, hi_set = false;
        float guess = mu + zq * sd; int third = 0;
#pragma unroll 1
        for (int it = 0; it < 64; ++it) {
            float mid = guess;
            if (it >= 20) mid = key2f(f2key(lo) + ((f2key(hi) - f2key(lo)) >> 1));
            if (!(mid > lo && mid < hi)) { mid = lo + (hi - lo) * 0.5f; if (!(mid > lo && mid < hi)) break; }
            int cnt = __popcll(__ballot(kreg[0] >= mid));
#pragma unroll
            for (int i = 1; i + 3 < NI; i += 4) {
                const unsigned long long b0 = __ballot(kreg[i] >= mid), b1 = __ballot(kreg[i + 1] >= mid), b2 = __ballot(kreg[i + 2] >= mid), b3 = __ballot(kreg[i + 3] >= mid);
                __builtin_amdgcn_sched_group_barrier(0x2, 4, 0); __builtin_amdgcn_sched_group_barrier(0x4, 8, 0);
                cnt += (__popcll(b0) + __popcll(b1)) + (__popcll(b2) + __popcll(b3)); }
            static_assert((NI - 1) % 4 == 0, "NI = 4m + 1");
            if (cnt == TOPK) { thr = mid; exact = true; break; }
            if (cnt > TOPK) { lo = mid; flo = (float)cnt; lo_set = true; } else { hi = mid; fhi = (float)cnt; hi_set = true; }
            if (lo_set && hi_set) { float tfr = (flo - 256.f) * __builtin_amdgcn_rcpf(flo - fhi); if (++third == 3) { third = 0; tfr = 0.5f; } tfr = fminf(fmaxf(tfr, 0.08f), 0.92f); guess = lo + (hi - lo) * tfr; }
            else guess = mid + ((float)cnt - 256.f) * idens; }
        unsigned m0 = 0u, m1 = 0u, m2 = 0u, m3 = 0u;
#define IDX_PUT(blk, ms) do { const unsigned long long ms_ = (ms); const unsigned lo_ = (unsigned)ms_, hi_ = (unsigned)(ms_ >> 32); \
            if (__builtin_constant_p(blk)) { \
                if (NI <= 64 || (blk) < 64) asm("s_nop 1\n\tv_writelane_b32 %0, %2, %4\n\tv_writelane_b32 %1, %3, %4" : "+v"(m0), "+v"(m1) : "s"(lo_), "s"(hi_), "n"((blk) & 63)); \
                else asm("s_nop 1\n\tv_writelane_b32 %0, %2, %4\n\tv_writelane_b32 %1, %3, %4" : "+v"(m2), "+v"(m3) : "s"(lo_), "s"(hi_), "n"((blk) & 63)); } \
            else { if (lane == (blk)) { m0 = lo_; m1 = hi_; } if (NI > 64 && lane + 64 == (blk)) { m2 = lo_; m3 = hi_; } } } while (0)
        if (exact) {
#pragma unroll
            for (int j = 1; j < NI; ++j) IDX_PUT(j - 1, __ballot(kreg[j] >= thr));
            IDX_PUT(ni - 1, __ballot(kreg[0] >= thr));
        } else {
            int ngt = 0;
#pragma unroll
            for (int i = 0; i < NI; ++i) ngt += __popcll(__ballot(kreg[i] >= hi));
            const int need = TOPK - ngt; int eqseen = 0;
#pragma unroll
            for (int jj = 1; jj <= NI; ++jj) { const int j = jj < NI ? jj : 0; const bool gt = kreg[j] >= hi, eq = (kreg[j] >= lo) && !gt; const unsigned long long meq = __ballot(eq);
                const bool sel = gt || (eq && (eqseen + __popcll(meq & lt_mask)) < need);
                if (j) IDX_PUT(j - 1, __ballot(sel)); else IDX_PUT(ni - 1, __ballot(sel));
                eqseen += __popcll(meq); }
        }
#undef IDX_PUT
        if (lane < ni) *(u32x2*)(mrow + 2 * lane) = (u32x2){m0, m1};
        if (NI > 64 && lane + 64 < ni) *(u32x2*)(mrow + 2 * (lane + 64)) = (u32x2){m2, m3};
    }
}
template <bool PR>
__device__ __forceinline__ void idx_unit(Frame& F, int b, int c, int qg) {
    constexpr int NQ = PR ? 16 : 8, NRB = NQ / 4;
    int tid_ = F.tid; asm volatile("" : "+v"(tid_));
    const int tid = tid_, lane = tid & 63, w = F.wave, r32 = lane & 31, hh = lane >> 5;
    LAS unsigned char* L_ = F.lds;
    const int Lk = PR ? NMETA + 64 * c : LS, LP = (Lk + 63) & ~63, nkb = LP >> 5;
    const int r0 = PR ? b * TP + NMETA + 64 * (c - 1) + NQ * qg : RPR + b * DSEQ + NQ * qg;
    const int krow0 = PR ? b * TP : RPR + b * DSEQ;
    const bf16_t* QI = (const bf16_t*)(F.ob + DO_QI); const bf16_t* KI = (const bf16_t*)(F.ws + WS_KI); const float* SM = (const float*)(F.ws + WS_SM); const float* ckidx = F.in[4];
    LAS float* wtab = (LAS float*)(L_ + idx::WTAB); LAS float* sc = (LAS float*)(L_ + idx::SCORES);
    if (tid < NQ * 8) wtab[tid] = SM[(size_t)(r0 + (tid >> 3)) * SMLD + 80 + (tid & 7)];
    const int a_tok = ((r32 >> 4) & 1) + 2 * ((r32 >> 2) & 1), a_head = (r32 & 3) + 4 * ((r32 >> 3) & 1);
    bf16x8 af[NRB][4];
#pragma unroll
    for (int rb = 0; rb < NRB; ++rb)
#pragma unroll
        for (int ks = 0; ks < 4; ++ks) af[rb][ks] = *(const bf16x8*)(QI + (size_t)(r0 + 4 * rb + a_tok) * 512 + a_head * 64 + 16 * ks + 8 * hh);
    __syncthreads();
    constexpr int ST = PR ? 3 : 2, RAWN = PR ? 4 : 8;
    u32x4 raw0[RAWN], raw1[RAWN], raw2[PR ? RAWN : 1];
#define IDX_LOADB(kb_, R) do { const int s_ = (kb_) * 32 + r32; const int sc_ = s_ < Lk ? s_ : Lk - 1; \
        if (!PR && (kb_) * 32 < PAST) { const float* kp = ckidx + ((size_t)b * PAST + sc_) * 64 + 8 * hh; \
            _Pragma("unroll") for (int ks = 0; ks < 4; ++ks) { R[(2 * ks) % RAWN] = *(const u32x4*)(kp + 16 * ks); R[(2 * ks + 1) % RAWN] = *(const u32x4*)(kp + 16 * ks + 4); } } \
        else { const bf16_t* kp = KI + (size_t)(PR ? krow0 + sc_ : krow0 + sc_ - PAST) * 64 + 8 * hh; \
            _Pragma("unroll") for (int ks = 0; ks < 4; ++ks) R[ks] = *(const u32x4*)(kp + 16 * ks); } } while (0)
#define IDX_GETB(kb_, R) do { if (!PR && (kb_) * 32 < PAST) { \
            _Pragma("unroll") for (int ks = 0; ks < 4; ++ks) { const u32x4 x0 = R[(2 * ks) % RAWN], x1 = R[(2 * ks + 1) % RAWN]; \
                u32x4 t; t.x = cvt_pk_bf16(__uint_as_float(x0.x), __uint_as_float(x0.y)); t.y = cvt_pk_bf16(__uint_as_float(x0.z), __uint_as_float(x0.w)); \
                t.z = cvt_pk_bf16(__uint_as_float(x1.x), __uint_as_float(x1.y)); t.w = cvt_pk_bf16(__uint_as_float(x1.z), __uint_as_float(x1.w)); bfr[ks] = __builtin_bit_cast(bf16x8, t); } } \
        else { _Pragma("unroll") for (int ks = 0; ks < 4; ++ks) bfr[ks] = __builtin_bit_cast(bf16x8, R[ks]); } } while (0)
    if (w < nkb) IDX_LOADB(w, raw0);
    if (w + 8 < nkb) IDX_LOADB(w + 8, raw1);
    if (PR && w + 16 < nkb) IDX_LOADB(w + 16, raw2);
#define IDX_STAGE(st, R) do { const int kb = kb0 + 8 * (st); \
        if (kb < nkb) { const int s = kb * 32 + r32; bf16x8 bfr[4]; \
            IDX_GETB(kb, R); \
            if (kb + 8 * ST < nkb) IDX_LOADB(kb + 8 * ST, R); \
            f32x16 d[NRB]; \
            _Pragma("unroll") for (int rb = 0; rb < NRB; ++rb) _Pragma("unroll") for (int e = 0; e < 16; ++e) d[rb][e] = 0.f; \
              \
            _Pragma("unroll") for (int ks = 0; ks < 4; ++ks) _Pragma("unroll") for (int rb = 0; rb < NRB; ++rb) d[rb] = __builtin_amdgcn_mfma_f32_32x32x16_bf16(af[rb][ks], bfr[ks], d[rb], 0, 0, 0); \
            _Pragma("unroll") for (int rb = 0; rb < NRB; ++rb) { \
                  \
                _Pragma("unroll") for (int q = 0; q < 2; ++q) { const int tok = 4 * rb + 2 * hh + q; const f32x4 w0 = *(const LAS f32x4*)(wtab + tok * 8), w1 = *(const LAS f32x4*)(wtab + tok * 8 + 4); \
                    f32x2 acc2 = {0.f, 0.f}; \
                    acc2 = pk_fma(pk_relu((f32x2){d[rb][8 * q], d[rb][8 * q + 1]}), (f32x2){w0.x, w0.y}, acc2); acc2 = pk_fma(pk_relu((f32x2){d[rb][8 * q + 2], d[rb][8 * q + 3]}), (f32x2){w0.z, w0.w}, acc2); \
                    acc2 = pk_fma(pk_relu((f32x2){d[rb][8 * q + 4], d[rb][8 * q + 5]}), (f32x2){w1.x, w1.y}, acc2); acc2 = pk_fma(pk_relu((f32x2){d[rb][8 * q + 6], d[rb][8 * q + 7]}), (f32x2){w1.z, w1.w}, acc2); \
                    float v = acc2.x + acc2.y; \
                    if (v == 0.f) v = 0.f;                                     \
                    sc[tok * LP + s] = s < Lk ? v : -__builtin_inff(); } } } } while (0)
#pragma unroll 1
    for (int kb0 = w; kb0 < nkb; kb0 += 8 * ST) {
        IDX_STAGE(0, raw0);
        IDX_STAGE(1, raw1);
        if (PR) IDX_STAGE(2, raw2);
    }
#undef IDX_STAGE
#undef IDX_GETB
#undef IDX_LOADB
    __syncthreads();
    if (PR) { if (LP <= 576) idx_select<9>(F, sc, LP, Lk, NQ, r0); else if (LP <= 1088) idx_select<17>(F, sc, LP, Lk, NQ, r0); else if (LP <= 1600) idx_select<25>(F, sc, LP, Lk, NQ, r0); else idx_select<33>(F, sc, LP, Lk, NQ, r0); }
    else idx_select<65>(F, sc, LP, Lk, NQ, r0);
    __syncthreads();
}
__device__ __forceinline__ void idx_allones(Frame& F, int b, int c) {
    const int Lk = NMETA + 64 * c, nw = ((Lk + 63) & ~63) >> 5;
    for (int e = F.tid; e < 64 * nw; e += NTHR) { const int q = e / nw, wd = e - q * nw; const int lo = 32 * wd;
        const unsigned m = lo + 32 <= Lk ? 0xffffffffu : (lo >= Lk ? 0u : ((1u << (Lk - lo)) - 1u));
        mask_row(F, b * TP + NMETA + 64 * (c - 1) + q)[wd] = m; }
}
__device__ __forceinline__ void idx_conv_units(Frame& F) {
    constexpr int NPU = NBATCH * 29 * 4, NSU = NBATCH * 8, NAU = NBATCH * 3, NCU = (NBATCH * 33 + NBATCH) * 2;
    LAS int* qslot = (LAS int*)(F.lds + MISC_OFF) + 16;
    for (;;) {
        refresh_ids(F);
        if (F.tid == 0) *qslot = (int)__hip_atomic_fetch_add((unsigned*)(F.ctl + CW_Q + 64), 1u, __ATOMIC_RELAXED, __HIP_MEMORY_SCOPE_AGENT);
        __syncthreads();
        const int u = __builtin_amdgcn_readfirstlane(*qslot);
        __syncthreads();
        if (u >= NPU + NSU + NAU + NCU) break;
        constexpr int NIU = NSU + NPU, NG = NIU / 2;
        static_assert(NIU % 2 == 0 && NG <= NCU, "queue pattern");
        int iu = -1, cu = -1, au = -1;
        if (u < 3 * NG) { const int gq = u / 3, kq = u - 3 * gq; if (kq < 2) iu = 2 * gq + kq; else cu = gq; } else if (u < NIU + NCU) cu = NG + (u - 3 * NG); else au = u - NIU - NCU;
        if (iu >= 0) {
            if (iu < NSU) { idx_unit<false>(F, iu >> 3, 0, iu & 7); }
            else { const int v = iu - NSU; const int qg = v & 3, bc = v >> 2, b = bc & 7, c = 32 - (bc >> 3); idx_unit<true>(F, b, c, qg); } }
        else if (cu >= 0) conv_unit(F, cu);
        else idx_allones(F, au & 7, 1 + (au >> 3));
    }
}
namespace att {
constexpr int SHM_V = 16384, SHM_K = 16384, OFF_V = 0, OFF_K = 2 * SHM_V, OFF_WS = OFF_K + 2 * SHM_K, OFF_TAB = OFF_WS + 8 * 256, OFF_OST = OFF_TAB + 4 * 320 * 4, OST_LD = 272, LDS_TOT = OFF_OST + 8 * 32 * OST_LD;
static_assert(LDS_TOT <= MISC_OFF, "attention LDS");
constexpr float NEG = -1e30f, MINIT = -1e20f, THR2 = 8.f, L2E = 1.4426950408889634f;
#define KSWZ(row, colB) ((row) * 256 + ((colB) ^ (((row) & 15) << 4)))
#define SBAR() __builtin_amdgcn_sched_barrier(0)
__device__ __forceinline__ int crow(int r, int hi) { return (r & 3) + 8 * (r >> 2) + 4 * hi; }
__device__ __forceinline__ int v_st(int k, int c) { const int kk = (k & ~0xC) | ((k & 4) << 1) | ((k & 8) >> 1); return ((kk >> 3) * 4 + (c >> 5)) * 512 + ((kk & 7) * 32 + (c & 31)) * 2; }
__device__ __forceinline__ int v_rd_base(int lane) { return ((lane & 3) << 3) | (((lane >> 2) & 3) << 6) | (((lane >> 4) & 1) << 5) | (((lane >> 5) & 1) << 8); }
constexpr int v_rd_off(int d0, int ks, int half) { return d0 * 512 + ks * 4096 + half * 2048; }
template <int OFF> __device__ __forceinline__ s16x4 tr_read(int vb) { s16x4 r; asm volatile("ds_read_b64_tr_b16 %0, %1 offset:%2" : "=&v"(r) : "v"(vb), "i"(OFF) : "memory"); return r; }
template <int D0> __device__ __forceinline__ void pv_one(f32x16& od, int vb, bf16x8 pa0, bf16x8 pa1, bf16x8 pa2, bf16x8 pa3) {
    const s16x4 l0 = tr_read<v_rd_off(D0, 0, 0)>(vb), h0 = tr_read<v_rd_off(D0, 0, 1)>(vb), l1 = tr_read<v_rd_off(D0, 1, 0)>(vb), h1 = tr_read<v_rd_off(D0, 1, 1)>(vb);
    const s16x4 l2 = tr_read<v_rd_off(D0, 2, 0)>(vb), h2 = tr_read<v_rd_off(D0, 2, 1)>(vb), l3 = tr_read<v_rd_off(D0, 3, 0)>(vb), h3 = tr_read<v_rd_off(D0, 3, 1)>(vb);
    asm volatile("s_waitcnt lgkmcnt(0)" ::: "memory"); SBAR();
#define PK(L, H) (bf16x8){L[0], L[1], L[2], L[3], H[0], H[1], H[2], H[3]}
    od = __builtin_amdgcn_mfma_f32_32x32x16_bf16(pa0, PK(l0, h0), od, 0, 0, 0);
    od = __builtin_amdgcn_mfma_f32_32x32x16_bf16(pa1, PK(l1, h1), od, 0, 0, 0);
    od = __builtin_amdgcn_mfma_f32_32x32x16_bf16(pa2, PK(l2, h2), od, 0, 0, 0);
    od = __builtin_amdgcn_mfma_f32_32x32x16_bf16(pa3, PK(l3, h3), od, 0, 0, 0);
#undef PK
}
__device__ __forceinline__ void qkt(f32x16& p0, f32x16& p1, const LAS unsigned char* Ks, const bf16x8* qr, float init, int r32, int hi) {
#pragma unroll
    for (int r = 0; r < 16; ++r) { p0[r] = init; p1[r] = init; }
#pragma unroll
    for (int d0 = 0; d0 < 8; ++d0) { const int cb = (d0 * 16 + hi * 8) * 2;
        const bf16x8 b0 = *(const LAS bf16x8*)(Ks + KSWZ(r32, cb)), b1 = *(const LAS bf16x8*)(Ks + KSWZ(32 + r32, cb));
        p0 = __builtin_amdgcn_mfma_f32_32x32x16_bf16(b0, qr[d0], p0, 0, 0, 0);
        p1 = __builtin_amdgcn_mfma_f32_32x32x16_bf16(b1, qr[d0], p1, 0, 0, 0); }
}
}

template <bool PR>
__device__ __forceinline__ void attn_unit(Frame& F, int b, int c, int g, int sp) {
    using namespace att;
    int tid_ = F.tid; asm volatile("" : "+v"(tid_));
    const int tid = tid_, lane = tid & 63, w = F.wave, r32 = lane & 31, hi = lane >> 5, hd = w >> 1, th = w & 1;
    LAS unsigned char* L = F.lds;
    const int qrow0 = PR ? b * TP + NMETA + 64 * (c - 1) : RPR + b * DSEQ, qpos0 = PR ? NMETA + 64 * (c - 1) : PAST;
    const int jt0 = PR ? 0 : (sp == 0 ? 0 : 1 + 8 * sp), NT = PR ? c + 1 : 9 + 8 * sp;
    bf16_t* Q = (bf16_t*)(F.ob + DO_Q);
    const bf16_t* Kb = (const bf16_t*)(F.ws + WS_K); const bf16_t* Vb = (const bf16_t*)(F.ws + WS_V); const bf16_t* CK = (const bf16_t*)(F.ws + WS_CK); const bf16_t* CV = (const bf16_t*)(F.ob + DO_CV);
    const float* relb = F.in[8];
    u32x4 qraw[8];
    { const bf16_t* qp = Q + (size_t)(qrow0 + 32 * th + r32) * 1024 + g * 512 + hd * 128 + hi * 8;
#pragma unroll
      for (int d0 = 0; d0 < 8; ++d0) qraw[d0] = *(const u32x4*)(qp + d0 * 16); }
    { LAS float* tab = (LAS float*)(L + OFF_TAB);
      float tv[3];
#pragma unroll
      for (int i = 0; i < 3; ++i) { const int e = tid + i * NTHR, ec = e < 4 * 320 ? e : 0; const int h4 = ec / 320, rel = ec - h4 * 320 - 192; tv[i] = relb[t5_bucket(rel) * 8 + g * 4 + h4]; }
#pragma unroll
      for (int i = 0; i < 3; ++i) { const int e = tid + i * NTHR; if (e < 4 * 320) tab[e] = tv[i] * L2E; } }
    const float cfar = relb[15 * 8 + g * 4 + hd] * L2E;
    bf16x8 qr[8];
    { const float* qnw = F.in[17] + hi * 8;
      constexpr float QSC = 0.08838834764831845f * L2E;
      float ss = 0.f;
#pragma unroll
      for (int d0 = 0; d0 < 8; ++d0)
#pragma unroll
          for (int j = 0; j < 4; ++j) { const float a = bf_lo(qraw[d0][j]), b2 = bf_hi(qraw[d0][j]); ss += a * a + b2 * b2; }
      { const auto rr = __builtin_amdgcn_permlane32_swap(__float_as_uint(ss), __float_as_uint(ss), false, false); ss = __uint_as_float(rr[0]) + __uint_as_float(rr[1]); }
      const float rs = __builtin_amdgcn_rsqf(ss * (1.f / HD) + EPS) * QSC;
#pragma unroll
      for (int d0 = 0; d0 < 8; ++d0) { const f32x4 w0 = *(const f32x4*)(qnw + d0 * 16), w1 = *(const f32x4*)(qnw + d0 * 16 + 4); const u32x4 v = qraw[d0];
          const u32x4 o_ = {cvt_pk_bf16(bf_lo(v.x) * rs * w0.x, bf_hi(v.x) * rs * w0.y), cvt_pk_bf16(bf_lo(v.y) * rs * w0.z, bf_hi(v.y) * rs * w0.w),
                            cvt_pk_bf16(bf_lo(v.z) * rs * w1.x, bf_hi(v.z) * rs * w1.y), cvt_pk_bf16(bf_lo(v.w) * rs * w1.z, bf_hi(v.w) * rs * w1.w)};
          qr[d0] = __builtin_bit_cast(bf16x8, o_); } }
    const unsigned* mrow = PR ? (const unsigned*)(F.ws + WS_MASK) + (size_t)(qrow0 + 32 * th + r32) * MASK_LDP : (const unsigned*)(F.ws + WS_MASKS) + (size_t)(qrow0 - RPR + 32 * th + r32) * MASK_LDS;
    LAS float* wsf = (LAS float*)(L + OFF_WS) + w * 64;
    const int sr = tid >> 4, scol = (tid & 15) * 8, vst0 = v_st(sr, scol), vst1 = v_st(32 + sr, scol);
    const int vb0 = (int)(uintptr_t)(L + OFF_V) + v_rd_base(lane);
    float m_reg = MINIT, l_reg = 0.f; f32x16 o[4] = {};
    u32x4 sv0, sv1, sk0, sk1;
#define ATT_SRC(j, kt, vt) const bf16_t* kt; const bf16_t* vt; { if (PR) { kt = Kb + (size_t)(b * TP + 64 * (j)) * 256 + g * 128; vt = Vb + (size_t)(b * TP + 64 * (j)) * 256 + g * 128; } \
        else if ((j) < PAST / 64) { kt = CK + ((size_t)b * PAST + 64 * (j)) * 256 + g * 128; vt = CV + ((size_t)b * PAST + 64 * (j)) * 256 + g * 128; } \
        else { kt = Kb + (size_t)(RPR + b * DSEQ) * 256 + g * 128; vt = Vb + (size_t)(RPR + b * DSEQ) * 256 + g * 128; } }
#define ATT_SLOAD(j) do { ATT_SRC(j, kt_, vt_); sv0 = *(const u32x4*)(vt_ + (size_t)sr * 256 + scol); sv1 = *(const u32x4*)(vt_ + (size_t)(32 + sr) * 256 + scol); \
        sk0 = *(const u32x4*)(kt_ + (size_t)sr * 256 + scol); sk1 = *(const u32x4*)(kt_ + (size_t)(32 + sr) * 256 + scol); } while (0)
#define ATT_SWRITE(bf) do { *(LAS u32x4*)(L + OFF_V + (bf) * SHM_V + vst0) = sv0; *(LAS u32x4*)(L + OFF_V + (bf) * SHM_V + vst1) = sv1; const int kc_ = scol * 2; \
        *(LAS u32x4*)(L + OFF_K + (bf) * SHM_K + KSWZ(sr, kc_)) = sk0; *(LAS u32x4*)(L + OFF_K + (bf) * SHM_K + KSWZ(32 + sr, kc_)) = sk1; } while (0)
    const int qlo = qpos0 + 32 * th;
    const LAS float* tabh = (const LAS float*)(L + OFF_TAB) + hd * 320;
    const bool evn = !((NT - jt0) & 1);
    int jtb = jt0; const int NTR = (NT - jt0) - (evn ? 1 : 0);
    f32x16 pA0, pA1, pB0, pB1; float alA = 1.f, alB = 1.f, cmA = 0.f, cmB = 0.f; u32x2 mwA = {0u, 0u}, mwB = {0u, 0u}; bf16x8 pa0, pa1, pa2, pa3;
#define ATT_MLOAD(k, MW) do { MW = *(const u32x2*)(mrow + 2 * (jtb + (k))); } while (0)
#define ATT_SCORE(P0, P1, k, bfk, MW, CADD) do { const int jj_ = jtb + (k); \
        qkt(P0, P1, L + OFF_K + (bfk) * SHM_K, qr, 0.f, r32, hi); \
        const bool far_ = (64 * jj_ + 63 - qlo) <= -91; CADD = far_ ? cfar : 0.f; \
        if (!far_) { const LAS float* tp = tabh + (64 * jj_ - qlo - r32 + 4 * hi + 192); \
            _Pragma("unroll") for (int r = 0; r < 16; ++r) { const int o_ = (r & 3) + 8 * (r >> 2); P0[r] += tp[o_]; P1[r] += tp[o_ + 32]; } } } while (0)
#define ATT_PARTIAL(P0, P1, MW, CADD, AL, CM) do { float pmax = P0[0]; \
        _Pragma("unroll") for (int r = 1; r < 16; ++r) pmax = fmaxf(pmax, P0[r]); \
        _Pragma("unroll") for (int r = 0; r < 16; ++r) pmax = fmaxf(pmax, P1[r]); \
        { const auto rr = __builtin_amdgcn_permlane32_swap(__float_as_uint(pmax), __float_as_uint(pmax), false, false); pmax = fmaxf(__uint_as_float(rr[0]), __uint_as_float(rr[1])) + CADD; } \
        if (__builtin_expect(__all(pmax - m_reg <= THR2), 1)) { AL = 1.f; } else { const float mn = fmaxf(m_reg, pmax); AL = __builtin_amdgcn_exp2f(m_reg - mn); m_reg = mn; } \
        CM = CADD - m_reg; const int m0_ = (int)(MW.x >> (4 * hi)); \
        _Pragma("unroll") for (int r = 0; r < 16; ++r) { const int o_ = (r & 3) + 8 * (r >> 2); \
            const float e_ = __builtin_amdgcn_exp2f(P0[r] + CM); asm("v_bfe_i32 %0, %2, %3, 1\n\tv_and_b32 %0, %0, %1" : "=&v"(P0[r]) : "v"(e_), "v"(m0_), "n"(o_)); } } while (0)
#define ATT_FINISH(P0, P1, MW, AL, CM) do { const int m1_ = (int)(MW.y >> (4 * hi)); float ps = 0.f; \
        _Pragma("unroll") for (int r = 0; r < 16; ++r) { const int o_ = (r & 3) + 8 * (r >> 2); \
            const float e_ = __builtin_amdgcn_exp2f(P1[r] + CM); asm("v_bfe_i32 %0, %2, %3, 1\n\tv_and_b32 %0, %0, %1" : "=&v"(P1[r]) : "v"(e_), "v"(m1_), "n"(o_)); ps += P0[r] + P1[r]; } \
        { const auto rr = __builtin_amdgcn_permlane32_swap(__float_as_uint(ps), __float_as_uint(ps), false, false); ps = __uint_as_float(rr[0]) + __uint_as_float(rr[1]); } \
        l_reg = l_reg * AL + ps; \
        ATT_PK4(P0, 0, pa0); ATT_PK4(P0, 8, pa1); ATT_PK4(P1, 0, pa2); ATT_PK4(P1, 8, pa3); } while (0)
#define ATT_PK4(P, BASE, OUT) do { const unsigned a0 = cvt_pk_bf16(P[BASE + 0], P[BASE + 1]), a1 = cvt_pk_bf16(P[BASE + 2], P[BASE + 3]); \
        const unsigned b0 = cvt_pk_bf16(P[BASE + 4], P[BASE + 5]), b1 = cvt_pk_bf16(P[BASE + 6], P[BASE + 7]); \
        const auto r0_ = __builtin_amdgcn_permlane32_swap(a0, b0, false, false); const auto r1_ = __builtin_amdgcn_permlane32_swap(a1, b1, false, false); \
        const u32x4 w_ = {r0_[0], r1_[0], r0_[1], r1_[1]}; OUT = __builtin_bit_cast(bf16x8, w_); } while (0)
#define ATT_PV(bfk) do { const int vb = vb0 + (bfk) * SHM_V; \
        pv_one<0>(o[0], vb, pa0, pa1, pa2, pa3); pv_one<1>(o[1], vb, pa0, pa1, pa2, pa3); pv_one<2>(o[2], vb, pa0, pa1, pa2, pa3); pv_one<3>(o[3], vb, pa0, pa1, pa2, pa3); } while (0)
#define ATT_RESC(AL) do { if (__any((AL) < 1.f)) { if (hi == 0) wsf[r32] = (AL); asm volatile("s_waitcnt lgkmcnt(0)" ::: "memory"); \
        _Pragma("unroll") for (int d = 0; d < 4; ++d) _Pragma("unroll") for (int r = 0; r < 16; ++r) o[d][r] *= wsf[crow(r, hi)]; } } while (0)
#define ATT_STAGE_LOAD(k) ATT_SLOAD(jtb + (k))
    if (evn) {
        ATT_STAGE_LOAD(0); ATT_SWRITE(1);
        __syncthreads();
        ATT_MLOAD(0, mwB); ATT_SCORE(pB0, pB1, 0, 1, mwB, cmB); { const float cadd_ = cmB; ATT_PARTIAL(pB0, pB1, mwB, cadd_, alB, cmB); }
        ATT_FINISH(pB0, pB1, mwB, alB, cmB); SBAR();
        ATT_PV(1);
        __syncthreads();
        jtb = jt0 + 1;
    }
    ATT_STAGE_LOAD(0); ATT_SWRITE(0);
    __syncthreads();
    ATT_MLOAD(0, mwA); ATT_SCORE(pA0, pA1, 0, 0, mwA, cmA); { const float cadd_ = cmA; ATT_PARTIAL(pA0, pA1, mwA, cadd_, alA, cmA); }
    if (NTR > 1) { ATT_STAGE_LOAD(1); ATT_SWRITE(1); }
    __syncthreads();
    ATT_RESC(alA);
#pragma unroll 1
    for (int k = 1; k + 1 < NTR; k += 2) {
        SBAR(); ATT_SCORE(pB0, pB1, k, 1, mwB, cmB);
        ATT_FINISH(pA0, pA1, mwA, alA, cmA); SBAR();
        ATT_STAGE_LOAD(k + 1); ATT_MLOAD(k, mwB); SBAR();
        ATT_PV(0); { const float cadd_ = cmB; ATT_PARTIAL(pB0, pB1, mwB, cadd_, alB, cmB); }
        __syncthreads(); ATT_SWRITE(0);
        ATT_RESC(alB); __syncthreads();
        SBAR(); ATT_SCORE(pA0, pA1, k + 1, 0, mwA, cmA);
        ATT_FINISH(pB0, pB1, mwB, alB, cmB); SBAR();
        if (k + 2 < NTR) ATT_STAGE_LOAD(k + 2); ATT_MLOAD(k + 1, mwA); SBAR();
        ATT_PV(1); { const float cadd_ = cmA; ATT_PARTIAL(pA0, pA1, mwA, cadd_, alA, cmA); }
        __syncthreads(); if (k + 2 < NTR) ATT_SWRITE(1);
        ATT_RESC(alA); __syncthreads();
    }
    SBAR(); ATT_FINISH(pA0, pA1, mwA, alA, cmA); SBAR();
    ATT_PV(0);
    __syncthreads();
#undef ATT_SCORE
#undef ATT_MLOAD
#undef ATT_PARTIAL
#undef ATT_FINISH
#undef ATT_PK4
#undef ATT_PV
#undef ATT_RESC
#undef ATT_STAGE_LOAD
#undef ATT_SRC
#undef ATT_SLOAD
#undef ATT_SWRITE
    int b_ = b, g_ = g, sp_ = sp; asm volatile("" : "+v"(b_), "+v"(g_), "+v"(sp_));
    LAS unsigned char* stg = L + OFF_OST + w * 32 * OST_LD;
    bf16_t* ob = (bf16_t*)(F.ob + DO_Q) + (size_t)((PR ? b_ * TP + NMETA + 64 * (c - 1) : RPR + b_ * DSEQ) + 32 * th) * 1024 + g_ * 512 + hd * 128;
    if (!PR) {
        float* pbase = (float*)(F.ob + DO_QI) + (size_t)((b_ * 2 + g_) * 8) * (256 * 132);
        float* pw = pbase + (size_t)sp_ * (256 * 132) + w * (64 * 64 + 128);
        { float* pp = pw + lane * 4;
#pragma unroll
          for (int d0 = 0; d0 < 4; ++d0) {
#pragma unroll
            for (int r4 = 0; r4 < 4; ++r4) { const u32x4 v = {__float_as_uint(o[d0][4 * r4]), __float_as_uint(o[d0][4 * r4 + 1]), __float_as_uint(o[d0][4 * r4 + 2]), __float_as_uint(o[d0][4 * r4 + 3])}; wt_store16(pp + r4 * 256, v); }
            pp += 16 * 64; asm volatile("" : "+v"(pp) :: "memory"); } }
        wt_store8(pw + 4096 + 2 * lane, (u32x2){__float_as_uint(m_reg), __float_as_uint(l_reg)});
        asm volatile("s_waitcnt vmcnt(0)" ::: "memory");
        __syncthreads();
        LAS int* flag = (LAS int*)(L + OFF_WS) + 8 * 64;
        if (tid == 0) {
            const unsigned old = __hip_atomic_fetch_add((unsigned*)(F.ctl + CW_Q + 128 + 64 * (b_ * 2 + g_)), 1u, __ATOMIC_RELAXED, __HIP_MEMORY_SCOPE_AGENT);
            if (old == 7u) { __builtin_amdgcn_fence(__ATOMIC_ACQUIRE, "agent"); asm volatile("s_waitcnt vmcnt(0)" ::: "memory"); }
            *flag = (int)old; }
        __syncthreads();
        const bool last = (*flag == 7);
        __syncthreads();
        if (!last) return;
        float mi[8], li[8];
#pragma unroll
        for (int s8 = 0; s8 < 8; ++s8) { const float* pq = pbase + (size_t)s8 * (256 * 132) + w * (64 * 64 + 128); const f32x2 ml = *(const f32x2*)(pq + 4096 + 2 * lane); mi[s8] = ml.x; li[s8] = ml.y; }
        float mm = mi[0];
#pragma unroll
        for (int s8 = 1; s8 < 8; ++s8) mm = fmaxf(mm, mi[s8]);
        float den = 0.f;
#pragma unroll
        for (int s8 = 0; s8 < 8; ++s8) { mi[s8] = __builtin_amdgcn_exp2f(mi[s8] - mm); den += mi[s8] * li[s8]; }
        const float rl = __builtin_amdgcn_rcpf(den);
        LAS float* wq = (LAS float*)(L + OFF_K) + w * 256;
        if (hi == 0) {
#pragma unroll
            for (int s8 = 0; s8 < 8; ++s8) wq[s8 * 32 + r32] = mi[s8] * rl; }
        asm volatile("s_waitcnt lgkmcnt(0)" ::: "memory");
#pragma unroll 1
        for (int d0 = 0; d0 < 4; ++d0) {
            f32x4 pv[4][8];
#pragma unroll
            for (int r4 = 0; r4 < 4; ++r4) { const float* pq = pbase + w * (64 * 64 + 128) + d0 * 16 * 64 + lane * 4 + r4 * 256;
#pragma unroll
                for (int s8 = 0; s8 < 8; ++s8) pv[r4][s8] = *(const f32x4*)(pq + (size_t)s8 * (256 * 132)); }
#pragma unroll
            for (int r4 = 0; r4 < 4; ++r4) { f32x4 acc4 = {0.f, 0.f, 0.f, 0.f};
#pragma unroll
                for (int s8 = 0; s8 < 8; ++s8) {
#pragma unroll
                    for (int e = 0; e < 4; ++e) acc4[e] += pv[r4][s8][e] * wq[s8 * 32 + crow(4 * r4 + e, hi)]; }
#pragma unroll
                for (int e = 0; e < 4; ++e) *(LAS bf16_t*)(stg + crow(4 * r4 + e, hi) * OST_LD + (d0 * 32 + r32) * 2) = f2bf(acc4[e]); } }
    } else {
        if (hi == 0) wsf[r32] = l_reg; asm volatile("s_waitcnt lgkmcnt(0)" ::: "memory");
        float rli[16];
#pragma unroll
        for (int r = 0; r < 16; ++r) rli[r] = __builtin_amdgcn_rcpf(wsf[crow(r, hi)]);
#pragma unroll
        for (int r = 0; r < 16; ++r) { const int orow = crow(r, hi);
#pragma unroll
            for (int d0 = 0; d0 < 4; ++d0) *(LAS bf16_t*)(stg + orow * OST_LD + (d0 * 32 + r32) * 2) = f2bf(o[d0][r] * rli[r]); }
    }
    asm volatile("s_waitcnt lgkmcnt(0)" ::: "memory");
#pragma unroll
    for (int i = 0; i < 8; ++i) { const int row = i * 4 + (lane >> 4), ch = lane & 15; const u32x4 v = *(const LAS u32x4*)(stg + row * OST_LD + ch * 16);
        if (PR) *(u32x4*)(ob + (size_t)row * 1024 + ch * 8) = v; else wt_store16(ob + (size_t)row * 1024 + ch * 8, v); }
    if (!PR) unit_publish_wt(F, CW_DEP);
    __syncthreads();
}
__device__ __forceinline__ int yrow_to_r(int pm) { return pm * 256 + (pm < 64 ? 16 * ((pm >> 3) + 1) : 128); }
struct SchedP5 {
    const char* A0; const char* A1; const char* B0; const char* B1; int G, c;
    __device__ __forceinline__ bool next(int i, pg8::Unit& u) const {
        const int L = (i >> 1) * G + c; if (L >= 64 * 4) return false;
        pg8::tile_of(L, 64, 4, u.pm, u.pn); u.part = i & 1;
        u.A = (u.part ? A1 : A0) + (size_t)yrow_to_r(u.pm) * 1024 * 2; u.B = (u.part ? B1 : B0) + (size_t)u.pn * 256 * 1024 * 2; return true; }
};
template <bool WT> struct EpiP5T {
    static constexpr bool PERM = true;
    const bf16_t* GS; const bf16_t* GA; const float* SSQ1; bf16_t* MERGED;
    __device__ __forceinline__ bool operator()(pg8::Acc& acc, const pg8::Unit& u, int wr, int wc, int fr, int fq) const {
        const int rr0 = yrow_to_r(u.pm) + wr * 64 + fr, ry0 = u.pm * 256 + wr * 64 + fr, col = u.pn * 256 + wc * 32 + 8 * fq;
#pragma unroll
        for (int ai = 0; ai < 2; ++ai)
#pragma unroll
            for (int m = 0; m < 4; ++m) { const int rr = rr0 + ai * 128 + m * 16, ry = ry0 + ai * 128 + m * 16;
                float rstd = 0.f; if (u.part == 0) rstd = __builtin_amdgcn_rsqf(SSQ1[rr] * (1.f / 1024.f) + EPS);
#pragma unroll
                for (int bj = 0; bj < 2; ++bj) {
                    const u32x4 ga = *(const u32x4*)(GA + (size_t)rr * 1024 + col + bj * 128);
                    float sa[8] = {bf_lo(ga.x), bf_hi(ga.x), bf_lo(ga.y), bf_hi(ga.y), bf_lo(ga.z), bf_hi(ga.z), bf_lo(ga.w), bf_hi(ga.w)};
                    if (u.part == 0) {
                        const u32x4 gs = *(const u32x4*)(GS + (size_t)rr * 1024 + col + bj * 128);
                        const float ss[8] = {bf_lo(gs.x), bf_hi(gs.x), bf_lo(gs.y), bf_hi(gs.y), bf_lo(gs.z), bf_hi(gs.z), bf_lo(gs.w), bf_hi(gs.w)};
#pragma unroll
                        for (int e = 0; e < 8; ++e) {
                            const float f = rstd * (1.f + __builtin_amdgcn_exp2f(-1.4426950408889634f * sa[e])) * __builtin_amdgcn_rcpf(1.f + __builtin_amdgcn_exp2f(-1.4426950408889634f * ss[e]));
                            acc[ai][bj][m][e >> 2][e & 3] *= f; }
                    } else {
                        float o[8];
#pragma unroll
                        for (int e = 0; e < 8; ++e) o[e] = acc[ai][bj][m][e >> 2][e & 3] * sigmoidf_(sa[e]);
                        u32x4 w; w.x = cvt_pk_bf16(o[0], o[1]); w.y = cvt_pk_bf16(o[2], o[3]); w.z = cvt_pk_bf16(o[4], o[5]); w.w = cvt_pk_bf16(o[6], o[7]);
                        if (WT) wt_store16(MERGED + (size_t)ry * 1024 + col + bj * 128, w); else *(u32x4*)(MERGED + (size_t)ry * 1024 + col + bj * 128) = w; } } }
        return u.part == 0;
    }
};
typedef EpiP5T<false> EpiP5;
struct EpiP5A {
    static constexpr bool PERM = true;
    const bf16_t* GS; const float* SSQ1; bf16_t* MERGED;
    __device__ __forceinline__ bool operator()(pg8::Acc& acc, const pg8::Unit& u, int wr, int wc, int fr, int fq) const {
        const int rr0 = yrow_to_r(u.pm) + wr * 64 + fr, ry0 = u.pm * 256 + wr * 64 + fr, col = u.pn * 256 + wc * 32 + 8 * fq;
#pragma unroll
        for (int ai = 0; ai < 2; ++ai)
#pragma unroll
            for (int m = 0; m < 4; ++m) { const int rr = rr0 + ai * 128 + m * 16, ry = ry0 + ai * 128 + m * 16; const float rstd = __builtin_amdgcn_rsqf(SSQ1[rr] * (1.f / 1024.f) + EPS);
#pragma unroll
                for (int bj = 0; bj < 2; ++bj) { const u32x4 gs = *(const u32x4*)(GS + (size_t)rr * 1024 + col + bj * 128);
                    const float ss[8] = {bf_lo(gs.x), bf_hi(gs.x), bf_lo(gs.y), bf_hi(gs.y), bf_lo(gs.z), bf_hi(gs.z), bf_lo(gs.w), bf_hi(gs.w)}; float o[8];
#pragma unroll
                    for (int e = 0; e < 8; ++e) o[e] = acc[ai][bj][m][e >> 2][e & 3] * rstd * sigmoidf_(ss[e]);
                    u32x4 w; w.x = cvt_pk_bf16(o[0], o[1]); w.y = cvt_pk_bf16(o[2], o[3]); w.z = cvt_pk_bf16(o[4], o[5]); w.w = cvt_pk_bf16(o[6], o[7]);
                    wt_store16(MERGED + (size_t)ry * 1024 + col + bj * 128, w); } }
        return false;
    }
};
struct EpiP5B {
    static constexpr bool PERM = true;
    const bf16_t* GA; bf16_t* MERGED;
    __device__ __forceinline__ bool operator()(pg8::Acc& acc, const pg8::Unit& u, int wr, int wc, int fr, int fq) const {
        const int rr0 = yrow_to_r(u.pm) + wr * 64 + fr, ry0 = u.pm * 256 + wr * 64 + fr, col = u.pn * 256 + wc * 32 + 8 * fq;
#pragma unroll
        for (int ai = 0; ai < 2; ++ai)
#pragma unroll
            for (int m = 0; m < 4; ++m) { const int rr = rr0 + ai * 128 + m * 16, ry = ry0 + ai * 128 + m * 16;
#pragma unroll
                for (int bj = 0; bj < 2; ++bj) { const u32x4 ga = *(const u32x4*)(GA + (size_t)rr * 1024 + col + bj * 128); bf16_t* mp = MERGED + (size_t)ry * 1024 + col + bj * 128; const u32x4 t = *(const u32x4*)mp;
                    const float sa[8] = {bf_lo(ga.x), bf_hi(ga.x), bf_lo(ga.y), bf_hi(ga.y), bf_lo(ga.z), bf_hi(ga.z), bf_lo(ga.w), bf_hi(ga.w)};
                    const float tv[8] = {bf_lo(t.x), bf_hi(t.x), bf_lo(t.y), bf_hi(t.y), bf_lo(t.z), bf_hi(t.z), bf_lo(t.w), bf_hi(t.w)}; float o[8];
#pragma unroll
                    for (int e = 0; e < 8; ++e) o[e] = tv[e] + acc[ai][bj][m][e >> 2][e & 3] * sigmoidf_(sa[e]);
                    u32x4 w; w.x = cvt_pk_bf16(o[0], o[1]); w.y = cvt_pk_bf16(o[2], o[3]); w.z = cvt_pk_bf16(o[4], o[5]); w.w = cvt_pk_bf16(o[6], o[7]);
                    wt_store16(mp, w); } }
        return false;
    }
};
struct SchedY {
    const char* A; const char* B; int nN, K, G, c;
    __device__ __forceinline__ bool next(int i, pg8::Unit& u) const {
        const int L = i * G + c; if (L >= 64 * nN) return false;
        pg8::tile_of(L, 64, nN, u.pm, u.pn); u.part = 0; u.A = A + (size_t)u.pm * 256 * K * 2; u.B = B + (size_t)u.pn * 256 * K * 2; return true; }
};
struct SchedTile {
    const char* A0; const char* A1; const char* B0; const char* B1; int pm, pn, nparts;
    __device__ __forceinline__ bool next(int i, pg8::Unit& u) const { if (i >= nparts) return false; u.pm = pm; u.pn = pn; u.part = i; u.A = i ? A1 : A0; u.B = i ? B1 : B0; return true; }
};
struct SchedP8 {
    const char* A; const char* B; int c;
    __device__ __forceinline__ bool next(int i, pg8::Unit& u) const {
        int L; if (c < 8) { if (i >= 3) return false; L = i * 8 + c; } else { L = 24 + i * 248 + (c - 8); if (L >= 64 * 22) return false; }
        pg8::tile_of(L, 64, 22, u.pm, u.pn); u.part = 0; u.A = A + (size_t)u.pm * 256 * 1024 * 2; u.B = B + (size_t)u.pn * 256 * 1024 * 2; return true; }
};
template <bool WT> struct EpiP6T {
    static constexpr bool PERM = false;
    const float* xp; const float* xs; bf16_t* HB; float* SSQ2;
    __device__ __forceinline__ bool operator()(pg8::Acc& acc, const pg8::Unit& u, int wr, int wc, int fr, int fq) const {
        const int ry0 = u.pm * 256 + wr * 64 + fr, col0 = u.pn * 256 + wc * 32 + 4 * fq;
#pragma unroll
        for (int ai = 0; ai < 2; ++ai)
#pragma unroll
            for (int m = 0; m < 4; ++m) { const int ry = ry0 + ai * 128 + m * 16;
                const float* xrow = ry < YPR ? xp + (size_t)ry * 1024 : xs + (size_t)(ry - YPR) * 1024; float ss = 0.f;
#pragma unroll
                for (int bj = 0; bj < 2; ++bj)
#pragma unroll
                    for (int n = 0; n < 2; ++n) { const int c = col0 + bj * 128 + n * 16; const f32x4 h = *(const f32x4*)(xrow + c) + acc[ai][bj][m][n];
                        ss += (h.x * h.x + h.y * h.y) + (h.z * h.z + h.w * h.w);
                        const u32x2 hv = {cvt_pk_bf16(h.x, h.y), cvt_pk_bf16(h.z, h.w)};
                        if (WT) wt_store8(HB + (size_t)ry * 1024 + c, hv); else *(u32x2*)(HB + (size_t)ry * 1024 + c) = hv; }
                ss += __shfl_xor(ss, 16); ss += __shfl_xor(ss, 32);
                if (fq == 0) atomicAdd(SSQ2 + ry, ss); }
        return false;
    }
};
typedef EpiP6T<false> EpiP6;
struct EpiP7 {
    static constexpr bool PERM = true;
    const float* SSQ2; bf16_t* ACT;
    __device__ __forceinline__ bool operator()(pg8::Acc& acc, const pg8::Unit& u, int wr, int wc, int fr, int fq) const {
        const int ry0 = u.pm * 256 + wr * 64 + fr, ch0 = u.pn * 128 + wc * 16 + 4 * fq;
#pragma unroll
        for (int ai = 0; ai < 2; ++ai)
#pragma unroll
            for (int m = 0; m < 4; ++m) { const int ry = ry0 + ai * 128 + m * 16; const float rs = __builtin_amdgcn_rsqf(SSQ2[ry] * (1.f / 1024.f) + EPS);
#pragma unroll
                for (int bj = 0; bj < 2; ++bj) { const f32x4 g = acc[ai][bj][m][0] * rs, up = acc[ai][bj][m][1] * rs;
                    const float a0 = siluf_(g.x) * up.x, a1 = siluf_(g.y) * up.y, a2 = siluf_(g.z) * up.z, a3 = siluf_(g.w) * up.w;
                    *(u32x2*)(ACT + (size_t)ry * DFF + ch0 + bj * 64) = (u32x2){cvt_pk_bf16(a0, a1), cvt_pk_bf16(a2, a3)}; } }
        return false;
    }
};
struct EpiP8 {
    static constexpr bool PERM = false;
    const bf16_t* HB; float* Y;
    __device__ __forceinline__ bool operator()(pg8::Acc& acc, const pg8::Unit& u, int wr, int wc, int fr, int fq) const {
        const int ry0 = u.pm * 256 + wr * 64 + fr, col0 = u.pn * 256 + wc * 32 + 4 * fq;
#pragma unroll
        for (int ai = 0; ai < 2; ++ai)
#pragma unroll
            for (int m = 0; m < 4; ++m) { const size_t ro = (size_t)(ry0 + ai * 128 + m * 16) * 1024 + col0;
#pragma unroll
                for (int bj = 0; bj < 2; ++bj)
#pragma unroll
                    for (int n = 0; n < 2; ++n) { const u32x2 hv = *(const u32x2*)(HB + ro + bj * 128 + n * 16);
                        const f32x4 h = {__uint_as_float(hv.x << 16), __uint_as_float(hv.x & 0xffff0000u), __uint_as_float(hv.y << 16), __uint_as_float(hv.y & 0xffff0000u)};
                        *(f32x4*)(Y + ro + bj * 128 + n * 16) = h + acc[ai][bj][m][n]; } }
        return false;
    }
};

constexpr size_t WS_MS = WS_CK, WS_HBS = WS_CK + (1u << 20), WS_ACTS = WS_CK + (2u << 20);
static_assert(WS_ACTS + (size_t)RSR * DFF * 2 <= WS_MASK, "sample intermediates");
__device__ __forceinline__ void mixer_units(Frame& F) {
    constexpr int Q0 = 128, Q1 = Q0 + 128, QA = Q1 + 8, Q2 = QA + 8, Q3 = Q2 + 128, Q4 = Q3 + 96, Q5 = Q4 + 8, Q6 = Q5 + 160, Q7 = Q6 + 44, Q8 = Q7 + 256;
    LAS int* qslot = (LAS int*)(F.lds + MISC_OFF) + 16;
    for (;;) {
        refresh_ids(F);
        if (F.tid == 0) *qslot = (int)__hip_atomic_fetch_add((unsigned*)(F.ctl + CW_Q), 1u, __ATOMIC_RELAXED, __HIP_MEMORY_SCOPE_AGENT);
        __syncthreads();
        const int u = __builtin_amdgcn_readfirstlane(*qslot);
        __syncthreads();
        if (u >= Q8) break;
        if (u < Q0) { attn_unit<false>(F, u >> 4, 0, (u >> 3) & 1, u & 7); }
        else if (u < Q1) ssd_chain_unit(F, 128 + (u - Q0));
        else if (u < QA) {
            const int k = u - Q1, pm = 64 + (k >> 2), pn = k & 3;
            unit_wait(F, CW_DEP + 192, 128u);
            SchedTile S{(const char*)(F.ws + WS_XS) + (size_t)yrow_to_r(pm) * 1024 * 2, nullptr, (const char*)(F.ws + WS_WBS) + (size_t)pn * 256 * 1024 * 2, nullptr, pm, pn, 1};
            EpiP5A E{(const bf16_t*)(F.ws + WS_GS), (const float*)(F.ws + WS_SSQ1), (bf16_t*)(F.ws + WS_MS) - (size_t)YPR * 1024};
            pg8::gemm_phase<EpiP5A, SchedTile>(F.lds, 1024, S, E, F.wave);
            unit_publish_wt(F, CW_DEP + 256);
        }
        else if (u < Q2) {
            const int k = u - QA, pm = 64 + (k >> 2), pn = k & 3;
            unit_wait(F, CW_DEP, 16u); unit_wait(F, CW_DEP + 256, 8u);
            SchedTile S{(const char*)(F.ob + DO_Q) + (size_t)yrow_to_r(pm) * 1024 * 2, nullptr, (const char*)(F.ws + WS_WBA) + (size_t)pn * 256 * 1024 * 2, nullptr, pm, pn, 1};
            EpiP5B E{(const bf16_t*)(F.ws + WS_GA), (bf16_t*)(F.ws + WS_MS) - (size_t)YPR * 1024};
            pg8::gemm_phase<EpiP5B, SchedTile>(F.lds, 1024, S, E, F.wave);
            unit_publish_wt(F, CW_DEP + 64);
        }
        else if (u < Q3) ssd_chain_unit(F, u - Q2);
        else if (u >= Q4 && u < Q5) {
            const int k = u - Q4, pm = 64 + (k >> 2), pn = k & 3;
            unit_wait(F, CW_DEP + 64, 8u);
            SchedTile S{(const char*)(F.ws + WS_MS) + (size_t)(pm - 64) * 256 * 1024 * 2, nullptr, (const char*)(F.ws + WS_WOUT) + (size_t)pn * 256 * 1024 * 2, nullptr, pm, pn, 1};
            EpiP6T<true> E{F.in[0], F.in[1], (bf16_t*)(F.ws + WS_HBS) - (size_t)YPR * 1024, (float*)(F.ws + WS_SSQ2)};
            pg8::gemm_phase<EpiP6T<true>, SchedTile>(F.lds, 1024, S, E, F.wave);
            unit_publish_wt(F, CW_DEP + 128);
        }
        else if (u >= Q6 && u < Q7) {
            const int k = u - Q6, pm = 64 + k / 22, pn = k % 22;
            unit_wait(F, CW_DEP + 128, 8u);
            SchedTile S{(const char*)(F.ws + WS_HBS) + (size_t)(pm - 64) * 256 * 1024 * 2, nullptr, (const char*)(F.ws + WS_WGU) + (size_t)pn * 256 * 1024 * 2, nullptr, pm, pn, 1};
            EpiP7 E{(const float*)(F.ws + WS_SSQ2), (bf16_t*)(F.ws + WS_ACTS) - (size_t)YPR * DFF};
            pg8::gemm_phase<EpiP7, SchedTile>(F.lds, 1024, S, E, F.wave);
        } else {
            const int v = u < Q4 ? u - Q3 : (u < Q6 ? 96 + (u - Q5) : 256 + (u - Q7));
            const int bg = v & 15, c = 32 - (v >> 4); attn_unit<true>(F, bg >> 1, c, bg & 1, 0);
        }
    }
}

constexpr int NPHASE = 9;
#ifndef PROBE_TIMING
#define PROBE_TIMING 0
#endif
#ifndef PROBE_BASE
#define PROBE_BASE 0
#endif
__global__ void __launch_bounds__(NTHR, 2) hybrid_fwd(Args args) {
    extern __shared__ __attribute__((aligned(16))) unsigned char lds[];
    Frame F;
    F.lds = (LAS unsigned char*)lds; F.MISC = (volatile LAS unsigned*)(F.lds + MISC_OFF);
    F.tid = threadIdx.x; F.lane = F.tid & 63; F.wave = __builtin_amdgcn_readfirstlane(F.tid >> 6);
    F.G = gridDim.x; { const int bx = blockIdx.x; F.vcu = (F.G % 8 == 0) ? (bx % 8) * (F.G / 8) + bx / 8 : bx; }
    F.in = args.in; F.out = args.out; F.ws = args.ws; F.ob = (unsigned char*)args.out; F.ctl = (gu32*)(args.ws + WS_CTL);
    if (F.tid < 64) ((LAS unsigned*)(F.lds + MISC_OFF))[F.tid] = 0u;
    __syncthreads();
    const int lo = args.ph_lo, hi = args.ph_hi;
    const bool multi = (hi - lo) > 1;
    XcdBarrier bar; bar.bar = (unsigned*)(F.ctl + CW_BAR) + args.li * XCD_BAR_WORDS; bar.x = 0; bar.st = nullptr;
    if (multi) bar = xcd_barrier_post((unsigned*)(F.ctl + CW_BAR) + args.li * XCD_BAR_WORDS, F.MISC + 8, F.tid);
#define IN(k) (lo <= (k) && (k) < hi)
#if PROBE_TIMING
    LAS unsigned long long* tst = (LAS unsigned long long*)(F.lds + MISC_OFF + 128); int nst = 0;
#define STAMP() do { if (F.tid == 0) tst[nst] = __builtin_amdgcn_s_memrealtime(); ++nst; } while (0)
#else
#define STAMP() do {} while (0)
#endif
    STAMP();
#define SEAM(k) do { refresh_ids(F); if (IN(k) && IN((k) + 1)) xcd_barrier(bar, F.tid); STAMP(); } while (0)
    if (IN(0)) { p0_prologue(F); SEAM(0); }
    if (IN(1)) {
        SchedP1 S{(const char*)(F.ob + DO_HN), (const char*)(F.ws + WS_WIN), F.G, (int)blockIdx.x};
        EpiP1 E{F.ws, F.ob};
        pg8::gemm_phase<EpiP1, SchedP1>(F.lds, 1024, S, E, F.wave);
        { constexpr int FULL = (67 * 29) % 256; if ((int)blockIdx.x >= FULL) cache_to_bf16(F, (int)blockIdx.x - FULL, 256 - FULL); }
        SEAM(1);
    }
    if (IN(2)) { p2_rows(F); SEAM(2); }
    if (IN(3)) { idx_conv_units(F); SEAM(3); }
    if (IN(4)) { mixer_units(F); SEAM(4); }
    if (IN(5)) {
        SchedP5 S{(const char*)(F.ws + WS_XS), (const char*)(F.ob + DO_Q), (const char*)(F.ws + WS_WBS), (const char*)(F.ws + WS_WBA), F.G, (int)blockIdx.x};
        EpiP5 E{(const bf16_t*)(F.ws + WS_GS), (const bf16_t*)(F.ws + WS_GA), (const float*)(F.ws + WS_SSQ1), (bf16_t*)(F.ws + WS_MERGED)};
        pg8::gemm_phase<EpiP5, SchedP5>(F.lds, 1024, S, E, F.wave);
        SEAM(5);
    }
    if (IN(6)) {
        SchedY S{(const char*)(F.ws + WS_MERGED), (const char*)(F.ws + WS_WOUT), 4, 1024, F.G, (int)blockIdx.x};
        EpiP6 E{F.in[0], F.in[1], (bf16_t*)(F.ws + WS_HB), (float*)(F.ws + WS_SSQ2)};
        pg8::gemm_phase<EpiP6, SchedY>(F.lds, 1024, S, E, F.wave);
        SEAM(6);
    }
    if (IN(7)) {
        if (blockIdx.x < 8) {
            const int k = (int)blockIdx.x, pm = 64 + (k >> 2), pn = k & 3;
            SchedTile S{(const char*)(F.ws + WS_ACTS) + (size_t)(pm - 64) * 256 * DFF * 2, nullptr, (const char*)(F.ws + WS_WDN) + (size_t)pn * 256 * DFF * 2, nullptr, pm, pn, 1};
            EpiP8 E{(const bf16_t*)(F.ws + WS_HBS) - (size_t)YPR * 1024, F.out};
            pg8::gemm_phase<EpiP8, SchedTile>(F.lds, DFF, S, E, F.wave);
        }
        SchedP8 S{(const char*)(F.ws + WS_HB), (const char*)(F.ws + WS_WGU), (int)blockIdx.x};
        EpiP7 E{(const float*)(F.ws + WS_SSQ2), (bf16_t*)(F.ws + WS_ACT)};
        pg8::gemm_phase<EpiP7, SchedP8>(F.lds, 1024, S, E, F.wave);
        SEAM(7);
    }
    if (IN(8)) {
        SchedY S{(const char*)(F.ws + WS_ACT), (const char*)(F.ws + WS_WDN), 4, DFF, F.G, (int)blockIdx.x};
        EpiP8 E{(const bf16_t*)(F.ws + WS_HB), F.out};
        pg8::gemm_phase<EpiP8, SchedY>(F.lds, DFF, S, E, F.wave);
        STAMP();
    }
#if PROBE_TIMING
    __syncthreads();
    if (blockIdx.x == 0 && F.tid < 64) {
        const size_t ooff[5] = {O_KP, O_VP, O_KIP, O_SSMP, O_SSMS};
#pragma unroll
        for (int i = 0; i < 5; ++i) { const int n = (int)((tst[PROBE_BASE + i + 1] - tst[PROBE_BASE + i] + 200) / 400); for (int e = F.tid; e < n && e < 32000; e += 64) ((unsigned*)F.out)[ooff[i] + e] = 0xAAAAAAAAu; }
    }
#endif
#undef IN
#undef SEAM
}

extern "C" void kernel_launch(void* const* d_in, const int* in_sizes, int n_in, void* d_out, int out_size, void* d_ws, size_t ws_size, hipStream_t stream) {
    static int grid = 0;
    if (grid == 0) {
        if (n_in != 27 || out_size != (int)O_END || ws_size < WS_END) { fprintf(stderr, "kernel_launch: unexpected shapes: n_in %d out %d ws %zu (need %zu)\n", n_in, out_size, ws_size, (size_t)WS_END); grid = -1; return; }
        int dev = 0, cus = 0;
        if (hipGetDevice(&dev) != hipSuccess || hipDeviceGetAttribute(&cus, hipDeviceAttributeMultiprocessorCount, dev) != hipSuccess) { grid = -1; return; }
        if (hipFuncSetAttribute((const void*)hybrid_fwd, hipFuncAttributeMaxDynamicSharedMemorySize, LDS_BYTES) != hipSuccess) { fprintf(stderr, "kernel_launch: hipFuncSetAttribute failed\n"); grid = -1; return; }
        (void)hipGetLastError();
        if (cus < 256) { fprintf(stderr, "kernel_launch: built for a 256-CU device (one resident workgroup per CU), found %d CUs\n", cus); grid = -1; return; }
        grid = 256;
    }
    if (grid < 0) return;
    (void)hipMemsetAsync((char*)d_ws + WS_CTL, 0, CTL_ZERO_BYTES, stream);
    Args a{};
    for (int i = 0; i < 27; ++i) a.in[i] = (const float*)d_in[i];
    a.out = (float*)d_out; a.ws = (unsigned char*)d_ws;
#ifndef MK_SPLIT
#define MK_SPLIT 0
#endif
#if MK_SPLIT
    for (int p = 0; p < NPHASE; ++p) { a.ph_lo = p; a.ph_hi = p + 1; a.li = 0; hipLaunchKernelGGL(hybrid_fwd, dim3(grid), dim3(NTHR), LDS_BYTES, stream, a); }
#else
    a.ph_lo = 0; a.ph_hi = NPHASE; a.li = 0; hipLaunchKernelGGL(hybrid_fwd, dim3(grid), dim3(NTHR), LDS_BYTES, stream, a);
#endif
    const hipError_t le = hipPeekAtLastError();
    if (le != hipSuccess) fprintf(stderr, "kernel_launch: launch failed: %s\n", hipGetErrorName(le));
}
```

```cpp
#include <hip/hip_runtime.h>
#include <cstdio>
#include <cstdint>

constexpr int DM = 1024, NBATCH = 8, SEQ = 2048, NMETA = 16, TP = NMETA + SEQ  , DSEQ = 64, PAST = 4096, LS = PAST + DSEQ  ;
constexpr int RPR = NBATCH * TP  , RSR = NBATCH * DSEQ  , RR = RPR + RSR  , RPAD = 17152  ;
constexpr int YPR = NBATCH * SEQ  , YR = YPR + RSR  ;
constexpr int NIN = 7424  , DFF = 2816, NGU = 2 * DFF;
constexpr int SSD_H = 16, SSD_P = 64, SSD_G = 4, SSD_N = 128, CONV_DIM = 2048;
constexpr int NH = 8, NKV = 2, HD = 128, IDXH = 8, IDXD = 64, TOPK = 256;
constexpr float EPS = 1e-6f;
constexpr int SMLD = 96;

constexpr size_t O_YP = 0, O_YS = O_YP + (size_t)YPR * DM, O_KP = O_YS + (size_t)RSR * DM, O_VP = O_KP + (size_t)RPR * 256, O_KIP = O_VP + (size_t)RPR * 256,
                 O_SSMP = O_KIP + (size_t)RPR * 64, O_CVP = O_SSMP + (size_t)NBATCH * 16 * 64 * 128, O_KS = O_CVP + (size_t)NBATCH * 3 * CONV_DIM, O_VS = O_KS + (size_t)RSR * 256,
                 O_KIS = O_VS + (size_t)RSR * 256, O_SSMS = O_KIS + (size_t)RSR * 64, O_CVS = O_SSMS + (size_t)NBATCH * 16 * 64 * 128, O_END = O_CVS + (size_t)NBATCH * 3 * CONV_DIM;
static_assert(O_END == 29302784, "d_out size");
constexpr size_t DO_Q = 0, DO_QI = DO_Q + (size_t)RR * 1024 * 2, DO_CV = DO_QI + (size_t)RR * 512 * 2, DO_YEND = DO_CV + (size_t)NBATCH * PAST * 256 * 2;
static_assert(DO_YEND <= O_KP * 4, "y-region scratch");
constexpr size_t DO_HN = O_KP * 4;
static_assert(DO_HN + (size_t)RPAD * 1024 * 2 <= O_CVP * 4, "hn scratch in tail");

constexpr size_t al256(size_t x) { return (x + 255) / 256 * 256; }
constexpr size_t WS_CTL = 0, CTL_BYTES = 1u << 20, CTL_ZERO_BYTES = 128u << 10;
constexpr size_t WS_WIN = CTL_BYTES, WS_WBS = WS_WIN + (size_t)NIN * 1024 * 2, WS_WBA = WS_WBS + 1024 * 1024 * 2, WS_WOUT = WS_WBA + 1024 * 1024 * 2, WS_WGU = WS_WOUT + 1024 * 1024 * 2,
                 WS_WDN = WS_WGU + (size_t)NGU * 1024 * 2, WS_Z = WS_WDN + (size_t)1024 * DFF * 2, WS_XS = WS_Z + (size_t)RR * 1024 * 2, WS_BC = WS_XS + (size_t)RR * 1024 * 2,
                 WS_GA = WS_BC + (size_t)RR * 1024 * 2, WS_GS = WS_GA + (size_t)RR * 1024 * 2, WS_K = WS_GS + (size_t)RR * 1024 * 2, WS_V = WS_K + (size_t)RR * 256 * 2,
                 WS_SM = WS_V + (size_t)RR * 256 * 2, WS_KI = WS_SM + (size_t)RR * SMLD * 4, WS_CK = WS_KI + (size_t)RR * 64 * 2, WS_MASK = WS_CK + (size_t)NBATCH * PAST * 256 * 2;
constexpr int MASK_LDP = 68, MASK_LDS = 132;
constexpr size_t WS_MASKS = WS_MASK + (size_t)RPR * MASK_LDP * 4, WS_SSQ1 = WS_MASKS + (size_t)RSR * MASK_LDS * 4, WS_SSQ2 = WS_SSQ1 + al256((size_t)RR * 4),
                 WS_PART = WS_SSQ2 + al256((size_t)YR * 4), WS_END = WS_PART + (size_t)32 * 256 * 132 * 4;
constexpr size_t WS_MERGED = WS_Z, WS_ACT = WS_XS, WS_HB = WS_GS, WS_HAL = WS_PART;
static_assert(WS_END <= 268435456, "d_ws map exceeds 256 MiB");
static_assert((size_t)YR * DFF * 2 <= WS_GS - WS_XS, "act overlay");
static_assert((size_t)NBATCH * 33 * 3 * CONV_DIM * 2 <= WS_END - WS_PART, "halo overlay");
constexpr int CW_TMO = 0, CW_BAR = 4096, CW_Q = 16384;
constexpr int CW_DEP = CW_Q + 64 * 32;

#define GAS __attribute__((address_space(1)))
#define LAS __attribute__((address_space(3)))
typedef unsigned short bf16_t;
typedef short bf16x8 __attribute__((ext_vector_type(8)));
typedef short s16x4 __attribute__((ext_vector_type(4)));
typedef float f32x4 __attribute__((ext_vector_type(4)));
typedef float f32x2 __attribute__((ext_vector_type(2)));
typedef float f32x16 __attribute__((ext_vector_type(16)));
typedef unsigned u32x4 __attribute__((ext_vector_type(4)));
typedef unsigned u32x2 __attribute__((ext_vector_type(2)));
typedef GAS unsigned gu32;
#define RLX_AGENT __ATOMIC_RELAXED, __HIP_MEMORY_SCOPE_AGENT
#define LDS_WAIT() asm volatile("s_waitcnt lgkmcnt(0)" ::: "memory")
#define VM_WAIT() asm volatile("s_waitcnt vmcnt(0)" ::: "memory")
__device__ __forceinline__ unsigned cvt_pk_bf16(float lo, float hi) { unsigned r; asm volatile("v_cvt_pk_bf16_f32 %0, %1, %2" : "=v"(r) : "v"(lo), "v"(hi)); return r; }
__device__ __forceinline__ float bf_lo(unsigned w) { return __uint_as_float(w << 16); }
__device__ __forceinline__ float bf_hi(unsigned w) { return __uint_as_float(w & 0xffff0000u); }
__device__ __forceinline__ float bf2f(bf16_t b) { return __uint_as_float((unsigned)b << 16); }
__device__ __forceinline__ bf16_t f2bf(float f) { return (bf16_t)(cvt_pk_bf16(f, 0.f) & 0xffffu); }
__device__ __forceinline__ float sigmoidf_(float x) { return __builtin_amdgcn_rcpf(1.f + __builtin_amdgcn_exp2f(-1.4426950408889634f * x)); }
__device__ __forceinline__ float siluf_(float x) { return x * sigmoidf_(x); }
__device__ __forceinline__ float wave_sum(float v) {
#pragma unroll
    for (int o = 1; o < 64; o <<= 1) v += __shfl_xor(v, o);
    return v;
}

#define XB_TMO      128
#define XB_XCNT(j)  (256  + 64 * (j))
#define XB_XSUB(j)  (1280 + 64 * (j))
#define XB_XGEN(j)  (2304 + 64 * (j))
#define XB_TOP      3328
#define XB_TOPGEN   3392
#define XCD_BAR_WORDS 3456
#define XB_SPIN_CAP (1u << 18)
__device__ __forceinline__ unsigned xb_ld(unsigned* p)              { return __hip_atomic_load(p, __ATOMIC_RELAXED, __HIP_MEMORY_SCOPE_AGENT); }
__device__ __forceinline__ unsigned xb_add(unsigned* p, unsigned v) { return __hip_atomic_fetch_add(p, v, __ATOMIC_RELAXED, __HIP_MEMORY_SCOPE_AGENT); }
__device__ __forceinline__ unsigned xb_xcc_id() { return (unsigned)__builtin_amdgcn_s_getreg((3 << 11) | 20) & 0xFu; }
#define XB_SPIN(cond, bar) do { unsigned _sp = 0; while (cond) { __builtin_amdgcn_s_sleep(1); \
    if ((++_sp & 255u) == 0u) { if (xb_ld(&(bar)[XB_TMO])) break; if (_sp > XB_SPIN_CAP) { atomicAdd(&(bar)[XB_TMO], 1u); break; } } } } while (0)
struct XcdBarrier { unsigned* bar; unsigned x; volatile LAS unsigned* st; };
__device__ __forceinline__ XcdBarrier xcd_barrier_post(unsigned* bar, volatile LAS unsigned* st, const int tid) {
    XcdBarrier b; b.bar = bar; b.x = xb_xcc_id(); b.st = st;
    if (tid == 0) (void)xb_add(&bar[XB_XCNT(b.x)], 1u);
    return b;
}
__device__ __forceinline__ void xcd_barrier_complete(unsigned* bar, unsigned x, unsigned& nloc, unsigned& nx) {
    const unsigned G = gridDim.x * gridDim.y * gridDim.z;
    unsigned sum, cnt, mine, sp = 0u;
    for (;;) {
        sum = 0u; cnt = 0u; mine = 0u;
#pragma unroll
        for (unsigned j = 0; j < 16; ++j) { const unsigned c = xb_ld(&bar[XB_XCNT(j)]); sum += c; cnt += (c > 0u) ? 1u : 0u; mine = (j == x) ? c : mine; }
        if (sum == G) break;
        __builtin_amdgcn_s_sleep(1);
        if ((++sp & 255u) == 0u) { if (xb_ld(&bar[XB_TMO])) break; if (sp > XB_SPIN_CAP) { atomicAdd(&bar[XB_TMO], 1u); break; } }
    }
    nloc = mine > 0u ? mine : 1u; nx = cnt > 0u ? cnt : 1u;
}
__device__ __forceinline__ void xcd_barrier(const XcdBarrier& b, const int tid) {
    asm volatile("s_waitcnt vmcnt(0)" ::: "memory");
    __syncthreads();
    if (tid == 0) {
        unsigned* bar = b.bar;
        __builtin_amdgcn_s_waitcnt(0);
        unsigned nloc = b.st[0], nx = b.st[1];
        if (nloc == 0u) { xcd_barrier_complete(bar, b.x, nloc, nx); b.st[0] = nloc; b.st[1] = nx; }
        const unsigned old = xb_add(&bar[XB_XSUB(b.x)], 1u);
        const unsigned gen = old / nloc;
        if (old + 1u == (gen + 1u) * nloc) {
            __builtin_amdgcn_fence(__ATOMIC_RELEASE, "agent");
            asm volatile("s_waitcnt vmcnt(0)" ::: "memory");
            const unsigned og = xb_add(&bar[XB_TOP], 1u);
            const unsigned tg = og / nx;
            if (og + 1u == (tg + 1u) * nx) xb_add(&bar[XB_TOPGEN], 1u);
            else XB_SPIN(xb_ld(&bar[XB_TOPGEN]) == tg, bar);
            __builtin_amdgcn_fence(__ATOMIC_ACQUIRE, "agent");
            xb_add(&bar[XB_XGEN(b.x)], 1u);
            asm volatile("s_waitcnt vmcnt(0)" ::: "memory");
        } else {
            XB_SPIN(xb_ld(&bar[XB_XGEN(b.x)]) == gen, bar);
            __builtin_amdgcn_fence(__ATOMIC_ACQUIRE, "agent");
            asm volatile("s_waitcnt vmcnt(0)" ::: "memory");
        }
    }
    __syncthreads();
}

namespace pg8 {
constexpr int BM = 256, BK = 64, HALF = 128, HTB = HALF * BK * 2, STAGE_BYTES = 8 * HTB, NXCD = 8, WGM = 8;
__host__ __device__ __forceinline__ int lds_byte(int r, int c) { const int st = (r >> 4) * 2 + (c >> 5), rr = r & 15, cc = c & 31, ob = rr * 64 + cc * 2; return st * 1024 + (ob ^ (((ob >> 9) & 1) << 5)); }
__host__ __device__ __forceinline__ void stage_rc(int b, int& R, int& C) { const int st = b / 1024, sb = b % 1024, swz = sb ^ (((sb >> 9) & 1) << 5); R = (st >> 1) * 16 + swz / 64; C = (st & 1) * 32 + (swz % 64) / 2; }
__host__ __device__ __forceinline__ int perm32(int rho) { const int n = rho >> 4, i = rho & 15; return 8 * (i >> 2) + 4 * n + (i & 3); }
struct Unit { int pm, pn, part; const char* A; const char* B; };
__device__ __forceinline__ void tile_of(int L, int nM, int nN, int& pm, int& pn) {
    const int nwg = nM * nN; int wgid = L; { const int q = nwg / NXCD, r = nwg % NXCD, xcd = wgid % NXCD, off = wgid / NXCD; wgid = (xcd < r ? xcd * (q + 1) : r * (q + 1) + (xcd - r) * q) + off; }
    const int nig = WGM * nN, gid = wgid / nig, fm = gid * WGM, gsz = (nM - fm) < WGM ? (nM - fm) : WGM;
    pm = fm + ((wgid % nig) % gsz); pn = (wgid % nig) / gsz;
}
typedef f32x4 Acc[2][2][4][2];
template <class Epi, class Sched>
__device__ __forceinline__ void gemm_phase(LAS unsigned char* lds, const int K, const Sched& S, const Epi& E, const int wave_id) {
    int tid_; asm volatile("v_mbcnt_lo_u32_b32 %0, -1, 0\n\tv_mbcnt_hi_u32_b32 %0, -1, %0" : "=v"(tid_)); tid_ += 64 * wave_id;
    const int tid = tid_, wid = __builtin_amdgcn_readfirstlane(tid >> 6), lane = tid & 63, wr = wid >> 2, wc = wid & 3, fr = lane & 15, fq = lane >> 4;
    const int nt = K / BK;
    unsigned voffA[2], voffB[2];
#pragma unroll
    for (int i = 0; i < 2; ++i) { int R, C; stage_rc(tid * 16 + i * 8192, R, C); const int Rb = Epi::PERM ? ((R & ~31) + perm32(R & 31)) : R;
        voffA[i] = (unsigned)(R * K + C) * 2u; voffB[i] = (unsigned)(Rb * K + C) * 2u; }
    const size_t kstep = (size_t)(BK * 2);
    const size_t hstep = (size_t)HALF * K * 2;
    const unsigned ldsw = (unsigned)wid * 1024u;
    const int aoff = lds_byte(wr * 64 + fr, fq * 8), boff = lds_byte(wc * 32 + fr, fq * 8);
#define PG8_SA(b, h) (((b) * 2 + (h)) * HTB)
#define PG8_SB(b, h) ((4 + (b) * 2 + (h)) * HTB)
#define PG8_STAGE(bufoff, gbase, voff) do { _Pragma("unroll") for (int _i = 0; _i < 2; ++_i) \
        __builtin_amdgcn_global_load_lds((const unsigned*)((const char*)(gbase) + (voff)[_i]), (LAS unsigned*)(lds + (bufoff) + ldsw + _i * 8192), 16, 0, 0); } while (0)
#define PG8_LDA(dst, b, h) do { _Pragma("unroll") for (int m = 0; m < 4; ++m) _Pragma("unroll") for (int k = 0; k < 2; ++k) dst[m][k] = *(const LAS bf16x8*)(lds + PG8_SA(b, h) + aoff + m * 2048 + k * 1024); } while (0)
#define PG8_LDB(dst, b, h) do { _Pragma("unroll") for (int n = 0; n < 2; ++n) _Pragma("unroll") for (int k = 0; k < 2; ++k) dst[n][k] = *(const LAS bf16x8*)(lds + PG8_SB(b, h) + boff + n * 2048 + k * 1024); } while (0)
#define PG8_MMA(ai, bj, At, Bt) do { __builtin_amdgcn_s_setprio(1); _Pragma("unroll") for (int m = 0; m < 4; ++m) _Pragma("unroll") for (int n = 0; n < 2; ++n) _Pragma("unroll") for (int k = 0; k < 2; ++k) \
        acc[ai][bj][m][n] = __builtin_amdgcn_mfma_f32_16x16x32_bf16(Bt[n][k], At[m][k], acc[ai][bj][m][n], 0, 0, 0); __builtin_amdgcn_s_setprio(0); } while (0)
#define PG8_WAIT_V(n) asm volatile("s_waitcnt vmcnt(" #n ")" ::: "memory")
#define PG8_WAIT_L(n) asm volatile("s_waitcnt lgkmcnt(" #n ")" ::: "memory")
#define PG8_BAR __builtin_amdgcn_s_barrier()
#define PG8_SCHED __builtin_amdgcn_sched_barrier(0)
    Unit cur, nxt; int ui = 0;
    if (!S.next(0, cur)) return;
    Acc acc;
#pragma unroll
    for (int a = 0; a < 2; ++a)
#pragma unroll
        for (int b = 0; b < 2; ++b)
#pragma unroll
            for (int m = 0; m < 4; ++m)
#pragma unroll
                for (int n = 0; n < 2; ++n) acc[a][b][m][n] = (f32x4){0.f, 0.f, 0.f, 0.f};
    bf16x8 At[4][2], B0[2][2], B1[2][2];
    const char* cA = cur.A; const char* cB = cur.B;
    PG8_STAGE(PG8_SB(0, 0), cB, voffB); PG8_STAGE(PG8_SB(0, 1), cB + hstep, voffB); PG8_STAGE(PG8_SA(0, 0), cA, voffA); PG8_STAGE(PG8_SA(0, 1), cA + hstep, voffA);
    if (wr == 1) PG8_BAR;
    PG8_WAIT_V(2); PG8_BAR;
    PG8_STAGE(PG8_SB(1, 0), cB + kstep, voffB); PG8_STAGE(PG8_SA(1, 0), cA + kstep, voffA); PG8_STAGE(PG8_SB(1, 1), cB + hstep + kstep, voffB);
    PG8_WAIT_V(6); PG8_BAR;
    for (;;) {
        const bool has_next = S.next(ui + 1, nxt);
        const char* nA = has_next ? nxt.A : cA; const char* nB = has_next ? nxt.B : cB;
        for (int t = 0; t < nt; t += 2) {
            const bool last = (t == nt - 2);
            const char* a1 = cA + (size_t)(t + 1) * kstep;
            const char* a2 = last ? nA : cA + (size_t)(t + 2) * kstep; const char* b2 = last ? nB : cB + (size_t)(t + 2) * kstep;
            const char* a3 = a2 + kstep; const char* b3 = b2 + kstep;
            PG8_LDB(B0, 0, 0); PG8_LDB(B1, 0, 1); PG8_SCHED; PG8_LDA(At, 0, 0); PG8_STAGE(PG8_SA(1, 1), a1 + hstep, voffA);
            PG8_WAIT_V(8); PG8_WAIT_L(0); PG8_BAR; PG8_MMA(0, 0, At, B0); PG8_MMA(0, 1, At, B1); PG8_BAR; PG8_SCHED;
            PG8_LDA(At, 0, 1); PG8_STAGE(PG8_SB(0, 0), b2, voffB); PG8_STAGE(PG8_SB(0, 1), b2 + hstep, voffB); PG8_STAGE(PG8_SA(0, 0), a2, voffA);
            PG8_WAIT_V(8); PG8_WAIT_L(0); PG8_BAR; PG8_MMA(1, 0, At, B0); PG8_MMA(1, 1, At, B1); PG8_BAR; PG8_SCHED;
            PG8_LDB(B0, 1, 0); PG8_LDB(B1, 1, 1); PG8_SCHED; PG8_LDA(At, 1, 0); PG8_STAGE(PG8_SA(0, 1), a2 + hstep, voffA);
            PG8_WAIT_V(8); PG8_WAIT_L(0); PG8_BAR; PG8_MMA(0, 0, At, B0); PG8_MMA(0, 1, At, B1); PG8_BAR; PG8_SCHED;
            PG8_LDA(At, 1, 1); PG8_STAGE(PG8_SB(1, 0), b3, voffB); PG8_STAGE(PG8_SB(1, 1), b3 + hstep, voffB); PG8_STAGE(PG8_SA(1, 0), a3, voffA);
            PG8_WAIT_V(8); PG8_WAIT_L(0); PG8_BAR; PG8_MMA(1, 0, At, B0); PG8_MMA(1, 1, At, B1); PG8_BAR; PG8_SCHED;
        }
        if (wr == 0) PG8_BAR;
        const bool keep = E(acc, cur, wr, wc, fr, fq);
        if (!has_next) break;
        if (!keep) {
#pragma unroll
            for (int a = 0; a < 2; ++a)
#pragma unroll
                for (int b = 0; b < 2; ++b)
#pragma unroll
                    for (int m = 0; m < 4; ++m)
#pragma unroll
                        for (int n = 0; n < 2; ++n) acc[a][b][m][n] = (f32x4){0.f, 0.f, 0.f, 0.f};
        }
        cur = nxt; cA = nA; cB = nB; ++ui;
        if (wr == 1) PG8_BAR;
    }
    PG8_WAIT_V(0);
    PG8_BAR;
#undef PG8_SA
#undef PG8_SB
#undef PG8_STAGE
#undef PG8_LDA
#undef PG8_LDB
#undef PG8_MMA
#undef PG8_WAIT_V
#undef PG8_WAIT_L
#undef PG8_BAR
#undef PG8_SCHED
}
}

struct Args { const float* in[27]; float* out; unsigned char* ws; int ph_lo, ph_hi, li, pad; };
constexpr int NWAVES = 8, NTHR = 512;
constexpr int RING_BYTES = 131072, LDS_BYTES = 147456, MISC_OFF = LDS_BYTES - 256;

struct Frame {
    LAS unsigned char* lds; volatile LAS unsigned* MISC; gu32* ctl;
    int tid, lane, wave, vcu, G;
    const float* const* in; float* out; unsigned char* ws; unsigned char* ob;
};

__device__ __forceinline__ void refresh_ids(Frame& F) { int l; asm volatile("v_mbcnt_lo_u32_b32 %0, -1, 0\n\tv_mbcnt_hi_u32_b32 %0, -1, %0" : "=v"(l)); F.lane = l; F.tid = F.wave * 64 + l; }

__device__ __forceinline__ void unit_publish(Frame& F, int ctr_word) {
    asm volatile("s_waitcnt vmcnt(0)" ::: "memory"); __syncthreads();
    if (F.tid == 0) { __builtin_amdgcn_fence(__ATOMIC_RELEASE, "agent"); asm volatile("s_waitcnt vmcnt(0)" ::: "memory");
        const unsigned o_ = __hip_atomic_fetch_add((unsigned*)(F.ctl + ctr_word), 1u, __ATOMIC_RELAXED, __HIP_MEMORY_SCOPE_AGENT); asm volatile("" :: "v"(o_)); }
    __syncthreads();
}
__device__ __forceinline__ void unit_wait(Frame& F, int ctr_word, unsigned need) {
    if (F.tid == 0) { unsigned sp = 0u; while (__hip_atomic_load((unsigned*)(F.ctl + ctr_word), __ATOMIC_RELAXED, __HIP_MEMORY_SCOPE_AGENT) < need) { __builtin_amdgcn_s_sleep(16); if (++sp > (1u << 18)) break; }
        __builtin_amdgcn_fence(__ATOMIC_ACQUIRE, "agent"); asm volatile("s_waitcnt vmcnt(0)" ::: "memory"); }
    __syncthreads();
}

typedef __attribute__((address_space(8))) void* rsrc_t;
__device__ __forceinline__ void wt_store16(void* p, u32x4 v) {
    asm volatile("global_store_dwordx4 %0, %1, off sc1\n\ts_nop 1" :: "v"(p), "v"(v) : "memory"); }
__device__ __forceinline__ void wt_store8(void* p, u32x2 v) { __hip_atomic_store((unsigned long long*)p, ((unsigned long long)v.y << 32) | v.x, __ATOMIC_RELAXED, __HIP_MEMORY_SCOPE_AGENT); }
__device__ __forceinline__ void unit_publish_wt(Frame& F, int ctr_word) {
    asm volatile("s_waitcnt vmcnt(0)" ::: "memory"); __syncthreads();
    if (F.tid == 0) { const unsigned o_ = __hip_atomic_fetch_add((unsigned*)(F.ctl + ctr_word), 1u, __ATOMIC_RELAXED, __HIP_MEMORY_SCOPE_AGENT); asm volatile("" :: "v"(o_)); }
    __syncthreads();
}

__device__ __forceinline__ int win_src(int n) {
    if (n < 3072) return n;
    if (n < 4096) return 3088 + (n - 3072);
    if (n < 4352) return 4112 + (n - 4096);
    if (n < 4608) return 4368 + (n - 4352);
    if (n < 5120) return 4624 + (n - 4608);
    if (n < 6144) return 5208 + (n - 5120);
    if (n < 7168) return 6232 + (n - 6144);
    if (n < 7184) return 3072 + (n - 7168);
    if (n < 7248) return 5136 + (n - 7184);
    if (n < 7256) return 5200 + (n - 7248);
    return -1;
}
template <bool VEC, class SrcFn>
__device__ __forceinline__ void p0_transpose_item(SrcFn src, int ldw, int Kdim, bf16_t* WT, LAS float* scr, int kb, int nb, int lane, const float* ksc = nullptr) {
    const int k0 = 64 * kb, n0 = 32 * nb;
    if (VEC) {
        const float* cp = src(n0 + 4 * (lane & 7)) + (size_t)(k0 + (lane >> 3)) * ldw;
#pragma unroll
        for (int i = 0; i < 8; ++i) { const f32x4 v = *(const f32x4*)(cp + (size_t)(8 * i) * ldw); LAS float* d = scr + (8 * i + (lane >> 3)) * 33 + 4 * (lane & 7); d[0] = v.x; d[1] = v.y; d[2] = v.z; d[3] = v.w; }
    } else {
        const float* cp = src(n0 + (lane & 31));
#pragma unroll 8
        for (int i = 0; i < 32; ++i) { const int kk = 2 * i + (lane >> 5); scr[kk * 33 + (lane & 31)] = cp ? cp[(size_t)(k0 + kk) * ldw] : 0.f; }
    }
    LDS_WAIT(); asm volatile("" ::: "memory");
    const int c = lane & 7;
    f32x4 k0s = {1.f, 1.f, 1.f, 1.f}, k1s = k0s;
    if (ksc) { k0s = *(const f32x4*)(ksc + k0 + 8 * c); k1s = *(const f32x4*)(ksc + k0 + 8 * c + 4); }
#pragma unroll
    for (int j = 0; j < 4; ++j) { const int n = (lane >> 3) + 8 * j; const LAS float* s = scr + (8 * c) * 33 + n;
        u32x4 o; o.x = cvt_pk_bf16(s[0 * 33] * k0s.x, s[1 * 33] * k0s.y); o.y = cvt_pk_bf16(s[2 * 33] * k0s.z, s[3 * 33] * k0s.w); o.z = cvt_pk_bf16(s[4 * 33] * k1s.x, s[5 * 33] * k1s.y); o.w = cvt_pk_bf16(s[6 * 33] * k1s.z, s[7 * 33] * k1s.w);
        *(GAS u32x4*)(WT + (size_t)(n0 + n) * Kdim + k0 + 8 * c) = o; }
    LDS_WAIT(); asm volatile("" ::: "memory");
}
__device__ __forceinline__ void cache_to_bf16(Frame& F, int wi, int nw) {
    const f32x4* ck = (const f32x4*)F.in[2]; const f32x4* cv = (const f32x4*)F.in[3]; GAS u32x4* ok = (GAS u32x4*)(F.ws + WS_CK); GAS u32x4* ov = (GAS u32x4*)(F.ob + DO_CV);
    const long n8 = (long)NBATCH * PAST * 256 / 8; const long gt = (long)wi * NTHR + F.tid, GT = (long)nw * NTHR;
    for (long i = gt; i < 2 * n8; i += 8 * GT) {
        f32x4 a[8], b[8];
#pragma unroll
        for (int u = 0; u < 8; ++u) { const long iu = i + u * GT; if (iu < 2 * n8) { const bool isk = iu < n8; const long j = isk ? iu : iu - n8; const f32x4* s = (isk ? ck : cv) + 2 * j; a[u] = s[0]; b[u] = s[1]; } }
#pragma unroll
        for (int u = 0; u < 8; ++u) { const long iu = i + u * GT; if (iu < 2 * n8) { const bool isk = iu < n8; const long j = isk ? iu : iu - n8;
            u32x4 o; o.x = cvt_pk_bf16(a[u].x, a[u].y); o.y = cvt_pk_bf16(a[u].z, a[u].w); o.z = cvt_pk_bf16(b[u].x, b[u].y); o.w = cvt_pk_bf16(b[u].z, b[u].w);
            (isk ? ok : ov)[j] = o; } }
    }
}
__device__ __forceinline__ void p0_prologue(Frame& F) {
    LAS float* scr = (LAS float*)(F.lds + F.wave * 16384);
    const int gw = F.vcu * NWAVES + F.wave, NGW = F.G * NWAVES, lane = F.lane;
    const float* w_in = F.in[10]; const float* w_bs = F.in[20]; const float* w_ba = F.in[21]; const float* w_out = F.in[22];
    const float* w_gate = F.in[24]; const float* w_up = F.in[25]; const float* w_dn = F.in[26];
    bf16_t* WIN = (bf16_t*)(F.ws + WS_WIN); bf16_t* WBS = (bf16_t*)(F.ws + WS_WBS); bf16_t* WBA = (bf16_t*)(F.ws + WS_WBA); bf16_t* WOUT = (bf16_t*)(F.ws + WS_WOUT);
    bf16_t* WGU = (bf16_t*)(F.ws + WS_WGU); bf16_t* WDN = (bf16_t*)(F.ws + WS_WDN);
    constexpr int I_IN = 16 * (NIN / 32), I_SQ = 16 * 32, I_GU = 16 * (NGU / 32), I_DN = (DFF / 64) * 32;
    constexpr int NITEMS = I_IN + 3 * I_SQ + I_GU + I_DN;
    for (int it = gw; it < NITEMS; it += NGW) {
        int r = it;
        if (r < I_IN) { const int nb = r % (NIN / 32), kb = r / (NIN / 32);
            if (nb < 224) p0_transpose_item<true>([&](int n) -> const float* { return w_in + win_src(n); }, 7256, 1024, WIN, scr, kb, nb, lane);
            else p0_transpose_item<false>([&](int n) -> const float* { const int s = win_src(n); return s >= 0 ? w_in + s : nullptr; }, 7256, 1024, WIN, scr, kb, nb, lane); continue; } r -= I_IN;
        if (r < I_SQ) { p0_transpose_item<true>([&](int n) -> const float* { return w_bs + n; }, 1024, 1024, WBS, scr, r / 32, r % 32, lane); continue; } r -= I_SQ;
        if (r < I_SQ) { p0_transpose_item<true>([&](int n) -> const float* { return w_ba + n; }, 1024, 1024, WBA, scr, r / 32, r % 32, lane); continue; } r -= I_SQ;
        if (r < I_SQ) { p0_transpose_item<true>([&](int n) -> const float* { return w_out + n; }, 1024, 1024, WOUT, scr, r / 32, r % 32, lane); continue; } r -= I_SQ;
        if (r < I_GU) { const int nb = r % (NGU / 32), kb = r / (NGU / 32);
            p0_transpose_item<true>([&](int n) -> const float* { const int t = n >> 8, j = n & 255, ch = t * 128 + (j >> 3) * 4 + (j & 3); return ((j & 4) ? w_up : w_gate) + ch; }, DFF, 1024, WGU, scr, kb, nb, lane, F.in[23]); continue; } r -= I_GU;
        p0_transpose_item<true>([&](int n) -> const float* { return w_dn + n; }, 1024, DFF, WDN, scr, r / 32, r % 32, lane);
    }
    const float* xp = F.in[0]; const float* xs = F.in[1]; const float* meta = F.in[7]; const float* n1w = F.in[9];
    bf16_t* HN = (bf16_t*)(F.ob + DO_HN);
    f32x4 wv[4];
#pragma unroll
    for (int j = 0; j < 4; ++j) wv[j] = *((const f32x4*)n1w + lane + 64 * j);
    for (int m = gw; m < RPAD; m += NGW) {
        GAS u32x2* o8 = (GAS u32x2*)(HN + (size_t)m * DM) + lane;
        if (m >= RR) {
#pragma unroll
            for (int j = 0; j < 4; ++j) o8[64 * j] = (u32x2){0u, 0u};
            continue; }
        const float* xrow;
        if (m < RPR) { const int b = m / TP, t = m - b * TP; xrow = t < NMETA ? meta + (size_t)t * DM : xp + ((size_t)b * SEQ + (t - NMETA)) * DM; }
        else xrow = xs + (size_t)(m - RPR) * DM;
        const f32x4* xr = (const f32x4*)xrow + lane;
        f32x4 v[4]; float s = 0.f;
#pragma unroll
        for (int j = 0; j < 4; ++j) { v[j] = xr[64 * j]; s += (v[j].x * v[j].x + v[j].y * v[j].y) + (v[j].z * v[j].z + v[j].w * v[j].w); }
        const float rs = __builtin_amdgcn_rsqf(wave_sum(s) * (1.f / DM) + EPS);
#pragma unroll
        for (int j = 0; j < 4; ++j) { const f32x4 y = v[j] * rs * wv[j]; o8[64 * j] = (u32x2){cvt_pk_bf16(y.x, y.y), cvt_pk_bf16(y.z, y.w)}; }
    }
    { float* s1 = (float*)(F.ws + WS_SSQ1); const int gt = F.vcu * NTHR + F.tid, GT = F.G * NTHR;
      for (int i = gt; i < (int)((WS_PART - WS_SSQ1) / 4); i += GT) s1[i] = 0.f; }
}

struct SchedP1 {
    const char* A; const char* B; int G, c;
    __device__ __forceinline__ bool next(int i, pg8::Unit& u) const {
        const int L = i * G + c; if (L >= 67 * 29) return false;
        pg8::tile_of(L, 67, 29, u.pm, u.pn); u.part = 0; u.A = A + (size_t)u.pm * 256 * 1024 * 2; u.B = B + (size_t)u.pn * 256 * 1024 * 2; return true; }
};
struct EpiP1 {
    static constexpr bool PERM = true;
    unsigned char* ws; unsigned char* ob;
    __device__ __forceinline__ bool operator()(pg8::Acc& acc, const pg8::Unit& u, int wr, int wc, int fr, int fq) const {
        const int pn = u.pn; const int row0 = u.pm * 256 + wr * 64 + fr, cw = wc * 32 + 8 * fq;
        if (pn == 28) {
            float* SM = (float*)(ws + WS_SM);
            if (cw < SMLD) {
#pragma unroll
                for (int ai = 0; ai < 2; ++ai)
#pragma unroll
                    for (int m = 0; m < 4; ++m) { const int r = row0 + ai * 128 + m * 16; if (r < RR) { float* p = SM + (size_t)r * SMLD + cw; *(f32x4*)p = acc[ai][0][m][0]; *(f32x4*)(p + 4) = acc[ai][0][m][1]; } }
            }
            return false;
        }
        bf16_t* base; int ld, c0;
        if (pn < 4) { base = (bf16_t*)(ws + WS_Z); ld = 1024; c0 = pn * 256; }
        else if (pn < 8) { base = (bf16_t*)(ws + WS_XS); ld = 1024; c0 = (pn - 4) * 256; }
        else if (pn < 12) { base = (bf16_t*)(ws + WS_BC); ld = 1024; c0 = (pn - 8) * 256; }
        else if (pn < 16) { base = (bf16_t*)(ob + DO_Q); ld = 1024; c0 = (pn - 12) * 256; }
        else if (pn == 16) { base = (bf16_t*)(ws + WS_K); ld = 256; c0 = 0; }
        else if (pn == 17) { base = (bf16_t*)(ws + WS_V); ld = 256; c0 = 0; }
        else if (pn < 20) { base = (bf16_t*)(ob + DO_QI); ld = 512; c0 = (pn - 18) * 256; }
        else if (pn < 24) { base = (bf16_t*)(ws + WS_GS); ld = 1024; c0 = (pn - 20) * 256; }
        else { base = (bf16_t*)(ws + WS_GA); ld = 1024; c0 = (pn - 24) * 256; }
#pragma unroll
        for (int ai = 0; ai < 2; ++ai)
#pragma unroll
            for (int m = 0; m < 4; ++m) { const int r = row0 + ai * 128 + m * 16;
                if (r < RR) { bf16_t* rowp = base + (size_t)r * ld + c0 + cw;
#pragma unroll
                    for (int bj = 0; bj < 2; ++bj) { const f32x4 v0 = acc[ai][bj][m][0], v1 = acc[ai][bj][m][1];
                        u32x4 w; w.x = cvt_pk_bf16(v0[0], v0[1]); w.y = cvt_pk_bf16(v0[2], v0[3]); w.z = cvt_pk_bf16(v1[0], v1[1]); w.w = cvt_pk_bf16(v1[2], v1[3]);
                        *(u32x4*)(rowp + bj * 128) = w; } } }
        return false;
    }
};

__device__ __forceinline__ void p2_rows(Frame& F) {
    const int gw = F.vcu * NWAVES + F.wave, NGW = F.G * NWAVES, lane = F.lane;
    bf16_t* K = (bf16_t*)(F.ws + WS_K); const bf16_t* V = (const bf16_t*)(F.ws + WS_V);
    float* SM = (float*)(F.ws + WS_SM); bf16_t* KI = (bf16_t*)(F.ws + WS_KI);
    const float* knw = F.in[18]; const float* ikw = F.in[19]; const float* dtb = F.in[13];
    const f32x4 kw = *(const f32x4*)(knw + (lane & 31) * 4);
    const float iw = ikw[lane]; const float dbias = lane < 16 ? dtb[lane] : 0.f;
    const int item = gw; u32x4 ixs[2] = {{0u, 0u, 0u, 0u}, {0u, 0u, 0u, 0u}}, ibc[2] = {{0u, 0u, 0u, 0u}, {0u, 0u, 0u, 0u}};
    if (item < 48 + 768) { int r;
        if (item < 48) { const int s = item / 3, i = item % 3; r = s < 8 ? s * TP + (TP - 3 + i) : RPR + (s - 8) * DSEQ + (DSEQ - 3 + i); }
        else { const int h = item - 48, b = h / 96, jb = (h % 96) / 3, i = h % 3; r = b * TP + 64 * (jb + 1) - 3 + i; }
#pragma unroll
        for (int j = 0; j < 2; ++j) { const int c = j * 512 + lane * 8; ixs[j] = *(const u32x4*)((const bf16_t*)(F.ws + WS_XS) + (size_t)r * 1024 + c); ibc[j] = *(const u32x4*)((const bf16_t*)(F.ws + WS_BC) + (size_t)r * 1024 + c); } }
    u32x2 nk, nv; float nki, ndt, nwi;
#define P2_LOAD(rr) do { nk = *((const u32x2*)(K + (size_t)(rr) * 256) + lane); nv = *((const u32x2*)(V + (size_t)(rr) * 256) + lane); \
        const float* sm_ = SM + (size_t)(rr) * SMLD; nki = sm_[16 + lane]; ndt = sm_[lane & 15]; nwi = sm_[80 + (lane & 7)]; } while (0)
    if (gw < RR) P2_LOAD(gw);
    for (int r = gw; r < RR; r += NGW) {
        const u32x2 kin = nk, vv = nv; const float kv = nki, dtv = ndt, wiv = nwi;
        if (r + NGW < RR) P2_LOAD(r + NGW);
        const bool pr = r < RPR; const size_t orow = pr ? (size_t)r : (size_t)(r - RPR);
        float* k_out = F.out + (pr ? O_KP : O_KS) + orow * 256; float* v_out = F.out + (pr ? O_VP : O_VS) + orow * 256; float* ki_out = F.out + (pr ? O_KIP : O_KIS) + orow * 64;
        { u32x2* kp = (u32x2*)(K + (size_t)r * 256) + lane;
          f32x4 x = {bf_lo(kin.x), bf_hi(kin.x), bf_lo(kin.y), bf_hi(kin.y)};
          float s = (x.x * x.x + x.y * x.y) + (x.z * x.z + x.w * x.w);
          s += __shfl_xor(s, 1); s += __shfl_xor(s, 2); s += __shfl_xor(s, 4); s += __shfl_xor(s, 8); s += __shfl_xor(s, 16);
          const float rs = __builtin_amdgcn_rsqf(s * (1.f / HD) + EPS);
          x = x * rs * kw;
          *kp = (u32x2){cvt_pk_bf16(x.x, x.y), cvt_pk_bf16(x.z, x.w)};
          *((f32x4*)k_out + lane) = x;
          *((f32x4*)v_out + lane) = (f32x4){bf_lo(vv.x), bf_hi(vv.x), bf_lo(vv.y), bf_hi(vv.y)}; }
        { float* sm = SM + (size_t)r * SMLD;
          const float ss = wave_sum(kv * kv);
          const float kn = kv * __builtin_amdgcn_rsqf(ss * (1.f / IDXD) + EPS) * iw;
          KI[(size_t)r * 64 + lane] = f2bf(kn); ki_out[lane] = kn;
          if (lane < 16) { const float x = dtv + dbias; sm[lane] = x > 20.f ? x : log1pf(expf(x)); }
          if (lane < 8) sm[80 + lane] = wiv * 0.04419417382415922f; }
    }
#undef P2_LOAD
    if (item < 48) { const int s = item / 3, i = item % 3; float* o = F.out + (s < 8 ? O_CVP + (size_t)(s * 3 + i) * CONV_DIM : O_CVS + (size_t)((s - 8) * 3 + i) * CONV_DIM);
#pragma unroll
        for (int j = 0; j < 2; ++j) { const int c = j * 512 + lane * 8; const u32x4 xa = ixs[j], xb = ibc[j];
            *(f32x4*)(o + c) = (f32x4){bf_lo(xa.x), bf_hi(xa.x), bf_lo(xa.y), bf_hi(xa.y)}; *(f32x4*)(o + c + 4) = (f32x4){bf_lo(xa.z), bf_hi(xa.z), bf_lo(xa.w), bf_hi(xa.w)};
            *(f32x4*)(o + 1024 + c) = (f32x4){bf_lo(xb.x), bf_hi(xb.x), bf_lo(xb.y), bf_hi(xb.y)}; *(f32x4*)(o + 1024 + c + 4) = (f32x4){bf_lo(xb.z), bf_hi(xb.z), bf_lo(xb.w), bf_hi(xb.w)}; } }
    else if (item < 48 + 768) { const int h = item - 48, b = h / 96, jb = (h % 96) / 3, i = h % 3; bf16_t* o = (bf16_t*)(F.ws + WS_HAL) + (size_t)((b * 33 + jb + 1) * 3 + i) * CONV_DIM;
#pragma unroll
        for (int j = 0; j < 2; ++j) { const int c = j * 512 + lane * 8; *(u32x4*)(o + c) = ixs[j]; *(u32x4*)(o + 1024 + c) = ibc[j]; } }
}

__device__ __forceinline__ int t5_bucket(int rel) {
    const int n = rel < 0 ? -rel : rel; const int ret = rel > 0 ? 16 : 0;
    const int v = n < 8 ? n : (n < 12 ? 8 : n < 16 ? 9 : n < 23 ? 10 : n < 32 ? 11 : n < 46 ? 12 : n < 64 ? 13 : n < 91 ? 14 : 15);
    return ret + v;
}
__device__ __forceinline__ void conv_unit(Frame& F, int u) {
    bf16_t* XS = (bf16_t*)(F.ws + WS_XS); bf16_t* BC = (bf16_t*)(F.ws + WS_BC); const bf16_t* HAL = (const bf16_t*)(F.ws + WS_HAL);
    const float* conv_w = F.in[11]; const float* conv_b = F.in[12]; const float* st_conv = F.in[6];
    const int cg = F.tid & 63, rc = F.wave;
    const int cq = u & 1, sb = u >> 1; const bool pr = sb < NBATCH * 33;
    const int b = pr ? sb / 33 : sb - NBATCH * 33, j = pr ? sb % 33 : 0;
    const int T = pr ? TP : DSEQ, row0 = (pr ? b * TP : RPR + b * DSEQ) + 64 * j, nvalid = T - 64 * j;
    const int t0 = 8 * rc;
    u32x4 raw[2][11];
#pragma unroll
    for (int h = 0; h < 2; ++h) { const int ch = 1024 * cq + 512 * h + 8 * cg; const bf16_t* colp = ch < 1024 ? XS + ch : BC + (ch - 1024);
#pragma unroll
        for (int i = 0; i < 11; ++i) { const int t = t0 - 3 + i;
            u32x4 v = {0u, 0u, 0u, 0u};
            if (t >= 0) { if (t < nvalid) v = __builtin_nontemporal_load((const u32x4*)(colp + (size_t)(row0 + t) * 1024)); }
            else if (j > 0) v = *(const u32x4*)(HAL + (size_t)((b * 33 + j) * 3 + (t + 3)) * CONV_DIM + ch);
            raw[h][i] = v; } }
    __syncthreads();
#pragma unroll
    for (int h = 0; h < 2; ++h) { const int ch = 1024 * cq + 512 * h + 8 * cg; bf16_t* colp = ch < 1024 ? XS + ch : BC + (ch - 1024);
        float w[4][8], bias[8];
#pragma unroll
        for (int i = 0; i < 4; ++i) { const f32x4 a = *(const f32x4*)(conv_w + i * CONV_DIM + ch), c = *(const f32x4*)(conv_w + i * CONV_DIM + ch + 4);
            w[i][0] = a.x; w[i][1] = a.y; w[i][2] = a.z; w[i][3] = a.w; w[i][4] = c.x; w[i][5] = c.y; w[i][6] = c.z; w[i][7] = c.w; }
        { const f32x4 a = *(const f32x4*)(conv_b + ch), c = *(const f32x4*)(conv_b + ch + 4); bias[0] = a.x; bias[1] = a.y; bias[2] = a.z; bias[3] = a.w; bias[4] = c.x; bias[5] = c.y; bias[6] = c.z; bias[7] = c.w; }
        float x[4][8];
#define CONV_ROW(dst, i) do { const int t_ = t0 - 3 + (i); \
            if (!pr && t_ < 0) { const float* sp = st_conv + (size_t)(b * 3 + (t_ + 3)) * CONV_DIM + ch; const f32x4 a_ = *(const f32x4*)sp, c_ = *(const f32x4*)(sp + 4); \
                dst[0] = a_.x; dst[1] = a_.y; dst[2] = a_.z; dst[3] = a_.w; dst[4] = c_.x; dst[5] = c_.y; dst[6] = c_.z; dst[7] = c_.w; } \
            else { const u32x4 v_ = raw[h][i]; dst[0] = bf_lo(v_.x); dst[1] = bf_hi(v_.x); dst[2] = bf_lo(v_.y); dst[3] = bf_hi(v_.y); dst[4] = bf_lo(v_.z); dst[5] = bf_hi(v_.z); dst[6] = bf_lo(v_.w); dst[7] = bf_hi(v_.w); } } while (0)
        CONV_ROW(x[0], 0); CONV_ROW(x[1], 1); CONV_ROW(x[2], 2);
#pragma unroll
        for (int r = 0; r < 8; ++r) { const int t = t0 + r;
            CONV_ROW(x[(r + 3) & 3], r + 3);
            if (t < nvalid) { float o[8];
#pragma unroll
                for (int e = 0; e < 8; ++e) o[e] = siluf_(bias[e] + x[r & 3][e] * w[0][e] + x[(r + 1) & 3][e] * w[1][e] + x[(r + 2) & 3][e] * w[2][e] + x[(r + 3) & 3][e] * w[3][e]);
                u32x4 ov; ov.x = cvt_pk_bf16(o[0], o[1]); ov.y = cvt_pk_bf16(o[2], o[3]); ov.z = cvt_pk_bf16(o[4], o[5]); ov.w = cvt_pk_bf16(o[6], o[7]);
                __builtin_nontemporal_store(ov, (u32x4*)(colp + (size_t)(row0 + t) * 1024)); } }
#undef CONV_ROW
    }
    __syncthreads();
}

namespace ssd {
constexpr int CL = 0, BL = 17408, XR = 34816, XW = 44032, WM = 53248, SB = 62464, FA = 79872, LDS_TOT = 80640;
constexpr int LDC = 272, LDX = 144, LDW = 144;
typedef short v4i16 __attribute__((ext_vector_type(4)));
__device__ __forceinline__ s16x4 trd(LAS unsigned char* p) { return __builtin_bit_cast(s16x4, __builtin_amdgcn_ds_read_tr16_b64_v4i16((LAS v4i16*)p)); }
__device__ __forceinline__ bf16x8 frag_tr(LAS unsigned char* img, int stride, int m0, int kb0, int i, int g4) {
    LAS unsigned char* p = img + (kb0 + 8 * g4 + (i >> 2)) * stride + (m0 + 4 * (i & 3)) * 2;
    const s16x4 lo = trd(p), hi = trd(p + 4 * stride);
    return (bf16x8){lo[0], lo[1], lo[2], lo[3], hi[0], hi[1], hi[2], hi[3]};
}
__device__ __forceinline__ bf16x8 frag_row(LAS unsigned char* img, int stride, int r0, int kb0, int i, int g4) {
    return *(const LAS bf16x8*)(img + (r0 + i) * stride + (kb0 + 8 * g4) * 2);
}
}
__device__ __forceinline__ void ssd_chain_unit(Frame& F, int unit) {
    using namespace ssd;
    int tid_ = F.tid; asm volatile("" : "+v"(tid_));
    const int tid = tid_, lane = tid & 63, w = F.wave, i16 = lane & 15, g4 = lane >> 4;
    LAS unsigned char* L = F.lds;
    const bool pr = unit < 128; const int uu = unit & 127, b = uu >> 4, h = uu & 15, g = h >> 2;
    const int T = pr ? TP : DSEQ, row0 = pr ? b * TP : RPR + b * DSEQ, nblk = (T + 63) >> 6;
    bf16_t* XS = (bf16_t*)(F.ws + WS_XS); const bf16_t* BC = (const bf16_t*)(F.ws + WS_BC); const bf16_t* Z = (const bf16_t*)(F.ws + WS_Z);
    const float* SM = (const float*)(F.ws + WS_SM); float* SSQ1 = (float*)(F.ws + WS_SSQ1);
    const int xcol = h * 64;
    const float a_h = -expf(F.in[14][h]), dsk = F.in[15][h];
    const int cb_sb = w >> 1, cb_tb0 = 2 * (w & 1), y_pb0 = 2 * (w & 1), y_tb = w >> 1;
    const int yp0 = 16 * y_pb0 + 4 * g4;
    f32x4 nwv[2];
#pragma unroll
    for (int q = 0; q < 2; ++q) nwv[q] = *(const f32x4*)(F.in[16] + xcol + yp0 + 16 * q);
    f32x4 st[4];
    float* sout = F.out + (pr ? O_SSMP : O_SSMS) + ((size_t)(b * 16 + h) * 64) * 128;
    if (pr) {
#pragma unroll
        for (int pb = 0; pb < 4; ++pb) st[pb] = (f32x4){0.f, 0.f, 0.f, 0.f}; }
    else { const float* sp = F.in[5] + ((size_t)(b * 16 + h) * 64) * 128;
#pragma unroll
        for (int pb = 0; pb < 4; ++pb) st[pb] = *(const f32x4*)(sp + (size_t)(16 * pb + i16) * 128 + 16 * w + 4 * g4); }
    const int srow = tid >> 3, sch = tid & 7;
    u32x4 pB[2], pC[2], pX; u32x2 pZ[2]; float pdt;
#define SSD_PREFETCH(jb) do { const int base_ = 64 * (jb); \
        { const bool ok_ = base_ + srow < T; const bf16_t* rp_ = BC + (size_t)(row0 + base_ + srow) * 1024 + g * 128 + 8 * sch; \
          pB[0] = ok_ ? *(const u32x4*)rp_ : (u32x4){0u, 0u, 0u, 0u}; pB[1] = ok_ ? *(const u32x4*)(rp_ + 64) : (u32x4){0u, 0u, 0u, 0u}; \
          pC[0] = ok_ ? *(const u32x4*)(rp_ + 512) : (u32x4){0u, 0u, 0u, 0u}; pC[1] = ok_ ? *(const u32x4*)(rp_ + 576) : (u32x4){0u, 0u, 0u, 0u}; \
          pX = ok_ ? *(const u32x4*)(XS + (size_t)(row0 + base_ + srow) * 1024 + xcol + 8 * sch) : (u32x4){0u, 0u, 0u, 0u}; } \
        { const int t_ = base_ + 16 * y_tb + i16; const bf16_t* zp_ = Z + (size_t)(row0 + t_) * 1024 + xcol + yp0; \
          pZ[0] = t_ < T ? *(const u32x2*)zp_ : (u32x2){0u, 0u}; pZ[1] = t_ < T ? *(const u32x2*)(zp_ + 16) : (u32x2){0u, 0u}; } \
        { const int t_ = base_ + lane; pdt = t_ < T ? SM[(size_t)(row0 + t_) * SMLD + h] : 0.f; } } while (0)
    SSD_PREFETCH(0);
#pragma unroll 1
    for (int jb = 0; jb < nblk; ++jb) {
        float ac = pdt * a_h;
#pragma unroll
        for (int o = 1; o < 64; o <<= 1) { const float v = __shfl_up(ac, o); if (lane >= o) ac += v; }
        const float tot = __shfl(ac, 63);
        const float wsc = __builtin_amdgcn_exp2f((tot - ac) * 1.4426950408889634f) * pdt;
        if (w == 0) { LAS float* fa = (LAS float*)(L + FA); fa[lane] = ac; fa[64 + lane] = pdt; }
        *(LAS u32x4*)(L + BL + srow * LDC + 16 * sch) = pB[0]; *(LAS u32x4*)(L + BL + srow * LDC + 128 + 16 * sch) = pB[1];
        *(LAS u32x4*)(L + CL + srow * LDC + 16 * sch) = pC[0]; *(LAS u32x4*)(L + CL + srow * LDC + 128 + 16 * sch) = pC[1];
        { *(LAS u32x4*)(L + XR + srow * LDX + 16 * sch) = pX;
            const float ws_ = __shfl(wsc, srow);
            u32x4 xw; xw.x = cvt_pk_bf16(bf_lo(pX.x) * ws_, bf_hi(pX.x) * ws_); xw.y = cvt_pk_bf16(bf_lo(pX.y) * ws_, bf_hi(pX.y) * ws_);
            xw.z = cvt_pk_bf16(bf_lo(pX.z) * ws_, bf_hi(pX.z) * ws_); xw.w = cvt_pk_bf16(bf_lo(pX.w) * ws_, bf_hi(pX.w) * ws_);
            *(LAS u32x4*)(L + XW + srow * LDX + 16 * sch) = xw; }
#pragma unroll
        for (int pb = 0; pb < 4; ++pb)
            *(LAS u32x2*)(L + SB + (16 * pb + i16) * LDC + (16 * w + 4 * g4) * 2) = (u32x2){cvt_pk_bf16(st[pb].x, st[pb].y), cvt_pk_bf16(st[pb].z, st[pb].w)};
        const u32x2 zreg0 = pZ[0], zreg1 = pZ[1];
        __syncthreads();
        if (jb + 1 < nblk) SSD_PREFETCH(jb + 1);
        {
            f32x4 cb[2] = {{0.f, 0.f, 0.f, 0.f}, {0.f, 0.f, 0.f, 0.f}};
#pragma unroll
            for (int ks = 0; ks < 4; ++ks) { const bf16x8 af = frag_row(L + BL, LDC, 16 * cb_sb, 32 * ks, i16, g4);
#pragma unroll
                for (int q = 0; q < 2; ++q) { const bf16x8 bfv = frag_row(L + CL, LDC, 16 * (cb_tb0 + q), 32 * ks, i16, g4);
                    cb[q] = __builtin_amdgcn_mfma_f32_16x16x32_bf16(af, bfv, cb[q], 0, 0, 0); } }
            const LAS float* fa = (const LAS float*)(L + FA);
            const int s0 = 16 * cb_sb + 4 * g4;
            const f32x4 acs = *(const LAS f32x4*)(fa + s0), dts = *(const LAS f32x4*)(fa + 64 + s0);
#pragma unroll
            for (int q = 0; q < 2; ++q) { const int t = 16 * (cb_tb0 + q) + i16; const float act = fa[t];
                float o[4];
#pragma unroll
                for (int e = 0; e < 4; ++e) o[e] = (s0 + e <= t) ? cb[q][e] * __builtin_amdgcn_exp2f((act - acs[e]) * 1.4426950408889634f) * dts[e] : 0.f;
                *(LAS u32x2*)(L + WM + t * LDW + s0 * 2) = (u32x2){cvt_pk_bf16(o[0], o[1]), cvt_pk_bf16(o[2], o[3])}; }
            const float dtot = __builtin_amdgcn_exp2f(tot * 1.4426950408889634f);
#pragma unroll
            for (int pb = 0; pb < 4; ++pb) st[pb] = st[pb] * dtot;
#pragma unroll
            for (int ks = 0; ks < 2; ++ks) { const bf16x8 af = frag_tr(L + BL, LDC, 16 * w, 32 * ks, i16, g4);
#pragma unroll
                for (int pb = 0; pb < 4; ++pb) { const bf16x8 bfv = frag_tr(L + XW, LDX, 16 * pb, 32 * ks, i16, g4);
                    st[pb] = __builtin_amdgcn_mfma_f32_16x16x32_bf16(af, bfv, st[pb], 0, 0, 0); } }
        }
        __syncthreads();
        {
            f32x4 y[2] = {{0.f, 0.f, 0.f, 0.f}, {0.f, 0.f, 0.f, 0.f}};
#pragma unroll
            for (int ks = 0; ks < 4; ++ks) { const bf16x8 bfv = frag_row(L + CL, LDC, 16 * y_tb, 32 * ks, i16, g4);
#pragma unroll
                for (int q = 0; q < 2; ++q) { const bf16x8 af = frag_row(L + SB, LDC, 16 * (y_pb0 + q), 32 * ks, i16, g4); y[q] = __builtin_amdgcn_mfma_f32_16x16x32_bf16(af, bfv, y[q], 0, 0, 0); } }
            const LAS float* fa = (const LAS float*)(L + FA);
            const int t = 16 * y_tb + i16; const float eac = __builtin_amdgcn_exp2f(fa[t] * 1.4426950408889634f);
            y[0] = y[0] * eac; y[1] = y[1] * eac;
#pragma unroll
            for (int ks = 0; ks < 2; ++ks) { const bf16x8 bfv = frag_row(L + WM, LDW, 16 * y_tb, 32 * ks, i16, g4);
#pragma unroll
                for (int q = 0; q < 2; ++q) { const bf16x8 af = frag_tr(L + XR, LDX, 16 * (y_pb0 + q), 32 * ks, i16, g4); y[q] = __builtin_amdgcn_mfma_f32_16x16x32_bf16(af, bfv, y[q], 0, 0, 0); } }
            const int tg = 64 * jb + t; float ss = 0.f; f32x4 yo[2];
#pragma unroll
            for (int q = 0; q < 2; ++q) { const u32x2 xv = *(const LAS u32x2*)(L + XR + t * LDX + (yp0 + 16 * q) * 2); const u32x2 zr = q ? zreg1 : zreg0;
                const f32x4 xf = {bf_lo(xv.x), bf_hi(xv.x), bf_lo(xv.y), bf_hi(xv.y)}, zf = {bf_lo(zr.x), bf_hi(zr.x), bf_lo(zr.y), bf_hi(zr.y)};
                yo[q].x = (y[q].x + dsk * xf.x) * siluf_(zf.x); yo[q].y = (y[q].y + dsk * xf.y) * siluf_(zf.y); yo[q].z = (y[q].z + dsk * xf.z) * siluf_(zf.z); yo[q].w = (y[q].w + dsk * xf.w) * siluf_(zf.w);
                ss += (yo[q].x * yo[q].x + yo[q].y * yo[q].y) + (yo[q].z * yo[q].z + yo[q].w * yo[q].w); }
            ss += __shfl_xor(ss, 16); ss += __shfl_xor(ss, 32);
            if (tg < T) { if (g4 == 0) atomicAdd(SSQ1 + row0 + tg, ss);
#pragma unroll
                for (int q = 0; q < 2; ++q) { const f32x4 yn = yo[q] * nwv[q]; const u32x2 yv = {cvt_pk_bf16(yn.x, yn.y), cvt_pk_bf16(yn.z, yn.w)}; bf16_t* yp = XS + (size_t)(row0 + tg) * 1024 + xcol + yp0 + 16 * q;
                    if (pr) *(u32x2*)yp = yv; else wt_store8(yp, yv); } }
        }
        __syncthreads();
    }
#undef SSD_PREFETCH
#pragma unroll
    for (int pb = 0; pb < 4; ++pb) *(f32x4*)(sout + (size_t)(16 * pb + i16) * 128 + 16 * w + 4 * g4) = st[pb];
    if (!pr) unit_publish_wt(F, CW_DEP + 192);
}
__device__ __forceinline__ float relu1(float a) { const int b = __float_as_int(a); return __int_as_float(b > 0 ? b : 0); }
__device__ __forceinline__ f32x2 pk_relu(f32x2 a) { return (f32x2){relu1(a.x), relu1(a.y)}; }
__device__ __forceinline__ f32x2 pk_fma(f32x2 a, f32x2 b, f32x2 c) { f32x2 r; asm volatile("v_pk_fma_f32 %0, %1, %2, %3" : "=v"(r) : "v"(a), "v"(b), "v"(c)); return r; }
namespace idx {
constexpr int WTAB = 0, SCORES = 512;
}
__device__ __forceinline__ unsigned* mask_row(Frame& F, int r) {
    return r < RPR ? (unsigned*)(F.ws + WS_MASK) + (size_t)r * MASK_LDP : (unsigned*)(F.ws + WS_MASKS) + (size_t)(r - RPR) * MASK_LDS;
}
__device__ __forceinline__ unsigned f2key(float f) { const unsigned u = __float_as_uint(f); return (u & 0x80000000u) ? ~u : (u | 0x80000000u); }
__device__ __forceinline__ float key2f(unsigned k) { return __uint_as_float((k & 0x80000000u) ? (k & 0x7fffffffu) : ~k); }
template <int NI>
__device__ __forceinline__ void idx_select(Frame& F, const LAS float* sc, int LP, int Lk, int NQ, int r0) {
    const int lane = F.lane, w = F.wave, ni = LP >> 6; const unsigned long long lt_mask = (1ull << lane) - 1ull;
    float zq, dfac;
    { const float qq = 0.5f - (float)TOPK / (float)Lk, r = qq * qq;
      zq = (((((-3.969683028665376e+01f * r + 2.209460984245205e+02f) * r - 2.759285104469687e+02f) * r + 1.383577518672690e+02f) * r - 3.066479806614716e+01f) * r + 2.506628277459239e+00f) * qq /
           (((((-5.447609879822406e+01f * r + 1.615858368580409e+02f) * r - 1.556989798598866e+02f) * r + 6.680131188771972e+01f) * r - 1.328068155288572e+01f) * r + 1.f);
      dfac = (float)Lk * 0.3989422804f * __builtin_amdgcn_exp2f(-0.7213475204f * zq * zq); }
    constexpr int NMIN = NI == 9 ? 5 : (NI == 65 ? 65 : NI - 7);
    const float NINF = -__builtin_inff(), PINF = __builtin_inff();
#pragma unroll 1
    for (int q = w; q < NQ; q += 8) {
        const LAS float* row = sc + q * LP + lane; unsigned* mrow = mask_row(F, r0 + q);
        float kreg[NI];
        kreg[0] = row[(ni - 1) * 64];
#pragma unroll
        for (int j = 1; j < NI; ++j) { if (j < NMIN) kreg[j] = row[(j - 1) * 64]; else kreg[j] = j < ni ? row[(j - 1) * 64] : NINF; }
        float mx = kreg[0], mn = kreg[0] == NINF ? PINF : kreg[0], sm = 0.f, sq = 0.f;
#pragma unroll
        for (int j = 1; j < NI; ++j) { const float x = kreg[j]; mx = fmaxf(mx, x);
            if (j < NMIN) { mn = fminf(mn, x); sm += x; sq = fmaf(x, x, sq); } else mn = fminf(mn, x == NINF ? PINF : x); }
#pragma unroll
        for (int o = 1; o < 64; o <<= 1) { mx = fmaxf(mx, __shfl_xor(mx, o)); mn = fminf(mn, __shfl_xor(mn, o)); sm += __shfl_xor(sm, o); sq += __shfl_xor(sq, o); }
        mx = __int_as_float(__builtin_amdgcn_readfirstlane(__float_as_int(mx))); mn = __int_as_float(__builtin_amdgcn_readfirstlane(__float_as_int(mn)));
        sm = __int_as_float(__builtin_amdgcn_readfirstlane(__float_as_int(sm))); sq = __int_as_float(__builtin_amdgcn_readfirstlane(__float_as_int(sq)));
        constexpr float RN = 1.f / (64.f * (NMIN - 1));
        const float mu = sm * RN, sd = __builtin_sqrtf(fmaxf(sq * RN - mu * mu, 0.f));
        const float idens = sd / dfac;
        float lo = mn, hi = __uint_as_float(__float_as_uint(mx) + (mx >= 0.f ? 1u : 0xffffffffu)); if (mx == 0.f) hi = 1e-38f;
        float thr = 0.f; bool exact = false; float flo = 0.f, fhi = 0.f; bool lo_set = false, hi_set = false;
        float guess = mu + zq * sd; int third = 0;
#pragma unroll 1
        for (int it = 0; it < 64; ++it) {
            float mid = guess;
            if (it >= 20) mid = key2f(f2key(lo) + ((f2key(hi) - f2key(lo)) >> 1));
            if (!(mid > lo && mid < hi)) { mid = lo + (hi - lo) * 0.5f; if (!(mid > lo && mid < hi)) break; }
            int cnt = __popcll(__ballot(kreg[0] >= mid));
#pragma unroll
            for (int i = 1; i + 3 < NI; i += 4) {
                const unsigned long long b0 = __ballot(kreg[i] >= mid), b1 = __ballot(kreg[i + 1] >= mid), b2 = __ballot(kreg[i + 2] >= mid), b3 = __ballot(kreg[i + 3] >= mid);
                __builtin_amdgcn_sched_group_barrier(0x2, 4, 0); __builtin_amdgcn_sched_group_barrier(0x4, 8, 0);
                cnt += (__popcll(b0) + __popcll(b1)) + (__popcll(b2) + __popcll(b3)); }
            static_assert((NI - 1) % 4 == 0, "NI = 4m + 1");
            if (cnt == TOPK) { thr = mid; exact = true; break; }
            if (cnt > TOPK) { lo = mid; flo = (float)cnt; lo_set = true; } else { hi = mid; fhi = (float)cnt; hi_set = true; }
            if (lo_set && hi_set) { float tfr = (flo - 256.f) * __builtin_amdgcn_rcpf(flo - fhi); if (++third == 3) { third = 0; tfr = 0.5f; } tfr = fminf(fmaxf(tfr, 0.08f), 0.92f); guess = lo + (hi - lo) * tfr; }
            else guess = mid + ((float)cnt - 256.f) * idens; }
        unsigned m0 = 0u, m1 = 0u, m2 = 0u, m3 = 0u;
#define IDX_PUT(blk, ms) do { const unsigned long long ms_ = (ms); const unsigned lo_ = (unsigned)ms_, hi_ = (unsigned)(ms_ >> 32); \
            if (__builtin_constant_p(blk)) { \
                if (NI <= 64 || (blk) < 64) asm("s_nop 1\n\tv_writelane_b32 %0, %2, %4\n\tv_writelane_b32 %1, %3, %4" : "+v"(m0), "+v"(m1) : "s"(lo_), "s"(hi_), "n"((blk) & 63)); \
                else asm("s_nop 1\n\tv_writelane_b32 %0, %2, %4\n\tv_writelane_b32 %1, %3, %4" : "+v"(m2), "+v"(m3) : "s"(lo_), "s"(hi_), "n"((blk) & 63)); } \
            else { if (lane == (blk)) { m0 = lo_; m1 = hi_; } if (NI > 64 && lane + 64 == (blk)) { m2 = lo_; m3 = hi_; } } } while (0)
        if (exact) {
#pragma unroll
            for (int j = 1; j < NI; ++j) IDX_PUT(j - 1, __ballot(kreg[j] >= thr));
            IDX_PUT(ni - 1, __ballot(kreg[0] >= thr));
        } else {
            int ngt = 0;
#pragma unroll
            for (int i = 0; i < NI; ++i) ngt += __popcll(__ballot(kreg[i] >= hi));
            const int need = TOPK - ngt; int eqseen = 0;
#pragma unroll
            for (int jj = 1; jj <= NI; ++jj) { const int j = jj < NI ? jj : 0; const bool gt = kreg[j] >= hi, eq = (kreg[j] >= lo) && !gt; const unsigned long long meq = __ballot(eq);
                const bool sel = gt || (eq && (eqseen + __popcll(meq & lt_mask)) < need);
                if (j) IDX_PUT(j - 1, __ballot(sel)); else IDX_PUT(ni - 1, __ballot(sel));
                eqseen += __popcll(meq); }
        }
#undef IDX_PUT
        if (lane < ni) *(u32x2*)(mrow + 2 * lane) = (u32x2){m0, m1};
        if (NI > 64 && lane + 64 < ni) *(u32x2*)(mrow + 2 * (lane + 64)) = (u32x2){m2, m3};
    }
}
template <bool PR>
__device__ __forceinline__ void idx_unit(Frame& F, int b, int c, int qg) {
    constexpr int NQ = PR ? 16 : 8, NRB = NQ / 4;
    int tid_ = F.tid; asm volatile("" : "+v"(tid_));
    const int tid = tid_, lane = tid & 63, w = F.wave, r32 = lane & 31, hh = lane >> 5;
    LAS unsigned char* L_ = F.lds;
    const int Lk = PR ? NMETA + 64 * c : LS, LP = (Lk + 63) & ~63, nkb = LP >> 5;
    const int r0 = PR ? b * TP + NMETA + 64 * (c - 1) + NQ * qg : RPR + b * DSEQ + NQ * qg;
    const int krow0 = PR ? b * TP : RPR + b * DSEQ;
    const bf16_t* QI = (const bf16_t*)(F.ob + DO_QI); const bf16_t* KI = (const bf16_t*)(F.ws + WS_KI); const float* SM = (const float*)(F.ws + WS_SM); const float* ckidx = F.in[4];
    LAS float* wtab = (LAS float*)(L_ + idx::WTAB); LAS float* sc = (LAS float*)(L_ + idx::SCORES);
    if (tid < NQ * 8) wtab[tid] = SM[(size_t)(r0 + (tid >> 3)) * SMLD + 80 + (tid & 7)];
    const int a_tok = ((r32 >> 4) & 1) + 2 * ((r32 >> 2) & 1), a_head = (r32 & 3) + 4 * ((r32 >> 3) & 1);
    bf16x8 af[NRB][4];
#pragma unroll
    for (int rb = 0; rb < NRB; ++rb)
#pragma unroll
        for (int ks = 0; ks < 4; ++ks) af[rb][ks] = *(const bf16x8*)(QI + (size_t)(r0 + 4 * rb + a_tok) * 512 + a_head * 64 + 16 * ks + 8 * hh);
    __syncthreads();
    constexpr int ST = PR ? 3 : 2, RAWN = PR ? 4 : 8;
    u32x4 raw0[RAWN], raw1[RAWN], raw2[PR ? RAWN : 1];
#define IDX_LOADB(kb_, R) do { const int s_ = (kb_) * 32 + r32; const int sc_ = s_ < Lk ? s_ : Lk - 1; \
        if (!PR && (kb_) * 32 < PAST) { const float* kp = ckidx + ((size_t)b * PAST + sc_) * 64 + 8 * hh; \
            _Pragma("unroll") for (int ks = 0; ks < 4; ++ks) { R[(2 * ks) % RAWN] = *(const u32x4*)(kp + 16 * ks); R[(2 * ks + 1) % RAWN] = *(const u32x4*)(kp + 16 * ks + 4); } } \
        else { const bf16_t* kp = KI + (size_t)(PR ? krow0 + sc_ : krow0 + sc_ - PAST) * 64 + 8 * hh; \
            _Pragma("unroll") for (int ks = 0; ks < 4; ++ks) R[ks] = *(const u32x4*)(kp + 16 * ks); } } while (0)
#define IDX_GETB(kb_, R) do { if (!PR && (kb_) * 32 < PAST) { \
            _Pragma("unroll") for (int ks = 0; ks < 4; ++ks) { const u32x4 x0 = R[(2 * ks) % RAWN], x1 = R[(2 * ks + 1) % RAWN]; \
                u32x4 t; t.x = cvt_pk_bf16(__uint_as_float(x0.x), __uint_as_float(x0.y)); t.y = cvt_pk_bf16(__uint_as_float(x0.z), __uint_as_float(x0.w)); \
                t.z = cvt_pk_bf16(__uint_as_float(x1.x), __uint_as_float(x1.y)); t.w = cvt_pk_bf16(__uint_as_float(x1.z), __uint_as_float(x1.w)); bfr[ks] = __builtin_bit_cast(bf16x8, t); } } \
        else { _Pragma("unroll") for (int ks = 0; ks < 4; ++ks) bfr[ks] = __builtin_bit_cast(bf16x8, R[ks]); } } while (0)
    if (w < nkb) IDX_LOADB(w, raw0);
    if (w + 8 < nkb) IDX_LOADB(w + 8, raw1);
    if (PR && w + 16 < nkb) IDX_LOADB(w + 16, raw2);
#define IDX_STAGE(st, R) do { const int kb = kb0 + 8 * (st); \
        if (kb < nkb) { const int s = kb * 32 + r32; bf16x8 bfr[4]; \
            IDX_GETB(kb, R); \
            if (kb + 8 * ST < nkb) IDX_LOADB(kb + 8 * ST, R); \
            f32x16 d[NRB]; \
            _Pragma("unroll") for (int rb = 0; rb < NRB; ++rb) _Pragma("unroll") for (int e = 0; e < 16; ++e) d[rb][e] = 0.f; \
              \
            _Pragma("unroll") for (int ks = 0; ks < 4; ++ks) _Pragma("unroll") for (int rb = 0; rb < NRB; ++rb) d[rb] = __builtin_amdgcn_mfma_f32_32x32x16_bf16(af[rb][ks], bfr[ks], d[rb], 0, 0, 0); \
            _Pragma("unroll") for (int rb = 0; rb < NRB; ++rb) { \
                  \
                _Pragma("unroll") for (int q = 0; q < 2; ++q) { const int tok = 4 * rb + 2 * hh + q; const f32x4 w0 = *(const LAS f32x4*)(wtab + tok * 8), w1 = *(const LAS f32x4*)(wtab + tok * 8 + 4); \
                    f32x2 acc2 = {0.f, 0.f}; \
                    acc2 = pk_fma(pk_relu((f32x2){d[rb][8 * q], d[rb][8 * q + 1]}), (f32x2){w0.x, w0.y}, acc2); acc2 = pk_fma(pk_relu((f32x2){d[rb][8 * q + 2], d[rb][8 * q + 3]}), (f32x2){w0.z, w0.w}, acc2); \
                    acc2 = pk_fma(pk_relu((f32x2){d[rb][8 * q + 4], d[rb][8 * q + 5]}), (f32x2){w1.x, w1.y}, acc2); acc2 = pk_fma(pk_relu((f32x2){d[rb][8 * q + 6], d[rb][8 * q + 7]}), (f32x2){w1.z, w1.w}, acc2); \
                    float v = acc2.x + acc2.y; \
                    if (v == 0.f) v = 0.f;                                     \
                    sc[tok * LP + s] = s < Lk ? v : -__builtin_inff(); } } } } while (0)
#pragma unroll 1
    for (int kb0 = w; kb0 < nkb; kb0 += 8 * ST) {
        IDX_STAGE(0, raw0);
        IDX_STAGE(1, raw1);
        if (PR) IDX_STAGE(2, raw2);
    }
#undef IDX_STAGE
#undef IDX_GETB
#undef IDX_LOADB
    __syncthreads();
    if (PR) { if (LP <= 576) idx_select<9>(F, sc, LP, Lk, NQ, r0); else if (LP <= 1088) idx_select<17>(F, sc, LP, Lk, NQ, r0); else if (LP <= 1600) idx_select<25>(F, sc, LP, Lk, NQ, r0); else idx_select<33>(F, sc, LP, Lk, NQ, r0); }
    else idx_select<65>(F, sc, LP, Lk, NQ, r0);
    __syncthreads();
}
__device__ __forceinline__ void idx_allones(Frame& F, int b, int c) {
    const int Lk = NMETA + 64 * c, nw = ((Lk + 63) & ~63) >> 5;
    for (int e = F.tid; e < 64 * nw; e += NTHR) { const int q = e / nw, wd = e - q * nw; const int lo = 32 * wd;
        const unsigned m = lo + 32 <= Lk ? 0xffffffffu : (lo >= Lk ? 0u : ((1u << (Lk - lo)) - 1u));
        mask_row(F, b * TP + NMETA + 64 * (c - 1) + q)[wd] = m; }
}
__device__ __forceinline__ void idx_conv_units(Frame& F) {
    constexpr int NPU = NBATCH * 29 * 4, NSU = NBATCH * 8, NAU = NBATCH * 3, NCU = (NBATCH * 33 + NBATCH) * 2;
    LAS int* qslot = (LAS int*)(F.lds + MISC_OFF) + 16;
    for (bool first = true; ; first = false) {
        refresh_ids(F);
        if (F.tid == 0) *qslot = first ? (int)blockIdx.x : (int)(F.G + __hip_atomic_fetch_add((unsigned*)(F.ctl + CW_Q + 64), 1u, __ATOMIC_RELAXED, __HIP_MEMORY_SCOPE_AGENT));
        __syncthreads();
        const int u = __builtin_amdgcn_readfirstlane(*qslot);
        __syncthreads();
        if (u >= NPU + NSU + NAU + NCU) break;
        constexpr int NIU = NSU + NPU, NG = NIU / 2;
        static_assert(NIU % 2 == 0 && NG <= NCU, "queue pattern");
        int iu = -1, cu = -1, au = -1;
        if (u < 3 * NG) { const int gq = u / 3, kq = u - 3 * gq; if (kq < 2) iu = 2 * gq + kq; else cu = gq; } else if (u < NIU + NCU) cu = NG + (u - 3 * NG); else au = u - NIU - NCU;
        if (iu >= 0) {
            if (iu < NSU) { idx_unit<false>(F, iu >> 3, 0, iu & 7); }
            else { const int v = iu - NSU; const int qg = v & 3, bc = v >> 2, b = bc & 7, c = 32 - (bc >> 3); idx_unit<true>(F, b, c, qg); } }
        else if (cu >= 0) conv_unit(F, cu);
        else idx_allones(F, au & 7, 1 + (au >> 3));
    }
}
namespace att {
constexpr int SHM_V = 16384, SHM_K = 16384, OFF_V = 0, OFF_K = 2 * SHM_V, OFF_WS = OFF_K + 2 * SHM_K, OFF_TAB = OFF_WS + 8 * 256, OFF_OST = OFF_TAB + 4 * 320 * 4, OST_LD = 272, LDS_TOT = OFF_OST + 8 * 32 * OST_LD;
static_assert(LDS_TOT <= MISC_OFF, "attention LDS");
constexpr float NEG = -1e30f, MINIT = -1e20f, THR2 = 8.f, L2E = 1.4426950408889634f;
#define KSWZ(row, colB) ((row) * 256 + ((colB) ^ (((row) & 15) << 4)))
#define SBAR() __builtin_amdgcn_sched_barrier(0)
__device__ __forceinline__ int crow(int r, int hi) { return (r & 3) + 8 * (r >> 2) + 4 * hi; }
__device__ __forceinline__ int v_st(int k, int c) { const int kk = (k & ~0xC) | ((k & 4) << 1) | ((k & 8) >> 1); return ((kk >> 3) * 4 + (c >> 5)) * 512 + ((kk & 7) * 32 + (c & 31)) * 2; }
__device__ __forceinline__ int v_rd_base(int lane) { return ((lane & 3) << 3) | (((lane >> 2) & 3) << 6) | (((lane >> 4) & 1) << 5) | (((lane >> 5) & 1) << 8); }
constexpr int v_rd_off(int d0, int ks, int half) { return d0 * 512 + ks * 4096 + half * 2048; }
template <int OFF> __device__ __forceinline__ s16x4 tr_read(int vb) { s16x4 r; asm volatile("ds_read_b64_tr_b16 %0, %1 offset:%2" : "=&v"(r) : "v"(vb), "i"(OFF) : "memory"); return r; }
template <int D0> __device__ __forceinline__ void pv_one(f32x16& od, int vb, bf16x8 pa0, bf16x8 pa1, bf16x8 pa2, bf16x8 pa3) {
    const s16x4 l0 = tr_read<v_rd_off(D0, 0, 0)>(vb), h0 = tr_read<v_rd_off(D0, 0, 1)>(vb), l1 = tr_read<v_rd_off(D0, 1, 0)>(vb), h1 = tr_read<v_rd_off(D0, 1, 1)>(vb);
    const s16x4 l2 = tr_read<v_rd_off(D0, 2, 0)>(vb), h2 = tr_read<v_rd_off(D0, 2, 1)>(vb), l3 = tr_read<v_rd_off(D0, 3, 0)>(vb), h3 = tr_read<v_rd_off(D0, 3, 1)>(vb);
    asm volatile("s_waitcnt lgkmcnt(0)" ::: "memory"); SBAR();
#define PK(L, H) (bf16x8){L[0], L[1], L[2], L[3], H[0], H[1], H[2], H[3]}
    od = __builtin_amdgcn_mfma_f32_32x32x16_bf16(pa0, PK(l0, h0), od, 0, 0, 0);
    od = __builtin_amdgcn_mfma_f32_32x32x16_bf16(pa1, PK(l1, h1), od, 0, 0, 0);
    od = __builtin_amdgcn_mfma_f32_32x32x16_bf16(pa2, PK(l2, h2), od, 0, 0, 0);
    od = __builtin_amdgcn_mfma_f32_32x32x16_bf16(pa3, PK(l3, h3), od, 0, 0, 0);
#undef PK
}
__device__ __forceinline__ void qkt(f32x16& p0, f32x16& p1, const LAS unsigned char* Ks, const bf16x8* qr, float init, int r32, int hi) {
#pragma unroll
    for (int r = 0; r < 16; ++r) { p0[r] = init; p1[r] = init; }
#pragma unroll
    for (int d0 = 0; d0 < 8; ++d0) { const int cb = (d0 * 16 + hi * 8) * 2;
        const bf16x8 b0 = *(const LAS bf16x8*)(Ks + KSWZ(r32, cb)), b1 = *(const LAS bf16x8*)(Ks + KSWZ(32 + r32, cb));
        p0 = __builtin_amdgcn_mfma_f32_32x32x16_bf16(b0, qr[d0], p0, 0, 0, 0);
        p1 = __builtin_amdgcn_mfma_f32_32x32x16_bf16(b1, qr[d0], p1, 0, 0, 0); }
}
}

template <bool PR>
__device__ __forceinline__ void attn_unit(Frame& F, int b, int c, int g, int sp) {
    using namespace att;
    int tid_ = F.tid; asm volatile("" : "+v"(tid_));
    const int tid = tid_, lane = tid & 63, w = F.wave, r32 = lane & 31, hi = lane >> 5, hd = w >> 1, th = w & 1;
    LAS unsigned char* L = F.lds;
    const int qrow0 = PR ? b * TP + NMETA + 64 * (c - 1) : RPR + b * DSEQ, qpos0 = PR ? NMETA + 64 * (c - 1) : PAST;
    const int jt0 = PR ? 0 : (sp == 0 ? 0 : 1 + 8 * sp), NT = PR ? c + 1 : 9 + 8 * sp;
    bf16_t* Q = (bf16_t*)(F.ob + DO_Q);
    const bf16_t* Kb = (const bf16_t*)(F.ws + WS_K); const bf16_t* Vb = (const bf16_t*)(F.ws + WS_V); const bf16_t* CK = (const bf16_t*)(F.ws + WS_CK); const bf16_t* CV = (const bf16_t*)(F.ob + DO_CV);
    const float* relb = F.in[8];
    { LAS float* tab = (LAS float*)(L + OFF_TAB);
      for (int e = tid; e < 4 * 320; e += NTHR) { const int h4 = e / 320, rel = e - h4 * 320 - 192; tab[e] = relb[t5_bucket(rel) * 8 + g * 4 + h4] * L2E; } }
    const float cfar = relb[15 * 8 + g * 4 + hd] * L2E;
    bf16x8 qr[8];
    { const bf16_t* qp = Q + (size_t)(qrow0 + 32 * th + r32) * 1024 + g * 512 + hd * 128 + hi * 8; const float* qnw = F.in[17] + hi * 8;
      constexpr float QSC = 0.08838834764831845f * L2E;
      u32x4 qraw[8]; float ss = 0.f;
#pragma unroll
      for (int d0 = 0; d0 < 8; ++d0) qraw[d0] = *(const u32x4*)(qp + d0 * 16);
#pragma unroll
      for (int d0 = 0; d0 < 8; ++d0)
#pragma unroll
          for (int j = 0; j < 4; ++j) { const float a = bf_lo(qraw[d0][j]), b2 = bf_hi(qraw[d0][j]); ss += a * a + b2 * b2; }
      { const auto rr = __builtin_amdgcn_permlane32_swap(__float_as_uint(ss), __float_as_uint(ss), false, false); ss = __uint_as_float(rr[0]) + __uint_as_float(rr[1]); }
      const float rs = __builtin_amdgcn_rsqf(ss * (1.f / HD) + EPS) * QSC;
#pragma unroll
      for (int d0 = 0; d0 < 8; ++d0) { const f32x4 w0 = *(const f32x4*)(qnw + d0 * 16), w1 = *(const f32x4*)(qnw + d0 * 16 + 4); const u32x4 v = qraw[d0];
          const u32x4 o_ = {cvt_pk_bf16(bf_lo(v.x) * rs * w0.x, bf_hi(v.x) * rs * w0.y), cvt_pk_bf16(bf_lo(v.y) * rs * w0.z, bf_hi(v.y) * rs * w0.w),
                            cvt_pk_bf16(bf_lo(v.z) * rs * w1.x, bf_hi(v.z) * rs * w1.y), cvt_pk_bf16(bf_lo(v.w) * rs * w1.z, bf_hi(v.w) * rs * w1.w)};
          qr[d0] = __builtin_bit_cast(bf16x8, o_); } }
    const unsigned* mrow = PR ? (const unsigned*)(F.ws + WS_MASK) + (size_t)(qrow0 + 32 * th + r32) * MASK_LDP : (const unsigned*)(F.ws + WS_MASKS) + (size_t)(qrow0 - RPR + 32 * th + r32) * MASK_LDS;
    LAS float* wsf = (LAS float*)(L + OFF_WS) + w * 64;
    const int sr = tid >> 4, scol = (tid & 15) * 8, vst0 = v_st(sr, scol), vst1 = v_st(32 + sr, scol);
    const int vb0 = (int)(uintptr_t)(L + OFF_V) + v_rd_base(lane);
    float m_reg = MINIT, l_reg = 0.f; f32x16 o[4] = {};
    u32x4 sv0, sv1, sk0, sk1;
#define ATT_SRC(j, kt, vt) const bf16_t* kt; const bf16_t* vt; { if (PR) { kt = Kb + (size_t)(b * TP + 64 * (j)) * 256 + g * 128; vt = Vb + (size_t)(b * TP + 64 * (j)) * 256 + g * 128; } \
        else if ((j) < PAST / 64) { kt = CK + ((size_t)b * PAST + 64 * (j)) * 256 + g * 128; vt = CV + ((size_t)b * PAST + 64 * (j)) * 256 + g * 128; } \
        else { kt = Kb + (size_t)(RPR + b * DSEQ) * 256 + g * 128; vt = Vb + (size_t)(RPR + b * DSEQ) * 256 + g * 128; } }
#define ATT_SLOAD(j) do { ATT_SRC(j, kt_, vt_); sv0 = *(const u32x4*)(vt_ + (size_t)sr * 256 + scol); sv1 = *(const u32x4*)(vt_ + (size_t)(32 + sr) * 256 + scol); \
        sk0 = *(const u32x4*)(kt_ + (size_t)sr * 256 + scol); sk1 = *(const u32x4*)(kt_ + (size_t)(32 + sr) * 256 + scol); } while (0)
#define ATT_SWRITE(bf) do { *(LAS u32x4*)(L + OFF_V + (bf) * SHM_V + vst0) = sv0; *(LAS u32x4*)(L + OFF_V + (bf) * SHM_V + vst1) = sv1; const int kc_ = scol * 2; \
        *(LAS u32x4*)(L + OFF_K + (bf) * SHM_K + KSWZ(sr, kc_)) = sk0; *(LAS u32x4*)(L + OFF_K + (bf) * SHM_K + KSWZ(32 + sr, kc_)) = sk1; } while (0)
    const int qlo = qpos0 + 32 * th;
    const LAS float* tabh = (const LAS float*)(L + OFF_TAB) + hd * 320;
    const bool evn = !((NT - jt0) & 1);
    int jtb = jt0; const int NTR = (NT - jt0) - (evn ? 1 : 0);
    f32x16 pA0, pA1, pB0, pB1; float alA = 1.f, alB = 1.f, cmA = 0.f, cmB = 0.f; u32x2 mwA = {0u, 0u}, mwB = {0u, 0u}; bf16x8 pa0, pa1, pa2, pa3;
#define ATT_MLOAD(k, MW) do { MW = *(const u32x2*)(mrow + 2 * (jtb + (k))); } while (0)
#define ATT_SCORE(P0, P1, k, bfk, MW, CADD) do { const int jj_ = jtb + (k); \
        qkt(P0, P1, L + OFF_K + (bfk) * SHM_K, qr, 0.f, r32, hi); \
        const bool far_ = (64 * jj_ + 63 - qlo) <= -91; CADD = far_ ? cfar : 0.f; \
        if (!far_) { const LAS float* tp = tabh + (64 * jj_ - qlo - r32 + 4 * hi + 192); \
            _Pragma("unroll") for (int r = 0; r < 16; ++r) { const int o_ = (r & 3) + 8 * (r >> 2); P0[r] += tp[o_]; P1[r] += tp[o_ + 32]; } } } while (0)
#define ATT_PARTIAL(P0, P1, MW, CADD, AL, CM) do { float pmax = P0[0]; \
        _Pragma("unroll") for (int r = 1; r < 16; ++r) pmax = fmaxf(pmax, P0[r]); \
        _Pragma("unroll") for (int r = 0; r < 16; ++r) pmax = fmaxf(pmax, P1[r]); \
        { const auto rr = __builtin_amdgcn_permlane32_swap(__float_as_uint(pmax), __float_as_uint(pmax), false, false); pmax = fmaxf(__uint_as_float(rr[0]), __uint_as_float(rr[1])) + CADD; } \
        if (__builtin_expect(__all(pmax - m_reg <= THR2), 1)) { AL = 1.f; } else { const float mn = fmaxf(m_reg, pmax); AL = __builtin_amdgcn_exp2f(m_reg - mn); m_reg = mn; } \
        CM = CADD - m_reg; const int m0_ = (int)(MW.x >> (4 * hi)); \
        _Pragma("unroll") for (int r = 0; r < 16; ++r) { const int o_ = (r & 3) + 8 * (r >> 2); \
            const float e_ = __builtin_amdgcn_exp2f(P0[r] + CM); asm("v_bfe_i32 %0, %2, %3, 1\n\tv_and_b32 %0, %0, %1" : "=&v"(P0[r]) : "v"(e_), "v"(m0_), "n"(o_)); } } while (0)
#define ATT_FINISH(P0, P1, MW, AL, CM) do { const int m1_ = (int)(MW.y >> (4 * hi)); float ps = 0.f; \
        _Pragma("unroll") for (int r = 0; r < 16; ++r) { const int o_ = (r & 3) + 8 * (r >> 2); \
            const float e_ = __builtin_amdgcn_exp2f(P1[r] + CM); asm("v_bfe_i32 %0, %2, %3, 1\n\tv_and_b32 %0, %0, %1" : "=&v"(P1[r]) : "v"(e_), "v"(m1_), "n"(o_)); ps += P0[r] + P1[r]; } \
        { const auto rr = __builtin_amdgcn_permlane32_swap(__float_as_uint(ps), __float_as_uint(ps), false, false); ps = __uint_as_float(rr[0]) + __uint_as_float(rr[1]); } \
        l_reg = l_reg * AL + ps; \
        ATT_PK4(P0, 0, pa0); ATT_PK4(P0, 8, pa1); ATT_PK4(P1, 0, pa2); ATT_PK4(P1, 8, pa3); } while (0)
#define ATT_PK4(P, BASE, OUT) do { const unsigned a0 = cvt_pk_bf16(P[BASE + 0], P[BASE + 1]), a1 = cvt_pk_bf16(P[BASE + 2], P[BASE + 3]); \
        const unsigned b0 = cvt_pk_bf16(P[BASE + 4], P[BASE + 5]), b1 = cvt_pk_bf16(P[BASE + 6], P[BASE + 7]); \
        const auto r0_ = __builtin_amdgcn_permlane32_swap(a0, b0, false, false); const auto r1_ = __builtin_amdgcn_permlane32_swap(a1, b1, false, false); \
        const u32x4 w_ = {r0_[0], r1_[0], r0_[1], r1_[1]}; OUT = __builtin_bit_cast(bf16x8, w_); } while (0)
#define ATT_PV(bfk) do { const int vb = vb0 + (bfk) * SHM_V; \
        pv_one<0>(o[0], vb, pa0, pa1, pa2, pa3); pv_one<1>(o[1], vb, pa0, pa1, pa2, pa3); pv_one<2>(o[2], vb, pa0, pa1, pa2, pa3); pv_one<3>(o[3], vb, pa0, pa1, pa2, pa3); } while (0)
#define ATT_RESC(AL) do { if (__any((AL) < 1.f)) { if (hi == 0) wsf[r32] = (AL); asm volatile("s_waitcnt lgkmcnt(0)" ::: "memory"); \
        _Pragma("unroll") for (int d = 0; d < 4; ++d) _Pragma("unroll") for (int r = 0; r < 16; ++r) o[d][r] *= wsf[crow(r, hi)]; } } while (0)
#define ATT_STAGE_LOAD(k) ATT_SLOAD(jtb + (k))
    if (evn) {
        ATT_STAGE_LOAD(0); ATT_SWRITE(1);
        __syncthreads();
        ATT_MLOAD(0, mwB); ATT_SCORE(pB0, pB1, 0, 1, mwB, cmB); { const float cadd_ = cmB; ATT_PARTIAL(pB0, pB1, mwB, cadd_, alB, cmB); }
        ATT_FINISH(pB0, pB1, mwB, alB, cmB); SBAR();
        ATT_PV(1);
        __syncthreads();
        jtb = jt0 + 1;
    }
    ATT_STAGE_LOAD(0); ATT_SWRITE(0);
    __syncthreads();
    ATT_MLOAD(0, mwA); ATT_SCORE(pA0, pA1, 0, 0, mwA, cmA); { const float cadd_ = cmA; ATT_PARTIAL(pA0, pA1, mwA, cadd_, alA, cmA); }
    if (NTR > 1) { ATT_STAGE_LOAD(1); ATT_SWRITE(1); }
    __syncthreads();
    ATT_RESC(alA);
#pragma unroll 1
    for (int k = 1; k + 1 < NTR; k += 2) {
        SBAR(); ATT_SCORE(pB0, pB1, k, 1, mwB, cmB);
        ATT_FINISH(pA0, pA1, mwA, alA, cmA); SBAR();
        ATT_STAGE_LOAD(k + 1); ATT_MLOAD(k, mwB); SBAR();
        ATT_PV(0); { const float cadd_ = cmB; ATT_PARTIAL(pB0, pB1, mwB, cadd_, alB, cmB); }
        __syncthreads(); ATT_SWRITE(0);
        ATT_RESC(alB); __syncthreads();
        SBAR(); ATT_SCORE(pA0, pA1, k + 1, 0, mwA, cmA);
        ATT_FINISH(pB0, pB1, mwB, alB, cmB); SBAR();
        if (k + 2 < NTR) ATT_STAGE_LOAD(k + 2); ATT_MLOAD(k + 1, mwA); SBAR();
        ATT_PV(1); { const float cadd_ = cmA; ATT_PARTIAL(pA0, pA1, mwA, cadd_, alA, cmA); }
        __syncthreads(); if (k + 2 < NTR) ATT_SWRITE(1);
        ATT_RESC(alA); __syncthreads();
    }
    SBAR(); ATT_FINISH(pA0, pA1, mwA, alA, cmA); SBAR();
    ATT_PV(0);
    __syncthreads();
#undef ATT_SCORE
#undef ATT_MLOAD
#undef ATT_PARTIAL
#undef ATT_FINISH
#undef ATT_PK4
#undef ATT_PV
#undef ATT_RESC
#undef ATT_STAGE_LOAD
#undef ATT_SRC
#undef ATT_SLOAD
#undef ATT_SWRITE
    int b_ = b, g_ = g, sp_ = sp; asm volatile("" : "+v"(b_), "+v"(g_), "+v"(sp_));
    LAS unsigned char* stg = L + OFF_OST + w * 32 * OST_LD;
    bf16_t* ob = (bf16_t*)(F.ob + DO_Q) + (size_t)((PR ? b_ * TP + NMETA + 64 * (c - 1) : RPR + b_ * DSEQ) + 32 * th) * 1024 + g_ * 512 + hd * 128;
    if (!PR) {
        float* pbase = (float*)(F.ob + DO_QI) + (size_t)((b_ * 2 + g_) * 8) * (256 * 132);
        float* pw = pbase + (size_t)sp_ * (256 * 132) + w * (64 * 64 + 128);
        { float* pp = pw + lane * 4;
#pragma unroll
          for (int d0 = 0; d0 < 4; ++d0) {
#pragma unroll
            for (int r4 = 0; r4 < 4; ++r4) { const u32x4 v = {__float_as_uint(o[d0][4 * r4]), __float_as_uint(o[d0][4 * r4 + 1]), __float_as_uint(o[d0][4 * r4 + 2]), __float_as_uint(o[d0][4 * r4 + 3])}; wt_store16(pp + r4 * 256, v); }
            pp += 16 * 64; asm volatile("" : "+v"(pp) :: "memory"); } }
        wt_store8(pw + 4096 + 2 * lane, (u32x2){__float_as_uint(m_reg), __float_as_uint(l_reg)});
        asm volatile("s_waitcnt vmcnt(0)" ::: "memory");
        __syncthreads();
        LAS int* flag = (LAS int*)(L + OFF_WS) + 8 * 64;
        if (tid == 0) {
            const unsigned old = __hip_atomic_fetch_add((unsigned*)(F.ctl + CW_Q + 128 + 64 * (b_ * 2 + g_)), 1u, __ATOMIC_RELAXED, __HIP_MEMORY_SCOPE_AGENT);
            if (old == 7u) { __builtin_amdgcn_fence(__ATOMIC_ACQUIRE, "agent"); asm volatile("s_waitcnt vmcnt(0)" ::: "memory"); }
            *flag = (int)old; }
        __syncthreads();
        const bool last = (*flag == 7);
        __syncthreads();
        if (!last) return;
        float mi[8], li[8];
#pragma unroll
        for (int s8 = 0; s8 < 8; ++s8) { const float* pq = pbase + (size_t)s8 * (256 * 132) + w * (64 * 64 + 128); const f32x2 ml = *(const f32x2*)(pq + 4096 + 2 * lane); mi[s8] = ml.x; li[s8] = ml.y; }
        float mm = mi[0];
#pragma unroll
        for (int s8 = 1; s8 < 8; ++s8) mm = fmaxf(mm, mi[s8]);
        float den = 0.f;
#pragma unroll
        for (int s8 = 0; s8 < 8; ++s8) { mi[s8] = __builtin_amdgcn_exp2f(mi[s8] - mm); den += mi[s8] * li[s8]; }
        const float rl = __builtin_amdgcn_rcpf(den);
        LAS float* wq = (LAS float*)(L + OFF_K) + w * 256;
        if (hi == 0) {
#pragma unroll
            for (int s8 = 0; s8 < 8; ++s8) wq[s8 * 32 + r32] = mi[s8] * rl; }
        asm volatile("s_waitcnt lgkmcnt(0)" ::: "memory");
#pragma unroll 1
        for (int d0 = 0; d0 < 4; ++d0) {
            f32x4 pv[4][8];
#pragma unroll
            for (int r4 = 0; r4 < 4; ++r4) { const float* pq = pbase + w * (64 * 64 + 128) + d0 * 16 * 64 + lane * 4 + r4 * 256;
#pragma unroll
                for (int s8 = 0; s8 < 8; ++s8) pv[r4][s8] = *(const f32x4*)(pq + (size_t)s8 * (256 * 132)); }
#pragma unroll
            for (int r4 = 0; r4 < 4; ++r4) { f32x4 acc4 = {0.f, 0.f, 0.f, 0.f};
#pragma unroll
                for (int s8 = 0; s8 < 8; ++s8) {
#pragma unroll
                    for (int e = 0; e < 4; ++e) acc4[e] += pv[r4][s8][e] * wq[s8 * 32 + crow(4 * r4 + e, hi)]; }
#pragma unroll
                for (int e = 0; e < 4; ++e) *(LAS bf16_t*)(stg + crow(4 * r4 + e, hi) * OST_LD + (d0 * 32 + r32) * 2) = f2bf(acc4[e]); } }
    } else {
        if (hi == 0) wsf[r32] = l_reg; asm volatile("s_waitcnt lgkmcnt(0)" ::: "memory");
        float rli[16];
#pragma unroll
        for (int r = 0; r < 16; ++r) rli[r] = __builtin_amdgcn_rcpf(wsf[crow(r, hi)]);
#pragma unroll
        for (int r = 0; r < 16; ++r) { const int orow = crow(r, hi);
#pragma unroll
            for (int d0 = 0; d0 < 4; ++d0) *(LAS bf16_t*)(stg + orow * OST_LD + (d0 * 32 + r32) * 2) = f2bf(o[d0][r] * rli[r]); }
    }
    asm volatile("s_waitcnt lgkmcnt(0)" ::: "memory");
#pragma unroll
    for (int i = 0; i < 8; ++i) { const int row = i * 4 + (lane >> 4), ch = lane & 15; const u32x4 v = *(const LAS u32x4*)(stg + row * OST_LD + ch * 16);
        if (PR) *(u32x4*)(ob + (size_t)row * 1024 + ch * 8) = v; else wt_store16(ob + (size_t)row * 1024 + ch * 8, v); }
    if (!PR) unit_publish_wt(F, CW_DEP);
    __syncthreads();
}
__device__ __forceinline__ int yrow_to_r(int pm) { return pm * 256 + (pm < 64 ? 16 * ((pm >> 3) + 1) : 128); }
struct SchedP5 {
    const char* A0; const char* A1; const char* B0; const char* B1; int G, c;
    __device__ __forceinline__ bool next(int i, pg8::Unit& u) const {
        const int L = (i >> 1) * G + c; if (L >= 64 * 4) return false;
        pg8::tile_of(L, 64, 4, u.pm, u.pn); u.part = i & 1;
        u.A = (u.part ? A1 : A0) + (size_t)yrow_to_r(u.pm) * 1024 * 2; u.B = (u.part ? B1 : B0) + (size_t)u.pn * 256 * 1024 * 2; return true; }
};
template <bool WT> struct EpiP5T {
    static constexpr bool PERM = true;
    const bf16_t* GS; const bf16_t* GA; const float* SSQ1; bf16_t* MERGED;
    __device__ __forceinline__ bool operator()(pg8::Acc& acc, const pg8::Unit& u, int wr, int wc, int fr, int fq) const {
        const int rr0 = yrow_to_r(u.pm) + wr * 64 + fr, ry0 = u.pm * 256 + wr * 64 + fr, col = u.pn * 256 + wc * 32 + 8 * fq;
#pragma unroll
        for (int ai = 0; ai < 2; ++ai)
#pragma unroll
            for (int m = 0; m < 4; ++m) { const int rr = rr0 + ai * 128 + m * 16, ry = ry0 + ai * 128 + m * 16;
                float rstd = 0.f; if (u.part == 0) rstd = __builtin_amdgcn_rsqf(SSQ1[rr] * (1.f / 1024.f) + EPS);
#pragma unroll
                for (int bj = 0; bj < 2; ++bj) {
                    const u32x4 ga = *(const u32x4*)(GA + (size_t)rr * 1024 + col + bj * 128);
                    float sa[8] = {bf_lo(ga.x), bf_hi(ga.x), bf_lo(ga.y), bf_hi(ga.y), bf_lo(ga.z), bf_hi(ga.z), bf_lo(ga.w), bf_hi(ga.w)};
                    if (u.part == 0) {
                        const u32x4 gs = *(const u32x4*)(GS + (size_t)rr * 1024 + col + bj * 128);
                        const float ss[8] = {bf_lo(gs.x), bf_hi(gs.x), bf_lo(gs.y), bf_hi(gs.y), bf_lo(gs.z), bf_hi(gs.z), bf_lo(gs.w), bf_hi(gs.w)};
#pragma unroll
                        for (int e = 0; e < 8; ++e) {
                            const float f = rstd * (1.f + __builtin_amdgcn_exp2f(-1.4426950408889634f * sa[e])) * __builtin_amdgcn_rcpf(1.f + __builtin_amdgcn_exp2f(-1.4426950408889634f * ss[e]));
                            acc[ai][bj][m][e >> 2][e & 3] *= f; }
                    } else {
                        float o[8];
#pragma unroll
                        for (int e = 0; e < 8; ++e) o[e] = acc[ai][bj][m][e >> 2][e & 3] * sigmoidf_(sa[e]);
                        u32x4 w; w.x = cvt_pk_bf16(o[0], o[1]); w.y = cvt_pk_bf16(o[2], o[3]); w.z = cvt_pk_bf16(o[4], o[5]); w.w = cvt_pk_bf16(o[6], o[7]);
                        if (WT) wt_store16(MERGED + (size_t)ry * 1024 + col + bj * 128, w); else *(u32x4*)(MERGED + (size_t)ry * 1024 + col + bj * 128) = w; } } }
        return u.part == 0;
    }
};
typedef EpiP5T<false> EpiP5;
struct EpiP5A {
    static constexpr bool PERM = true;
    const bf16_t* GS; const float* SSQ1; bf16_t* MERGED;
    __device__ __forceinline__ bool operator()(pg8::Acc& acc, const pg8::Unit& u, int wr, int wc, int fr, int fq) const {
        const int rr0 = yrow_to_r(u.pm) + wr * 64 + fr, ry0 = u.pm * 256 + wr * 64 + fr, col = u.pn * 256 + wc * 32 + 8 * fq;
#pragma unroll
        for (int ai = 0; ai < 2; ++ai)
#pragma unroll
            for (int m = 0; m < 4; ++m) { const int rr = rr0 + ai * 128 + m * 16, ry = ry0 + ai * 128 + m * 16; const float rstd = __builtin_amdgcn_rsqf(SSQ1[rr] * (1.f / 1024.f) + EPS);
#pragma unroll
                for (int bj = 0; bj < 2; ++bj) { const u32x4 gs = *(const u32x4*)(GS + (size_t)rr * 1024 + col + bj * 128);
                    const float ss[8] = {bf_lo(gs.x), bf_hi(gs.x), bf_lo(gs.y), bf_hi(gs.y), bf_lo(gs.z), bf_hi(gs.z), bf_lo(gs.w), bf_hi(gs.w)}; float o[8];
#pragma unroll
                    for (int e = 0; e < 8; ++e) o[e] = acc[ai][bj][m][e >> 2][e & 3] * rstd * sigmoidf_(ss[e]);
                    u32x4 w; w.x = cvt_pk_bf16(o[0], o[1]); w.y = cvt_pk_bf16(o[2], o[3]); w.z = cvt_pk_bf16(o[4], o[5]); w.w = cvt_pk_bf16(o[6], o[7]);
                    wt_store16(MERGED + (size_t)ry * 1024 + col + bj * 128, w); } }
        return false;
    }
};
struct EpiP5B {
    static constexpr bool PERM = true;
    const bf16_t* GA; bf16_t* MERGED;
    __device__ __forceinline__ bool operator()(pg8::Acc& acc, const pg8::Unit& u, int wr, int wc, int fr, int fq) const {
        const int rr0 = yrow_to_r(u.pm) + wr * 64 + fr, ry0 = u.pm * 256 + wr * 64 + fr, col = u.pn * 256 + wc * 32 + 8 * fq;
#pragma unroll
        for (int ai = 0; ai < 2; ++ai)
#pragma unroll
            for (int m = 0; m < 4; ++m) { const int rr = rr0 + ai * 128 + m * 16, ry = ry0 + ai * 128 + m * 16;
#pragma unroll
                for (int bj = 0; bj < 2; ++bj) { const u32x4 ga = *(const u32x4*)(GA + (size_t)rr * 1024 + col + bj * 128); bf16_t* mp = MERGED + (size_t)ry * 1024 + col + bj * 128; const u32x4 t = *(const u32x4*)mp;
                    const float sa[8] = {bf_lo(ga.x), bf_hi(ga.x), bf_lo(ga.y), bf_hi(ga.y), bf_lo(ga.z), bf_hi(ga.z), bf_lo(ga.w), bf_hi(ga.w)};
                    const float tv[8] = {bf_lo(t.x), bf_hi(t.x), bf_lo(t.y), bf_hi(t.y), bf_lo(t.z), bf_hi(t.z), bf_lo(t.w), bf_hi(t.w)}; float o[8];
#pragma unroll
                    for (int e = 0; e < 8; ++e) o[e] = tv[e] + acc[ai][bj][m][e >> 2][e & 3] * sigmoidf_(sa[e]);
                    u32x4 w; w.x = cvt_pk_bf16(o[0], o[1]); w.y = cvt_pk_bf16(o[2], o[3]); w.z = cvt_pk_bf16(o[4], o[5]); w.w = cvt_pk_bf16(o[6], o[7]);
                    wt_store16(mp, w); } }
        return false;
    }
};
struct SchedY {
    const char* A; const char* B; int nN, K, G, c;
    __device__ __forceinline__ bool next(int i, pg8::Unit& u) const {
        const int L = i * G + c; if (L >= 64 * nN) return false;
        pg8::tile_of(L, 64, nN, u.pm, u.pn); u.part = 0; u.A = A + (size_t)u.pm * 256 * K * 2; u.B = B + (size_t)u.pn * 256 * K * 2; return true; }
};
struct SchedTile {
    const char* A0; const char* A1; const char* B0; const char* B1; int pm, pn, nparts;
    __device__ __forceinline__ bool next(int i, pg8::Unit& u) const { if (i >= nparts) return false; u.pm = pm; u.pn = pn; u.part = i; u.A = i ? A1 : A0; u.B = i ? B1 : B0; return true; }
};
struct SchedP8 {
    const char* A; const char* B; int c;
    __device__ __forceinline__ bool next(int i, pg8::Unit& u) const {
        int L; if (c < 8) { if (i >= 3) return false; L = i * 8 + c; } else { L = 24 + i * 248 + (c - 8); if (L >= 64 * 22) return false; }
        pg8::tile_of(L, 64, 22, u.pm, u.pn); u.part = 0; u.A = A + (size_t)u.pm * 256 * 1024 * 2; u.B = B + (size_t)u.pn * 256 * 1024 * 2; return true; }
};
template <bool WT> struct EpiP6T {
    static constexpr bool PERM = false;
    const float* xp; const float* xs; bf16_t* HB; float* SSQ2;
    __device__ __forceinline__ bool operator()(pg8::Acc& acc, const pg8::Unit& u, int wr, int wc, int fr, int fq) const {
        const int ry0 = u.pm * 256 + wr * 64 + fr, col0 = u.pn * 256 + wc * 32 + 4 * fq;
#pragma unroll
        for (int ai = 0; ai < 2; ++ai)
#pragma unroll
            for (int m = 0; m < 4; ++m) { const int ry = ry0 + ai * 128 + m * 16;
                const float* xrow = ry < YPR ? xp + (size_t)ry * 1024 : xs + (size_t)(ry - YPR) * 1024; float ss = 0.f;
#pragma unroll
                for (int bj = 0; bj < 2; ++bj)
#pragma unroll
                    for (int n = 0; n < 2; ++n) { const int c = col0 + bj * 128 + n * 16; const f32x4 h = *(const f32x4*)(xrow + c) + acc[ai][bj][m][n];
                        ss += (h.x * h.x + h.y * h.y) + (h.z * h.z + h.w * h.w);
                        const u32x2 hv = {cvt_pk_bf16(h.x, h.y), cvt_pk_bf16(h.z, h.w)};
                        if (WT) wt_store8(HB + (size_t)ry * 1024 + c, hv); else *(u32x2*)(HB + (size_t)ry * 1024 + c) = hv; }
                ss += __shfl_xor(ss, 16); ss += __shfl_xor(ss, 32);
                if (fq == 0) atomicAdd(SSQ2 + ry, ss); }
        return false;
    }
};
typedef EpiP6T<false> EpiP6;
struct EpiP7 {
    static constexpr bool PERM = true;
    const float* SSQ2; bf16_t* ACT;
    __device__ __forceinline__ bool operator()(pg8::Acc& acc, const pg8::Unit& u, int wr, int wc, int fr, int fq) const {
        const int ry0 = u.pm * 256 + wr * 64 + fr, ch0 = u.pn * 128 + wc * 16 + 4 * fq;
#pragma unroll
        for (int ai = 0; ai < 2; ++ai)
#pragma unroll
            for (int m = 0; m < 4; ++m) { const int ry = ry0 + ai * 128 + m * 16; const float rs = __builtin_amdgcn_rsqf(SSQ2[ry] * (1.f / 1024.f) + EPS);
#pragma unroll
                for (int bj = 0; bj < 2; ++bj) { const f32x4 g = acc[ai][bj][m][0] * rs, up = acc[ai][bj][m][1] * rs;
                    const float a0 = siluf_(g.x) * up.x, a1 = siluf_(g.y) * up.y, a2 = siluf_(g.z) * up.z, a3 = siluf_(g.w) * up.w;
                    *(u32x2*)(ACT + (size_t)ry * DFF + ch0 + bj * 64) = (u32x2){cvt_pk_bf16(a0, a1), cvt_pk_bf16(a2, a3)}; } }
        return false;
    }
};
struct EpiP8 {
    static constexpr bool PERM = false;
    const bf16_t* HB; float* Y;
    __device__ __forceinline__ bool operator()(pg8::Acc& acc, const pg8::Unit& u, int wr, int wc, int fr, int fq) const {
        const int ry0 = u.pm * 256 + wr * 64 + fr, col0 = u.pn * 256 + wc * 32 + 4 * fq;
#pragma unroll
        for (int ai = 0; ai < 2; ++ai)
#pragma unroll
            for (int m = 0; m < 4; ++m) { const size_t ro = (size_t)(ry0 + ai * 128 + m * 16) * 1024 + col0;
#pragma unroll
                for (int bj = 0; bj < 2; ++bj)
#pragma unroll
                    for (int n = 0; n < 2; ++n) { const u32x2 hv = *(const u32x2*)(HB + ro + bj * 128 + n * 16);
                        const f32x4 h = {__uint_as_float(hv.x << 16), __uint_as_float(hv.x & 0xffff0000u), __uint_as_float(hv.y << 16), __uint_as_float(hv.y & 0xffff0000u)};
                        *(f32x4*)(Y + ro + bj * 128 + n * 16) = h + acc[ai][bj][m][n]; } }
        return false;
    }
};

constexpr size_t WS_MS = WS_CK, WS_HBS = WS_CK + (1u << 20), WS_ACTS = WS_CK + (2u << 20);
static_assert(WS_ACTS + (size_t)RSR * DFF * 2 <= WS_MASK, "sample intermediates");
__device__ __forceinline__ void mixer_units(Frame& F) {
    constexpr int Q0 = 128, Q1 = Q0 + 128, QA = Q1 + 8, Q2 = QA + 8, Q3 = Q2 + 128, Q4 = Q3 + 96, Q5 = Q4 + 8, Q6 = Q5 + 160, Q7 = Q6 + 44, Q8 = Q7 + 256;
    LAS int* qslot = (LAS int*)(F.lds + MISC_OFF) + 16;
    for (bool first = true; ; first = false) {
        refresh_ids(F);
        if (F.tid == 0) *qslot = first ? (int)blockIdx.x : (int)(F.G + __hip_atomic_fetch_add((unsigned*)(F.ctl + CW_Q), 1u, __ATOMIC_RELAXED, __HIP_MEMORY_SCOPE_AGENT));
        __syncthreads();
        const int u = __builtin_amdgcn_readfirstlane(*qslot);
        __syncthreads();
        if (u >= Q8) break;
        if (u < Q0) { attn_unit<false>(F, u >> 4, 0, (u >> 3) & 1, u & 7); }
        else if (u < Q1) ssd_chain_unit(F, 128 + (u - Q0));
        else if (u < QA) {
            const int k = u - Q1, pm = 64 + (k >> 2), pn = k & 3;
            unit_wait(F, CW_DEP + 192, 128u);
            SchedTile S{(const char*)(F.ws + WS_XS) + (size_t)yrow_to_r(pm) * 1024 * 2, nullptr, (const char*)(F.ws + WS_WBS) + (size_t)pn * 256 * 1024 * 2, nullptr, pm, pn, 1};
            EpiP5A E{(const bf16_t*)(F.ws + WS_GS), (const float*)(F.ws + WS_SSQ1), (bf16_t*)(F.ws + WS_MS) - (size_t)YPR * 1024};
            pg8::gemm_phase<EpiP5A, SchedTile>(F.lds, 1024, S, E, F.wave);
            unit_publish_wt(F, CW_DEP + 256);
        }
        else if (u < Q2) {
            const int k = u - QA, pm = 64 + (k >> 2), pn = k & 3;
            unit_wait(F, CW_DEP, 16u); unit_wait(F, CW_DEP + 256, 8u);
            SchedTile S{(const char*)(F.ob + DO_Q) + (size_t)yrow_to_r(pm) * 1024 * 2, nullptr, (const char*)(F.ws + WS_WBA) + (size_t)pn * 256 * 1024 * 2, nullptr, pm, pn, 1};
            EpiP5B E{(const bf16_t*)(F.ws + WS_GA), (bf16_t*)(F.ws + WS_MS) - (size_t)YPR * 1024};
            pg8::gemm_phase<EpiP5B, SchedTile>(F.lds, 1024, S, E, F.wave);
            unit_publish_wt(F, CW_DEP + 64);
        }
        else if (u < Q3) ssd_chain_unit(F, u - Q2);
        else if (u >= Q4 && u < Q5) {
            const int k = u - Q4, pm = 64 + (k >> 2), pn = k & 3;
            unit_wait(F, CW_DEP + 64, 8u);
            SchedTile S{(const char*)(F.ws + WS_MS) + (size_t)(pm - 64) * 256 * 1024 * 2, nullptr, (const char*)(F.ws + WS_WOUT) + (size_t)pn * 256 * 1024 * 2, nullptr, pm, pn, 1};
            EpiP6T<true> E{F.in[0], F.in[1], (bf16_t*)(F.ws + WS_HBS) - (size_t)YPR * 1024, (float*)(F.ws + WS_SSQ2)};
            pg8::gemm_phase<EpiP6T<true>, SchedTile>(F.lds, 1024, S, E, F.wave);
            unit_publish_wt(F, CW_DEP + 128);
        }
        else if (u >= Q6 && u < Q7) {
            const int k = u - Q6, pm = 64 + k / 22, pn = k % 22;
            unit_wait(F, CW_DEP + 128, 8u);
            SchedTile S{(const char*)(F.ws + WS_HBS) + (size_t)(pm - 64) * 256 * 1024 * 2, nullptr, (const char*)(F.ws + WS_WGU) + (size_t)pn * 256 * 1024 * 2, nullptr, pm, pn, 1};
            EpiP7 E{(const float*)(F.ws + WS_SSQ2), (bf16_t*)(F.ws + WS_ACTS) - (size_t)YPR * DFF};
            pg8::gemm_phase<EpiP7, SchedTile>(F.lds, 1024, S, E, F.wave);
        } else {
            const int v = u < Q4 ? u - Q3 : (u < Q6 ? 96 + (u - Q5) : 256 + (u - Q7));
            const int bg = v & 15, c = 32 - (v >> 4); attn_unit<true>(F, bg >> 1, c, bg & 1, 0);
        }
    }
}

constexpr int NPHASE = 9;
#ifndef PROBE_TIMING
#define PROBE_TIMING 0
#endif
#ifndef PROBE_BASE
#define PROBE_BASE 0
#endif
__global__ void __launch_bounds__(NTHR, 2) hybrid_fwd(Args args) {
    extern __shared__ __attribute__((aligned(16))) unsigned char lds[];
    Frame F;
    F.lds = (LAS unsigned char*)lds; F.MISC = (volatile LAS unsigned*)(F.lds + MISC_OFF);
    F.tid = threadIdx.x; F.lane = F.tid & 63; F.wave = __builtin_amdgcn_readfirstlane(F.tid >> 6);
    F.G = gridDim.x; { const int bx = blockIdx.x; F.vcu = (F.G % 8 == 0) ? (bx % 8) * (F.G / 8) + bx / 8 : bx; }
    F.in = args.in; F.out = args.out; F.ws = args.ws; F.ob = (unsigned char*)args.out; F.ctl = (gu32*)(args.ws + WS_CTL);
    if (F.tid < 64) ((LAS unsigned*)(F.lds + MISC_OFF))[F.tid] = 0u;
    __syncthreads();
    const int lo = args.ph_lo, hi = args.ph_hi;
    const bool multi = (hi - lo) > 1;
    XcdBarrier bar; bar.bar = (unsigned*)(F.ctl + CW_BAR) + args.li * XCD_BAR_WORDS; bar.x = 0; bar.st = nullptr;
    if (multi) bar = xcd_barrier_post((unsigned*)(F.ctl + CW_BAR) + args.li * XCD_BAR_WORDS, F.MISC + 8, F.tid);
#define IN(k) (lo <= (k) && (k) < hi)
#if PROBE_TIMING
    LAS unsigned long long* tst = (LAS unsigned long long*)(F.lds + MISC_OFF + 128); int nst = 0;
#define STAMP() do { if (F.tid == 0) tst[nst] = __builtin_amdgcn_s_memrealtime(); ++nst; } while (0)
#else
#define STAMP() do {} while (0)
#endif
    STAMP();
#define SEAM(k) do { refresh_ids(F); if (IN(k) && IN((k) + 1)) xcd_barrier(bar, F.tid); STAMP(); } while (0)
    if (IN(0)) { p0_prologue(F); SEAM(0); }
    if (IN(1)) {
        SchedP1 S{(const char*)(F.ob + DO_HN), (const char*)(F.ws + WS_WIN), F.G, (int)blockIdx.x};
        EpiP1 E{F.ws, F.ob};
        pg8::gemm_phase<EpiP1, SchedP1>(F.lds, 1024, S, E, F.wave);
        { constexpr int FULL = (67 * 29) % 256; if ((int)blockIdx.x >= FULL) cache_to_bf16(F, (int)blockIdx.x - FULL, 256 - FULL); }
        SEAM(1);
    }
    if (IN(2)) { p2_rows(F); SEAM(2); }
    if (IN(3)) { idx_conv_units(F); SEAM(3); }
    if (IN(4)) { mixer_units(F); SEAM(4); }
    if (IN(5)) {
        SchedP5 S{(const char*)(F.ws + WS_XS), (const char*)(F.ob + DO_Q), (const char*)(F.ws + WS_WBS), (const char*)(F.ws + WS_WBA), F.G, (int)blockIdx.x};
        EpiP5 E{(const bf16_t*)(F.ws + WS_GS), (const bf16_t*)(F.ws + WS_GA), (const float*)(F.ws + WS_SSQ1), (bf16_t*)(F.ws + WS_MERGED)};
        pg8::gemm_phase<EpiP5, SchedP5>(F.lds, 1024, S, E, F.wave);
        SEAM(5);
    }
    if (IN(6)) {
        SchedY S{(const char*)(F.ws + WS_MERGED), (const char*)(F.ws + WS_WOUT), 4, 1024, F.G, (int)blockIdx.x};
        EpiP6 E{F.in[0], F.in[1], (bf16_t*)(F.ws + WS_HB), (float*)(F.ws + WS_SSQ2)};
        pg8::gemm_phase<EpiP6, SchedY>(F.lds, 1024, S, E, F.wave);
        SEAM(6);
    }
    if (IN(7)) {
        if (blockIdx.x < 8) {
            const int k = (int)blockIdx.x, pm = 64 + (k >> 2), pn = k & 3;
            SchedTile S{(const char*)(F.ws + WS_ACTS) + (size_t)(pm - 64) * 256 * DFF * 2, nullptr, (const char*)(F.ws + WS_WDN) + (size_t)pn * 256 * DFF * 2, nullptr, pm, pn, 1};
            EpiP8 E{(const bf16_t*)(F.ws + WS_HBS) - (size_t)YPR * 1024, F.out};
            pg8::gemm_phase<EpiP8, SchedTile>(F.lds, DFF, S, E, F.wave);
        }
        SchedP8 S{(const char*)(F.ws + WS_HB), (const char*)(F.ws + WS_WGU), (int)blockIdx.x};
        EpiP7 E{(const float*)(F.ws + WS_SSQ2), (bf16_t*)(F.ws + WS_ACT)};
        pg8::gemm_phase<EpiP7, SchedP8>(F.lds, 1024, S, E, F.wave);
        SEAM(7);
    }
    if (IN(8)) {
        SchedY S{(const char*)(F.ws + WS_ACT), (const char*)(F.ws + WS_WDN), 4, DFF, F.G, (int)blockIdx.x};
        EpiP8 E{(const bf16_t*)(F.ws + WS_HB), F.out};
        pg8::gemm_phase<EpiP8, SchedY>(F.lds, DFF, S, E, F.wave);
        STAMP();
    }
#if PROBE_TIMING
    __syncthreads();
    if (blockIdx.x == 0 && F.tid < 64) {
        const size_t ooff[5] = {O_KP, O_VP, O_KIP, O_SSMP, O_SSMS};
#pragma unroll
        for (int i = 0; i < 5; ++i) { const int n = (int)((tst[PROBE_BASE + i + 1] - tst[PROBE_BASE + i] + 200) / 400); for (int e = F.tid; e < n && e < 32000; e += 64) ((unsigned*)F.out)[ooff[i] + e] = 0xAAAAAAAAu; }
    }
#endif
#undef IN
#undef SEAM
}

extern "C" void kernel_launch(void* const* d_in, const int* in_sizes, int n_in, void* d_out, int out_size, void* d_ws, size_t ws_size, hipStream_t stream) {
    static int grid = 0;
    if (grid == 0) {
        if (n_in != 27 || out_size != (int)O_END || ws_size < WS_END) { fprintf(stderr, "kernel_launch: unexpected shapes: n_in %d out %d ws %zu (need %zu)\n", n_in, out_size, ws_size, (size_t)WS_END); grid = -1; return; }
        int dev = 0, cus = 0;
        if (hipGetDevice(&dev) != hipSuccess || hipDeviceGetAttribute(&cus, hipDeviceAttributeMultiprocessorCount, dev) != hipSuccess) { grid = -1; return; }
        if (hipFuncSetAttribute((const void*)hybrid_fwd, hipFuncAttributeMaxDynamicSharedMemorySize, LDS_BYTES) != hipSuccess) { fprintf(stderr, "kernel_launch: hipFuncSetAttribute failed\n"); grid = -1; return; }
        (void)hipGetLastError();
        if (cus < 256) { fprintf(stderr, "kernel_launch: built for a 256-CU device (one resident workgroup per CU), found %d CUs\n", cus); grid = -1; return; }
        grid = 256;
    }
    if (grid < 0) return;
    (void)hipMemsetAsync((char*)d_ws + WS_CTL, 0, CTL_ZERO_BYTES, stream);
    Args a{};
    for (int i = 0; i < 27; ++i) a.in[i] = (const float*)d_in[i];
    a.out = (float*)d_out; a.ws = (unsigned char*)d_ws;
#ifndef MK_SPLIT
#define MK_SPLIT 0
#endif
#if MK_SPLIT
    for (int p = 0; p < NPHASE; ++p) { a.ph_lo = p; a.ph_hi = p + 1; a.li = 0; hipLaunchKernelGGL(hybrid_fwd, dim3(grid), dim3(NTHR), LDS_BYTES, stream, a); }
#else
    a.ph_lo = 0; a.ph_hi = NPHASE; a.li = 0; hipLaunchKernelGGL(hybrid_fwd, dim3(grid), dim3(NTHR), LDS_BYTES, stream, a);
#endif
    const hipError_t le = hipPeekAtLastError();
    if (le != hipSuccess) fprintf(stderr, "kernel_launch: launch failed: %s\n", hipGetErrorName(le));
}
```

```cpp
#include <hip/hip_runtime.h>
#include <cstdio>
#include <cstdint>

constexpr int DM = 1024, NBATCH = 8, SEQ = 2048, NMETA = 16, TP = NMETA + SEQ  , DSEQ = 64, PAST = 4096, LS = PAST + DSEQ  ;
constexpr int RPR = NBATCH * TP  , RSR = NBATCH * DSEQ  , RR = RPR + RSR  , RPAD = 17152  ;
constexpr int YPR = NBATCH * SEQ  , YR = YPR + RSR  ;
constexpr int NIN = 7424  , DFF = 2816, NGU = 2 * DFF;
constexpr int SSD_H = 16, SSD_P = 64, SSD_G = 4, SSD_N = 128, CONV_DIM = 2048;
constexpr int NH = 8, NKV = 2, HD = 128, IDXH = 8, IDXD = 64, TOPK = 256;
constexpr float EPS = 1e-6f;
constexpr int SMLD = 96;

constexpr size_t O_YP = 0, O_YS = O_YP + (size_t)YPR * DM, O_KP = O_YS + (size_t)RSR * DM, O_VP = O_KP + (size_t)RPR * 256, O_KIP = O_VP + (size_t)RPR * 256,
                 O_SSMP = O_KIP + (size_t)RPR * 64, O_CVP = O_SSMP + (size_t)NBATCH * 16 * 64 * 128, O_KS = O_CVP + (size_t)NBATCH * 3 * CONV_DIM, O_VS = O_KS + (size_t)RSR * 256,
                 O_KIS = O_VS + (size_t)RSR * 256, O_SSMS = O_KIS + (size_t)RSR * 64, O_CVS = O_SSMS + (size_t)NBATCH * 16 * 64 * 128, O_END = O_CVS + (size_t)NBATCH * 3 * CONV_DIM;
static_assert(O_END == 29302784, "d_out size");
constexpr size_t DO_Q = 0, DO_QI = DO_Q + (size_t)RR * 1024 * 2, DO_CV = DO_QI + (size_t)RR * 512 * 2, DO_YEND = DO_CV + (size_t)NBATCH * PAST * 256 * 2;
static_assert(DO_YEND <= O_KP * 4, "y-region scratch");
constexpr size_t DO_HN = O_KP * 4;
static_assert(DO_HN + (size_t)RPAD * 1024 * 2 <= O_CVP * 4, "hn scratch in tail");

constexpr size_t al256(size_t x) { return (x + 255) / 256 * 256; }
constexpr size_t WS_CTL = 0, CTL_BYTES = 1u << 20, CTL_ZERO_BYTES = 128u << 10;
constexpr size_t WS_WIN = CTL_BYTES, WS_WBS = WS_WIN + (size_t)NIN * 1024 * 2, WS_WBA = WS_WBS + 1024 * 1024 * 2, WS_WOUT = WS_WBA + 1024 * 1024 * 2, WS_WGU = WS_WOUT + 1024 * 1024 * 2,
                 WS_WDN = WS_WGU + (size_t)NGU * 1024 * 2, WS_Z = WS_WDN + (size_t)1024 * DFF * 2, WS_XS = WS_Z + (size_t)RR * 1024 * 2, WS_BC = WS_XS + (size_t)RR * 1024 * 2,
                 WS_GA = WS_BC + (size_t)RR * 1024 * 2, WS_GS = WS_GA + (size_t)RR * 1024 * 2, WS_K = WS_GS + (size_t)RR * 1024 * 2, WS_V = WS_K + (size_t)RR * 256 * 2,
                 WS_SM = WS_V + (size_t)RR * 256 * 2, WS_KI = WS_SM + (size_t)RR * SMLD * 4, WS_CK = WS_KI + (size_t)RR * 64 * 2, WS_MASK = WS_CK + (size_t)NBATCH * PAST * 256 * 2;
constexpr int MASK_LDP = 68, MASK_LDS = 132;
constexpr size_t WS_MASKS = WS_MASK + (size_t)RPR * MASK_LDP * 4, WS_SSQ1 = WS_MASKS + (size_t)RSR * MASK_LDS * 4, WS_SSQ2 = WS_SSQ1 + al256((size_t)RR * 4),
                 WS_PART = WS_SSQ2 + al256((size_t)YR * 4), WS_END = WS_PART + (size_t)32 * 256 * 132 * 4;
constexpr size_t WS_MERGED = WS_Z, WS_ACT = WS_XS, WS_HB = WS_GS, WS_HAL = WS_PART;
static_assert(WS_END <= 268435456, "d_ws map exceeds 256 MiB");
static_assert((size_t)YR * DFF * 2 <= WS_GS - WS_XS, "act overlay");
static_assert((size_t)NBATCH * 33 * 3 * CONV_DIM * 2 <= WS_END - WS_PART, "halo overlay");
constexpr int CW_TMO = 0, CW_BAR = 4096, CW_Q = 16384;
constexpr int CW_DEP = CW_Q + 64 * 32;

#define GAS __attribute__((address_space(1)))
#define LAS __attribute__((address_space(3)))
typedef unsigned short bf16_t;
typedef short bf16x8 __attribute__((ext_vector_type(8)));
typedef short s16x4 __attribute__((ext_vector_type(4)));
typedef float f32x4 __attribute__((ext_vector_type(4)));
typedef float f32x2 __attribute__((ext_vector_type(2)));
typedef float f32x16 __attribute__((ext_vector_type(16)));
typedef unsigned u32x4 __attribute__((ext_vector_type(4)));
typedef unsigned u32x2 __attribute__((ext_vector_type(2)));
typedef GAS unsigned gu32;
#define RLX_AGENT __ATOMIC_RELAXED, __HIP_MEMORY_SCOPE_AGENT
#define LDS_WAIT() asm volatile("s_waitcnt lgkmcnt(0)" ::: "memory")
#define VM_WAIT() asm volatile("s_waitcnt vmcnt(0)" ::: "memory")
__device__ __forceinline__ unsigned cvt_pk_bf16(float lo, float hi) { unsigned r; asm volatile("v_cvt_pk_bf16_f32 %0, %1, %2" : "=v"(r) : "v"(lo), "v"(hi)); return r; }
__device__ __forceinline__ float bf_lo(unsigned w) { return __uint_as_float(w << 16); }
__device__ __forceinline__ float bf_hi(unsigned w) { return __uint_as_float(w & 0xffff0000u); }
__device__ __forceinline__ float bf2f(bf16_t b) { return __uint_as_float((unsigned)b << 16); }
__device__ __forceinline__ bf16_t f2bf(float f) { return (bf16_t)(cvt_pk_bf16(f, 0.f) & 0xffffu); }
__device__ __forceinline__ float sigmoidf_(float x) { return __builtin_amdgcn_rcpf(1.f + __builtin_amdgcn_exp2f(-1.4426950408889634f * x)); }
__device__ __forceinline__ float siluf_(float x) { return x * sigmoidf_(x); }
__device__ __forceinline__ float wave_sum(float v) {
#pragma unroll
    for (int o = 1; o < 64; o <<= 1) v += __shfl_xor(v, o);
    return v;
}

#define XB_TMO      128
#define XB_XCNT(j)  (256  + 64 * (j))
#define XB_XSUB(j)  (1280 + 64 * (j))
#define XB_XGEN(j)  (2304 + 64 * (j))
#define XB_TOP      3328
#define XB_TOPGEN   3392
#define XCD_BAR_WORDS 3456
#define XB_SPIN_CAP (1u << 18)
__device__ __forceinline__ unsigned xb_ld(unsigned* p)              { return __hip_atomic_load(p, __ATOMIC_RELAXED, __HIP_MEMORY_SCOPE_AGENT); }
__device__ __forceinline__ unsigned xb_add(unsigned* p, unsigned v) { return __hip_atomic_fetch_add(p, v, __ATOMIC_RELAXED, __HIP_MEMORY_SCOPE_AGENT); }
__device__ __forceinline__ unsigned xb_xcc_id() { return (unsigned)__builtin_amdgcn_s_getreg((3 << 11) | 20) & 0xFu; }
#define XB_SPIN(cond, bar) do { unsigned _sp = 0; while (cond) { __builtin_amdgcn_s_sleep(1); \
    if ((++_sp & 255u) == 0u) { if (xb_ld(&(bar)[XB_TMO])) break; if (_sp > XB_SPIN_CAP) { atomicAdd(&(bar)[XB_TMO], 1u); break; } } } } while (0)
struct XcdBarrier { unsigned* bar; unsigned x; volatile LAS unsigned* st; };
__device__ __forceinline__ XcdBarrier xcd_barrier_post(unsigned* bar, volatile LAS unsigned* st, const int tid) {
    XcdBarrier b; b.bar = bar; b.x = xb_xcc_id(); b.st = st;
    if (tid == 0) (void)xb_add(&bar[XB_XCNT(b.x)], 1u);
    return b;
}
__device__ __forceinline__ void xcd_barrier_complete(unsigned* bar, unsigned x, unsigned& nloc, unsigned& nx) {
    const unsigned G = gridDim.x * gridDim.y * gridDim.z;
    unsigned sum, cnt, mine, sp = 0u;
    for (;;) {
        sum = 0u; cnt = 0u; mine = 0u;
#pragma unroll
        for (unsigned j = 0; j < 16; ++j) { const unsigned c = xb_ld(&bar[XB_XCNT(j)]); sum += c; cnt += (c > 0u) ? 1u : 0u; mine = (j == x) ? c : mine; }
        if (sum == G) break;
        __builtin_amdgcn_s_sleep(1);
        if ((++sp & 255u) == 0u) { if (xb_ld(&bar[XB_TMO])) break; if (sp > XB_SPIN_CAP) { atomicAdd(&bar[XB_TMO], 1u); break; } }
    }
    nloc = mine > 0u ? mine : 1u; nx = cnt > 0u ? cnt : 1u;
}
__device__ __forceinline__ void xcd_barrier(const XcdBarrier& b, const int tid) {
    asm volatile("s_waitcnt vmcnt(0)" ::: "memory");
    __syncthreads();
    if (tid == 0) {
        unsigned* bar = b.bar;
        __builtin_amdgcn_s_waitcnt(0);
        unsigned nloc = b.st[0], nx = b.st[1];
        if (nloc == 0u) { xcd_barrier_complete(bar, b.x, nloc, nx); b.st[0] = nloc; b.st[1] = nx; }
        const unsigned old = xb_add(&bar[XB_XSUB(b.x)], 1u);
        const unsigned gen = old / nloc;
        if (old + 1u == (gen + 1u) * nloc) {
            __builtin_amdgcn_fence(__ATOMIC_RELEASE, "agent");
            asm volatile("s_waitcnt vmcnt(0)" ::: "memory");
            const unsigned og = xb_add(&bar[XB_TOP], 1u);
            const unsigned tg = og / nx;
            if (og + 1u == (tg + 1u) * nx) xb_add(&bar[XB_TOPGEN], 1u);
            else XB_SPIN(xb_ld(&bar[XB_TOPGEN]) == tg, bar);
            __builtin_amdgcn_fence(__ATOMIC_ACQUIRE, "agent");
            xb_add(&bar[XB_XGEN(b.x)], 1u);
            asm volatile("s_waitcnt vmcnt(0)" ::: "memory");
        } else {
            XB_SPIN(xb_ld(&bar[XB_XGEN(b.x)]) == gen, bar);
            __builtin_amdgcn_fence(__ATOMIC_ACQUIRE, "agent");
            asm volatile("s_waitcnt vmcnt(0)" ::: "memory");
        }
    }
    __syncthreads();
}

namespace pg8 {
constexpr int BM = 256, BK = 64, HALF = 128, HTB = HALF * BK * 2, STAGE_BYTES = 8 * HTB, NXCD = 8, WGM = 8;
__host__ __device__ __forceinline__ int lds_byte(int r, int c) { const int st = (r >> 4) * 2 + (c >> 5), rr = r & 15, cc = c & 31, ob = rr * 64 + cc * 2; return st * 1024 + (ob ^ (((ob >> 9) & 1) << 5)); }
__host__ __device__ __forceinline__ void stage_rc(int b, int& R, int& C) { const int st = b / 1024, sb = b % 1024, swz = sb ^ (((sb >> 9) & 1) << 5); R = (st >> 1) * 16 + swz / 64; C = (st & 1) * 32 + (swz % 64) / 2; }
__host__ __device__ __forceinline__ int perm32(int rho) { const int n = rho >> 4, i = rho & 15; return 8 * (i >> 2) + 4 * n + (i & 3); }
struct Unit { int pm, pn, part; const char* A; const char* B; };
__device__ __forceinline__ void tile_of(int L, int nM, int nN, int& pm, int& pn) {
    const int nwg = nM * nN; int wgid = L; { const int q = nwg / NXCD, r = nwg % NXCD, xcd = wgid % NXCD, off = wgid / NXCD; wgid = (xcd < r ? xcd * (q + 1) : r * (q + 1) + (xcd - r) * q) + off; }
    const int nig = WGM * nN, gid = wgid / nig, fm = gid * WGM, gsz = (nM - fm) < WGM ? (nM - fm) : WGM;
    pm = fm + ((wgid % nig) % gsz); pn = (wgid % nig) / gsz;
}
typedef f32x4 Acc[2][2][4][2];
template <class Epi, class Sched>
__device__ __forceinline__ void gemm_phase(LAS unsigned char* lds, const int K, const Sched& S, const Epi& E, const int wave_id) {
    int tid_; asm volatile("v_mbcnt_lo_u32_b32 %0, -1, 0\n\tv_mbcnt_hi_u32_b32 %0, -1, %0" : "=v"(tid_)); tid_ += 64 * wave_id;
    const int tid = tid_, wid = __builtin_amdgcn_readfirstlane(tid >> 6), lane = tid & 63, wr = wid >> 2, wc = wid & 3, fr = lane & 15, fq = lane >> 4;
    const int nt = K / BK;
    unsigned voffA[2], voffB[2];
#pragma unroll
    for (int i = 0; i < 2; ++i) { int R, C; stage_rc(tid * 16 + i * 8192, R, C); const int Rb = Epi::PERM ? ((R & ~31) + perm32(R & 31)) : R;
        voffA[i] = (unsigned)(R * K + C) * 2u; voffB[i] = (unsigned)(Rb * K + C) * 2u; }
    const size_t kstep = (size_t)(BK * 2);
    const size_t hstep = (size_t)HALF * K * 2;
    const unsigned ldsw = (unsigned)wid * 1024u;
    const int aoff = lds_byte(wr * 64 + fr, fq * 8), boff = lds_byte(wc * 32 + fr, fq * 8);
#define PG8_SA(b, h) (((b) * 2 + (h)) * HTB)
#define PG8_SB(b, h) ((4 + (b) * 2 + (h)) * HTB)
#define PG8_STAGE(bufoff, gbase, voff) do { _Pragma("unroll") for (int _i = 0; _i < 2; ++_i) \
        __builtin_amdgcn_global_load_lds((const unsigned*)((const char*)(gbase) + (voff)[_i]), (LAS unsigned*)(lds + (bufoff) + ldsw + _i * 8192), 16, 0, 0); } while (0)
#define PG8_LDA(dst, b, h) do { _Pragma("unroll") for (int m = 0; m < 4; ++m) _Pragma("unroll") for (int k = 0; k < 2; ++k) dst[m][k] = *(const LAS bf16x8*)(lds + PG8_SA(b, h) + aoff + m * 2048 + k * 1024); } while (0)
#define PG8_LDB(dst, b, h) do { _Pragma("unroll") for (int n = 0; n < 2; ++n) _Pragma("unroll") for (int k = 0; k < 2; ++k) dst[n][k] = *(const LAS bf16x8*)(lds + PG8_SB(b, h) + boff + n * 2048 + k * 1024); } while (0)
#define PG8_MMA(ai, bj, At, Bt) do { __builtin_amdgcn_s_setprio(1); _Pragma("unroll") for (int m = 0; m < 4; ++m) _Pragma("unroll") for (int n = 0; n < 2; ++n) _Pragma("unroll") for (int k = 0; k < 2; ++k) \
        acc[ai][bj][m][n] = __builtin_amdgcn_mfma_f32_16x16x32_bf16(Bt[n][k], At[m][k], acc[ai][bj][m][n], 0, 0, 0); __builtin_amdgcn_s_setprio(0); } while (0)
#define PG8_WAIT_V(n) asm volatile("s_waitcnt vmcnt(" #n ")" ::: "memory")
#define PG8_WAIT_L(n) asm volatile("s_waitcnt lgkmcnt(" #n ")" ::: "memory")
#define PG8_BAR __builtin_amdgcn_s_barrier()
#define PG8_SCHED __builtin_amdgcn_sched_barrier(0)
    Unit cur, nxt; int ui = 0;
    if (!S.next(0, cur)) return;
    Acc acc;
#pragma unroll
    for (int a = 0; a < 2; ++a)
#pragma unroll
        for (int b = 0; b < 2; ++b)
#pragma unroll
            for (int m = 0; m < 4; ++m)
#pragma unroll
                for (int n = 0; n < 2; ++n) acc[a][b][m][n] = (f32x4){0.f, 0.f, 0.f, 0.f};
    bf16x8 At[4][2], B0[2][2], B1[2][2];
    const char* cA = cur.A; const char* cB = cur.B;
    PG8_STAGE(PG8_SB(0, 0), cB, voffB); PG8_STAGE(PG8_SB(0, 1), cB + hstep, voffB); PG8_STAGE(PG8_SA(0, 0), cA, voffA); PG8_STAGE(PG8_SA(0, 1), cA + hstep, voffA);
    if (wr == 1) PG8_BAR;
    PG8_WAIT_V(2); PG8_BAR;
    PG8_STAGE(PG8_SB(1, 0), cB + kstep, voffB); PG8_STAGE(PG8_SA(1, 0), cA + kstep, voffA); PG8_STAGE(PG8_SB(1, 1), cB + hstep + kstep, voffB);
    PG8_WAIT_V(6); PG8_BAR;
    for (;;) {
        const bool has_next = S.next(ui + 1, nxt);
        const char* nA = has_next ? nxt.A : cA; const char* nB = has_next ? nxt.B : cB;
        for (int t = 0; t < nt; t += 2) {
            const bool last = (t == nt - 2);
            const char* a1 = cA + (size_t)(t + 1) * kstep;
            const char* a2 = last ? nA : cA + (size_t)(t + 2) * kstep; const char* b2 = last ? nB : cB + (size_t)(t + 2) * kstep;
            const char* a3 = a2 + kstep; const char* b3 = b2 + kstep;
            PG8_LDB(B0, 0, 0); PG8_LDB(B1, 0, 1); PG8_SCHED; PG8_LDA(At, 0, 0); PG8_STAGE(PG8_SA(1, 1), a1 + hstep, voffA);
            PG8_WAIT_V(8); PG8_WAIT_L(0); PG8_BAR; PG8_MMA(0, 0, At, B0); PG8_MMA(0, 1, At, B1); PG8_BAR; PG8_SCHED;
            PG8_LDA(At, 0, 1); PG8_STAGE(PG8_SB(0, 0), b2, voffB); PG8_STAGE(PG8_SB(0, 1), b2 + hstep, voffB); PG8_STAGE(PG8_SA(0, 0), a2, voffA);
            PG8_WAIT_V(8); PG8_WAIT_L(0); PG8_BAR; PG8_MMA(1, 0, At, B0); PG8_MMA(1, 1, At, B1); PG8_BAR; PG8_SCHED;
            PG8_LDB(B0, 1, 0); PG8_LDB(B1, 1, 1); PG8_SCHED; PG8_LDA(At, 1, 0); PG8_STAGE(PG8_SA(0, 1), a2 + hstep, voffA);
            PG8_WAIT_V(8); PG8_WAIT_L(0); PG8_BAR; PG8_MMA(0, 0, At, B0); PG8_MMA(0, 1, At, B1); PG8_BAR; PG8_SCHED;
            PG8_LDA(At, 1, 1); PG8_STAGE(PG8_SB(1, 0), b3, voffB); PG8_STAGE(PG8_SB(1, 1), b3 + hstep, voffB); PG8_STAGE(PG8_SA(1, 0), a3, voffA);
            PG8_WAIT_V(8); PG8_WAIT_L(0); PG8_BAR; PG8_MMA(1, 0, At, B0); PG8_MMA(1, 1, At, B1); PG8_BAR; PG8_SCHED;
        }
        if (wr == 0) PG8_BAR;
        const bool keep = E(acc, cur, wr, wc, fr, fq);
        if (!has_next) break;
        if (!keep) {
#pragma unroll
            for (int a = 0; a < 2; ++a)
#pragma unroll
                for (int b = 0; b < 2; ++b)
#pragma unroll
                    for (int m = 0; m < 4; ++m)
#pragma unroll
                        for (int n = 0; n < 2; ++n) acc[a][b][m][n] = (f32x4){0.f, 0.f, 0.f, 0.f};
        }
        cur = nxt; cA = nA; cB = nB; ++ui;
        if (wr == 1) PG8_BAR;
    }
    PG8_WAIT_V(0);
    PG8_BAR;
#undef PG8_SA
#undef PG8_SB
#undef PG8_STAGE
#undef PG8_LDA
#undef PG8_LDB
#undef PG8_MMA
#undef PG8_WAIT_V
#undef PG8_WAIT_L
#undef PG8_BAR
#undef PG8_SCHED
}
}

struct Args { const float* in[27]; float* out; unsigned char* ws; int ph_lo, ph_hi, li, pad; };
constexpr int NWAVES = 8, NTHR = 512;
constexpr int RING_BYTES = 131072, LDS_BYTES = 147456, MISC_OFF = LDS_BYTES - 256;

struct Frame {
    LAS unsigned char* lds; volatile LAS unsigned* MISC; gu32* ctl;
    int tid, lane, wave, vcu, G;
    const float* const* in; float* out; unsigned char* ws; unsigned char* ob;
};

__device__ __forceinline__ void refresh_ids(Frame& F) { int l; asm volatile("v_mbcnt_lo_u32_b32 %0, -1, 0\n\tv_mbcnt_hi_u32_b32 %0, -1, %0" : "=v"(l)); F.lane = l; F.tid = F.wave * 64 + l; }

__device__ __forceinline__ void unit_publish(Frame& F, int ctr_word) {
    asm volatile("s_waitcnt vmcnt(0)" ::: "memory"); __syncthreads();
    if (F.tid == 0) { __builtin_amdgcn_fence(__ATOMIC_RELEASE, "agent"); asm volatile("s_waitcnt vmcnt(0)" ::: "memory");
        const unsigned o_ = __hip_atomic_fetch_add((unsigned*)(F.ctl + ctr_word), 1u, __ATOMIC_RELAXED, __HIP_MEMORY_SCOPE_AGENT); asm volatile("" :: "v"(o_)); }
    __syncthreads();
}
__device__ __forceinline__ void unit_wait(Frame& F, int ctr_word, unsigned need) {
    if (F.tid == 0) { unsigned sp = 0u; while (__hip_atomic_load((unsigned*)(F.ctl + ctr_word), __ATOMIC_RELAXED, __HIP_MEMORY_SCOPE_AGENT) < need) { __builtin_amdgcn_s_sleep(16); if (++sp > (1u << 18)) break; }
        __builtin_amdgcn_fence(__ATOMIC_ACQUIRE, "agent"); asm volatile("s_waitcnt vmcnt(0)" ::: "memory"); }
    __syncthreads();
}

typedef __attribute__((address_space(8))) void* rsrc_t;
__device__ __forceinline__ void wt_store16(void* p, u32x4 v) {
    asm volatile("global_store_dwordx4 %0, %1, off sc1\n\ts_nop 1" :: "v"(p), "v"(v) : "memory"); }
__device__ __forceinline__ void wt_store8(void* p, u32x2 v) { __hip_atomic_store((unsigned long long*)p, ((unsigned long long)v.y << 32) | v.x, __ATOMIC_RELAXED, __HIP_MEMORY_SCOPE_AGENT); }
__device__ __forceinline__ void unit_publish_wt(Frame& F, int ctr_word) {
    asm volatile("s_waitcnt vmcnt(0)" ::: "memory"); __syncthreads();
    if (F.tid == 0) { const unsigned o_ = __hip_atomic_fetch_add((unsigned*)(F.ctl + ctr_word), 1u, __ATOMIC_RELAXED, __HIP_MEMORY_SCOPE_AGENT); asm volatile("" :: "v"(o_)); }
    __syncthreads();
}

__device__ __forceinline__ int win_src(int n) {
    if (n < 3072) return n;
    if (n < 4096) return 3088 + (n - 3072);
    if (n < 4352) return 4112 + (n - 4096);
    if (n < 4608) return 4368 + (n - 4352);
    if (n < 5120) return 4624 + (n - 4608);
    if (n < 6144) return 5208 + (n - 5120);
    if (n < 7168) return 6232 + (n - 6144);
    if (n < 7184) return 3072 + (n - 7168);
    if (n < 7248) return 5136 + (n - 7184);
    if (n < 7256) return 5200 + (n - 7248);
    return -1;
}
template <bool VEC, class SrcFn>
__device__ __forceinline__ void p0_transpose_item(SrcFn src, int ldw, int Kdim, bf16_t* WT, LAS float* scr, int kb, int nb, int lane, const float* ksc = nullptr) {
    const int k0 = 64 * kb, n0 = 32 * nb;
    if (VEC) {
        const float* cp = src(n0 + 4 * (lane & 7)) + (size_t)(k0 + (lane >> 3)) * ldw;
#pragma unroll
        for (int i = 0; i < 8; ++i) { const f32x4 v = *(const f32x4*)(cp + (size_t)(8 * i) * ldw); LAS float* d = scr + (8 * i + (lane >> 3)) * 33 + 4 * (lane & 7); d[0] = v.x; d[1] = v.y; d[2] = v.z; d[3] = v.w; }
    } else {
        const float* cp = src(n0 + (lane & 31));
#pragma unroll 8
        for (int i = 0; i < 32; ++i) { const int kk = 2 * i + (lane >> 5); scr[kk * 33 + (lane & 31)] = cp ? cp[(size_t)(k0 + kk) * ldw] : 0.f; }
    }
    LDS_WAIT(); asm volatile("" ::: "memory");
    const int c = lane & 7;
    f32x4 k0s = {1.f, 1.f, 1.f, 1.f}, k1s = k0s;
    if (ksc) { k0s = *(const f32x4*)(ksc + k0 + 8 * c); k1s = *(const f32x4*)(ksc + k0 + 8 * c + 4); }
#pragma unroll
    for (int j = 0; j < 4; ++j) { const int n = (lane >> 3) + 8 * j; const LAS float* s = scr + (8 * c) * 33 + n;
        u32x4 o; o.x = cvt_pk_bf16(s[0 * 33] * k0s.x, s[1 * 33] * k0s.y); o.y = cvt_pk_bf16(s[2 * 33] * k0s.z, s[3 * 33] * k0s.w); o.z = cvt_pk_bf16(s[4 * 33] * k1s.x, s[5 * 33] * k1s.y); o.w = cvt_pk_bf16(s[6 * 33] * k1s.z, s[7 * 33] * k1s.w);
        *(GAS u32x4*)(WT + (size_t)(n0 + n) * Kdim + k0 + 8 * c) = o; }
    LDS_WAIT(); asm volatile("" ::: "memory");
}
__device__ __forceinline__ void cache_to_bf16(Frame& F, int wi, int nw) {
    const f32x4* ck = (const f32x4*)F.in[2]; const f32x4* cv = (const f32x4*)F.in[3]; GAS u32x4* ok = (GAS u32x4*)(F.ws + WS_CK); GAS u32x4* ov = (GAS u32x4*)(F.ob + DO_CV);
    const long n8 = (long)NBATCH * PAST * 256 / 8; const long gt = (long)wi * NTHR + F.tid, GT = (long)nw * NTHR;
    for (long i = gt; i < 2 * n8; i += 8 * GT) {
        f32x4 a[8], b[8];
#pragma unroll
        for (int u = 0; u < 8; ++u) { const long iu = i + u * GT; if (iu < 2 * n8) { const bool isk = iu < n8; const long j = isk ? iu : iu - n8; const f32x4* s = (isk ? ck : cv) + 2 * j; a[u] = s[0]; b[u] = s[1]; } }
#pragma unroll
        for (int u = 0; u < 8; ++u) { const long iu = i + u * GT; if (iu < 2 * n8) { const bool isk = iu < n8; const long j = isk ? iu : iu - n8;
            u32x4 o; o.x = cvt_pk_bf16(a[u].x, a[u].y); o.y = cvt_pk_bf16(a[u].z, a[u].w); o.z = cvt_pk_bf16(b[u].x, b[u].y); o.w = cvt_pk_bf16(b[u].z, b[u].w);
            (isk ? ok : ov)[j] = o; } }
    }
}
__device__ __forceinline__ void p0_prologue(Frame& F) {
    LAS float* scr = (LAS float*)(F.lds + F.wave * 16384);
    const int gw = F.vcu * NWAVES + F.wave, NGW = F.G * NWAVES, lane = F.lane;
    const float* w_in = F.in[10]; const float* w_bs = F.in[20]; const float* w_ba = F.in[21]; const float* w_out = F.in[22];
    const float* w_gate = F.in[24]; const float* w_up = F.in[25]; const float* w_dn = F.in[26];
    bf16_t* WIN = (bf16_t*)(F.ws + WS_WIN); bf16_t* WBS = (bf16_t*)(F.ws + WS_WBS); bf16_t* WBA = (bf16_t*)(F.ws + WS_WBA); bf16_t* WOUT = (bf16_t*)(F.ws + WS_WOUT);
    bf16_t* WGU = (bf16_t*)(F.ws + WS_WGU); bf16_t* WDN = (bf16_t*)(F.ws + WS_WDN);
    constexpr int I_IN = 16 * (NIN / 32), I_SQ = 16 * 32, I_GU = 16 * (NGU / 32), I_DN = (DFF / 64) * 32;
    constexpr int NITEMS = I_IN + 3 * I_SQ + I_GU + I_DN;
    for (int it = gw; it < NITEMS; it += NGW) {
        int r = it;
        if (r < I_IN) { const int nb = r % (NIN / 32), kb = r / (NIN / 32);
            if (nb < 224) p0_transpose_item<true>([&](int n) -> const float* { return w_in + win_src(n); }, 7256, 1024, WIN, scr, kb, nb, lane);
            else p0_transpose_item<false>([&](int n) -> const float* { const int s = win_src(n); return s >= 0 ? w_in + s : nullptr; }, 7256, 1024, WIN, scr, kb, nb, lane); continue; } r -= I_IN;
        if (r < I_SQ) { p0_transpose_item<true>([&](int n) -> const float* { return w_bs + n; }, 1024, 1024, WBS, scr, r / 32, r % 32, lane); continue; } r -= I_SQ;
        if (r < I_SQ) { p0_transpose_item<true>([&](int n) -> const float* { return w_ba + n; }, 1024, 1024, WBA, scr, r / 32, r % 32, lane); continue; } r -= I_SQ;
        if (r < I_SQ) { p0_transpose_item<true>([&](int n) -> const float* { return w_out + n; }, 1024, 1024, WOUT, scr, r / 32, r % 32, lane); continue; } r -= I_SQ;
        if (r < I_GU) { const int nb = r % (NGU / 32), kb = r / (NGU / 32);
            p0_transpose_item<true>([&](int n) -> const float* { const int t = n >> 8, j = n & 255, ch = t * 128 + (j >> 3) * 4 + (j & 3); return ((j & 4) ? w_up : w_gate) + ch; }, DFF, 1024, WGU, scr, kb, nb, lane, F.in[23]); continue; } r -= I_GU;
        p0_transpose_item<true>([&](int n) -> const float* { return w_dn + n; }, 1024, DFF, WDN, scr, r / 32, r % 32, lane);
    }
    const float* xp = F.in[0]; const float* xs = F.in[1]; const float* meta = F.in[7]; const float* n1w = F.in[9];
    bf16_t* HN = (bf16_t*)(F.ob + DO_HN);
    f32x4 wv[4];
#pragma unroll
    for (int j = 0; j < 4; ++j) wv[j] = *((const f32x4*)n1w + lane + 64 * j);
    for (int m = gw; m < RPAD; m += NGW) {
        GAS u32x2* o8 = (GAS u32x2*)(HN + (size_t)m * DM) + lane;
        if (m >= RR) {
#pragma unroll
            for (int j = 0; j < 4; ++j) o8[64 * j] = (u32x2){0u, 0u};
            continue; }
        const float* xrow;
        if (m < RPR) { const int b = m / TP, t = m - b * TP; xrow = t < NMETA ? meta + (size_t)t * DM : xp + ((size_t)b * SEQ + (t - NMETA)) * DM; }
        else xrow = xs + (size_t)(m - RPR) * DM;
        const f32x4* xr = (const f32x4*)xrow + lane;
        f32x4 v[4]; float s = 0.f;
#pragma unroll
        for (int j = 0; j < 4; ++j) { v[j] = xr[64 * j]; s += (v[j].x * v[j].x + v[j].y * v[j].y) + (v[j].z * v[j].z + v[j].w * v[j].w); }
        const float rs = __builtin_amdgcn_rsqf(wave_sum(s) * (1.f / DM) + EPS);
#pragma unroll
        for (int j = 0; j < 4; ++j) { const f32x4 y = v[j] * rs * wv[j]; o8[64 * j] = (u32x2){cvt_pk_bf16(y.x, y.y), cvt_pk_bf16(y.z, y.w)}; }
    }
    { float* s1 = (float*)(F.ws + WS_SSQ1); const int gt = F.vcu * NTHR + F.tid, GT = F.G * NTHR;
      for (int i = gt; i < (int)((WS_PART - WS_SSQ1) / 4); i += GT) s1[i] = 0.f; }
}

struct SchedP1 {
    const char* A; const char* B; int G, c;
    __device__ __forceinline__ bool next(int i, pg8::Unit& u) const {
        const int L = i * G + c; if (L >= 67 * 29) return false;
        pg8::tile_of(L, 67, 29, u.pm, u.pn); u.part = 0; u.A = A + (size_t)u.pm * 256 * 1024 * 2; u.B = B + (size_t)u.pn * 256 * 1024 * 2; return true; }
};
struct EpiP1 {
    static constexpr bool PERM = true;
    unsigned char* ws; unsigned char* ob;
    __device__ __forceinline__ bool operator()(pg8::Acc& acc, const pg8::Unit& u, int wr, int wc, int fr, int fq) const {
        const int pn = u.pn; const int row0 = u.pm * 256 + wr * 64 + fr, cw = wc * 32 + 8 * fq;
        if (pn == 28) {
            float* SM = (float*)(ws + WS_SM);
            if (cw < SMLD) {
#pragma unroll
                for (int ai = 0; ai < 2; ++ai)
#pragma unroll
                    for (int m = 0; m < 4; ++m) { const int r = row0 + ai * 128 + m * 16; if (r < RR) { float* p = SM + (size_t)r * SMLD + cw; *(f32x4*)p = acc[ai][0][m][0]; *(f32x4*)(p + 4) = acc[ai][0][m][1]; } }
            }
            return false;
        }
        bf16_t* base; int ld, c0;
        if (pn < 4) { base = (bf16_t*)(ws + WS_Z); ld = 1024; c0 = pn * 256; }
        else if (pn < 8) { base = (bf16_t*)(ws + WS_XS); ld = 1024; c0 = (pn - 4) * 256; }
        else if (pn < 12) { base = (bf16_t*)(ws + WS_BC); ld = 1024; c0 = (pn - 8) * 256; }
        else if (pn < 16) { base = (bf16_t*)(ob + DO_Q); ld = 1024; c0 = (pn - 12) * 256; }
        else if (pn == 16) { base = (bf16_t*)(ws + WS_K); ld = 256; c0 = 0; }
        else if (pn == 17) { base = (bf16_t*)(ws + WS_V); ld = 256; c0 = 0; }
        else if (pn < 20) { base = (bf16_t*)(ob + DO_QI); ld = 512; c0 = (pn - 18) * 256; }
        else if (pn < 24) { base = (bf16_t*)(ws + WS_GS); ld = 1024; c0 = (pn - 20) * 256; }
        else { base = (bf16_t*)(ws + WS_GA); ld = 1024; c0 = (pn - 24) * 256; }
#pragma unroll
        for (int ai = 0; ai < 2; ++ai)
#pragma unroll
            for (int m = 0; m < 4; ++m) { const int r = row0 + ai * 128 + m * 16;
                if (r < RR) { bf16_t* rowp = base + (size_t)r * ld + c0 + cw;
#pragma unroll
                    for (int bj = 0; bj < 2; ++bj) { const f32x4 v0 = acc[ai][bj][m][0], v1 = acc[ai][bj][m][1];
                        u32x4 w; w.x = cvt_pk_bf16(v0[0], v0[1]); w.y = cvt_pk_bf16(v0[2], v0[3]); w.z = cvt_pk_bf16(v1[0], v1[1]); w.w = cvt_pk_bf16(v1[2], v1[3]);
                        *(u32x4*)(rowp + bj * 128) = w; } } }
        return false;
    }
};

__device__ __forceinline__ void p2_rows(Frame& F) {
    const int gw = F.vcu * NWAVES + F.wave, NGW = F.G * NWAVES, lane = F.lane;
    bf16_t* K = (bf16_t*)(F.ws + WS_K); const bf16_t* V = (const bf16_t*)(F.ws + WS_V);
    float* SM = (float*)(F.ws + WS_SM); bf16_t* KI = (bf16_t*)(F.ws + WS_KI);
    const float* knw = F.in[18]; const float* ikw = F.in[19]; const float* dtb = F.in[13];
    const f32x4 kw = *(const f32x4*)(knw + (lane & 31) * 4);
    const float iw = ikw[lane]; const float dbias = lane < 16 ? dtb[lane] : 0.f;
    const int item = gw; u32x4 ixs[2] = {{0u, 0u, 0u, 0u}, {0u, 0u, 0u, 0u}}, ibc[2] = {{0u, 0u, 0u, 0u}, {0u, 0u, 0u, 0u}};
    if (item < 48 + 768) { int r;
        if (item < 48) { const int s = item / 3, i = item % 3; r = s < 8 ? s * TP + (TP - 3 + i) : RPR + (s - 8) * DSEQ + (DSEQ - 3 + i); }
        else { const int h = item - 48, b = h / 96, jb = (h % 96) / 3, i = h % 3; r = b * TP + 64 * (jb + 1) - 3 + i; }
#pragma unroll
        for (int j = 0; j < 2; ++j) { const int c = j * 512 + lane * 8; ixs[j] = *(const u32x4*)((const bf16_t*)(F.ws + WS_XS) + (size_t)r * 1024 + c); ibc[j] = *(const u32x4*)((const bf16_t*)(F.ws + WS_BC) + (size_t)r * 1024 + c); } }
    u32x2 nk, nv; float nki, ndt, nwi;
#define P2_LOAD(rr) do { nk = *((const u32x2*)(K + (size_t)(rr) * 256) + lane); nv = *((const u32x2*)(V + (size_t)(rr) * 256) + lane); \
        const float* sm_ = SM + (size_t)(rr) * SMLD; nki = sm_[16 + lane]; ndt = sm_[lane & 15]; nwi = sm_[80 + (lane & 7)]; } while (0)
    if (gw < RR) P2_LOAD(gw);
    for (int r = gw; r < RR; r += NGW) {
        const u32x2 kin = nk, vv = nv; const float kv = nki, dtv = ndt, wiv = nwi;
        if (r + NGW < RR) P2_LOAD(r + NGW);
        const bool pr = r < RPR; const size_t orow = pr ? (size_t)r : (size_t)(r - RPR);
        float* k_out = F.out + (pr ? O_KP : O_KS) + orow * 256; float* v_out = F.out + (pr ? O_VP : O_VS) + orow * 256; float* ki_out = F.out + (pr ? O_KIP : O_KIS) + orow * 64;
        { u32x2* kp = (u32x2*)(K + (size_t)r * 256) + lane;
          f32x4 x = {bf_lo(kin.x), bf_hi(kin.x), bf_lo(kin.y), bf_hi(kin.y)};
          float s = (x.x * x.x + x.y * x.y) + (x.z * x.z + x.w * x.w);
          s += __shfl_xor(s, 1); s += __shfl_xor(s, 2); s += __shfl_xor(s, 4); s += __shfl_xor(s, 8); s += __shfl_xor(s, 16);
          const float rs = __builtin_amdgcn_rsqf(s * (1.f / HD) + EPS);
          x = x * rs * kw;
          *kp = (u32x2){cvt_pk_bf16(x.x, x.y), cvt_pk_bf16(x.z, x.w)};
          *((f32x4*)k_out + lane) = x;
          *((f32x4*)v_out + lane) = (f32x4){bf_lo(vv.x), bf_hi(vv.x), bf_lo(vv.y), bf_hi(vv.y)}; }
        { float* sm = SM + (size_t)r * SMLD;
          const float ss = wave_sum(kv * kv);
          const float kn = kv * __builtin_amdgcn_rsqf(ss * (1.f / IDXD) + EPS) * iw;
          KI[(size_t)r * 64 + lane] = f2bf(kn); ki_out[lane] = kn;
          if (lane < 16) { const float x = dtv + dbias; sm[lane] = x > 20.f ? x : log1pf(expf(x)); }
          if (lane < 8) sm[80 + lane] = wiv * 0.04419417382415922f; }
    }
#undef P2_LOAD
    if (item < 48) { const int s = item / 3, i = item % 3; float* o = F.out + (s < 8 ? O_CVP + (size_t)(s * 3 + i) * CONV_DIM : O_CVS + (size_t)((s - 8) * 3 + i) * CONV_DIM);
#pragma unroll
        for (int j = 0; j < 2; ++j) { const int c = j * 512 + lane * 8; const u32x4 xa = ixs[j], xb = ibc[j];
            *(f32x4*)(o + c) = (f32x4){bf_lo(xa.x), bf_hi(xa.x), bf_lo(xa.y), bf_hi(xa.y)}; *(f32x4*)(o + c + 4) = (f32x4){bf_lo(xa.z), bf_hi(xa.z), bf_lo(xa.w), bf_hi(xa.w)};
            *(f32x4*)(o + 1024 + c) = (f32x4){bf_lo(xb.x), bf_hi(xb.x), bf_lo(xb.y), bf_hi(xb.y)}; *(f32x4*)(o + 1024 + c + 4) = (f32x4){bf_lo(xb.z), bf_hi(xb.z), bf_lo(xb.w), bf_hi(xb.w)}; } }
    else if (item < 48 + 768) { const int h = item - 48, b = h / 96, jb = (h % 96) / 3, i = h % 3; bf16_t* o = (bf16_t*)(F.ws + WS_HAL) + (size_t)((b * 33 + jb + 1) * 3 + i) * CONV_DIM;
#pragma unroll
        for (int j = 0; j < 2; ++j) { const int c = j * 512 + lane * 8; *(u32x4*)(o + c) = ixs[j]; *(u32x4*)(o + 1024 + c) = ibc[j]; } }
}

__device__ __forceinline__ int t5_bucket(int rel) {
    const int n = rel < 0 ? -rel : rel; const int ret = rel > 0 ? 16 : 0;
    const int v = n < 8 ? n : (n < 12 ? 8 : n < 16 ? 9 : n < 23 ? 10 : n < 32 ? 11 : n < 46 ? 12 : n < 64 ? 13 : n < 91 ? 14 : 15);
    return ret + v;
}
__device__ __forceinline__ void conv_unit(Frame& F, int u) {
    bf16_t* XS = (bf16_t*)(F.ws + WS_XS); bf16_t* BC = (bf16_t*)(F.ws + WS_BC); const bf16_t* HAL = (const bf16_t*)(F.ws + WS_HAL);
    const float* conv_w = F.in[11]; const float* conv_b = F.in[12]; const float* st_conv = F.in[6];
    const int cg = F.tid & 63, rc = F.wave;
    const int cq = u & 1, sb = u >> 1; const bool pr = sb < NBATCH * 33;
    const int b = pr ? sb / 33 : sb - NBATCH * 33, j = pr ? sb % 33 : 0;
    const int T = pr ? TP : DSEQ, row0 = (pr ? b * TP : RPR + b * DSEQ) + 64 * j, nvalid = T - 64 * j;
    const int t0 = 8 * rc;
    u32x4 raw[2][11];
#pragma unroll
    for (int h = 0; h < 2; ++h) { const int ch = 1024 * cq + 512 * h + 8 * cg; const bf16_t* colp = ch < 1024 ? XS + ch : BC + (ch - 1024);
#pragma unroll
        for (int i = 0; i < 11; ++i) { const int t = t0 - 3 + i;
            u32x4 v = {0u, 0u, 0u, 0u};
            if (t >= 0) { if (t < nvalid) v = __builtin_nontemporal_load((const u32x4*)(colp + (size_t)(row0 + t) * 1024)); }
            else if (j > 0) v = *(const u32x4*)(HAL + (size_t)((b * 33 + j) * 3 + (t + 3)) * CONV_DIM + ch);
            raw[h][i] = v; } }
    __syncthreads();
#pragma unroll
    for (int h = 0; h < 2; ++h) { const int ch = 1024 * cq + 512 * h + 8 * cg; bf16_t* colp = ch < 1024 ? XS + ch : BC + (ch - 1024);
        float w[4][8], bias[8];
#pragma unroll
        for (int i = 0; i < 4; ++i) { const f32x4 a = *(const f32x4*)(conv_w + i * CONV_DIM + ch), c = *(const f32x4*)(conv_w + i * CONV_DIM + ch + 4);
            w[i][0] = a.x; w[i][1] = a.y; w[i][2] = a.z; w[i][3] = a.w; w[i][4] = c.x; w[i][5] = c.y; w[i][6] = c.z; w[i][7] = c.w; }
        { const f32x4 a = *(const f32x4*)(conv_b + ch), c = *(const f32x4*)(conv_b + ch + 4); bias[0] = a.x; bias[1] = a.y; bias[2] = a.z; bias[3] = a.w; bias[4] = c.x; bias[5] = c.y; bias[6] = c.z; bias[7] = c.w; }
        float x[4][8];
#define CONV_ROW(dst, i) do { const int t_ = t0 - 3 + (i); \
            if (!pr && t_ < 0) { const float* sp = st_conv + (size_t)(b * 3 + (t_ + 3)) * CONV_DIM + ch; const f32x4 a_ = *(const f32x4*)sp, c_ = *(const f32x4*)(sp + 4); \
                dst[0] = a_.x; dst[1] = a_.y; dst[2] = a_.z; dst[3] = a_.w; dst[4] = c_.x; dst[5] = c_.y; dst[6] = c_.z; dst[7] = c_.w; } \
            else { const u32x4 v_ = raw[h][i]; dst[0] = bf_lo(v_.x); dst[1] = bf_hi(v_.x); dst[2] = bf_lo(v_.y); dst[3] = bf_hi(v_.y); dst[4] = bf_lo(v_.z); dst[5] = bf_hi(v_.z); dst[6] = bf_lo(v_.w); dst[7] = bf_hi(v_.w); } } while (0)
        CONV_ROW(x[0], 0); CONV_ROW(x[1], 1); CONV_ROW(x[2], 2);
#pragma unroll
        for (int r = 0; r < 8; ++r) { const int t = t0 + r;
            CONV_ROW(x[(r + 3) & 3], r + 3);
            if (t < nvalid) { float o[8];
#pragma unroll
                for (int e = 0; e < 8; ++e) o[e] = siluf_(bias[e] + x[r & 3][e] * w[0][e] + x[(r + 1) & 3][e] * w[1][e] + x[(r + 2) & 3][e] * w[2][e] + x[(r + 3) & 3][e] * w[3][e]);
                u32x4 ov; ov.x = cvt_pk_bf16(o[0], o[1]); ov.y = cvt_pk_bf16(o[2], o[3]); ov.z = cvt_pk_bf16(o[4], o[5]); ov.w = cvt_pk_bf16(o[6], o[7]);
                __builtin_nontemporal_store(ov, (u32x4*)(colp + (size_t)(row0 + t) * 1024)); } }
#undef CONV_ROW
    }
    __syncthreads();
}

namespace ssd {
constexpr int CL = 0, BL = 17408, XR = 34816, XW = 44032, WM = 53248, SB = 62464, FA = 79872, LDS_TOT = 80640;
constexpr int LDC = 272, LDX = 144, LDW = 144;
typedef short v4i16 __attribute__((ext_vector_type(4)));
__device__ __forceinline__ s16x4 trd(LAS unsigned char* p) { return __builtin_bit_cast(s16x4, __builtin_amdgcn_ds_read_tr16_b64_v4i16((LAS v4i16*)p)); }
__device__ __forceinline__ bf16x8 frag_tr(LAS unsigned char* img, int stride, int m0, int kb0, int i, int g4) {
    LAS unsigned char* p = img + (kb0 + 8 * g4 + (i >> 2)) * stride + (m0 + 4 * (i & 3)) * 2;
    const s16x4 lo = trd(p), hi = trd(p + 4 * stride);
    return (bf16x8){lo[0], lo[1], lo[2], lo[3], hi[0], hi[1], hi[2], hi[3]};
}
__device__ __forceinline__ bf16x8 frag_row(LAS unsigned char* img, int stride, int r0, int kb0, int i, int g4) {
    return *(const LAS bf16x8*)(img + (r0 + i) * stride + (kb0 + 8 * g4) * 2);
}
}
__device__ __forceinline__ void ssd_chain_unit(Frame& F, int unit) {
    using namespace ssd;
    int tid_ = F.tid; asm volatile("" : "+v"(tid_));
    const int tid = tid_, lane = tid & 63, w = F.wave, i16 = lane & 15, g4 = lane >> 4;
    LAS unsigned char* L = F.lds;
    const bool pr = unit < 128; const int uu = unit & 127, b = uu >> 4, h = uu & 15, g = h >> 2;
    const int T = pr ? TP : DSEQ, row0 = pr ? b * TP : RPR + b * DSEQ, nblk = (T + 63) >> 6;
    bf16_t* XS = (bf16_t*)(F.ws + WS_XS); const bf16_t* BC = (const bf16_t*)(F.ws + WS_BC); const bf16_t* Z = (const bf16_t*)(F.ws + WS_Z);
    const float* SM = (const float*)(F.ws + WS_SM); float* SSQ1 = (float*)(F.ws + WS_SSQ1);
    const int xcol = h * 64;
    const float a_h = -expf(F.in[14][h]), dsk = F.in[15][h];
    const int cb_sb = w >> 1, cb_tb0 = 2 * (w & 1), y_pb0 = 2 * (w & 1), y_tb = w >> 1;
    const int yp0 = 16 * y_pb0 + 4 * g4;
    f32x4 nwv[2];
#pragma unroll
    for (int q = 0; q < 2; ++q) nwv[q] = *(const f32x4*)(F.in[16] + xcol + yp0 + 16 * q);
    f32x4 st[4];
    float* sout = F.out + (pr ? O_SSMP : O_SSMS) + ((size_t)(b * 16 + h) * 64) * 128;
    if (pr) {
#pragma unroll
        for (int pb = 0; pb < 4; ++pb) st[pb] = (f32x4){0.f, 0.f, 0.f, 0.f}; }
    else { const float* sp = F.in[5] + ((size_t)(b * 16 + h) * 64) * 128;
#pragma unroll
        for (int pb = 0; pb < 4; ++pb) st[pb] = *(const f32x4*)(sp + (size_t)(16 * pb + i16) * 128 + 16 * w + 4 * g4); }
    const int srow = tid >> 3, sch = tid & 7;
    u32x4 pB[2], pC[2], pX; u32x2 pZ[2]; float pdt;
#define SSD_PREFETCH(jb) do { const int base_ = 64 * (jb); \
        { const bool ok_ = base_ + srow < T; const bf16_t* rp_ = BC + (size_t)(row0 + base_ + srow) * 1024 + g * 128 + 8 * sch; \
          pB[0] = ok_ ? *(const u32x4*)rp_ : (u32x4){0u, 0u, 0u, 0u}; pB[1] = ok_ ? *(const u32x4*)(rp_ + 64) : (u32x4){0u, 0u, 0u, 0u}; \
          pC[0] = ok_ ? *(const u32x4*)(rp_ + 512) : (u32x4){0u, 0u, 0u, 0u}; pC[1] = ok_ ? *(const u32x4*)(rp_ + 576) : (u32x4){0u, 0u, 0u, 0u}; \
          pX = ok_ ? *(const u32x4*)(XS + (size_t)(row0 + base_ + srow) * 1024 + xcol + 8 * sch) : (u32x4){0u, 0u, 0u, 0u}; } \
        { const int t_ = base_ + 16 * y_tb + i16; const bf16_t* zp_ = Z + (size_t)(row0 + t_) * 1024 + xcol + yp0; \
          pZ[0] = t_ < T ? *(const u32x2*)zp_ : (u32x2){0u, 0u}; pZ[1] = t_ < T ? *(const u32x2*)(zp_ + 16) : (u32x2){0u, 0u}; } \
        { const int t_ = base_ + lane; pdt = t_ < T ? SM[(size_t)(row0 + t_) * SMLD + h] : 0.f; } } while (0)
    SSD_PREFETCH(0);
#pragma unroll 1
    for (int jb = 0; jb < nblk; ++jb) {
        float ac = pdt * a_h;
#pragma unroll
        for (int o = 1; o < 64; o <<= 1) { const float v = __shfl_up(ac, o); if (lane >= o) ac += v; }
        const float tot = __shfl(ac, 63);
        const float wsc = __builtin_amdgcn_exp2f((tot - ac) * 1.4426950408889634f) * pdt;
        if (w == 0) { LAS float* fa = (LAS float*)(L + FA); fa[lane] = ac; fa[64 + lane] = pdt; }
        *(LAS u32x4*)(L + BL + srow * LDC + 16 * sch) = pB[0]; *(LAS u32x4*)(L + BL + srow * LDC + 128 + 16 * sch) = pB[1];
        *(LAS u32x4*)(L + CL + srow * LDC + 16 * sch) = pC[0]; *(LAS u32x4*)(L + CL + srow * LDC + 128 + 16 * sch) = pC[1];
        { *(LAS u32x4*)(L + XR + srow * LDX + 16 * sch) = pX;
            const float ws_ = __shfl(wsc, srow);
            u32x4 xw; xw.x = cvt_pk_bf16(bf_lo(pX.x) * ws_, bf_hi(pX.x) * ws_); xw.y = cvt_pk_bf16(bf_lo(pX.y) * ws_, bf_hi(pX.y) * ws_);
            xw.z = cvt_pk_bf16(bf_lo(pX.z) * ws_, bf_hi(pX.z) * ws_); xw.w = cvt_pk_bf16(bf_lo(pX.w) * ws_, bf_hi(pX.w) * ws_);
            *(LAS u32x4*)(L + XW + srow * LDX + 16 * sch) = xw; }
#pragma unroll
        for (int pb = 0; pb < 4; ++pb)
            *(LAS u32x2*)(L + SB + (16 * pb + i16) * LDC + (16 * w + 4 * g4) * 2) = (u32x2){cvt_pk_bf16(st[pb].x, st[pb].y), cvt_pk_bf16(st[pb].z, st[pb].w)};
        const u32x2 zreg0 = pZ[0], zreg1 = pZ[1];
        __syncthreads();
        if (jb + 1 < nblk) SSD_PREFETCH(jb + 1);
        {
            f32x4 cb[2] = {{0.f, 0.f, 0.f, 0.f}, {0.f, 0.f, 0.f, 0.f}};
#pragma unroll
            for (int ks = 0; ks < 4; ++ks) { const bf16x8 af = frag_row(L + BL, LDC, 16 * cb_sb, 32 * ks, i16, g4);
#pragma unroll
                for (int q = 0; q < 2; ++q) { const bf16x8 bfv = frag_row(L + CL, LDC, 16 * (cb_tb0 + q), 32 * ks, i16, g4);
                    cb[q] = __builtin_amdgcn_mfma_f32_16x16x32_bf16(af, bfv, cb[q], 0, 0, 0); } }
            const LAS float* fa = (const LAS float*)(L + FA);
            const int s0 = 16 * cb_sb + 4 * g4;
            const f32x4 acs = *(const LAS f32x4*)(fa + s0), dts = *(const LAS f32x4*)(fa + 64 + s0);
#pragma unroll
            for (int q = 0; q < 2; ++q) { const int t = 16 * (cb_tb0 + q) + i16; const float act = fa[t];
                float o[4];
#pragma unroll
                for (int e = 0; e < 4; ++e) o[e] = (s0 + e <= t) ? cb[q][e] * __builtin_amdgcn_exp2f((act - acs[e]) * 1.4426950408889634f) * dts[e] : 0.f;
                *(LAS u32x2*)(L + WM + t * LDW + s0 * 2) = (u32x2){cvt_pk_bf16(o[0], o[1]), cvt_pk_bf16(o[2], o[3])}; }
            const float dtot = __builtin_amdgcn_exp2f(tot * 1.4426950408889634f);
#pragma unroll
            for (int pb = 0; pb < 4; ++pb) st[pb] = st[pb] * dtot;
#pragma unroll
            for (int ks = 0; ks < 2; ++ks) { const bf16x8 af = frag_tr(L + BL, LDC, 16 * w, 32 * ks, i16, g4);
#pragma unroll
                for (int pb = 0; pb < 4; ++pb) { const bf16x8 bfv = frag_tr(L + XW, LDX, 16 * pb, 32 * ks, i16, g4);
                    st[pb] = __builtin_amdgcn_mfma_f32_16x16x32_bf16(af, bfv, st[pb], 0, 0, 0); } }
        }
        __syncthreads();
        {
            f32x4 y[2] = {{0.f, 0.f, 0.f, 0.f}, {0.f, 0.f, 0.f, 0.f}};
#pragma unroll
            for (int ks = 0; ks < 4; ++ks) { const bf16x8 bfv = frag_row(L + CL, LDC, 16 * y_tb, 32 * ks, i16, g4);
#pragma unroll
                for (int q = 0; q < 2; ++q) { const bf16x8 af = frag_row(L + SB, LDC, 16 * (y_pb0 + q), 32 * ks, i16, g4); y[q] = __builtin_amdgcn_mfma_f32_16x16x32_bf16(af, bfv, y[q], 0, 0, 0); } }
            const LAS float* fa = (const LAS float*)(L + FA);
            const int t = 16 * y_tb + i16; const float eac = __builtin_amdgcn_exp2f(fa[t] * 1.4426950408889634f);
            y[0] = y[0] * eac; y[1] = y[1] * eac;
#pragma unroll
            for (int ks = 0; ks < 2; ++ks) { const bf16x8 bfv = frag_row(L + WM, LDW, 16 * y_tb, 32 * ks, i16, g4);
#pragma unroll
                for (int q = 0; q < 2; ++q) { const bf16x8 af = frag_tr(L + XR, LDX, 16 * (y_pb0 + q), 32 * ks, i16, g4); y[q] = __builtin_amdgcn_mfma_f32_16x16x32_bf16(af, bfv, y[q], 0, 0, 0); } }
            const int tg = 64 * jb + t; float ss = 0.f; f32x4 yo[2];
#pragma unroll
            for (int q = 0; q < 2; ++q) { const u32x2 xv = *(const LAS u32x2*)(L + XR + t * LDX + (yp0 + 16 * q) * 2); const u32x2 zr = q ? zreg1 : zreg0;
                const f32x4 xf = {bf_lo(xv.x), bf_hi(xv.x), bf_lo(xv.y), bf_hi(xv.y)}, zf = {bf_lo(zr.x), bf_hi(zr.x), bf_lo(zr.y), bf_hi(zr.y)};
                yo[q].x = (y[q].x + dsk * xf.x) * siluf_(zf.x); yo[q].y = (y[q].y + dsk * xf.y) * siluf_(zf.y); yo[q].z = (y[q].z + dsk * xf.z) * siluf_(zf.z); yo[q].w = (y[q].w + dsk * xf.w) * siluf_(zf.w);
                ss += (yo[q].x * yo[q].x + yo[q].y * yo[q].y) + (yo[q].z * yo[q].z + yo[q].w * yo[q].w); }
            ss += __shfl_xor(ss, 16); ss += __shfl_xor(ss, 32);
            if (tg < T) { if (g4 == 0) atomicAdd(SSQ1 + row0 + tg, ss);
#pragma unroll
                for (int q = 0; q < 2; ++q) { const f32x4 yn = yo[q] * nwv[q]; const u32x2 yv = {cvt_pk_bf16(yn.x, yn.y), cvt_pk_bf16(yn.z, yn.w)}; bf16_t* yp = XS + (size_t)(row0 + tg) * 1024 + xcol + yp0 + 16 * q;
                    if (pr) *(u32x2*)yp = yv; else wt_store8(yp, yv); } }
        }
        __syncthreads();
    }
#undef SSD_PREFETCH
#pragma unroll
    for (int pb = 0; pb < 4; ++pb) *(f32x4*)(sout + (size_t)(16 * pb + i16) * 128 + 16 * w + 4 * g4) = st[pb];
    if (!pr) unit_publish_wt(F, CW_DEP + 192);
}
__device__ __forceinline__ float relu1(float a) { const int b = __float_as_int(a); return __int_as_float(b > 0 ? b : 0); }
__device__ __forceinline__ f32x2 pk_relu(f32x2 a) { return (f32x2){relu1(a.x), relu1(a.y)}; }
__device__ __forceinline__ f32x2 pk_fma(f32x2 a, f32x2 b, f32x2 c) { f32x2 r; asm volatile("v_pk_fma_f32 %0, %1, %2, %3" : "=v"(r) : "v"(a), "v"(b), "v"(c)); return r; }
namespace idx {
constexpr int WTAB = 0, SCORES = 512;
}
__device__ __forceinline__ unsigned* mask_row(Frame& F, int r) {
    return r < RPR ? (unsigned*)(F.ws + WS_MASK) + (size_t)r * MASK_LDP : (unsigned*)(F.ws + WS_MASKS) + (size_t)(r - RPR) * MASK_LDS;
}
__device__ __forceinline__ unsigned f2key(float f) { const unsigned u = __float_as_uint(f); return (u & 0x80000000u) ? ~u : (u | 0x80000000u); }
__device__ __forceinline__ float key2f(unsigned k) { return __uint_as_float((k & 0x80000000u) ? (k & 0x7fffffffu) : ~k); }
template <int NI>
__device__ __forceinline__ void idx_select(Frame& F, const LAS float* sc, int LP, int Lk, int NQ, int r0) {
    const int lane = F.lane, w = F.wave, ni = LP >> 6; const unsigned long long lt_mask = (1ull << lane) - 1ull;
    float zq, dfac;
    { const float qq = 0.5f - (float)TOPK / (float)Lk, r = qq * qq;
      zq = (((((-3.969683028665376e+01f * r + 2.209460984245205e+02f) * r - 2.759285104469687e+02f) * r + 1.383577518672690e+02f) * r - 3.066479806614716e+01f) * r + 2.506628277459239e+00f) * qq /
           (((((-5.447609879822406e+01f * r + 1.615858368580409e+02f) * r - 1.556989798598866e+02f) * r + 6.680131188771972e+01f) * r - 1.328068155288572e+01f) * r + 1.f);
      dfac = (float)Lk * 0.3989422804f * __builtin_amdgcn_exp2f(-0.7213475204f * zq * zq); }
    constexpr int NMIN = NI == 9 ? 5 : (NI == 65 ? 65 : NI - 7);
    const float NINF = -__builtin_inff(), PINF = __builtin_inff();
#pragma unroll 1
    for (int q = w; q < NQ; q += 8) {
        const LAS float* row = sc + q * LP + lane; unsigned* mrow = mask_row(F, r0 + q);
        float kreg[NI];
        kreg[0] = row[(ni - 1) * 64];
#pragma unroll
        for (int j = 1; j < NI; ++j) { if (j < NMIN) kreg[j] = row[(j - 1) * 64]; else kreg[j] = j < ni ? row[(j - 1) * 64] : NINF; }
        float mx = kreg[0], mn = kreg[0] == NINF ? PINF : kreg[0], sm = 0.f, sq = 0.f;
#pragma unroll
        for (int j = 1; j < NI; ++j) { const float x = kreg[j]; mx = fmaxf(mx, x);
            if (j < NMIN) { mn = fminf(mn, x); sm += x; sq = fmaf(x, x, sq); } else mn = fminf(mn, x == NINF ? PINF : x); }
#pragma unroll
        for (int o = 1; o < 64; o <<= 1) { mx = fmaxf(mx, __shfl_xor(mx, o)); mn = fminf(mn, __shfl_xor(mn, o)); sm += __shfl_xor(sm, o); sq += __shfl_xor(sq, o); }
        mx = __int_as_float(__builtin_amdgcn_readfirstlane(__float_as_int(mx))); mn = __int_as_float(__builtin_amdgcn_readfirstlane(__float_as_int(mn)));
        sm = __int_as_float(__builtin_amdgcn_readfirstlane(__float_as_int(sm))); sq = __int_as_float(__builtin_amdgcn_readfirstlane(__float_as_int(sq)));
        constexpr float RN = 1.f / (64.f * (NMIN - 1));
        const float mu = sm * RN, sd = __builtin_sqrtf(fmaxf(sq * RN - mu * mu, 0.f));
        const float idens = sd / dfac;
        float lo = mn, hi = __uint_as_float(__float_as_uint(mx) + (mx >= 0.f ? 1u : 0xffffffffu)); if (mx == 0.f) hi = 1e-38f;
        float thr = 0.f; bool exact = false; float flo = 0.f, fhi = 0.f; bool lo_set = false, hi_set = false;
        float guess = mu + zq * sd; int third = 0;
#pragma unroll 1
        for (int it = 0; it < 64; ++it) {
            float mid = guess;
            if (it >= 20) mid = key2f(f2key(lo) + ((f2key(hi) - f2key(lo)) >> 1));
            if (!(mid > lo && mid < hi)) { mid = lo + (hi - lo) * 0.5f; if (!(mid > lo && mid < hi)) break; }
            int cnt = __popcll(__ballot(kreg[0] >= mid));
#pragma unroll
            for (int i = 1; i + 3 < NI; i += 4) {
                const unsigned long long b0 = __ballot(kreg[i] >= mid), b1 = __ballot(kreg[i + 1] >= mid), b2 = __ballot(kreg[i + 2] >= mid), b3 = __ballot(kreg[i + 3] >= mid);
                __builtin_amdgcn_sched_group_barrier(0x2, 4, 0); __builtin_amdgcn_sched_group_barrier(0x4, 8, 0);
                cnt += (__popcll(b0) + __popcll(b1)) + (__popcll(b2) + __popcll(b3)); }
            static_assert((NI - 1) % 4 == 0, "NI = 4m + 1");
            if (cnt == TOPK) { thr = mid; exact = true; break; }
            if (cnt > TOPK) { lo = mid; flo = (float)cnt; lo_set = true; } else { hi = mid; fhi = (float)cnt; hi_set = true; }
            if (lo_set && hi_set) { float tfr = (flo - 256.f) * __builtin_amdgcn_rcpf(flo - fhi); if (++third == 3) { third = 0; tfr = 0.5f; } tfr = fminf(fmaxf(tfr, 0.08f), 0.92f); guess = lo + (hi - lo) * tfr; }
            else guess = mid + ((float)cnt - 256.f) * idens; }
        unsigned m0 = 0u, m1 = 0u, m2 = 0u, m3 = 0u;
#define IDX_PUT(blk, ms) do { const unsigned long long ms_ = (ms); const unsigned lo_ = (unsigned)ms_, hi_ = (unsigned)(ms_ >> 32); \
            if (__builtin_constant_p(blk)) { \
                if (NI <= 64 || (blk) < 64) asm("s_nop 1\n\tv_writelane_b32 %0, %2, %4\n\tv_writelane_b32 %1, %3, %4" : "+v"(m0), "+v"(m1) : "s"(lo_), "s"(hi_), "n"((blk) & 63)); \
                else asm("s_nop 1\n\tv_writelane_b32 %0, %2, %4\n\tv_writelane_b32 %1, %3, %4" : "+v"(m2), "+v"(m3) : "s"(lo_), "s"(hi_), "n"((blk) & 63)); } \
            else { if (lane == (blk)) { m0 = lo_; m1 = hi_; } if (NI > 64 && lane + 64 == (blk)) { m2 = lo_; m3 = hi_; } } } while (0)
        if (exact) {
#pragma unroll
            for (int j = 1; j < NI; ++j) IDX_PUT(j - 1, __ballot(kreg[j] >= thr));
            IDX_PUT(ni - 1, __ballot(kreg[0] >= thr));
        } else {
            int ngt = 0;
#pragma unroll
            for (int i = 0; i < NI; ++i) ngt += __popcll(__ballot(kreg[i] >= hi));
            const int need = TOPK - ngt; int eqseen = 0;
#pragma unroll
            for (int jj = 1; jj <= NI; ++jj) { const int j = jj < NI ? jj : 0; const bool gt = kreg[j] >= hi, eq = (kreg[j] >= lo) && !gt; const unsigned long long meq = __ballot(eq);
                const bool sel = gt || (eq && (eqseen + __popcll(meq & lt_mask)) < need);
                if (j) IDX_PUT(j - 1, __ballot(sel)); else IDX_PUT(ni - 1, __ballot(sel));
                eqseen += __popcll(meq); }
        }
#undef IDX_PUT
        if (lane < ni) *(u32x2*)(mrow + 2 * lane) = (u32x2){m0, m1};
        if (NI > 64 && lane + 64 < ni) *(u32x2*)(mrow + 2 * (lane + 64)) = (u32x2){m2, m3};
    }
}
template <bool PR>
__device__ __forceinline__ void idx_unit(Frame& F, int b, int c, int qg) {
    constexpr int NQ = PR ? 16 : 8, NRB = NQ / 4;
    int tid_ = F.tid; asm volatile("" : "+v"(tid_));
    const int tid = tid_, lane = tid & 63, w = F.wave, r32 = lane & 31, hh = lane >> 5;
    LAS unsigned char* L_ = F.lds;
    const int Lk = PR ? NMETA + 64 * c : LS, LP = (Lk + 63) & ~63, nkb = LP >> 5;
    const int r0 = PR ? b * TP + NMETA + 64 * (c - 1) + NQ * qg : RPR + b * DSEQ + NQ * qg;
    const int krow0 = PR ? b * TP : RPR + b * DSEQ;
    const bf16_t* QI = (const bf16_t*)(F.ob + DO_QI); const bf16_t* KI = (const bf16_t*)(F.ws + WS_KI); const float* SM = (const float*)(F.ws + WS_SM); const float* ckidx = F.in[4];
    LAS float* wtab = (LAS float*)(L_ + idx::WTAB); LAS float* sc = (LAS float*)(L_ + idx::SCORES);
    if (tid < NQ * 8) wtab[tid] = SM[(size_t)(r0 + (tid >> 3)) * SMLD + 80 + (tid & 7)];
    const int a_tok = ((r32 >> 4) & 1) + 2 * ((r32 >> 2) & 1), a_head = (r32 & 3) + 4 * ((r32 >> 3) & 1);
    bf16x8 af[NRB][4];
#pragma unroll
    for (int rb = 0; rb < NRB; ++rb)
#pragma unroll
        for (int ks = 0; ks < 4; ++ks) af[rb][ks] = *(const bf16x8*)(QI + (size_t)(r0 + 4 * rb + a_tok) * 512 + a_head * 64 + 16 * ks + 8 * hh);
    __syncthreads();
    constexpr int ST = PR ? 3 : 2, RAWN = PR ? 4 : 8;
    u32x4 raw0[RAWN], raw1[RAWN], raw2[PR ? RAWN : 1];
#define IDX_LOADB(kb_, R) do { const int s_ = (kb_) * 32 + r32; const int sc_ = s_ < Lk ? s_ : Lk - 1; \
        if (!PR && (kb_) * 32 < PAST) { const float* kp = ckidx + ((size_t)b * PAST + sc_) * 64 + 8 * hh; \
            _Pragma("unroll") for (int ks = 0; ks < 4; ++ks) { R[(2 * ks) % RAWN] = *(const u32x4*)(kp + 16 * ks); R[(2 * ks + 1) % RAWN] = *(const u32x4*)(kp + 16 * ks + 4); } } \
        else { const bf16_t* kp = KI + (size_t)(PR ? krow0 + sc_ : krow0 + sc_ - PAST) * 64 + 8 * hh; \
            _Pragma("unroll") for (int ks = 0; ks < 4; ++ks) R[ks] = *(const u32x4*)(kp + 16 * ks); } } while (0)
#define IDX_GETB(kb_, R) do { if (!PR && (kb_) * 32 < PAST) { \
            _Pragma("unroll") for (int ks = 0; ks < 4; ++ks) { const u32x4 x0 = R[(2 * ks) % RAWN], x1 = R[(2 * ks + 1) % RAWN]; \
                u32x4 t; t.x = cvt_pk_bf16(__uint_as_float(x0.x), __uint_as_float(x0.y)); t.y = cvt_pk_bf16(__uint_as_float(x0.z), __uint_as_float(x0.w)); \
                t.z = cvt_pk_bf16(__uint_as_float(x1.x), __uint_as_float(x1.y)); t.w = cvt_pk_bf16(__uint_as_float(x1.z), __uint_as_float(x1.w)); bfr[ks] = __builtin_bit_cast(bf16x8, t); } } \
        else { _Pragma("unroll") for (int ks = 0; ks < 4; ++ks) bfr[ks] = __builtin_bit_cast(bf16x8, R[ks]); } } while (0)
    if (w < nkb) IDX_LOADB(w, raw0);
    if (w + 8 < nkb) IDX_LOADB(w + 8, raw1);
    if (PR && w + 16 < nkb) IDX_LOADB(w + 16, raw2);
#define IDX_STAGE(st, R) do { const int kb = kb0 + 8 * (st); \
        if (kb < nkb) { const int s = kb * 32 + r32; bf16x8 bfr[4]; \
            IDX_GETB(kb, R); \
            if (kb + 8 * ST < nkb) IDX_LOADB(kb + 8 * ST, R); \
            f32x16 d[NRB]; \
            _Pragma("unroll") for (int rb = 0; rb < NRB; ++rb) _Pragma("unroll") for (int e = 0; e < 16; ++e) d[rb][e] = 0.f; \
              \
            _Pragma("unroll") for (int ks = 0; ks < 4; ++ks) _Pragma("unroll") for (int rb = 0; rb < NRB; ++rb) d[rb] = __builtin_amdgcn_mfma_f32_32x32x16_bf16(af[rb][ks], bfr[ks], d[rb], 0, 0, 0); \
            _Pragma("unroll") for (int rb = 0; rb < NRB; ++rb) { \
                  \
                _Pragma("unroll") for (int q = 0; q < 2; ++q) { const int tok = 4 * rb + 2 * hh + q; const f32x4 w0 = *(const LAS f32x4*)(wtab + tok * 8), w1 = *(const LAS f32x4*)(wtab + tok * 8 + 4); \
                    f32x2 acc2 = {0.f, 0.f}; \
                    acc2 = pk_fma(pk_relu((f32x2){d[rb][8 * q], d[rb][8 * q + 1]}), (f32x2){w0.x, w0.y}, acc2); acc2 = pk_fma(pk_relu((f32x2){d[rb][8 * q + 2], d[rb][8 * q + 3]}), (f32x2){w0.z, w0.w}, acc2); \
                    acc2 = pk_fma(pk_relu((f32x2){d[rb][8 * q + 4], d[rb][8 * q + 5]}), (f32x2){w1.x, w1.y}, acc2); acc2 = pk_fma(pk_relu((f32x2){d[rb][8 * q + 6], d[rb][8 * q + 7]}), (f32x2){w1.z, w1.w}, acc2); \
                    float v = acc2.x + acc2.y; \
                    if (v == 0.f) v = 0.f;                                     \
                    sc[tok * LP + s] = s < Lk ? v : -__builtin_inff(); } } } } while (0)
#pragma unroll 1
    for (int kb0 = w; kb0 < nkb; kb0 += 8 * ST) {
        IDX_STAGE(0, raw0);
        IDX_STAGE(1, raw1);
        if (PR) IDX_STAGE(2, raw2);
    }
#undef IDX_STAGE
#undef IDX_GETB
#undef IDX_LOADB
    __syncthreads();
    if (PR) { if (LP <= 576) idx_select<9>(F, sc, LP, Lk, NQ, r0); else if (LP <= 1088) idx_select<17>(F, sc, LP, Lk, NQ, r0); else if (LP <= 1600) idx_select<25>(F, sc, LP, Lk, NQ, r0); else idx_select<33>(F, sc, LP, Lk, NQ, r0); }
    else idx_select<65>(F, sc, LP, Lk, NQ, r0);
    __syncthreads();
}
__device__ __forceinline__ void idx_allones(Frame& F, int b, int c) {
    const int Lk = NMETA + 64 * c, nw = ((Lk + 63) & ~63) >> 5;
    for (int e = F.tid; e < 64 * nw; e += NTHR) { const int q = e / nw, wd = e - q * nw; const int lo = 32 * wd;
        const unsigned m = lo + 32 <= Lk ? 0xffffffffu : (lo >= Lk ? 0u : ((1u << (Lk - lo)) - 1u));
        mask_row(F, b * TP + NMETA + 64 * (c - 1) + q)[wd] = m; }
}
__device__ __forceinline__ void idx_conv_units(Frame& F) {
    constexpr int NPU = NBATCH * 29 * 4, NSU = NBATCH * 8, NAU = NBATCH * 3, NCU = (NBATCH * 33 + NBATCH) * 2;
    LAS int* qslot = (LAS int*)(F.lds + MISC_OFF) + 16;
    for (bool first = true; ; first = false) {
        refresh_ids(F);
        if (F.tid == 0) *qslot = first ? (int)blockIdx.x : (int)(F.G + __hip_atomic_fetch_add((unsigned*)(F.ctl + CW_Q + 64), 1u, __ATOMIC_RELAXED, __HIP_MEMORY_SCOPE_AGENT));
        __syncthreads();
        const int u = __builtin_amdgcn_readfirstlane(*qslot);
        __syncthreads();
        if (u >= NPU + NSU + NAU + NCU) break;
        constexpr int NIU = NSU + NPU, NG = NIU / 2;
        static_assert(NIU % 2 == 0 && NG <= NCU, "queue pattern");
        int iu = -1, cu = -1, au = -1;
        if (u < 3 * NG) { const int gq = u / 3, kq = u - 3 * gq; if (kq < 2) iu = 2 * gq + kq; else cu = gq; } else if (u < NIU + NCU) cu = NG + (u - 3 * NG); else au = u - NIU - NCU;
        if (iu >= 0) {
            if (iu < NSU) { idx_unit<false>(F, iu >> 3, 0, iu & 7); }
            else { const int v = iu - NSU; const int qg = v & 3, bc = v >> 2, b = bc & 7, c = 32 - (bc >> 3); idx_unit<true>(F, b, c, qg); } }
        else if (cu >= 0) conv_unit(F, cu);
        else idx_allones(F, au & 7, 1 + (au >> 3));
    }
}
namespace att {
constexpr int SHM_V = 16384, SHM_K = 16384, OFF_V = 0, OFF_K = 2 * SHM_V, OFF_WS = OFF_K + 2 * SHM_K, OFF_TAB = OFF_WS + 8 * 256, OFF_OST = OFF_TAB + 4 * 320 * 4, OST_LD = 272, LDS_TOT = OFF_OST + 8 * 32 * OST_LD;
static_assert(LDS_TOT <= MISC_OFF, "attention LDS");
constexpr float NEG = -1e30f, MINIT = -1e20f, THR2 = 8.f, L2E = 1.4426950408889634f;
#define KSWZ(row, colB) ((row) * 256 + ((colB) ^ (((row) & 15) << 4)))
#define SBAR() __builtin_amdgcn_sched_barrier(0)
__device__ __forceinline__ int crow(int r, int hi) { return (r & 3) + 8 * (r >> 2) + 4 * hi; }
__device__ __forceinline__ int v_st(int k, int c) { const int kk = (k & ~0xC) | ((k & 4) << 1) | ((k & 8) >> 1); return ((kk >> 3) * 4 + (c >> 5)) * 512 + ((kk & 7) * 32 + (c & 31)) * 2; }
__device__ __forceinline__ int v_rd_base(int lane) { return ((lane & 3) << 3) | (((lane >> 2) & 3) << 6) | (((lane >> 4) & 1) << 5) | (((lane >> 5) & 1) << 8); }
constexpr int v_rd_off(int d0, int ks, int half) { return d0 * 512 + ks * 4096 + half * 2048; }
template <int OFF> __device__ __forceinline__ s16x4 tr_read(int vb) { s16x4 r; asm volatile("ds_read_b64_tr_b16 %0, %1 offset:%2" : "=&v"(r) : "v"(vb), "i"(OFF) : "memory"); return r; }
template <int D0> __device__ __forceinline__ void pv_one(f32x16& od, int vb, bf16x8 pa0, bf16x8 pa1, bf16x8 pa2, bf16x8 pa3) {
    const s16x4 l0 = tr_read<v_rd_off(D0, 0, 0)>(vb), h0 = tr_read<v_rd_off(D0, 0, 1)>(vb), l1 = tr_read<v_rd_off(D0, 1, 0)>(vb), h1 = tr_read<v_rd_off(D0, 1, 1)>(vb);
    const s16x4 l2 = tr_read<v_rd_off(D0, 2, 0)>(vb), h2 = tr_read<v_rd_off(D0, 2, 1)>(vb), l3 = tr_read<v_rd_off(D0, 3, 0)>(vb), h3 = tr_read<v_rd_off(D0, 3, 1)>(vb);
    asm volatile("s_waitcnt lgkmcnt(0)" ::: "memory"); SBAR();
#define PK(L, H) (bf16x8){L[0], L[1], L[2], L[3], H[0], H[1], H[2], H[3]}
    od = __builtin_amdgcn_mfma_f32_32x32x16_bf16(pa0, PK(l0, h0), od, 0, 0, 0);
    od = __builtin_amdgcn_mfma_f32_32x32x16_bf16(pa1, PK(l1, h1), od, 0, 0, 0);
    od = __builtin_amdgcn_mfma_f32_32x32x16_bf16(pa2, PK(l2, h2), od, 0, 0, 0);
    od = __builtin_amdgcn_mfma_f32_32x32x16_bf16(pa3, PK(l3, h3), od, 0, 0, 0);
#undef PK
}
__device__ __forceinline__ void qkt(f32x16& p0, f32x16& p1, const LAS unsigned char* Ks, const bf16x8* qr, float init, int r32, int hi) {
#pragma unroll
    for (int r = 0; r < 16; ++r) { p0[r] = init; p1[r] = init; }
#pragma unroll
    for (int d0 = 0; d0 < 8; ++d0) { const int cb = (d0 * 16 + hi * 8) * 2;
        const bf16x8 b0 = *(const LAS bf16x8*)(Ks + KSWZ(r32, cb)), b1 = *(const LAS bf16x8*)(Ks + KSWZ(32 + r32, cb));
        p0 = __builtin_amdgcn_mfma_f32_32x32x16_bf16(b0, qr[d0], p0, 0, 0, 0);
        p1 = __builtin_amdgcn_mfma_f32_32x32x16_bf16(b1, qr[d0], p1, 0, 0, 0); }
}
}

template <bool PR>
__device__ __forceinline__ void attn_unit(Frame& F, int b, int c, int g, int sp) {
    using namespace att;
    int tid_ = F.tid; asm volatile("" : "+v"(tid_));
    const int tid = tid_, lane = tid & 63, w = F.wave, r32 = lane & 31, hi = lane >> 5, hd = w >> 1, th = w & 1;
    LAS unsigned char* L = F.lds;
    const int qrow0 = PR ? b * TP + NMETA + 64 * (c - 1) : RPR + b * DSEQ, qpos0 = PR ? NMETA + 64 * (c - 1) : PAST;
    const int jt0 = PR ? 0 : (sp == 0 ? 0 : 1 + 8 * sp), NT = PR ? c + 1 : 9 + 8 * sp;
    bf16_t* Q = (bf16_t*)(F.ob + DO_Q);
    const bf16_t* Kb = (const bf16_t*)(F.ws + WS_K); const bf16_t* Vb = (const bf16_t*)(F.ws + WS_V); const bf16_t* CK = (const bf16_t*)(F.ws + WS_CK); const bf16_t* CV = (const bf16_t*)(F.ob + DO_CV);
    const float* relb = F.in[8];
    { LAS float* tab = (LAS float*)(L + OFF_TAB);
      for (int e = tid; e < 4 * 320; e += NTHR) { const int h4 = e / 320, rel = e - h4 * 320 - 192; tab[e] = relb[t5_bucket(rel) * 8 + g * 4 + h4] * L2E; } }
    const float cfar = relb[15 * 8 + g * 4 + hd] * L2E;
    bf16x8 qr[8];
    { const bf16_t* qp = Q + (size_t)(qrow0 + 32 * th + r32) * 1024 + g * 512 + hd * 128 + hi * 8; const float* qnw = F.in[17] + hi * 8;
      constexpr float QSC = 0.08838834764831845f * L2E;
      u32x4 qraw[8]; float ss = 0.f;
#pragma unroll
      for (int d0 = 0; d0 < 8; ++d0) qraw[d0] = *(const u32x4*)(qp + d0 * 16);
#pragma unroll
      for (int d0 = 0; d0 < 8; ++d0)
#pragma unroll
          for (int j = 0; j < 4; ++j) { const float a = bf_lo(qraw[d0][j]), b2 = bf_hi(qraw[d0][j]); ss += a * a + b2 * b2; }
      { const auto rr = __builtin_amdgcn_permlane32_swap(__float_as_uint(ss), __float_as_uint(ss), false, false); ss = __uint_as_float(rr[0]) + __uint_as_float(rr[1]); }
      const float rs = __builtin_amdgcn_rsqf(ss * (1.f / HD) + EPS) * QSC;
#pragma unroll
      for (int d0 = 0; d0 < 8; ++d0) { const f32x4 w0 = *(const f32x4*)(qnw + d0 * 16), w1 = *(const f32x4*)(qnw + d0 * 16 + 4); const u32x4 v = qraw[d0];
          const u32x4 o_ = {cvt_pk_bf16(bf_lo(v.x) * rs * w0.x, bf_hi(v.x) * rs * w0.y), cvt_pk_bf16(bf_lo(v.y) * rs * w0.z, bf_hi(v.y) * rs * w0.w),
                            cvt_pk_bf16(bf_lo(v.z) * rs * w1.x, bf_hi(v.z) * rs * w1.y), cvt_pk_bf16(bf_lo(v.w) * rs * w1.z, bf_hi(v.w) * rs * w1.w)};
          qr[d0] = __builtin_bit_cast(bf16x8, o_); } }
    const unsigned* mrow = PR ? (const unsigned*)(F.ws + WS_MASK) + (size_t)(qrow0 + 32 * th + r32) * MASK_LDP : (const unsigned*)(F.ws + WS_MASKS) + (size_t)(qrow0 - RPR + 32 * th + r32) * MASK_LDS;
    LAS float* wsf = (LAS float*)(L + OFF_WS) + w * 64;
    const int sr = tid >> 4, scol = (tid & 15) * 8, vst0 = v_st(sr, scol), vst1 = v_st(32 + sr, scol);
    const int vb0 = (int)(uintptr_t)(L + OFF_V) + v_rd_base(lane);
    float m_reg = MINIT, l_reg = 0.f; f32x16 o[4] = {};
    u32x4 sv0, sv1, sk0, sk1;
#define ATT_SRC(j, kt, vt) const bf16_t* kt; const bf16_t* vt; { if (PR) { kt = Kb + (size_t)(b * TP + 64 * (j)) * 256 + g * 128; vt = Vb + (size_t)(b * TP + 64 * (j)) * 256 + g * 128; } \
        else if ((j) < PAST / 64) { kt = CK + ((size_t)b * PAST + 64 * (j)) * 256 + g * 128; vt = CV + ((size_t)b * PAST + 64 * (j)) * 256 + g * 128; } \
        else { kt = Kb + (size_t)(RPR + b * DSEQ) * 256 + g * 128; vt = Vb + (size_t)(RPR + b * DSEQ) * 256 + g * 128; } }
#define ATT_SLOAD(j) do { ATT_SRC(j, kt_, vt_); sv0 = *(const u32x4*)(vt_ + (size_t)sr * 256 + scol); sv1 = *(const u32x4*)(vt_ + (size_t)(32 + sr) * 256 + scol); \
        sk0 = *(const u32x4*)(kt_ + (size_t)sr * 256 + scol); sk1 = *(const u32x4*)(kt_ + (size_t)(32 + sr) * 256 + scol); } while (0)
#define ATT_SWRITE(bf) do { *(LAS u32x4*)(L + OFF_V + (bf) * SHM_V + vst0) = sv0; *(LAS u32x4*)(L + OFF_V + (bf) * SHM_V + vst1) = sv1; const int kc_ = scol * 2; \
        *(LAS u32x4*)(L + OFF_K + (bf) * SHM_K + KSWZ(sr, kc_)) = sk0; *(LAS u32x4*)(L + OFF_K + (bf) * SHM_K + KSWZ(32 + sr, kc_)) = sk1; } while (0)
    const int qlo = qpos0 + 32 * th;
    const LAS float* tabh = (const LAS float*)(L + OFF_TAB) + hd * 320;
    const bool evn = !((NT - jt0) & 1);
    int jtb = jt0; const int NTR = (NT - jt0) - (evn ? 1 : 0);
    f32x16 pA0, pA1, pB0, pB1; float alA = 1.f, alB = 1.f, cmA = 0.f, cmB = 0.f; u32x2 mwA = {0u, 0u}, mwB = {0u, 0u}; bf16x8 pa0, pa1, pa2, pa3;
#define ATT_MLOAD(k, MW) do { MW = *(const u32x2*)(mrow + 2 * (jtb + (k))); } while (0)
#define ATT_SCORE(P0, P1, k, bfk, MW, CADD) do { const int jj_ = jtb + (k); \
        qkt(P0, P1, L + OFF_K + (bfk) * SHM_K, qr, 0.f, r32, hi); \
        const bool far_ = (64 * jj_ + 63 - qlo) <= -91; CADD = far_ ? cfar : 0.f; \
        if (!far_) { const LAS float* tp = tabh + (64 * jj_ - qlo - r32 + 4 * hi + 192); \
            _Pragma("unroll") for (int r = 0; r < 16; ++r) { const int o_ = (r & 3) + 8 * (r >> 2); P0[r] += tp[o_]; P1[r] += tp[o_ + 32]; } } } while (0)
#define ATT_PARTIAL(P0, P1, MW, CADD, AL, CM) do { float pmax = P0[0]; \
        _Pragma("unroll") for (int r = 1; r < 16; ++r) pmax = fmaxf(pmax, P0[r]); \
        _Pragma("unroll") for (int r = 0; r < 16; ++r) pmax = fmaxf(pmax, P1[r]); \
        { const auto rr = __builtin_amdgcn_permlane32_swap(__float_as_uint(pmax), __float_as_uint(pmax), false, false); pmax = fmaxf(__uint_as_float(rr[0]), __uint_as_float(rr[1])) + CADD; } \
        if (__builtin_expect(__all(pmax - m_reg <= THR2), 1)) { AL = 1.f; } else { const float mn = fmaxf(m_reg, pmax); AL = __builtin_amdgcn_exp2f(m_reg - mn); m_reg = mn; } \
        CM = CADD - m_reg; const int m0_ = (int)(MW.x >> (4 * hi)); \
        _Pragma("unroll") for (int r = 0; r < 16; ++r) { const int o_ = (r & 3) + 8 * (r >> 2); \
            const float e_ = __builtin_amdgcn_exp2f(P0[r] + CM); asm("v_bfe_i32 %0, %2, %3, 1\n\tv_and_b32 %0, %0, %1" : "=&v"(P0[r]) : "v"(e_), "v"(m0_), "n"(o_)); } } while (0)
#define ATT_FINISH(P0, P1, MW, AL, CM) do { const int m1_ = (int)(MW.y >> (4 * hi)); float ps = 0.f; \
        _Pragma("unroll") for (int r = 0; r < 16; ++r) { const int o_ = (r & 3) + 8 * (r >> 2); \
            const float e_ = __builtin_amdgcn_exp2f(P1[r] + CM); asm("v_bfe_i32 %0, %2, %3, 1\n\tv_and_b32 %0, %0, %1" : "=&v"(P1[r]) : "v"(e_), "v"(m1_), "n"(o_)); ps += P0[r] + P1[r]; } \
        { const auto rr = __builtin_amdgcn_permlane32_swap(__float_as_uint(ps), __float_as_uint(ps), false, false); ps = __uint_as_float(rr[0]) + __uint_as_float(rr[1]); } \
        l_reg = l_reg * AL + ps; \
        ATT_PK4(P0, 0, pa0); ATT_PK4(P0, 8, pa1); ATT_PK4(P1, 0, pa2); ATT_PK4(P1, 8, pa3); } while (0)
#define ATT_PK4(P, BASE, OUT) do { const unsigned a0 = cvt_pk_bf16(P[BASE + 0], P[BASE + 1]), a1 = cvt_pk_bf16(P[BASE + 2], P[BASE + 3]); \
        const unsigned b0 = cvt_pk_bf16(P[BASE + 4], P[BASE + 5]), b1 = cvt_pk_bf16(P[BASE + 6], P[BASE + 7]); \
        const auto r0_ = __builtin_amdgcn_permlane32_swap(a0, b0, false, false); const auto r1_ = __builtin_amdgcn_permlane32_swap(a1, b1, false, false); \
        const u32x4 w_ = {r0_[0], r1_[0], r0_[1], r1_[1]}; OUT = __builtin_bit_cast(bf16x8, w_); } while (0)
#define ATT_PV(bfk) do { const int vb = vb0 + (bfk) * SHM_V; \
        pv_one<0>(o[0], vb, pa0, pa1, pa2, pa3); pv_one<1>(o[1], vb, pa0, pa1, pa2, pa3); pv_one<2>(o[2], vb, pa0, pa1, pa2, pa3); pv_one<3>(o[3], vb, pa0, pa1, pa2, pa3); } while (0)
#define ATT_RESC(AL) do { if (__any((AL) < 1.f)) { if (hi == 0) wsf[r32] = (AL); asm volatile("s_waitcnt lgkmcnt(0)" ::: "memory"); \
        _Pragma("unroll") for (int d = 0; d < 4; ++d) _Pragma("unroll") for (int r = 0; r < 16; ++r) o[d][r] *= wsf[crow(r, hi)]; } } while (0)
#define ATT_STAGE_LOAD(k) ATT_SLOAD(jtb + (k))
    if (evn) {
        ATT_STAGE_LOAD(0); ATT_SWRITE(1);
        __syncthreads();
        ATT_MLOAD(0, mwB); ATT_SCORE(pB0, pB1, 0, 1, mwB, cmB); { const float cadd_ = cmB; ATT_PARTIAL(pB0, pB1, mwB, cadd_, alB, cmB); }
        ATT_FINISH(pB0, pB1, mwB, alB, cmB); SBAR();
        ATT_PV(1);
        __syncthreads();
        jtb = jt0 + 1;
    }
    ATT_STAGE_LOAD(0); ATT_SWRITE(0);
    __syncthreads();
    ATT_MLOAD(0, mwA); ATT_SCORE(pA0, pA1, 0, 0, mwA, cmA); { const float cadd_ = cmA; ATT_PARTIAL(pA0, pA1, mwA, cadd_, alA, cmA); }
    if (NTR > 1) { ATT_STAGE_LOAD(1); ATT_SWRITE(1); }
    __syncthreads();
    ATT_RESC(alA);
#pragma unroll 1
    for (int k = 1; k + 1 < NTR; k += 2) {
        SBAR(); ATT_SCORE(pB0, pB1, k, 1, mwB, cmB);
        ATT_FINISH(pA0, pA1, mwA, alA, cmA); SBAR();
        ATT_STAGE_LOAD(k + 1); ATT_MLOAD(k, mwB); SBAR();
        ATT_PV(0); { const float cadd_ = cmB; ATT_PARTIAL(pB0, pB1, mwB, cadd_, alB, cmB); }
        __syncthreads(); ATT_SWRITE(0);
        ATT_RESC(alB); __syncthreads();
        SBAR(); ATT_SCORE(pA0, pA1, k + 1, 0, mwA, cmA);
        ATT_FINISH(pB0, pB1, mwB, alB, cmB); SBAR();
        if (k + 2 < NTR) ATT_STAGE_LOAD(k + 2); ATT_MLOAD(k + 1, mwA); SBAR();
        ATT_PV(1); { const float cadd_ = cmA; ATT_PARTIAL(pA0, pA1, mwA, cadd_, alA, cmA); }
        __syncthreads(); if (k + 2 < NTR) ATT_SWRITE(1);
        ATT_RESC(alA); __syncthreads();
    }
    SBAR(); ATT_FINISH(pA0, pA1, mwA, alA, cmA); SBAR();
    ATT_PV(0);
    __syncthreads();
#undef ATT_SCORE
#undef ATT_MLOAD
#undef ATT_PARTIAL
#undef ATT_FINISH
#undef ATT_PK4
#undef ATT_PV
#undef ATT_RESC
#undef ATT_STAGE_LOAD
#undef ATT_SRC
#undef ATT_SLOAD
#undef ATT_SWRITE
    int b_ = b, g_ = g, sp_ = sp; asm volatile("" : "+v"(b_), "+v"(g_), "+v"(sp_));
    LAS unsigned char* stg = L + OFF_OST + w * 32 * OST_LD;
    bf16_t* ob = (bf16_t*)(F.ob + DO_Q) + (size_t)((PR ? b_ * TP + NMETA + 64 * (c - 1) : RPR + b_ * DSEQ) + 32 * th) * 1024 + g_ * 512 + hd * 128;
    if (!PR) {
        float* pbase = (float*)(F.ob + DO_QI) + (size_t)((b_ * 2 + g_) * 8) * (256 * 132);
        float* pw = pbase + (size_t)sp_ * (256 * 132) + w * (64 * 64 + 128);
        { float* pp = pw + lane * 4;
#pragma unroll
          for (int d0 = 0; d0 < 4; ++d0) {
#pragma unroll
            for (int r4 = 0; r4 < 4; ++r4) { const u32x4 v = {__float_as_uint(o[d0][4 * r4]), __float_as_uint(o[d0][4 * r4 + 1]), __float_as_uint(o[d0][4 * r4 + 2]), __float_as_uint(o[d0][4 * r4 + 3])}; wt_store16(pp + r4 * 256, v); }
            pp += 16 * 64; asm volatile("" : "+v"(pp) :: "memory"); } }
        wt_store8(pw + 4096 + 2 * lane, (u32x2){__float_as_uint(m_reg), __float_as_uint(l_reg)});
        asm volatile("s_waitcnt vmcnt(0)" ::: "memory");
        __syncthreads();
        LAS int* flag = (LAS int*)(L + OFF_WS) + 8 * 64;
        if (tid == 0) {
            const unsigned old = __hip_atomic_fetch_add((unsigned*)(F.ctl + CW_Q + 128 + 64 * (b_ * 2 + g_)), 1u, __ATOMIC_RELAXED, __HIP_MEMORY_SCOPE_AGENT);
            if (old == 7u) { __builtin_amdgcn_fence(__ATOMIC_ACQUIRE, "agent"); asm volatile("s_waitcnt vmcnt(0)" ::: "memory"); }
            *flag = (int)old; }
        __syncthreads();
        const bool last = (*flag == 7);
        __syncthreads();
        if (!last) return;
        float mi[8], li[8];
#pragma unroll
        for (int s8 = 0; s8 < 8; ++s8) { const float* pq = pbase + (size_t)s8 * (256 * 132) + w * (64 * 64 + 128); const f32x2 ml = *(const f32x2*)(pq + 4096 + 2 * lane); mi[s8] = ml.x; li[s8] = ml.y; }
        float mm = mi[0];
#pragma unroll
        for (int s8 = 1; s8 < 8; ++s8) mm = fmaxf(mm, mi[s8]);
        float den = 0.f;
#pragma unroll
        for (int s8 = 0; s8 < 8; ++s8) { mi[s8] = __builtin_amdgcn_exp2f(mi[s8] - mm); den += mi[s8] * li[s8]; }
        const float rl = __builtin_amdgcn_rcpf(den);
        LAS float* wq = (LAS float*)(L + OFF_K) + w * 256;
        if (hi == 0) {
#pragma unroll
            for (int s8 = 0; s8 < 8; ++s8) wq[s8 * 32 + r32] = mi[s8] * rl; }
        asm volatile("s_waitcnt lgkmcnt(0)" ::: "memory");
#pragma unroll 1
        for (int d0 = 0; d0 < 4; ++d0) {
            f32x4 pv[4][8];
#pragma unroll
            for (int r4 = 0; r4 < 4; ++r4) { const float* pq = pbase + w * (64 * 64 + 128) + d0 * 16 * 64 + lane * 4 + r4 * 256;
#pragma unroll
                for (int s8 = 0; s8 < 8; ++s8) pv[r4][s8] = *(const f32x4*)(pq + (size_t)s8 * (256 * 132)); }
#pragma unroll
            for (int r4 = 0; r4 < 4; ++r4) { f32x4 acc4 = {0.f, 0.f, 0.f, 0.f};
#pragma unroll
                for (int s8 = 0; s8 < 8; ++s8) {
#pragma unroll
                    for (int e = 0; e < 4; ++e) acc4[e] += pv[r4][s8][e] * wq[s8 * 32 + crow(4 * r4 + e, hi)]; }
#pragma unroll
                for (int e = 0; e < 4; ++e) *(LAS bf16_t*)(stg + crow(4 * r4 + e, hi) * OST_LD + (d0 * 32 + r32) * 2) = f2bf(acc4[e]); } }
    } else {
        if (hi == 0) wsf[r32] = l_reg; asm volatile("s_waitcnt lgkmcnt(0)" ::: "memory");
        float rli[16];
#pragma unroll
        for (int r = 0; r < 16; ++r) rli[r] = __builtin_amdgcn_rcpf(wsf[crow(r, hi)]);
#pragma unroll
        for (int r = 0; r < 16; ++r) { const int orow = crow(r, hi);
#pragma unroll
            for (int d0 = 0; d0 < 4; ++d0) *(LAS bf16_t*)(stg + orow * OST_LD + (d0 * 32 + r32) * 2) = f2bf(o[d0][r] * rli[r]); }
    }
    asm volatile("s_waitcnt lgkmcnt(0)" ::: "memory");
#pragma unroll
    for (int i = 0; i < 8; ++i) { const int row = i * 4 + (lane >> 4), ch = lane & 15; const u32x4 v = *(const LAS u32x4*)(stg + row * OST_LD + ch * 16);
        if (PR) *(u32x4*)(ob + (size_t)row * 1024 + ch * 8) = v; else wt_store16(ob + (size_t)row * 1024 + ch * 8, v); }
    if (!PR) unit_publish_wt(F, CW_DEP);
    __syncthreads();
}
__device__ __forceinline__ int yrow_to_r(int pm) { return pm * 256 + (pm < 64 ? 16 * ((pm >> 3) + 1) : 128); }
struct SchedP5 {
    const char* A0; const char* A1; const char* B0; const char* B1; int G, c;
    __device__ __forceinline__ bool next(int i, pg8::Unit& u) const {
        const int L = (i >> 1) * G + c; if (L >= 64 * 4) return false;
        pg8::tile_of(L, 64, 4, u.pm, u.pn); u.part = i & 1;
        u.A = (u.part ? A1 : A0) + (size_t)yrow_to_r(u.pm) * 1024 * 2; u.B = (u.part ? B1 : B0) + (size_t)u.pn * 256 * 1024 * 2; return true; }
};
template <bool WT> struct EpiP5T {
    static constexpr bool PERM = true;
    const bf16_t* GS; const bf16_t* GA; const float* SSQ1; bf16_t* MERGED;
    __device__ __forceinline__ bool operator()(pg8::Acc& acc, const pg8::Unit& u, int wr, int wc, int fr, int fq) const {
        const int rr0 = yrow_to_r(u.pm) + wr * 64 + fr, ry0 = u.pm * 256 + wr * 64 + fr, col = u.pn * 256 + wc * 32 + 8 * fq;
#pragma unroll
        for (int ai = 0; ai < 2; ++ai)
#pragma unroll
            for (int m = 0; m < 4; ++m) { const int rr = rr0 + ai * 128 + m * 16, ry = ry0 + ai * 128 + m * 16;
                float rstd = 0.f; if (u.part == 0) rstd = __builtin_amdgcn_rsqf(SSQ1[rr] * (1.f / 1024.f) + EPS);
#pragma unroll
                for (int bj = 0; bj < 2; ++bj) {
                    const u32x4 ga = *(const u32x4*)(GA + (size_t)rr * 1024 + col + bj * 128);
                    float sa[8] = {bf_lo(ga.x), bf_hi(ga.x), bf_lo(ga.y), bf_hi(ga.y), bf_lo(ga.z), bf_hi(ga.z), bf_lo(ga.w), bf_hi(ga.w)};
                    if (u.part == 0) {
                        const u32x4 gs = *(const u32x4*)(GS + (size_t)rr * 1024 + col + bj * 128);
                        const float ss[8] = {bf_lo(gs.x), bf_hi(gs.x), bf_lo(gs.y), bf_hi(gs.y), bf_lo(gs.z), bf_hi(gs.z), bf_lo(gs.w), bf_hi(gs.w)};
#pragma unroll
                        for (int e = 0; e < 8; ++e) {
                            const float f = rstd * (1.f + __builtin_amdgcn_exp2f(-1.4426950408889634f * sa[e])) * __builtin_amdgcn_rcpf(1.f + __builtin_amdgcn_exp2f(-1.4426950408889634f * ss[e]));
                            acc[ai][bj][m][e >> 2][e & 3] *= f; }
                    } else {
                        float o[8];
#pragma unroll
                        for (int e = 0; e < 8; ++e) o[e] = acc[ai][bj][m][e >> 2][e & 3] * sigmoidf_(sa[e]);
                        u32x4 w; w.x = cvt_pk_bf16(o[0], o[1]); w.y = cvt_pk_bf16(o[2], o[3]); w.z = cvt_pk_bf16(o[4], o[5]); w.w = cvt_pk_bf16(o[6], o[7]);
                        if (WT) wt_store16(MERGED + (size_t)ry * 1024 + col + bj * 128, w); else *(u32x4*)(MERGED + (size_t)ry * 1024 + col + bj * 128) = w; } } }
        return u.part == 0;
    }
};
typedef EpiP5T<false> EpiP5;
struct EpiP5A {
    static constexpr bool PERM = true;
    const bf16_t* GS; const float* SSQ1; bf16_t* MERGED;
    __device__ __forceinline__ bool operator()(pg8::Acc& acc, const pg8::Unit& u, int wr, int wc, int fr, int fq) const {
        const int rr0 = yrow_to_r(u.pm) + wr * 64 + fr, ry0 = u.pm * 256 + wr * 64 + fr, col = u.pn * 256 + wc * 32 + 8 * fq;
#pragma unroll
        for (int ai = 0; ai < 2; ++ai)
#pragma unroll
            for (int m = 0; m < 4; ++m) { const int rr = rr0 + ai * 128 + m * 16, ry = ry0 + ai * 128 + m * 16; const float rstd = __builtin_amdgcn_rsqf(SSQ1[rr] * (1.f / 1024.f) + EPS);
#pragma unroll
                for (int bj = 0; bj < 2; ++bj) { const u32x4 gs = *(const u32x4*)(GS + (size_t)rr * 1024 + col + bj * 128);
                    const float ss[8] = {bf_lo(gs.x), bf_hi(gs.x), bf_lo(gs.y), bf_hi(gs.y), bf_lo(gs.z), bf_hi(gs.z), bf_lo(gs.w), bf_hi(gs.w)}; float o[8];
#pragma unroll
                    for (int e = 0; e < 8; ++e) o[e] = acc[ai][bj][m][e >> 2][e & 3] * rstd * sigmoidf_(ss[e]);
                    u32x4 w; w.x = cvt_pk_bf16(o[0], o[1]); w.y = cvt_pk_bf16(o[2], o[3]); w.z = cvt_pk_bf16(o[4], o[5]); w.w = cvt_pk_bf16(o[6], o[7]);
                    wt_store16(MERGED + (size_t)ry * 1024 + col + bj * 128, w); } }
        return false;
    }
};
struct EpiP5B {
    static constexpr bool PERM = true;
    const bf16_t* GA; bf16_t* MERGED;
    __device__ __forceinline__ bool operator()(pg8::Acc& acc, const pg8::Unit& u, int wr, int wc, int fr, int fq) const {
        const int rr0 = yrow_to_r(u.pm) + wr * 64 + fr, ry0 = u.pm * 256 + wr * 64 + fr, col = u.pn * 256 + wc * 32 + 8 * fq;
#pragma unroll
        for (int ai = 0; ai < 2; ++ai)
#pragma unroll
            for (int m = 0; m < 4; ++m) { const int rr = rr0 + ai * 128 + m * 16, ry = ry0 + ai * 128 + m * 16;
#pragma unroll
                for (int bj = 0; bj < 2; ++bj) { const u32x4 ga = *(const u32x4*)(GA + (size_t)rr * 1024 + col + bj * 128); bf16_t* mp = MERGED + (size_t)ry * 1024 + col + bj * 128; const u32x4 t = *(const u32x4*)mp;
                    const float sa[8] = {bf_lo(ga.x), bf_hi(ga.x), bf_lo(ga.y), bf_hi(ga.y), bf_lo(ga.z), bf_hi(ga.z), bf_lo(ga.w), bf_hi(ga.w)};
                    const float tv[8] = {bf_lo(t.x), bf_hi(t.x), bf_lo(t.y), bf_hi(t.y), bf_lo(t.z), bf_hi(t.z), bf_lo(t.w), bf_hi(t.w)}; float o[8];
#pragma unroll
                    for (int e = 0; e < 8; ++e) o[e] = tv[e] + acc[ai][bj][m][e >> 2][e & 3] * sigmoidf_(sa[e]);
                    u32x4 w; w.x = cvt_pk_bf16(o[0], o[1]); w.y = cvt_pk_bf16(o[2], o[3]); w.z = cvt_pk_bf16(o[4], o[5]); w.w = cvt_pk_bf16(o[6], o[7]);
                    wt_store16(mp, w); } }
        return false;
    }
};
struct SchedY {
    const char* A; const char* B; int nN, K, G, c;
    __device__ __forceinline__ bool next(int i, pg8::Unit& u) const {
        const int L = i * G + c; if (L >= 64 * nN) return false;
        pg8::tile_of(L, 64, nN, u.pm, u.pn); u.part = 0; u.A = A + (size_t)u.pm * 256 * K * 2; u.B = B + (size_t)u.pn * 256 * K * 2; return true; }
};
struct SchedTile {
    const char* A0; const char* A1; const char* B0; const char* B1; int pm, pn, nparts;
    __device__ __forceinline__ bool next(int i, pg8::Unit& u) const { if (i >= nparts) return false; u.pm = pm; u.pn = pn; u.part = i; u.A = i ? A1 : A0; u.B = i ? B1 : B0; return true; }
};
struct SchedP8 {
    const char* A; const char* B; int c;
    __device__ __forceinline__ bool next(int i, pg8::Unit& u) const {
        int L; if (c < 8) { if (i >= 3) return false; L = i * 8 + c; } else { L = 24 + i * 248 + (c - 8); if (L >= 64 * 22) return false; }
        pg8::tile_of(L, 64, 22, u.pm, u.pn); u.part = 0; u.A = A + (size_t)u.pm * 256 * 1024 * 2; u.B = B + (size_t)u.pn * 256 * 1024 * 2; return true; }
};
template <bool WT> struct EpiP6T {
    static constexpr bool PERM = false;
    const float* xp; const float* xs; bf16_t* HB; float* SSQ2;
    __device__ __forceinline__ bool operator()(pg8::Acc& acc, const pg8::Unit& u, int wr, int wc, int fr, int fq) const {
        const int ry0 = u.pm * 256 + wr * 64 + fr, col0 = u.pn * 256 + wc * 32 + 4 * fq;
#pragma unroll
        for (int ai = 0; ai < 2; ++ai)
#pragma unroll
            for (int m = 0; m < 4; ++m) { const int ry = ry0 + ai * 128 + m * 16;
                const float* xrow = ry < YPR ? xp + (size_t)ry * 1024 : xs + (size_t)(ry - YPR) * 1024; float ss = 0.f;
#pragma unroll
                for (int bj = 0; bj < 2; ++bj)
#pragma unroll
                    for (int n = 0; n < 2; ++n) { const int c = col0 + bj * 128 + n * 16; const f32x4 h = *(const f32x4*)(xrow + c) + acc[ai][bj][m][n];
                        ss += (h.x * h.x + h.y * h.y) + (h.z * h.z + h.w * h.w);
                        const u32x2 hv = {cvt_pk_bf16(h.x, h.y), cvt_pk_bf16(h.z, h.w)};
                        if (WT) wt_store8(HB + (size_t)ry * 1024 + c, hv); else *(u32x2*)(HB + (size_t)ry * 1024 + c) = hv; }
                ss += __shfl_xor(ss, 16); ss += __shfl_xor(ss, 32);
                if (fq == 0) atomicAdd(SSQ2 + ry, ss); }
        return false;
    }
};
typedef EpiP6T<false> EpiP6;
struct EpiP7 {
    static constexpr bool PERM = true;
    const float* SSQ2; bf16_t* ACT;
    __device__ __forceinline__ bool operator()(pg8::Acc& acc, const pg8::Unit& u, int wr, int wc, int fr, int fq) const {
        const int ry0 = u.pm * 256 + wr * 64 + fr, ch0 = u.pn * 128 + wc * 16 + 4 * fq;
#pragma unroll
        for (int ai = 0; ai < 2; ++ai)
#pragma unroll
            for (int m = 0; m < 4; ++m) { const int ry = ry0 + ai * 128 + m * 16; const float rs = __builtin_amdgcn_rsqf(SSQ2[ry] * (1.f / 1024.f) + EPS);
#pragma unroll
                for (int bj = 0; bj < 2; ++bj) { const f32x4 g = acc[ai][bj][m][0] * rs, up = acc[ai][bj][m][1] * rs;
                    const float a0 = siluf_(g.x) * up.x, a1 = siluf_(g.y) * up.y, a2 = siluf_(g.z) * up.z, a3 = siluf_(g.w) * up.w;
                    *(u32x2*)(ACT + (size_t)ry * DFF + ch0 + bj * 64) = (u32x2){cvt_pk_bf16(a0, a1), cvt_pk_bf16(a2, a3)}; } }
        return false;
    }
};
struct EpiP8 {
    static constexpr bool PERM = false;
    const bf16_t* HB; float* Y;
    __device__ __forceinline__ bool operator()(pg8::Acc& acc, const pg8::Unit& u, int wr, int wc, int fr, int fq) const {
        const int ry0 = u.pm * 256 + wr * 64 + fr, col0 = u.pn * 256 + wc * 32 + 4 * fq;
#pragma unroll
        for (int ai = 0; ai < 2; ++ai)
#pragma unroll
            for (int m = 0; m < 4; ++m) { const size_t ro = (size_t)(ry0 + ai * 128 + m * 16) * 1024 + col0;
#pragma unroll
                for (int bj = 0; bj < 2; ++bj)
#pragma unroll
                    for (int n = 0; n < 2; ++n) { const u32x2 hv = *(const u32x2*)(HB + ro + bj * 128 + n * 16);
                        const f32x4 h = {__uint_as_float(hv.x << 16), __uint_as_float(hv.x & 0xffff0000u), __uint_as_float(hv.y << 16), __uint_as_float(hv.y & 0xffff0000u)};
                        __builtin_nontemporal_store(h + acc[ai][bj][m][n], (f32x4*)(Y + ro + bj * 128 + n * 16)); } }
        return false;
    }
};

constexpr size_t WS_MS = WS_CK, WS_HBS = WS_CK + (1u << 20), WS_ACTS = WS_CK + (2u << 20);
static_assert(WS_ACTS + (size_t)RSR * DFF * 2 <= WS_MASK, "sample intermediates");
__device__ __forceinline__ void mixer_units(Frame& F) {
    constexpr int Q0 = 128, Q1 = Q0 + 128, QA = Q1 + 8, Q2 = QA + 8, Q3 = Q2 + 128, Q4 = Q3 + 96, Q5 = Q4 + 8, Q6 = Q5 + 160, Q7 = Q6 + 44, Q8 = Q7 + 256;
    LAS int* qslot = (LAS int*)(F.lds + MISC_OFF) + 16;
    for (bool first = true; ; first = false) {
        refresh_ids(F);
        if (F.tid == 0) *qslot = first ? (int)blockIdx.x : (int)(F.G + __hip_atomic_fetch_add((unsigned*)(F.ctl + CW_Q), 1u, __ATOMIC_RELAXED, __HIP_MEMORY_SCOPE_AGENT));
        __syncthreads();
        const int u = __builtin_amdgcn_readfirstlane(*qslot);
        __syncthreads();
        if (u >= Q8) break;
        if (u < Q0) { attn_unit<false>(F, u >> 4, 0, (u >> 3) & 1, u & 7); }
        else if (u < Q1) ssd_chain_unit(F, 128 + (u - Q0));
        else if (u < QA) {
            const int k = u - Q1, pm = 64 + (k >> 2), pn = k & 3;
            unit_wait(F, CW_DEP + 192, 128u);
            SchedTile S{(const char*)(F.ws + WS_XS) + (size_t)yrow_to_r(pm) * 1024 * 2, nullptr, (const char*)(F.ws + WS_WBS) + (size_t)pn * 256 * 1024 * 2, nullptr, pm, pn, 1};
            EpiP5A E{(const bf16_t*)(F.ws + WS_GS), (const float*)(F.ws + WS_SSQ1), (bf16_t*)(F.ws + WS_MS) - (size_t)YPR * 1024};
            pg8::gemm_phase<EpiP5A, SchedTile>(F.lds, 1024, S, E, F.wave);
            unit_publish_wt(F, CW_DEP + 256);
        }
        else if (u < Q2) {
            const int k = u - QA, pm = 64 + (k >> 2), pn = k & 3;
            unit_wait(F, CW_DEP, 16u); unit_wait(F, CW_DEP + 256, 8u);
            SchedTile S{(const char*)(F.ob + DO_Q) + (size_t)yrow_to_r(pm) * 1024 * 2, nullptr, (const char*)(F.ws + WS_WBA) + (size_t)pn * 256 * 1024 * 2, nullptr, pm, pn, 1};
            EpiP5B E{(const bf16_t*)(F.ws + WS_GA), (bf16_t*)(F.ws + WS_MS) - (size_t)YPR * 1024};
            pg8::gemm_phase<EpiP5B, SchedTile>(F.lds, 1024, S, E, F.wave);
            unit_publish_wt(F, CW_DEP + 64);
        }
        else if (u < Q3) ssd_chain_unit(F, u - Q2);
        else if (u >= Q4 && u < Q5) {
            const int k = u - Q4, pm = 64 + (k >> 2), pn = k & 3;
            unit_wait(F, CW_DEP + 64, 8u);
            SchedTile S{(const char*)(F.ws + WS_MS) + (size_t)(pm - 64) * 256 * 1024 * 2, nullptr, (const char*)(F.ws + WS_WOUT) + (size_t)pn * 256 * 1024 * 2, nullptr, pm, pn, 1};
            EpiP6T<true> E{F.in[0], F.in[1], (bf16_t*)(F.ws + WS_HBS) - (size_t)YPR * 1024, (float*)(F.ws + WS_SSQ2)};
            pg8::gemm_phase<EpiP6T<true>, SchedTile>(F.lds, 1024, S, E, F.wave);
            unit_publish_wt(F, CW_DEP + 128);
        }
        else if (u >= Q6 && u < Q7) {
            const int k = u - Q6, pm = 64 + k / 22, pn = k % 22;
            unit_wait(F, CW_DEP + 128, 8u);
            SchedTile S{(const char*)(F.ws + WS_HBS) + (size_t)(pm - 64) * 256 * 1024 * 2, nullptr, (const char*)(F.ws + WS_WGU) + (size_t)pn * 256 * 1024 * 2, nullptr, pm, pn, 1};
            EpiP7 E{(const float*)(F.ws + WS_SSQ2), (bf16_t*)(F.ws + WS_ACTS) - (size_t)YPR * DFF};
            pg8::gemm_phase<EpiP7, SchedTile>(F.lds, 1024, S, E, F.wave);
        } else {
            const int v = u < Q4 ? u - Q3 : (u < Q6 ? 96 + (u - Q5) : 256 + (u - Q7));
            const int bg = v & 15, c = 32 - (v >> 4); attn_unit<true>(F, bg >> 1, c, bg & 1, 0);
        }
    }
}

constexpr int NPHASE = 9;
#ifndef PROBE_TIMING
#define PROBE_TIMING 0
#endif
#ifndef PROBE_BASE
#define PROBE_BASE 0
#endif
__global__ void __launch_bounds__(NTHR, 2) hybrid_fwd(Args args) {
    extern __shared__ __attribute__((aligned(16))) unsigned char lds[];
    Frame F;
    F.lds = (LAS unsigned char*)lds; F.MISC = (volatile LAS unsigned*)(F.lds + MISC_OFF);
    F.tid = threadIdx.x; F.lane = F.tid & 63; F.wave = __builtin_amdgcn_readfirstlane(F.tid >> 6);
    F.G = gridDim.x; { const int bx = blockIdx.x; F.vcu = (F.G % 8 == 0) ? (bx % 8) * (F.G / 8) + bx / 8 : bx; }
    F.in = args.in; F.out = args.out; F.ws = args.ws; F.ob = (unsigned char*)args.out; F.ctl = (gu32*)(args.ws + WS_CTL);
    if (F.tid < 64) ((LAS unsigned*)(F.lds + MISC_OFF))[F.tid] = 0u;
    __syncthreads();
    const int lo = args.ph_lo, hi = args.ph_hi;
    const bool multi = (hi - lo) > 1;
    XcdBarrier bar; bar.bar = (unsigned*)(F.ctl + CW_BAR) + args.li * XCD_BAR_WORDS; bar.x = 0; bar.st = nullptr;
    if (multi) bar = xcd_barrier_post((unsigned*)(F.ctl + CW_BAR) + args.li * XCD_BAR_WORDS, F.MISC + 8, F.tid);
#define IN(k) (lo <= (k) && (k) < hi)
#if PROBE_TIMING
    LAS unsigned long long* tst = (LAS unsigned long long*)(F.lds + MISC_OFF + 128); int nst = 0;
#define STAMP() do { if (F.tid == 0) tst[nst] = __builtin_amdgcn_s_memrealtime(); ++nst; } while (0)
#else
#define STAMP() do {} while (0)
#endif
    STAMP();
#define SEAM(k) do { refresh_ids(F); if (IN(k) && IN((k) + 1)) xcd_barrier(bar, F.tid); STAMP(); } while (0)
    if (IN(0)) { p0_prologue(F); SEAM(0); }
    if (IN(1)) {
        SchedP1 S{(const char*)(F.ob + DO_HN), (const char*)(F.ws + WS_WIN), F.G, (int)blockIdx.x};
        EpiP1 E{F.ws, F.ob};
        pg8::gemm_phase<EpiP1, SchedP1>(F.lds, 1024, S, E, F.wave);
        { constexpr int FULL = (67 * 29) % 256; if ((int)blockIdx.x >= FULL) cache_to_bf16(F, (int)blockIdx.x - FULL, 256 - FULL); }
        SEAM(1);
    }
    if (IN(2)) { p2_rows(F); SEAM(2); }
    if (IN(3)) { idx_conv_units(F); SEAM(3); }
    if (IN(4)) { mixer_units(F); SEAM(4); }
    if (IN(5)) {
        SchedP5 S{(const char*)(F.ws + WS_XS), (const char*)(F.ob + DO_Q), (const char*)(F.ws + WS_WBS), (const char*)(F.ws + WS_WBA), F.G, (int)blockIdx.x};
        EpiP5 E{(const bf16_t*)(F.ws + WS_GS), (const bf16_t*)(F.ws + WS_GA), (const float*)(F.ws + WS_SSQ1), (bf16_t*)(F.ws + WS_MERGED)};
        pg8::gemm_phase<EpiP5, SchedP5>(F.lds, 1024, S, E, F.wave);
        SEAM(5);
    }
    if (IN(6)) {
        SchedY S{(const char*)(F.ws + WS_MERGED), (const char*)(F.ws + WS_WOUT), 4, 1024, F.G, (int)blockIdx.x};
        EpiP6 E{F.in[0], F.in[1], (bf16_t*)(F.ws + WS_HB), (float*)(F.ws + WS_SSQ2)};
        pg8::gemm_phase<EpiP6, SchedY>(F.lds, 1024, S, E, F.wave);
        SEAM(6);
    }
    if (IN(7)) {
        if (blockIdx.x < 8) {
            const int k = (int)blockIdx.x, pm = 64 + (k >> 2), pn = k & 3;
            SchedTile S{(const char*)(F.ws + WS_ACTS) + (size_t)(pm - 64) * 256 * DFF * 2, nullptr, (const char*)(F.ws + WS_WDN) + (size_t)pn * 256 * DFF * 2, nullptr, pm, pn, 1};
            EpiP8 E{(const bf16_t*)(F.ws + WS_HBS) - (size_t)YPR * 1024, F.out};
            pg8::gemm_phase<EpiP8, SchedTile>(F.lds, DFF, S, E, F.wave);
        }
        SchedP8 S{(const char*)(F.ws + WS_HB), (const char*)(F.ws + WS_WGU), (int)blockIdx.x};
        EpiP7 E{(const float*)(F.ws + WS_SSQ2), (bf16_t*)(F.ws + WS_ACT)};
        pg8::gemm_phase<EpiP7, SchedP8>(F.lds, 1024, S, E, F.wave);
        SEAM(7);
    }
    if (IN(8)) {
        SchedY S{(const char*)(F.ws + WS_ACT), (const char*)(F.ws + WS_WDN), 4, DFF, F.G, (int)blockIdx.x};
        EpiP8 E{(const bf16_t*)(F.ws + WS_HB), F.out};
        pg8::gemm_phase<EpiP8, SchedY>(F.lds, DFF, S, E, F.wave);
        STAMP();
    }
#if PROBE_TIMING
    __syncthreads();
    if (blockIdx.x == 0 && F.tid < 64) {
        const size_t ooff[5] = {O_KP, O_VP, O_KIP, O_SSMP, O_SSMS};
#pragma unroll
        for (int i = 0; i < 5; ++i) { const int n = (int)((tst[PROBE_BASE + i + 1] - tst[PROBE_BASE + i] + 200) / 400); for (int e = F.tid; e < n && e < 32000; e += 64) ((unsigned*)F.out)[ooff[i] + e] = 0xAAAAAAAAu; }
    }
#endif
#undef IN
#undef SEAM
}

extern "C" void kernel_launch(void* const* d_in, const int* in_sizes, int n_in, void* d_out, int out_size, void* d_ws, size_t ws_size, hipStream_t stream) {
    static int grid = 0;
    if (grid == 0) {
        if (n_in != 27 || out_size != (int)O_END || ws_size < WS_END) { fprintf(stderr, "kernel_launch: unexpected shapes: n_in %d out %d ws %zu (need %zu)\n", n_in, out_size, ws_size, (size_t)WS_END); grid = -1; return; }
        int dev = 0, cus = 0;
        if (hipGetDevice(&dev) != hipSuccess || hipDeviceGetAttribute(&cus, hipDeviceAttributeMultiprocessorCount, dev) != hipSuccess) { grid = -1; return; }
        if (hipFuncSetAttribute((const void*)hybrid_fwd, hipFuncAttributeMaxDynamicSharedMemorySize, LDS_BYTES) != hipSuccess) { fprintf(stderr, "kernel_launch: hipFuncSetAttribute failed\n"); grid = -1; return; }
        (void)hipGetLastError();
        if (cus < 256) { fprintf(stderr, "kernel_launch: built for a 256-CU device (one resident workgroup per CU), found %d CUs\n", cus); grid = -1; return; }
        grid = 256;
    }
    if (grid < 0) return;
    (void)hipMemsetAsync((char*)d_ws + WS_CTL, 0, CTL_ZERO_BYTES, stream);
    Args a{};
    for (int i = 0; i < 27; ++i) a.in[i] = (const float*)d_in[i];
    a.out = (float*)d_out; a.ws = (unsigned char*)d_ws;
#ifndef MK_SPLIT
#define MK_SPLIT 0
#endif
#if MK_SPLIT
    for (int p = 0; p < NPHASE; ++p) { a.ph_lo = p; a.ph_hi = p + 1; a.li = 0; hipLaunchKernelGGL(hybrid_fwd, dim3(grid), dim3(NTHR), LDS_BYTES, stream, a); }
#else
    a.ph_lo = 0; a.ph_hi = NPHASE; a.li = 0; hipLaunchKernelGGL(hybrid_fwd, dim3(grid), dim3(NTHR), LDS_BYTES, stream, a);
#endif
    const hipError_t le = hipPeekAtLastError();
    if (le != hipSuccess) fprintf(stderr, "kernel_launch: launch failed: %s\n", hipGetErrorName(le));
}
```

```cpp
#include <hip/hip_runtime.h>
#include <cstdio>
#include <cstdint>

constexpr int DM = 1024, NBATCH = 8, SEQ = 2048, NMETA = 16, TP = NMETA + SEQ  , DSEQ = 64, PAST = 4096, LS = PAST + DSEQ  ;
constexpr int RPR = NBATCH * TP  , RSR = NBATCH * DSEQ  , RR = RPR + RSR  , RPAD = 17152  ;
constexpr int YPR = NBATCH * SEQ  , YR = YPR + RSR  ;
constexpr int NIN = 7424  , DFF = 2816, NGU = 2 * DFF;
constexpr int SSD_H = 16, SSD_P = 64, SSD_G = 4, SSD_N = 128, CONV_DIM = 2048;
constexpr int NH = 8, NKV = 2, HD = 128, IDXH = 8, IDXD = 64, TOPK = 256;
constexpr float EPS = 1e-6f;
constexpr int SMLD = 96;

constexpr size_t O_YP = 0, O_YS = O_YP + (size_t)YPR * DM, O_KP = O_YS + (size_t)RSR * DM, O_VP = O_KP + (size_t)RPR * 256, O_KIP = O_VP + (size_t)RPR * 256,
                 O_SSMP = O_KIP + (size_t)RPR * 64, O_CVP = O_SSMP + (size_t)NBATCH * 16 * 64 * 128, O_KS = O_CVP + (size_t)NBATCH * 3 * CONV_DIM, O_VS = O_KS + (size_t)RSR * 256,
                 O_KIS = O_VS + (size_t)RSR * 256, O_SSMS = O_KIS + (size_t)RSR * 64, O_CVS = O_SSMS + (size_t)NBATCH * 16 * 64 * 128, O_END = O_CVS + (size_t)NBATCH * 3 * CONV_DIM;
static_assert(O_END == 29302784, "d_out size");
constexpr size_t DO_Q = 0, DO_QI = DO_Q + (size_t)RR * 1024 * 2, DO_CV = DO_QI + (size_t)RR * 512 * 2, DO_YEND = DO_CV + (size_t)NBATCH * PAST * 256 * 2;
static_assert(DO_YEND <= O_KP * 4, "y-region scratch");
constexpr size_t DO_HN = O_KP * 4;
static_assert(DO_HN + (size_t)RPAD * 1024 * 2 <= O_CVP * 4, "hn scratch in tail");

constexpr size_t al256(size_t x) { return (x + 255) / 256 * 256; }
constexpr size_t WS_CTL = 0, CTL_BYTES = 1u << 20, CTL_ZERO_BYTES = 128u << 10;
constexpr size_t WS_WIN = CTL_BYTES, WS_WBS = WS_WIN + (size_t)NIN * 1024 * 2, WS_WBA = WS_WBS + 1024 * 1024 * 2, WS_WOUT = WS_WBA + 1024 * 1024 * 2, WS_WGU = WS_WOUT + 1024 * 1024 * 2,
                 WS_WDN = WS_WGU + (size_t)NGU * 1024 * 2, WS_Z = WS_WDN + (size_t)1024 * DFF * 2, WS_XS = WS_Z + (size_t)RR * 1024 * 2, WS_BC = WS_XS + (size_t)RR * 1024 * 2,
                 WS_GA = WS_BC + (size_t)RR * 1024 * 2, WS_GS = WS_GA + (size_t)RR * 1024 * 2, WS_K = WS_GS + (size_t)RR * 1024 * 2, WS_V = WS_K + (size_t)RR * 256 * 2,
                 WS_SM = WS_V + (size_t)RR * 256 * 2, WS_KI = WS_SM + (size_t)RR * SMLD * 4, WS_CK = WS_KI + (size_t)RR * 64 * 2, WS_MASK = WS_CK + (size_t)NBATCH * PAST * 256 * 2;
constexpr int MASK_LDP = 68, MASK_LDS = 132;
constexpr size_t WS_MASKS = WS_MASK + (size_t)RPR * MASK_LDP * 4, WS_SSQ1 = WS_MASKS + (size_t)RSR * MASK_LDS * 4, WS_SSQ2 = WS_SSQ1 + al256((size_t)RR * 4),
                 WS_PART = WS_SSQ2 + al256((size_t)YR * 4), WS_END = WS_PART + (size_t)32 * 256 * 132 * 4;
constexpr size_t WS_MERGED = WS_Z, WS_ACT = WS_XS, WS_HB = WS_GS, WS_HAL = WS_PART;
static_assert(WS_END <= 268435456, "d_ws map exceeds 256 MiB");
static_assert((size_t)YR * DFF * 2 <= WS_GS - WS_XS, "act overlay");
static_assert((size_t)NBATCH * 33 * 3 * CONV_DIM * 2 <= WS_END - WS_PART, "halo overlay");
constexpr int CW_TMO = 0, CW_BAR = 4096, CW_Q = 16384;
constexpr int CW_DEP = CW_Q + 64 * 32;

#define GAS __attribute__((address_space(1)))
#define LAS __attribute__((address_space(3)))
typedef unsigned short bf16_t;
typedef short bf16x8 __attribute__((ext_vector_type(8)));
typedef short s16x4 __attribute__((ext_vector_type(4)));
typedef float f32x4 __attribute__((ext_vector_type(4)));
typedef float f32x2 __attribute__((ext_vector_type(2)));
typedef float f32x16 __attribute__((ext_vector_type(16)));
typedef unsigned u32x4 __attribute__((ext_vector_type(4)));
typedef unsigned u32x2 __attribute__((ext_vector_type(2)));
typedef GAS unsigned gu32;
#define RLX_AGENT __ATOMIC_RELAXED, __HIP_MEMORY_SCOPE_AGENT
#define LDS_WAIT() asm volatile("s_waitcnt lgkmcnt(0)" ::: "memory")
#define VM_WAIT() asm volatile("s_waitcnt vmcnt(0)" ::: "memory")
__device__ __forceinline__ unsigned cvt_pk_bf16(float lo, float hi) { unsigned r; asm volatile("v_cvt_pk_bf16_f32 %0, %1, %2" : "=v"(r) : "v"(lo), "v"(hi)); return r; }
__device__ __forceinline__ float bf_lo(unsigned w) { return __uint_as_float(w << 16); }
__device__ __forceinline__ float bf_hi(unsigned w) { return __uint_as_float(w & 0xffff0000u); }
__device__ __forceinline__ float bf2f(bf16_t b) { return __uint_as_float((unsigned)b << 16); }
__device__ __forceinline__ bf16_t f2bf(float f) { return (bf16_t)(cvt_pk_bf16(f, 0.f) & 0xffffu); }
__device__ __forceinline__ float sigmoidf_(float x) { return __builtin_amdgcn_rcpf(1.f + __builtin_amdgcn_exp2f(-1.4426950408889634f * x)); }
__device__ __forceinline__ float siluf_(float x) { return x * sigmoidf_(x); }
__device__ __forceinline__ float wave_sum(float v) {
#pragma unroll
    for (int o = 1; o < 64; o <<= 1) v += __shfl_xor(v, o);
    return v;
}

#define XB_TMO      128
#define XB_XCNT(j)  (256  + 64 * (j))
#define XB_XSUB(j)  (1280 + 64 * (j))
#define XB_XGEN(j)  (2304 + 64 * (j))
#define XB_TOP      3328
#define XB_TOPGEN   3392
#define XCD_BAR_WORDS 3456
#define XB_SPIN_CAP (1u << 18)
__device__ __forceinline__ unsigned xb_ld(unsigned* p)              { return __hip_atomic_load(p, __ATOMIC_RELAXED, __HIP_MEMORY_SCOPE_AGENT); }
__device__ __forceinline__ unsigned xb_add(unsigned* p, unsigned v) { return __hip_atomic_fetch_add(p, v, __ATOMIC_RELAXED, __HIP_MEMORY_SCOPE_AGENT); }
__device__ __forceinline__ unsigned xb_xcc_id() { return (unsigned)__builtin_amdgcn_s_getreg((3 << 11) | 20) & 0xFu; }
#define XB_SPIN(cond, bar) do { unsigned _sp = 0; while (cond) { __builtin_amdgcn_s_sleep(1); \
    if ((++_sp & 255u) == 0u) { if (xb_ld(&(bar)[XB_TMO])) break; if (_sp > XB_SPIN_CAP) { atomicAdd(&(bar)[XB_TMO], 1u); break; } } } } while (0)
struct XcdBarrier { unsigned* bar; unsigned x; volatile LAS unsigned* st; };
__device__ __forceinline__ XcdBarrier xcd_barrier_post(unsigned* bar, volatile LAS unsigned* st, const int tid) {
    XcdBarrier b; b.bar = bar; b.x = xb_xcc_id(); b.st = st;
    if (tid == 0) (void)xb_add(&bar[XB_XCNT(b.x)], 1u);
    return b;
}
__device__ __forceinline__ void xcd_barrier_complete(unsigned* bar, unsigned x, unsigned& nloc, unsigned& nx) {
    const unsigned G = gridDim.x * gridDim.y * gridDim.z;
    unsigned sum, cnt, mine, sp = 0u;
    for (;;) {
        sum = 0u; cnt = 0u; mine = 0u;
#pragma unroll
        for (unsigned j = 0; j < 16; ++j) { const unsigned c = xb_ld(&bar[XB_XCNT(j)]); sum += c; cnt += (c > 0u) ? 1u : 0u; mine = (j == x) ? c : mine; }
        if (sum == G) break;
        __builtin_amdgcn_s_sleep(1);
        if ((++sp & 255u) == 0u) { if (xb_ld(&bar[XB_TMO])) break; if (sp > XB_SPIN_CAP) { atomicAdd(&bar[XB_TMO], 1u); break; } }
    }
    nloc = mine > 0u ? mine : 1u; nx = cnt > 0u ? cnt : 1u;
}
__device__ __forceinline__ void xcd_barrier(const XcdBarrier& b, const int tid) {
    asm volatile("s_waitcnt vmcnt(0)" ::: "memory");
    __syncthreads();
    if (tid == 0) {
        unsigned* bar = b.bar;
        __builtin_amdgcn_s_waitcnt(0);
        unsigned nloc = b.st[0], nx = b.st[1];
        if (nloc == 0u) { xcd_barrier_complete(bar, b.x, nloc, nx); b.st[0] = nloc; b.st[1] = nx; }
        const unsigned old = xb_add(&bar[XB_XSUB(b.x)], 1u);
        const unsigned gen = old / nloc;
        if (old + 1u == (gen + 1u) * nloc) {
            __builtin_amdgcn_fence(__ATOMIC_RELEASE, "agent");
            asm volatile("s_waitcnt vmcnt(0)" ::: "memory");
            const unsigned og = xb_add(&bar[XB_TOP], 1u);
            const unsigned tg = og / nx;
            if (og + 1u == (tg + 1u) * nx) xb_add(&bar[XB_TOPGEN], 1u);
            else XB_SPIN(xb_ld(&bar[XB_TOPGEN]) == tg, bar);
            __builtin_amdgcn_fence(__ATOMIC_ACQUIRE, "agent");
            xb_add(&bar[XB_XGEN(b.x)], 1u);
            asm volatile("s_waitcnt vmcnt(0)" ::: "memory");
        } else {
            XB_SPIN(xb_ld(&bar[XB_XGEN(b.x)]) == gen, bar);
            __builtin_amdgcn_fence(__ATOMIC_ACQUIRE, "agent");
            asm volatile("s_waitcnt vmcnt(0)" ::: "memory");
        }
    }
    __syncthreads();
}

namespace pg8 {
constexpr int BM = 256, BK = 64, HALF = 128, HTB = HALF * BK * 2, STAGE_BYTES = 8 * HTB, NXCD = 8, WGM = 8;
__host__ __device__ __forceinline__ int lds_byte(int r, int c) { const int st = (r >> 4) * 2 + (c >> 5), rr = r & 15, cc = c & 31, ob = rr * 64 + cc * 2; return st * 1024 + (ob ^ (((ob >> 9) & 1) << 5)); }
__host__ __device__ __forceinline__ void stage_rc(int b, int& R, int& C) { const int st = b / 1024, sb = b % 1024, swz = sb ^ (((sb >> 9) & 1) << 5); R = (st >> 1) * 16 + swz / 64; C = (st & 1) * 32 + (swz % 64) / 2; }
__host__ __device__ __forceinline__ int perm32(int rho) { const int n = rho >> 4, i = rho & 15; return 8 * (i >> 2) + 4 * n + (i & 3); }
struct Unit { int pm, pn, part; const char* A; const char* B; };
__device__ __forceinline__ void tile_of(int L, int nM, int nN, int& pm, int& pn) {
    const int nwg = nM * nN; int wgid = L; { const int q = nwg / NXCD, r = nwg % NXCD, xcd = wgid % NXCD, off = wgid / NXCD; wgid = (xcd < r ? xcd * (q + 1) : r * (q + 1) + (xcd - r) * q) + off; }
    const int nig = WGM * nN, gid = wgid / nig, fm = gid * WGM, gsz = (nM - fm) < WGM ? (nM - fm) : WGM;
    pm = fm + ((wgid % nig) % gsz); pn = (wgid % nig) / gsz;
}
typedef f32x4 Acc[2][2][4][2];
template <class Epi, class Sched>
__device__ __forceinline__ void gemm_phase(LAS unsigned char* lds, const int K, const Sched& S, const Epi& E, const int wave_id) {
    int tid_; asm volatile("v_mbcnt_lo_u32_b32 %0, -1, 0\n\tv_mbcnt_hi_u32_b32 %0, -1, %0" : "=v"(tid_)); tid_ += 64 * wave_id;
    const int tid = tid_, wid = __builtin_amdgcn_readfirstlane(tid >> 6), lane = tid & 63, wr = wid >> 2, wc = wid & 3, fr = lane & 15, fq = lane >> 4;
    const int nt = K / BK;
    unsigned voffA[2], voffB[2];
#pragma unroll
    for (int i = 0; i < 2; ++i) { int R, C; stage_rc(tid * 16 + i * 8192, R, C); const int Rb = Epi::PERM ? ((R & ~31) + perm32(R & 31)) : R;
        voffA[i] = (unsigned)(R * K + C) * 2u; voffB[i] = (unsigned)(Rb * K + C) * 2u; }
    const size_t kstep = (size_t)(BK * 2);
    const size_t hstep = (size_t)HALF * K * 2;
    const unsigned ldsw = (unsigned)wid * 1024u;
    const int aoff = lds_byte(wr * 64 + fr, fq * 8), boff = lds_byte(wc * 32 + fr, fq * 8);
#define PG8_SA(b, h) (((b) * 2 + (h)) * HTB)
#define PG8_SB(b, h) ((4 + (b) * 2 + (h)) * HTB)
#define PG8_STAGE(bufoff, gbase, voff) do { _Pragma("unroll") for (int _i = 0; _i < 2; ++_i) \
        __builtin_amdgcn_global_load_lds((const unsigned*)((const char*)(gbase) + (voff)[_i]), (LAS unsigned*)(lds + (bufoff) + ldsw + _i * 8192), 16, 0, 0); } while (0)
#define PG8_LDA(dst, b, h) do { _Pragma("unroll") for (int m = 0; m < 4; ++m) _Pragma("unroll") for (int k = 0; k < 2; ++k) dst[m][k] = *(const LAS bf16x8*)(lds + PG8_SA(b, h) + aoff + m * 2048 + k * 1024); } while (0)
#define PG8_LDB(dst, b, h) do { _Pragma("unroll") for (int n = 0; n < 2; ++n) _Pragma("unroll") for (int k = 0; k < 2; ++k) dst[n][k] = *(const LAS bf16x8*)(lds + PG8_SB(b, h) + boff + n * 2048 + k * 1024); } while (0)
#define PG8_MMA(ai, bj, At, Bt) do { __builtin_amdgcn_s_setprio(1); _Pragma("unroll") for (int m = 0; m < 4; ++m) _Pragma("unroll") for (int n = 0; n < 2; ++n) _Pragma("unroll") for (int k = 0; k < 2; ++k) \
        acc[ai][bj][m][n] = __builtin_amdgcn_mfma_f32_16x16x32_bf16(Bt[n][k], At[m][k], acc[ai][bj][m][n], 0, 0, 0); __builtin_amdgcn_s_setprio(0); } while (0)
#define PG8_WAIT_V(n) asm volatile("s_waitcnt vmcnt(" #n ")" ::: "memory")
#define PG8_WAIT_L(n) asm volatile("s_waitcnt lgkmcnt(" #n ")" ::: "memory")
#define PG8_BAR __builtin_amdgcn_s_barrier()
#define PG8_SCHED __builtin_amdgcn_sched_barrier(0)
    Unit cur, nxt; int ui = 0;
    if (!S.next(0, cur)) return;
    Acc acc;
#pragma unroll
    for (int a = 0; a < 2; ++a)
#pragma unroll
        for (int b = 0; b < 2; ++b)
#pragma unroll
            for (int m = 0; m < 4; ++m)
#pragma unroll
                for (int n = 0; n < 2; ++n) acc[a][b][m][n] = (f32x4){0.f, 0.f, 0.f, 0.f};
    bf16x8 At[4][2], B0[2][2], B1[2][2];
    const char* cA = cur.A; const char* cB = cur.B;
    PG8_STAGE(PG8_SB(0, 0), cB, voffB); PG8_STAGE(PG8_SB(0, 1), cB + hstep, voffB); PG8_STAGE(PG8_SA(0, 0), cA, voffA); PG8_STAGE(PG8_SA(0, 1), cA + hstep, voffA);
    if (wr == 1) PG8_BAR;
    PG8_WAIT_V(2); PG8_BAR;
    PG8_STAGE(PG8_SB(1, 0), cB + kstep, voffB); PG8_STAGE(PG8_SA(1, 0), cA + kstep, voffA); PG8_STAGE(PG8_SB(1, 1), cB + hstep + kstep, voffB);
    PG8_WAIT_V(6); PG8_BAR;
    for (;;) {
        const bool has_next = S.next(ui + 1, nxt);
        const char* nA = has_next ? nxt.A : cA; const char* nB = has_next ? nxt.B : cB;
        for (int t = 0; t < nt; t += 2) {
            const bool last = (t == nt - 2);
            const char* a1 = cA + (size_t)(t + 1) * kstep;
            const char* a2 = last ? nA : cA + (size_t)(t + 2) * kstep; const char* b2 = last ? nB : cB + (size_t)(t + 2) * kstep;
            const char* a3 = a2 + kstep; const char* b3 = b2 + kstep;
            PG8_LDB(B0, 0, 0); PG8_LDB(B1, 0, 1); PG8_SCHED; PG8_LDA(At, 0, 0); PG8_STAGE(PG8_SA(1, 1), a1 + hstep, voffA);
            PG8_WAIT_V(8); PG8_WAIT_L(0); PG8_BAR; PG8_MMA(0, 0, At, B0); PG8_MMA(0, 1, At, B1); PG8_BAR; PG8_SCHED;
            PG8_LDA(At, 0, 1); PG8_STAGE(PG8_SB(0, 0), b2, voffB); PG8_STAGE(PG8_SB(0, 1), b2 + hstep, voffB); PG8_STAGE(PG8_SA(0, 0), a2, voffA);
            PG8_WAIT_V(8); PG8_WAIT_L(0); PG8_BAR; PG8_MMA(1, 0, At, B0); PG8_MMA(1, 1, At, B1); PG8_BAR; PG8_SCHED;
            PG8_LDB(B0, 1, 0); PG8_LDB(B1, 1, 1); PG8_SCHED; PG8_LDA(At, 1, 0); PG8_STAGE(PG8_SA(0, 1), a2 + hstep, voffA);
            PG8_WAIT_V(8); PG8_WAIT_L(0); PG8_BAR; PG8_MMA(0, 0, At, B0); PG8_MMA(0, 1, At, B1); PG8_BAR; PG8_SCHED;
            PG8_LDA(At, 1, 1); PG8_STAGE(PG8_SB(1, 0), b3, voffB); PG8_STAGE(PG8_SB(1, 1), b3 + hstep, voffB); PG8_STAGE(PG8_SA(1, 0), a3, voffA);
            PG8_WAIT_V(8); PG8_WAIT_L(0); PG8_BAR; PG8_MMA(1, 0, At, B0); PG8_MMA(1, 1, At, B1); PG8_BAR; PG8_SCHED;
        }
        if (wr == 0) PG8_BAR;
        const bool keep = E(acc, cur, wr, wc, fr, fq);
        if (!has_next) break;
        if (!keep) {
#pragma unroll
            for (int a = 0; a < 2; ++a)
#pragma unroll
                for (int b = 0; b < 2; ++b)
#pragma unroll
                    for (int m = 0; m < 4; ++m)
#pragma unroll
                        for (int n = 0; n < 2; ++n) acc[a][b][m][n] = (f32x4){0.f, 0.f, 0.f, 0.f};
        }
        cur = nxt; cA = nA; cB = nB; ++ui;
        if (wr == 1) PG8_BAR;
    }
    PG8_WAIT_V(0);
    PG8_BAR;
#undef PG8_SA
#undef PG8_SB
#undef PG8_STAGE
#undef PG8_LDA
#undef PG8_LDB
#undef PG8_MMA
#undef PG8_WAIT_V
#undef PG8_WAIT_L
#undef PG8_BAR
#undef PG8_SCHED
}
}

struct Args { const float* in[27]; float* out; unsigned char* ws; int ph_lo, ph_hi, li, pad; };
constexpr int NWAVES = 8, NTHR = 512;
constexpr int RING_BYTES = 131072, LDS_BYTES = 147456, MISC_OFF = LDS_BYTES - 256;

struct Frame {
    LAS unsigned char* lds; volatile LAS unsigned* MISC; gu32* ctl;
    int tid, lane, wave, vcu, G;
    const float* const* in; float* out; unsigned char* ws; unsigned char* ob;
};

__device__ __forceinline__ void refresh_ids(Frame& F) { int l; asm volatile("v_mbcnt_lo_u32_b32 %0, -1, 0\n\tv_mbcnt_hi_u32_b32 %0, -1, %0" : "=v"(l)); F.lane = l; F.tid = F.wave * 64 + l; }

__device__ __forceinline__ void unit_publish(Frame& F, int ctr_word) {
    asm volatile("s_waitcnt vmcnt(0)" ::: "memory"); __syncthreads();
    if (F.tid == 0) { __builtin_amdgcn_fence(__ATOMIC_RELEASE, "agent"); asm volatile("s_waitcnt vmcnt(0)" ::: "memory");
        const unsigned o_ = __hip_atomic_fetch_add((unsigned*)(F.ctl + ctr_word), 1u, __ATOMIC_RELAXED, __HIP_MEMORY_SCOPE_AGENT); asm volatile("" :: "v"(o_)); }
    __syncthreads();
}
__device__ __forceinline__ void unit_wait(Frame& F, int ctr_word, unsigned need) {
    if (F.tid == 0) { unsigned sp = 0u; while (__hip_atomic_load((unsigned*)(F.ctl + ctr_word), __ATOMIC_RELAXED, __HIP_MEMORY_SCOPE_AGENT) < need) { __builtin_amdgcn_s_sleep(16); if (++sp > (1u << 18)) break; }
        __builtin_amdgcn_fence(__ATOMIC_ACQUIRE, "agent"); asm volatile("s_waitcnt vmcnt(0)" ::: "memory"); }
    __syncthreads();
}

typedef __attribute__((address_space(8))) void* rsrc_t;
__device__ __forceinline__ void wt_store16(void* p, u32x4 v) {
    asm volatile("global_store_dwordx4 %0, %1, off sc1\n\ts_nop 1" :: "v"(p), "v"(v) : "memory"); }
__device__ __forceinline__ void wt_store8(void* p, u32x2 v) { __hip_atomic_store((unsigned long long*)p, ((unsigned long long)v.y << 32) | v.x, __ATOMIC_RELAXED, __HIP_MEMORY_SCOPE_AGENT); }
__device__ __forceinline__ void unit_publish_wt(Frame& F, int ctr_word) {
    asm volatile("s_waitcnt vmcnt(0)" ::: "memory"); __syncthreads();
    if (F.tid == 0) { const unsigned o_ = __hip_atomic_fetch_add((unsigned*)(F.ctl + ctr_word), 1u, __ATOMIC_RELAXED, __HIP_MEMORY_SCOPE_AGENT); asm volatile("" :: "v"(o_)); }
    __syncthreads();
}

__device__ __forceinline__ int win_src(int n) {
    if (n < 3072) return n;
    if (n < 4096) return 3088 + (n - 3072);
    if (n < 4352) return 4112 + (n - 4096);
    if (n < 4608) return 4368 + (n - 4352);
    if (n < 5120) return 4624 + (n - 4608);
    if (n < 6144) return 5208 + (n - 5120);
    if (n < 7168) return 6232 + (n - 6144);
    if (n < 7184) return 3072 + (n - 7168);
    if (n < 7248) return 5136 + (n - 7184);
    if (n < 7256) return 5200 + (n - 7248);
    return -1;
}
template <bool VEC, class SrcFn>
__device__ __forceinline__ void p0_transpose_item(SrcFn src, int ldw, int Kdim, bf16_t* WT, LAS float* scr, int kb, int nb, int lane, const float* ksc = nullptr) {
    const int k0 = 64 * kb, n0 = 32 * nb;
    if (VEC) {
        const float* cp = src(n0 + 4 * (lane & 7)) + (size_t)(k0 + (lane >> 3)) * ldw;
#pragma unroll
        for (int i = 0; i < 8; ++i) { const f32x4 v = *(const f32x4*)(cp + (size_t)(8 * i) * ldw); LAS float* d = scr + (8 * i + (lane >> 3)) * 33 + 4 * (lane & 7); d[0] = v.x; d[1] = v.y; d[2] = v.z; d[3] = v.w; }
    } else {
        const float* cp = src(n0 + (lane & 31));
#pragma unroll 8
        for (int i = 0; i < 32; ++i) { const int kk = 2 * i + (lane >> 5); scr[kk * 33 + (lane & 31)] = cp ? cp[(size_t)(k0 + kk) * ldw] : 0.f; }
    }
    LDS_WAIT(); asm volatile("" ::: "memory");
    const int c = lane & 7;
    f32x4 k0s = {1.f, 1.f, 1.f, 1.f}, k1s = k0s;
    if (ksc) { k0s = *(const f32x4*)(ksc + k0 + 8 * c); k1s = *(const f32x4*)(ksc + k0 + 8 * c + 4); }
#pragma unroll
    for (int j = 0; j < 4; ++j) { const int n = (lane >> 3) + 8 * j; const LAS float* s = scr + (8 * c) * 33 + n;
        u32x4 o; o.x = cvt_pk_bf16(s[0 * 33] * k0s.x, s[1 * 33] * k0s.y); o.y = cvt_pk_bf16(s[2 * 33] * k0s.z, s[3 * 33] * k0s.w); o.z = cvt_pk_bf16(s[4 * 33] * k1s.x, s[5 * 33] * k1s.y); o.w = cvt_pk_bf16(s[6 * 33] * k1s.z, s[7 * 33] * k1s.w);
        *(GAS u32x4*)(WT + (size_t)(n0 + n) * Kdim + k0 + 8 * c) = o; }
    LDS_WAIT(); asm volatile("" ::: "memory");
}
__device__ __forceinline__ void cache_to_bf16(Frame& F, int wi, int nw) {
    const f32x4* ck = (const f32x4*)F.in[2]; const f32x4* cv = (const f32x4*)F.in[3]; GAS u32x4* ok = (GAS u32x4*)(F.ws + WS_CK); GAS u32x4* ov = (GAS u32x4*)(F.ob + DO_CV);
    const long n8 = (long)NBATCH * PAST * 256 / 8; const long gt = (long)wi * NTHR + F.tid, GT = (long)nw * NTHR;
    for (long i = gt; i < 2 * n8; i += 8 * GT) {
        f32x4 a[8], b[8];
#pragma unroll
        for (int u = 0; u < 8; ++u) { const long iu = i + u * GT; if (iu < 2 * n8) { const bool isk = iu < n8; const long j = isk ? iu : iu - n8; const f32x4* s = (isk ? ck : cv) + 2 * j; a[u] = s[0]; b[u] = s[1]; } }
#pragma unroll
        for (int u = 0; u < 8; ++u) { const long iu = i + u * GT; if (iu < 2 * n8) { const bool isk = iu < n8; const long j = isk ? iu : iu - n8;
            u32x4 o; o.x = cvt_pk_bf16(a[u].x, a[u].y); o.y = cvt_pk_bf16(a[u].z, a[u].w); o.z = cvt_pk_bf16(b[u].x, b[u].y); o.w = cvt_pk_bf16(b[u].z, b[u].w);
            (isk ? ok : ov)[j] = o; } }
    }
}
__device__ __forceinline__ void p0_prologue(Frame& F) {
    LAS float* scr = (LAS float*)(F.lds + F.wave * 16384);
    const int gw = F.vcu * NWAVES + F.wave, NGW = F.G * NWAVES, lane = F.lane;
    const float* w_in = F.in[10]; const float* w_bs = F.in[20]; const float* w_ba = F.in[21]; const float* w_out = F.in[22];
    const float* w_gate = F.in[24]; const float* w_up = F.in[25]; const float* w_dn = F.in[26];
    bf16_t* WIN = (bf16_t*)(F.ws + WS_WIN); bf16_t* WBS = (bf16_t*)(F.ws + WS_WBS); bf16_t* WBA = (bf16_t*)(F.ws + WS_WBA); bf16_t* WOUT = (bf16_t*)(F.ws + WS_WOUT);
    bf16_t* WGU = (bf16_t*)(F.ws + WS_WGU); bf16_t* WDN = (bf16_t*)(F.ws + WS_WDN);
    constexpr int I_IN = 16 * (NIN / 32), I_SQ = 16 * 32, I_GU = 16 * (NGU / 32), I_DN = (DFF / 64) * 32;
    constexpr int NITEMS = I_IN + 3 * I_SQ + I_GU + I_DN;
    for (int it = gw; it < NITEMS; it += NGW) {
        int r = it;
        if (r < I_IN) { const int nb = r % (NIN / 32), kb = r / (NIN / 32);
            if (nb < 224) p0_transpose_item<true>([&](int n) -> const float* { return w_in + win_src(n); }, 7256, 1024, WIN, scr, kb, nb, lane);
            else p0_transpose_item<false>([&](int n) -> const float* { const int s = win_src(n); return s >= 0 ? w_in + s : nullptr; }, 7256, 1024, WIN, scr, kb, nb, lane); continue; } r -= I_IN;
        if (r < I_SQ) { p0_transpose_item<true>([&](int n) -> const float* { return w_bs + n; }, 1024, 1024, WBS, scr, r / 32, r % 32, lane); continue; } r -= I_SQ;
        if (r < I_SQ) { p0_transpose_item<true>([&](int n) -> const float* { return w_ba + n; }, 1024, 1024, WBA, scr, r / 32, r % 32, lane); continue; } r -= I_SQ;
        if (r < I_SQ) { p0_transpose_item<true>([&](int n) -> const float* { return w_out + n; }, 1024, 1024, WOUT, scr, r / 32, r % 32, lane); continue; } r -= I_SQ;
        if (r < I_GU) { const int nb = r % (NGU / 32), kb = r / (NGU / 32);
            p0_transpose_item<true>([&](int n) -> const float* { const int t = n >> 8, j = n & 255, ch = t * 128 + (j >> 3) * 4 + (j & 3); return ((j & 4) ? w_up : w_gate) + ch; }, DFF, 1024, WGU, scr, kb, nb, lane, F.in[23]); continue; } r -= I_GU;
        p0_transpose_item<true>([&](int n) -> const float* { return w_dn + n; }, 1024, DFF, WDN, scr, r / 32, r % 32, lane);
    }
    const float* xp = F.in[0]; const float* xs = F.in[1]; const float* meta = F.in[7]; const float* n1w = F.in[9];
    bf16_t* HN = (bf16_t*)(F.ob + DO_HN);
    f32x4 wv[4];
#pragma unroll
    for (int j = 0; j < 4; ++j) wv[j] = *((const f32x4*)n1w + lane + 64 * j);
    for (int m = gw; m < RPAD; m += NGW) {
        GAS u32x2* o8 = (GAS u32x2*)(HN + (size_t)m * DM) + lane;
        if (m >= RR) {
#pragma unroll
            for (int j = 0; j < 4; ++j) o8[64 * j] = (u32x2){0u, 0u};
            continue; }
        const float* xrow;
        if (m < RPR) { const int b = m / TP, t = m - b * TP; xrow = t < NMETA ? meta + (size_t)t * DM : xp + ((size_t)b * SEQ + (t - NMETA)) * DM; }
        else xrow = xs + (size_t)(m - RPR) * DM;
        const f32x4* xr = (const f32x4*)xrow + lane;
        f32x4 v[4]; float s = 0.f;
#pragma unroll
        for (int j = 0; j < 4; ++j) { v[j] = xr[64 * j]; s += (v[j].x * v[j].x + v[j].y * v[j].y) + (v[j].z * v[j].z + v[j].w * v[j].w); }
        const float rs = __builtin_amdgcn_rsqf(wave_sum(s) * (1.f / DM) + EPS);
#pragma unroll
        for (int j = 0; j < 4; ++j) { const f32x4 y = v[j] * rs * wv[j]; o8[64 * j] = (u32x2){cvt_pk_bf16(y.x, y.y), cvt_pk_bf16(y.z, y.w)}; }
    }
    { float* s1 = (float*)(F.ws + WS_SSQ1); const int gt = F.vcu * NTHR + F.tid, GT = F.G * NTHR;
      for (int i = gt; i < (int)((WS_PART - WS_SSQ1) / 4); i += GT) s1[i] = 0.f; }
}

struct SchedP1 {
    const char* A; const char* B; int G, c;
    __device__ __forceinline__ bool next(int i, pg8::Unit& u) const {
        const int L = i * G + c; if (L >= 67 * 29) return false;
        pg8::tile_of(L, 67, 29, u.pm, u.pn); u.part = 0; u.A = A + (size_t)u.pm * 256 * 1024 * 2; u.B = B + (size_t)u.pn * 256 * 1024 * 2; return true; }
};
struct EpiP1 {
    static constexpr bool PERM = true;
    unsigned char* ws; unsigned char* ob;
    __device__ __forceinline__ bool operator()(pg8::Acc& acc, const pg8::Unit& u, int wr, int wc, int fr, int fq) const {
        const int pn = u.pn; const int row0 = u.pm * 256 + wr * 64 + fr, cw = wc * 32 + 8 * fq;
        if (pn == 28) {
            float* SM = (float*)(ws + WS_SM);
            if (cw < SMLD) {
#pragma unroll
                for (int ai = 0; ai < 2; ++ai)
#pragma unroll
                    for (int m = 0; m < 4; ++m) { const int r = row0 + ai * 128 + m * 16; if (r < RR) { float* p = SM + (size_t)r * SMLD + cw; *(f32x4*)p = acc[ai][0][m][0]; *(f32x4*)(p + 4) = acc[ai][0][m][1]; } }
            }
            return false;
        }
        bf16_t* base; int ld, c0;
        if (pn < 4) { base = (bf16_t*)(ws + WS_Z); ld = 1024; c0 = pn * 256; }
        else if (pn < 8) { base = (bf16_t*)(ws + WS_XS); ld = 1024; c0 = (pn - 4) * 256; }
        else if (pn < 12) { base = (bf16_t*)(ws + WS_BC); ld = 1024; c0 = (pn - 8) * 256; }
        else if (pn < 16) { base = (bf16_t*)(ob + DO_Q); ld = 1024; c0 = (pn - 12) * 256; }
        else if (pn == 16) { base = (bf16_t*)(ws + WS_K); ld = 256; c0 = 0; }
        else if (pn == 17) { base = (bf16_t*)(ws + WS_V); ld = 256; c0 = 0; }
        else if (pn < 20) { base = (bf16_t*)(ob + DO_QI); ld = 512; c0 = (pn - 18) * 256; }
        else if (pn < 24) { base = (bf16_t*)(ws + WS_GS); ld = 1024; c0 = (pn - 20) * 256; }
        else { base = (bf16_t*)(ws + WS_GA); ld = 1024; c0 = (pn - 24) * 256; }
#pragma unroll
        for (int ai = 0; ai < 2; ++ai)
#pragma unroll
            for (int m = 0; m < 4; ++m) { const int r = row0 + ai * 128 + m * 16;
                if (r < RR) { bf16_t* rowp = base + (size_t)r * ld + c0 + cw;
#pragma unroll
                    for (int bj = 0; bj < 2; ++bj) { const f32x4 v0 = acc[ai][bj][m][0], v1 = acc[ai][bj][m][1];
                        u32x4 w; w.x = cvt_pk_bf16(v0[0], v0[1]); w.y = cvt_pk_bf16(v0[2], v0[3]); w.z = cvt_pk_bf16(v1[0], v1[1]); w.w = cvt_pk_bf16(v1[2], v1[3]);
                        *(u32x4*)(rowp + bj * 128) = w; } } }
        return false;
    }
};

__device__ __forceinline__ void p2_rows(Frame& F) {
    const int gw = F.vcu * NWAVES + F.wave, NGW = F.G * NWAVES, lane = F.lane;
    bf16_t* K = (bf16_t*)(F.ws + WS_K); const bf16_t* V = (const bf16_t*)(F.ws + WS_V);
    float* SM = (float*)(F.ws + WS_SM); bf16_t* KI = (bf16_t*)(F.ws + WS_KI);
    const float* knw = F.in[18]; const float* ikw = F.in[19]; const float* dtb = F.in[13];
    const f32x4 kw = *(const f32x4*)(knw + (lane & 31) * 4);
    const float iw = ikw[lane]; const float dbias = lane < 16 ? dtb[lane] : 0.f;
    const int item = gw; u32x4 ixs[2] = {{0u, 0u, 0u, 0u}, {0u, 0u, 0u, 0u}}, ibc[2] = {{0u, 0u, 0u, 0u}, {0u, 0u, 0u, 0u}};
    if (item < 48 + 768) { int r;
        if (item < 48) { const int s = item / 3, i = item % 3; r = s < 8 ? s * TP + (TP - 3 + i) : RPR + (s - 8) * DSEQ + (DSEQ - 3 + i); }
        else { const int h = item - 48, b = h / 96, jb = (h % 96) / 3, i = h % 3; r = b * TP + 64 * (jb + 1) - 3 + i; }
#pragma unroll
        for (int j = 0; j < 2; ++j) { const int c = j * 512 + lane * 8; ixs[j] = *(const u32x4*)((const bf16_t*)(F.ws + WS_XS) + (size_t)r * 1024 + c); ibc[j] = *(const u32x4*)((const bf16_t*)(F.ws + WS_BC) + (size_t)r * 1024 + c); } }
    u32x2 nk, nv; float nki, ndt, nwi;
#define P2_LOAD(rr) do { nk = *((const u32x2*)(K + (size_t)(rr) * 256) + lane); nv = *((const u32x2*)(V + (size_t)(rr) * 256) + lane); \
        const float* sm_ = SM + (size_t)(rr) * SMLD; nki = sm_[16 + lane]; ndt = sm_[lane & 15]; nwi = sm_[80 + (lane & 7)]; } while (0)
    if (gw < RR) P2_LOAD(gw);
    for (int r = gw; r < RR; r += NGW) {
        const u32x2 kin = nk, vv = nv; const float kv = nki, dtv = ndt, wiv = nwi;
        if (r + NGW < RR) P2_LOAD(r + NGW);
        const bool pr = r < RPR; const size_t orow = pr ? (size_t)r : (size_t)(r - RPR);
        float* k_out = F.out + (pr ? O_KP : O_KS) + orow * 256; float* v_out = F.out + (pr ? O_VP : O_VS) + orow * 256; float* ki_out = F.out + (pr ? O_KIP : O_KIS) + orow * 64;
        { u32x2* kp = (u32x2*)(K + (size_t)r * 256) + lane;
          f32x4 x = {bf_lo(kin.x), bf_hi(kin.x), bf_lo(kin.y), bf_hi(kin.y)};
          float s = (x.x * x.x + x.y * x.y) + (x.z * x.z + x.w * x.w);
          s += __shfl_xor(s, 1); s += __shfl_xor(s, 2); s += __shfl_xor(s, 4); s += __shfl_xor(s, 8); s += __shfl_xor(s, 16);
          const float rs = __builtin_amdgcn_rsqf(s * (1.f / HD) + EPS);
          x = x * rs * kw;
          *kp = (u32x2){cvt_pk_bf16(x.x, x.y), cvt_pk_bf16(x.z, x.w)};
          *((f32x4*)k_out + lane) = x;
          *((f32x4*)v_out + lane) = (f32x4){bf_lo(vv.x), bf_hi(vv.x), bf_lo(vv.y), bf_hi(vv.y)}; }
        { float* sm = SM + (size_t)r * SMLD;
          const float ss = wave_sum(kv * kv);
          const float kn = kv * __builtin_amdgcn_rsqf(ss * (1.f / IDXD) + EPS) * iw;
          KI[(size_t)r * 64 + lane] = f2bf(kn); ki_out[lane] = kn;
          if (lane < 16) { const float x = dtv + dbias; sm[lane] = x > 20.f ? x : log1pf(expf(x)); }
          if (lane < 8) sm[80 + lane] = wiv * 0.04419417382415922f; }
    }
#undef P2_LOAD
    if (item < 48) { const int s = item / 3, i = item % 3; float* o = F.out + (s < 8 ? O_CVP + (size_t)(s * 3 + i) * CONV_DIM : O_CVS + (size_t)((s - 8) * 3 + i) * CONV_DIM);
#pragma unroll
        for (int j = 0; j < 2; ++j) { const int c = j * 512 + lane * 8; const u32x4 xa = ixs[j], xb = ibc[j];
            *(f32x4*)(o + c) = (f32x4){bf_lo(xa.x), bf_hi(xa.x), bf_lo(xa.y), bf_hi(xa.y)}; *(f32x4*)(o + c + 4) = (f32x4){bf_lo(xa.z), bf_hi(xa.z), bf_lo(xa.w), bf_hi(xa.w)};
            *(f32x4*)(o + 1024 + c) = (f32x4){bf_lo(xb.x), bf_hi(xb.x), bf_lo(xb.y), bf_hi(xb.y)}; *(f32x4*)(o + 1024 + c + 4) = (f32x4){bf_lo(xb.z), bf_hi(xb.z), bf_lo(xb.w), bf_hi(xb.w)}; } }
    else if (item < 48 + 768) { const int h = item - 48, b = h / 96, jb = (h % 96) / 3, i = h % 3; bf16_t* o = (bf16_t*)(F.ws + WS_HAL) + (size_t)((b * 33 + jb + 1) * 3 + i) * CONV_DIM;
#pragma unroll
        for (int j = 0; j < 2; ++j) { const int c = j * 512 + lane * 8; *(u32x4*)(o + c) = ixs[j]; *(u32x4*)(o + 1024 + c) = ibc[j]; } }
}

__device__ __forceinline__ int t5_bucket(int rel) {
    const int n = rel < 0 ? -rel : rel; const int ret = rel > 0 ? 16 : 0;
    const int v = n < 8 ? n : (n < 12 ? 8 : n < 16 ? 9 : n < 23 ? 10 : n < 32 ? 11 : n < 46 ? 12 : n < 64 ? 13 : n < 91 ? 14 : 15);
    return ret + v;
}
__device__ __forceinline__ void conv_unit(Frame& F, int u) {
    bf16_t* XS = (bf16_t*)(F.ws + WS_XS); bf16_t* BC = (bf16_t*)(F.ws + WS_BC); const bf16_t* HAL = (const bf16_t*)(F.ws + WS_HAL);
    const float* conv_w = F.in[11]; const float* conv_b = F.in[12]; const float* st_conv = F.in[6];
    const int cg = F.tid & 63, rc = F.wave;
    const int cq = u & 1, sb = u >> 1; const bool pr = sb < NBATCH * 33;
    const int b = pr ? sb / 33 : sb - NBATCH * 33, j = pr ? sb % 33 : 0;
    const int T = pr ? TP : DSEQ, row0 = (pr ? b * TP : RPR + b * DSEQ) + 64 * j, nvalid = T - 64 * j;
    const int t0 = 8 * rc;
    u32x4 raw[2][11];
#pragma unroll
    for (int h = 0; h < 2; ++h) { const int ch = 1024 * cq + 512 * h + 8 * cg; const bf16_t* colp = ch < 1024 ? XS + ch : BC + (ch - 1024);
#pragma unroll
        for (int i = 0; i < 11; ++i) { const int t = t0 - 3 + i;
            u32x4 v = {0u, 0u, 0u, 0u};
            if (t >= 0) { if (t < nvalid) v = __builtin_nontemporal_load((const u32x4*)(colp + (size_t)(row0 + t) * 1024)); }
            else if (j > 0) v = *(const u32x4*)(HAL + (size_t)((b * 33 + j) * 3 + (t + 3)) * CONV_DIM + ch);
            raw[h][i] = v; } }
    __syncthreads();
#pragma unroll
    for (int h = 0; h < 2; ++h) { const int ch = 1024 * cq + 512 * h + 8 * cg; bf16_t* colp = ch < 1024 ? XS + ch : BC + (ch - 1024);
        float w[4][8], bias[8];
#pragma unroll
        for (int i = 0; i < 4; ++i) { const f32x4 a = *(const f32x4*)(conv_w + i * CONV_DIM + ch), c = *(const f32x4*)(conv_w + i * CONV_DIM + ch + 4);
            w[i][0] = a.x; w[i][1] = a.y; w[i][2] = a.z; w[i][3] = a.w; w[i][4] = c.x; w[i][5] = c.y; w[i][6] = c.z; w[i][7] = c.w; }
        { const f32x4 a = *(const f32x4*)(conv_b + ch), c = *(const f32x4*)(conv_b + ch + 4); bias[0] = a.x; bias[1] = a.y; bias[2] = a.z; bias[3] = a.w; bias[4] = c.x; bias[5] = c.y; bias[6] = c.z; bias[7] = c.w; }
        float x[4][8];
#define CONV_ROW(dst, i) do { const int t_ = t0 - 3 + (i); \
            if (!pr && t_ < 0) { const float* sp = st_conv + (size_t)(b * 3 + (t_ + 3)) * CONV_DIM + ch; const f32x4 a_ = *(const f32x4*)sp, c_ = *(const f32x4*)(sp + 4); \
                dst[0] = a_.x; dst[1] = a_.y; dst[2] = a_.z; dst[3] = a_.w; dst[4] = c_.x; dst[5] = c_.y; dst[6] = c_.z; dst[7] = c_.w; } \
            else { const u32x4 v_ = raw[h][i]; dst[0] = bf_lo(v_.x); dst[1] = bf_hi(v_.x); dst[2] = bf_lo(v_.y); dst[3] = bf_hi(v_.y); dst[4] = bf_lo(v_.z); dst[5] = bf_hi(v_.z); dst[6] = bf_lo(v_.w); dst[7] = bf_hi(v_.w); } } while (0)
        CONV_ROW(x[0], 0); CONV_ROW(x[1], 1); CONV_ROW(x[2], 2);
#pragma unroll
        for (int r = 0; r < 8; ++r) { const int t = t0 + r;
            CONV_ROW(x[(r + 3) & 3], r + 3);
            if (t < nvalid) { float o[8];
#pragma unroll
                for (int e = 0; e < 8; ++e) o[e] = siluf_(bias[e] + x[r & 3][e] * w[0][e] + x[(r + 1) & 3][e] * w[1][e] + x[(r + 2) & 3][e] * w[2][e] + x[(r + 3) & 3][e] * w[3][e]);
                u32x4 ov; ov.x = cvt_pk_bf16(o[0], o[1]); ov.y = cvt_pk_bf16(o[2], o[3]); ov.z = cvt_pk_bf16(o[4], o[5]); ov.w = cvt_pk_bf16(o[6], o[7]);
                __builtin_nontemporal_store(ov, (u32x4*)(colp + (size_t)(row0 + t) * 1024)); } }
#undef CONV_ROW
    }
    __syncthreads();
}

namespace ssd {
constexpr int CL = 0, BL = 17408, XR = 34816, XW = 44032, WM = 53248, SB = 62464, FA = 79872, LDS_TOT = 80640;
constexpr int LDC = 272, LDX = 144, LDW = 144;
typedef short v4i16 __attribute__((ext_vector_type(4)));
__device__ __forceinline__ s16x4 trd(LAS unsigned char* p) { return __builtin_bit_cast(s16x4, __builtin_amdgcn_ds_read_tr16_b64_v4i16((LAS v4i16*)p)); }
__device__ __forceinline__ bf16x8 frag_tr(LAS unsigned char* img, int stride, int m0, int kb0, int i, int g4) {
    LAS unsigned char* p = img + (kb0 + 8 * g4 + (i >> 2)) * stride + (m0 + 4 * (i & 3)) * 2;
    const s16x4 lo = trd(p), hi = trd(p + 4 * stride);
    return (bf16x8){lo[0], lo[1], lo[2], lo[3], hi[0], hi[1], hi[2], hi[3]};
}
__device__ __forceinline__ bf16x8 frag_row(LAS unsigned char* img, int stride, int r0, int kb0, int i, int g4) {
    return *(const LAS bf16x8*)(img + (r0 + i) * stride + (kb0 + 8 * g4) * 2);
}
}
__device__ __forceinline__ void ssd_chain_unit(Frame& F, int unit) {
    using namespace ssd;
    int tid_ = F.tid; asm volatile("" : "+v"(tid_));
    const int tid = tid_, lane = tid & 63, w = F.wave, i16 = lane & 15, g4 = lane >> 4;
    LAS unsigned char* L = F.lds;
    const bool pr = unit < 128; const int uu = unit & 127, b = uu >> 4, h = uu & 15, g = h >> 2;
    const int T = pr ? TP : DSEQ, row0 = pr ? b * TP : RPR + b * DSEQ, nblk = (T + 63) >> 6;
    bf16_t* XS = (bf16_t*)(F.ws + WS_XS); const bf16_t* BC = (const bf16_t*)(F.ws + WS_BC); const bf16_t* Z = (const bf16_t*)(F.ws + WS_Z);
    const float* SM = (const float*)(F.ws + WS_SM); float* SSQ1 = (float*)(F.ws + WS_SSQ1);
    const int xcol = h * 64;
    const float a_h = -expf(F.in[14][h]), dsk = F.in[15][h];
    const int cb_sb = w >> 1, cb_tb0 = 2 * (w & 1), y_pb0 = 2 * (w & 1), y_tb = w >> 1;
    const int yp0 = 16 * y_pb0 + 4 * g4;
    f32x4 nwv[2];
#pragma unroll
    for (int q = 0; q < 2; ++q) nwv[q] = *(const f32x4*)(F.in[16] + xcol + yp0 + 16 * q);
    f32x4 st[4];
    float* sout = F.out + (pr ? O_SSMP : O_SSMS) + ((size_t)(b * 16 + h) * 64) * 128;
    if (pr) {
#pragma unroll
        for (int pb = 0; pb < 4; ++pb) st[pb] = (f32x4){0.f, 0.f, 0.f, 0.f}; }
    else { const float* sp = F.in[5] + ((size_t)(b * 16 + h) * 64) * 128;
#pragma unroll
        for (int pb = 0; pb < 4; ++pb) st[pb] = *(const f32x4*)(sp + (size_t)(16 * pb + i16) * 128 + 16 * w + 4 * g4); }
    const int srow = tid >> 3, sch = tid & 7;
    u32x4 pB[2], pC[2], pX; u32x2 pZ[2]; float pdt;
#define SSD_PREFETCH(jb) do { const int base_ = 64 * (jb); \
        { const bool ok_ = base_ + srow < T; const bf16_t* rp_ = BC + (size_t)(row0 + base_ + srow) * 1024 + g * 128 + 8 * sch; \
          pB[0] = ok_ ? *(const u32x4*)rp_ : (u32x4){0u, 0u, 0u, 0u}; pB[1] = ok_ ? *(const u32x4*)(rp_ + 64) : (u32x4){0u, 0u, 0u, 0u}; \
          pC[0] = ok_ ? *(const u32x4*)(rp_ + 512) : (u32x4){0u, 0u, 0u, 0u}; pC[1] = ok_ ? *(const u32x4*)(rp_ + 576) : (u32x4){0u, 0u, 0u, 0u}; \
          pX = ok_ ? *(const u32x4*)(XS + (size_t)(row0 + base_ + srow) * 1024 + xcol + 8 * sch) : (u32x4){0u, 0u, 0u, 0u}; } \
        { const int t_ = base_ + 16 * y_tb + i16; const bf16_t* zp_ = Z + (size_t)(row0 + t_) * 1024 + xcol + yp0; \
          pZ[0] = t_ < T ? *(const u32x2*)zp_ : (u32x2){0u, 0u}; pZ[1] = t_ < T ? *(const u32x2*)(zp_ + 16) : (u32x2){0u, 0u}; } \
        { const int t_ = base_ + lane; pdt = t_ < T ? SM[(size_t)(row0 + t_) * SMLD + h] : 0.f; } } while (0)
    SSD_PREFETCH(0);
#pragma unroll 1
    for (int jb = 0; jb < nblk; ++jb) {
        float ac = pdt * a_h;
#pragma unroll
        for (int o = 1; o < 64; o <<= 1) { const float v = __shfl_up(ac, o); if (lane >= o) ac += v; }
        const float tot = __shfl(ac, 63);
        const float wsc = __builtin_amdgcn_exp2f((tot - ac) * 1.4426950408889634f) * pdt;
        if (w == 0) { LAS float* fa = (LAS float*)(L + FA); fa[lane] = ac; fa[64 + lane] = pdt; }
        *(LAS u32x4*)(L + BL + srow * LDC + 16 * sch) = pB[0]; *(LAS u32x4*)(L + BL + srow * LDC + 128 + 16 * sch) = pB[1];
        *(LAS u32x4*)(L + CL + srow * LDC + 16 * sch) = pC[0]; *(LAS u32x4*)(L + CL + srow * LDC + 128 + 16 * sch) = pC[1];
        { *(LAS u32x4*)(L + XR + srow * LDX + 16 * sch) = pX;
            const float ws_ = __shfl(wsc, srow);
            u32x4 xw; xw.x = cvt_pk_bf16(bf_lo(pX.x) * ws_, bf_hi(pX.x) * ws_); xw.y = cvt_pk_bf16(bf_lo(pX.y) * ws_, bf_hi(pX.y) * ws_);
            xw.z = cvt_pk_bf16(bf_lo(pX.z) * ws_, bf_hi(pX.z) * ws_); xw.w = cvt_pk_bf16(bf_lo(pX.w) * ws_, bf_hi(pX.w) * ws_);
            *(LAS u32x4*)(L + XW + srow * LDX + 16 * sch) = xw; }
#pragma unroll
        for (int pb = 0; pb < 4; ++pb)
            *(LAS u32x2*)(L + SB + (16 * pb + i16) * LDC + (16 * w + 4 * g4) * 2) = (u32x2){cvt_pk_bf16(st[pb].x, st[pb].y), cvt_pk_bf16(st[pb].z, st[pb].w)};
        const u32x2 zreg0 = pZ[0], zreg1 = pZ[1];
        __syncthreads();
        if (jb + 1 < nblk) SSD_PREFETCH(jb + 1);
        {
            f32x4 cb[2] = {{0.f, 0.f, 0.f, 0.f}, {0.f, 0.f, 0.f, 0.f}};
#pragma unroll
            for (int ks = 0; ks < 4; ++ks) { const bf16x8 af = frag_row(L + BL, LDC, 16 * cb_sb, 32 * ks, i16, g4);
#pragma unroll
                for (int q = 0; q < 2; ++q) { const bf16x8 bfv = frag_row(L + CL, LDC, 16 * (cb_tb0 + q), 32 * ks, i16, g4);
                    cb[q] = __builtin_amdgcn_mfma_f32_16x16x32_bf16(af, bfv, cb[q], 0, 0, 0); } }
            const LAS float* fa = (const LAS float*)(L + FA);
            const int s0 = 16 * cb_sb + 4 * g4;
            const f32x4 acs = *(const LAS f32x4*)(fa + s0), dts = *(const LAS f32x4*)(fa + 64 + s0);
#pragma unroll
            for (int q = 0; q < 2; ++q) { const int t = 16 * (cb_tb0 + q) + i16; const float act = fa[t];
                float o[4];
#pragma unroll
                for (int e = 0; e < 4; ++e) o[e] = (s0 + e <= t) ? cb[q][e] * __builtin_amdgcn_exp2f((act - acs[e]) * 1.4426950408889634f) * dts[e] : 0.f;
                *(LAS u32x2*)(L + WM + t * LDW + s0 * 2) = (u32x2){cvt_pk_bf16(o[0], o[1]), cvt_pk_bf16(o[2], o[3])}; }
            const float dtot = __builtin_amdgcn_exp2f(tot * 1.4426950408889634f);
#pragma unroll
            for (int pb = 0; pb < 4; ++pb) st[pb] = st[pb] * dtot;
#pragma unroll
            for (int ks = 0; ks < 2; ++ks) { const bf16x8 af = frag_tr(L + BL, LDC, 16 * w, 32 * ks, i16, g4);
#pragma unroll
                for (int pb = 0; pb < 4; ++pb) { const bf16x8 bfv = frag_tr(L + XW, LDX, 16 * pb, 32 * ks, i16, g4);
                    st[pb] = __builtin_amdgcn_mfma_f32_16x16x32_bf16(af, bfv, st[pb], 0, 0, 0); } }
        }
        __syncthreads();
        {
            f32x4 y[2] = {{0.f, 0.f, 0.f, 0.f}, {0.f, 0.f, 0.f, 0.f}};
#pragma unroll
            for (int ks = 0; ks < 4; ++ks) { const bf16x8 bfv = frag_row(L + CL, LDC, 16 * y_tb, 32 * ks, i16, g4);
#pragma unroll
                for (int q = 0; q < 2; ++q) { const bf16x8 af = frag_row(L + SB, LDC, 16 * (y_pb0 + q), 32 * ks, i16, g4); y[q] = __builtin_amdgcn_mfma_f32_16x16x32_bf16(af, bfv, y[q], 0, 0, 0); } }
            const LAS float* fa = (const LAS float*)(L + FA);
            const int t = 16 * y_tb + i16; const float eac = __builtin_amdgcn_exp2f(fa[t] * 1.4426950408889634f);
            y[0] = y[0] * eac; y[1] = y[1] * eac;
#pragma unroll
            for (int ks = 0; ks < 2; ++ks) { const bf16x8 bfv = frag_row(L + WM, LDW, 16 * y_tb, 32 * ks, i16, g4);
#pragma unroll
                for (int q = 0; q < 2; ++q) { const bf16x8 af = frag_tr(L + XR, LDX, 16 * (y_pb0 + q), 32 * ks, i16, g4); y[q] = __builtin_amdgcn_mfma_f32_16x16x32_bf16(af, bfv, y[q], 0, 0, 0); } }
            const int tg = 64 * jb + t; float ss = 0.f; f32x4 yo[2];
#pragma unroll
            for (int q = 0; q < 2; ++q) { const u32x2 xv = *(const LAS u32x2*)(L + XR + t * LDX + (yp0 + 16 * q) * 2); const u32x2 zr = q ? zreg1 : zreg0;
                const f32x4 xf = {bf_lo(xv.x), bf_hi(xv.x), bf_lo(xv.y), bf_hi(xv.y)}, zf = {bf_lo(zr.x), bf_hi(zr.x), bf_lo(zr.y), bf_hi(zr.y)};
                yo[q].x = (y[q].x + dsk * xf.x) * siluf_(zf.x); yo[q].y = (y[q].y + dsk * xf.y) * siluf_(zf.y); yo[q].z = (y[q].z + dsk * xf.z) * siluf_(zf.z); yo[q].w = (y[q].w + dsk * xf.w) * siluf_(zf.w);
                ss += (yo[q].x * yo[q].x + yo[q].y * yo[q].y) + (yo[q].z * yo[q].z + yo[q].w * yo[q].w); }
            ss += __shfl_xor(ss, 16); ss += __shfl_xor(ss, 32);
            if (tg < T) { if (g4 == 0) atomicAdd(SSQ1 + row0 + tg, ss);
#pragma unroll
                for (int q = 0; q < 2; ++q) { const f32x4 yn = yo[q] * nwv[q]; const u32x2 yv = {cvt_pk_bf16(yn.x, yn.y), cvt_pk_bf16(yn.z, yn.w)}; bf16_t* yp = XS + (size_t)(row0 + tg) * 1024 + xcol + yp0 + 16 * q;
                    if (pr) *(u32x2*)yp = yv; else wt_store8(yp, yv); } }
        }
        __syncthreads();
    }
#undef SSD_PREFETCH
#pragma unroll
    for (int pb = 0; pb < 4; ++pb) *(f32x4*)(sout + (size_t)(16 * pb + i16) * 128 + 16 * w + 4 * g4) = st[pb];
    if (!pr) unit_publish_wt(F, CW_DEP + 192);
}
__device__ __forceinline__ float relu1(float a) { const int b = __float_as_int(a); return __int_as_float(b > 0 ? b : 0); }
__device__ __forceinline__ f32x2 pk_relu(f32x2 a) { return (f32x2){relu1(a.x), relu1(a.y)}; }
__device__ __forceinline__ f32x2 pk_fma(f32x2 a, f32x2 b, f32x2 c) { f32x2 r; asm volatile("v_pk_fma_f32 %0, %1, %2, %3" : "=v"(r) : "v"(a), "v"(b), "v"(c)); return r; }
namespace idx {
constexpr int WTAB = 0, SCORES = 512;
}
__device__ __forceinline__ unsigned* mask_row(Frame& F, int r) {
    return r < RPR ? (unsigned*)(F.ws + WS_MASK) + (size_t)r * MASK_LDP : (unsigned*)(F.ws + WS_MASKS) + (size_t)(r - RPR) * MASK_LDS;
}
__device__ __forceinline__ unsigned f2key(float f) { const unsigned u = __float_as_uint(f); return (u & 0x80000000u) ? ~u : (u | 0x80000000u); }
__device__ __forceinline__ float key2f(unsigned k) { return __uint_as_float((k & 0x80000000u) ? (k & 0x7fffffffu) : ~k); }
template <int NI>
__device__ __forceinline__ void idx_select(Frame& F, const LAS float* sc, int LP, int Lk, int NQ, int r0) {
    const int lane = F.lane, w = F.wave, ni = LP >> 6; const unsigned long long lt_mask = (1ull << lane) - 1ull;
    float zq, dfac;
    { const float qq = 0.5f - (float)TOPK / (float)Lk, r = qq * qq;
      zq = (((((-3.969683028665376e+01f * r + 2.209460984245205e+02f) * r - 2.759285104469687e+02f) * r + 1.383577518672690e+02f) * r - 3.066479806614716e+01f) * r + 2.506628277459239e+00f) * qq /
           (((((-5.447609879822406e+01f * r + 1.615858368580409e+02f) * r - 1.556989798598866e+02f) * r + 6.680131188771972e+01f) * r - 1.328068155288572e+01f) * r + 1.f);
      dfac = (float)Lk * 0.3989422804f * __builtin_amdgcn_exp2f(-0.7213475204f * zq * zq); }
    constexpr int NMIN = NI == 9 ? 5 : (NI == 65 ? 65 : NI - 7);
    const float NINF = -__builtin_inff(), PINF = __builtin_inff();
#pragma unroll 1
    for (int q = w; q < NQ; q += 8) {
        const LAS float* row = sc + q * LP + lane; unsigned* mrow = mask_row(F, r0 + q);
        float kreg[NI];
        kreg[0] = row[(ni - 1) * 64];
#pragma unroll
        for (int j = 1; j < NI; ++j) { if (j < NMIN) kreg[j] = row[(j - 1) * 64]; else kreg[j] = j < ni ? row[(j - 1) * 64] : NINF; }
        float mx = kreg[0], mn = kreg[0] == NINF ? PINF : kreg[0], sm = 0.f, sq = 0.f;
#pragma unroll
        for (int j = 1; j < NI; ++j) { const float x = kreg[j]; mx = fmaxf(mx, x);
            if (j < NMIN) { mn = fminf(mn, x); sm += x; sq = fmaf(x, x, sq); } else mn = fminf(mn, x == NINF ? PINF : x); }
#pragma unroll
        for (int o = 1; o < 64; o <<= 1) { mx = fmaxf(mx, __shfl_xor(mx, o)); mn = fminf(mn, __shfl_xor(mn, o)); sm += __shfl_xor(sm, o); sq += __shfl_xor(sq, o); }
        mx = __int_as_float(__builtin_amdgcn_readfirstlane(__float_as_int(mx))); mn = __int_as_float(__builtin_amdgcn_readfirstlane(__float_as_int(mn)));
        sm = __int_as_float(__builtin_amdgcn_readfirstlane(__float_as_int(sm))); sq = __int_as_float(__builtin_amdgcn_readfirstlane(__float_as_int(sq)));
        constexpr float RN = 1.f / (64.f * (NMIN - 1));
        const float mu = sm * RN, sd = __builtin_sqrtf(fmaxf(sq * RN - mu * mu, 0.f));
        const float idens = sd / dfac;
        float lo = mn, hi = __uint_as_float(__float_as_uint(mx) + (mx >= 0.f ? 1u : 0xffffffffu)); if (mx == 0.f) hi = 1e-38f;
        float thr = 0.f; bool exact = false; float flo = 0.f, fhi = 0.f; bool lo_set = false, hi_set = false;
        float guess = mu + zq * sd; int third = 0;
#pragma unroll 1
        for (int it = 0; it < 64; ++it) {
            float mid = guess;
            if (it >= 20) mid = key2f(f2key(lo) + ((f2key(hi) - f2key(lo)) >> 1));
            if (!(mid > lo && mid < hi)) { mid = lo + (hi - lo) * 0.5f; if (!(mid > lo && mid < hi)) break; }
            int cnt = __popcll(__ballot(kreg[0] >= mid));
#pragma unroll
            for (int i = 1; i + 3 < NI; i += 4) {
                const unsigned long long b0 = __ballot(kreg[i] >= mid), b1 = __ballot(kreg[i + 1] >= mid), b2 = __ballot(kreg[i + 2] >= mid), b3 = __ballot(kreg[i + 3] >= mid);
                __builtin_amdgcn_sched_group_barrier(0x2, 4, 0); __builtin_amdgcn_sched_group_barrier(0x4, 8, 0);
                cnt += (__popcll(b0) + __popcll(b1)) + (__popcll(b2) + __popcll(b3)); }
            static_assert((NI - 1) % 4 == 0, "NI = 4m + 1");
            if (cnt == TOPK) { thr = mid; exact = true; break; }
            if (cnt > TOPK) { lo = mid; flo = (float)cnt; lo_set = true; } else { hi = mid; fhi = (float)cnt; hi_set = true; }
            if (lo_set && hi_set) { float tfr = (flo - 256.f) * __builtin_amdgcn_rcpf(flo - fhi); if (++third == 3) { third = 0; tfr = 0.5f; } tfr = fminf(fmaxf(tfr, 0.08f), 0.92f); guess = lo + (hi - lo) * tfr; }
            else guess = mid + ((float)cnt - 256.f) * idens; }
        unsigned m0 = 0u, m1 = 0u, m2 = 0u, m3 = 0u;
#define IDX_PUT(blk, ms) do { const unsigned long long ms_ = (ms); const unsigned lo_ = (unsigned)ms_, hi_ = (unsigned)(ms_ >> 32); \
            if (__builtin_constant_p(blk)) { \
                if (NI <= 64 || (blk) < 64) asm("s_nop 1\n\tv_writelane_b32 %0, %2, %4\n\tv_writelane_b32 %1, %3, %4" : "+v"(m0), "+v"(m1) : "s"(lo_), "s"(hi_), "n"((blk) & 63)); \
                else asm("s_nop 1\n\tv_writelane_b32 %0, %2, %4\n\tv_writelane_b32 %1, %3, %4" : "+v"(m2), "+v"(m3) : "s"(lo_), "s"(hi_), "n"((blk) & 63)); } \
            else { if (lane == (blk)) { m0 = lo_; m1 = hi_; } if (NI > 64 && lane + 64 == (blk)) { m2 = lo_; m3 = hi_; } } } while (0)
        if (exact) {
#pragma unroll
            for (int j = 1; j < NI; ++j) IDX_PUT(j - 1, __ballot(kreg[j] >= thr));
            IDX_PUT(ni - 1, __ballot(kreg[0] >= thr));
        } else {
            int ngt = 0;
#pragma unroll
            for (int i = 0; i < NI; ++i) ngt += __popcll(__ballot(kreg[i] >= hi));
            const int need = TOPK - ngt; int eqseen = 0;
#pragma unroll
            for (int jj = 1; jj <= NI; ++jj) { const int j = jj < NI ? jj : 0; const bool gt = kreg[j] >= hi, eq = (kreg[j] >= lo) && !gt; const unsigned long long meq = __ballot(eq);
                const bool sel = gt || (eq && (eqseen + __popcll(meq & lt_mask)) < need);
                if (j) IDX_PUT(j - 1, __ballot(sel)); else IDX_PUT(ni - 1, __ballot(sel));
                eqseen += __popcll(meq); }
        }
#undef IDX_PUT
        if (lane < ni) *(u32x2*)(mrow + 2 * lane) = (u32x2){m0, m1};
        if (NI > 64 && lane + 64 < ni) *(u32x2*)(mrow + 2 * (lane + 64)) = (u32x2){m2, m3};
    }
}
template <bool PR>
__device__ __forceinline__ void idx_unit(Frame& F, int b, int c, int qg) {
    constexpr int NQ = PR ? 16 : 8, NRB = NQ / 4;
    int tid_ = F.tid; asm volatile("" : "+v"(tid_));
    const int tid = tid_, lane = tid & 63, w = F.wave, r32 = lane & 31, hh = lane >> 5;
    LAS unsigned char* L_ = F.lds;
    const int Lk = PR ? NMETA + 64 * c : LS, LP = (Lk + 63) & ~63, nkb = LP >> 5;
    const int r0 = PR ? b * TP + NMETA + 64 * (c - 1) + NQ * qg : RPR + b * DSEQ + NQ * qg;
    const int krow0 = PR ? b * TP : RPR + b * DSEQ;
    const bf16_t* QI = (const bf16_t*)(F.ob + DO_QI); const bf16_t* KI = (const bf16_t*)(F.ws + WS_KI); const float* SM = (const float*)(F.ws + WS_SM); const float* ckidx = F.in[4];
    LAS float* wtab = (LAS float*)(L_ + idx::WTAB); LAS float* sc = (LAS float*)(L_ + idx::SCORES);
    if (tid < NQ * 8) wtab[tid] = SM[(size_t)(r0 + (tid >> 3)) * SMLD + 80 + (tid & 7)];
    const int a_tok = ((r32 >> 4) & 1) + 2 * ((r32 >> 2) & 1), a_head = (r32 & 3) + 4 * ((r32 >> 3) & 1);
    bf16x8 af[NRB][4];
#pragma unroll
    for (int rb = 0; rb < NRB; ++rb)
#pragma unroll
        for (int ks = 0; ks < 4; ++ks) af[rb][ks] = *(const bf16x8*)(QI + (size_t)(r0 + 4 * rb + a_tok) * 512 + a_head * 64 + 16 * ks + 8 * hh);
    __syncthreads();
    constexpr int ST = PR ? 3 : 2, RAWN = PR ? 4 : 8;
    u32x4 raw0[RAWN], raw1[RAWN], raw2[PR ? RAWN : 1];
#define IDX_LOADB(kb_, R) do { const int s_ = (kb_) * 32 + r32; const int sc_ = s_ < Lk ? s_ : Lk - 1; \
        if (!PR && (kb_) * 32 < PAST) { const float* kp = ckidx + ((size_t)b * PAST + sc_) * 64 + 8 * hh; \
            _Pragma("unroll") for (int ks = 0; ks < 4; ++ks) { R[(2 * ks) % RAWN] = *(const u32x4*)(kp + 16 * ks); R[(2 * ks + 1) % RAWN] = *(const u32x4*)(kp + 16 * ks + 4); } } \
        else { const bf16_t* kp = KI + (size_t)(PR ? krow0 + sc_ : krow0 + sc_ - PAST) * 64 + 8 * hh; \
            _Pragma("unroll") for (int ks = 0; ks < 4; ++ks) R[ks] = *(const u32x4*)(kp + 16 * ks); } } while (0)
#define IDX_GETB(kb_, R) do { if (!PR && (kb_) * 32 < PAST) { \
            _Pragma("unroll") for (int ks = 0; ks < 4; ++ks) { const u32x4 x0 = R[(2 * ks) % RAWN], x1 = R[(2 * ks + 1) % RAWN]; \
                u32x4 t; t.x = cvt_pk_bf16(__uint_as_float(x0.x), __uint_as_float(x0.y)); t.y = cvt_pk_bf16(__uint_as_float(x0.z), __uint_as_float(x0.w)); \
                t.z = cvt_pk_bf16(__uint_as_float(x1.x), __uint_as_float(x1.y)); t.w = cvt_pk_bf16(__uint_as_float(x1.z), __uint_as_float(x1.w)); bfr[ks] = __builtin_bit_cast(bf16x8, t); } } \
        else { _Pragma("unroll") for (int ks = 0; ks < 4; ++ks) bfr[ks] = __builtin_bit_cast(bf16x8, R[ks]); } } while (0)
    if (w < nkb) IDX_LOADB(w, raw0);
    if (w + 8 < nkb) IDX_LOADB(w + 8, raw1);
    if (PR && w + 16 < nkb) IDX_LOADB(w + 16, raw2);
#define IDX_STAGE(st, R) do { const int kb = kb0 + 8 * (st); \
        if (kb < nkb) { const int s = kb * 32 + r32; bf16x8 bfr[4]; \
            IDX_GETB(kb, R); \
            if (kb + 8 * ST < nkb) IDX_LOADB(kb + 8 * ST, R); \
            f32x16 d[NRB]; \
            _Pragma("unroll") for (int rb = 0; rb < NRB; ++rb) _Pragma("unroll") for (int e = 0; e < 16; ++e) d[rb][e] = 0.f; \
              \
            _Pragma("unroll") for (int ks = 0; ks < 4; ++ks) _Pragma("unroll") for (int rb = 0; rb < NRB; ++rb) d[rb] = __builtin_amdgcn_mfma_f32_32x32x16_bf16(af[rb][ks], bfr[ks], d[rb], 0, 0, 0); \
            _Pragma("unroll") for (int rb = 0; rb < NRB; ++rb) { \
                  \
                _Pragma("unroll") for (int q = 0; q < 2; ++q) { const int tok = 4 * rb + 2 * hh + q; const f32x4 w0 = *(const LAS f32x4*)(wtab + tok * 8), w1 = *(const LAS f32x4*)(wtab + tok * 8 + 4); \
                    f32x2 acc2 = {0.f, 0.f}; \
                    acc2 = pk_fma(pk_relu((f32x2){d[rb][8 * q], d[rb][8 * q + 1]}), (f32x2){w0.x, w0.y}, acc2); acc2 = pk_fma(pk_relu((f32x2){d[rb][8 * q + 2], d[rb][8 * q + 3]}), (f32x2){w0.z, w0.w}, acc2); \
                    acc2 = pk_fma(pk_relu((f32x2){d[rb][8 * q + 4], d[rb][8 * q + 5]}), (f32x2){w1.x, w1.y}, acc2); acc2 = pk_fma(pk_relu((f32x2){d[rb][8 * q + 6], d[rb][8 * q + 7]}), (f32x2){w1.z, w1.w}, acc2); \
                    float v = acc2.x + acc2.y; \
                      \
                    sc[tok * LP + s] = s < Lk ? v : -__builtin_inff(); } } } } while (0)
#pragma unroll 1
    for (int kb0 = w; kb0 < nkb; kb0 += 8 * ST) {
        IDX_STAGE(0, raw0);
        IDX_STAGE(1, raw1);
        if (PR) IDX_STAGE(2, raw2);
    }
#undef IDX_STAGE
#undef IDX_GETB
#undef IDX_LOADB
    __syncthreads();
    if (PR) { if (LP <= 576) idx_select<9>(F, sc, LP, Lk, NQ, r0); else if (LP <= 1088) idx_select<17>(F, sc, LP, Lk, NQ, r0); else if (LP <= 1600) idx_select<25>(F, sc, LP, Lk, NQ, r0); else idx_select<33>(F, sc, LP, Lk, NQ, r0); }
    else idx_select<65>(F, sc, LP, Lk, NQ, r0);
    __syncthreads();
}
__device__ __forceinline__ void idx_allones(Frame& F, int b, int c) {
    const int Lk = NMETA + 64 * c, nw = ((Lk + 63) & ~63) >> 5;
    for (int e = F.tid; e < 64 * nw; e += NTHR) { const int q = e / nw, wd = e - q * nw; const int lo = 32 * wd;
        const unsigned m = lo + 32 <= Lk ? 0xffffffffu : (lo >= Lk ? 0u : ((1u << (Lk - lo)) - 1u));
        mask_row(F, b * TP + NMETA + 64 * (c - 1) + q)[wd] = m; }
}
__device__ __forceinline__ void idx_conv_units(Frame& F) {
    constexpr int NPU = NBATCH * 29 * 4, NSU = NBATCH * 8, NAU = NBATCH * 3, NCU = (NBATCH * 33 + NBATCH) * 2;
    LAS int* qslot = (LAS int*)(F.lds + MISC_OFF) + 16;
    for (bool first = true; ; first = false) {
        refresh_ids(F);
        if (F.tid == 0) *qslot = first ? (int)blockIdx.x : (int)(F.G + __hip_atomic_fetch_add((unsigned*)(F.ctl + CW_Q + 64), 1u, __ATOMIC_RELAXED, __HIP_MEMORY_SCOPE_AGENT));
        __syncthreads();
        const int u = __builtin_amdgcn_readfirstlane(*qslot);
        __syncthreads();
        if (u >= NPU + NSU + NAU + NCU) break;
        constexpr int NIU = NSU + NPU, NG = NIU / 2;
        static_assert(NIU % 2 == 0 && NG <= NCU, "queue pattern");
        int iu = -1, cu = -1, au = -1;
        if (u < 3 * NG) { const int gq = u / 3, kq = u - 3 * gq; if (kq < 2) iu = 2 * gq + kq; else cu = gq; } else if (u < NIU + NCU) cu = NG + (u - 3 * NG); else au = u - NIU - NCU;
        if (iu >= 0) {
            if (iu < NSU) { idx_unit<false>(F, iu >> 3, 0, iu & 7); }
            else { const int v = iu - NSU; const int qg = v & 3, bc = v >> 2, b = bc & 7, c = 32 - (bc >> 3); idx_unit<true>(F, b, c, qg); } }
        else if (cu >= 0) conv_unit(F, cu);
        else idx_allones(F, au & 7, 1 + (au >> 3));
    }
}
namespace att {
constexpr int SHM_V = 16384, SHM_K = 16384, OFF_V = 0, OFF_K = 2 * SHM_V, OFF_WS = OFF_K + 2 * SHM_K, OFF_TAB = OFF_WS + 8 * 256, OFF_OST = OFF_TAB + 4 * 320 * 4, OST_LD = 272, LDS_TOT = OFF_OST + 8 * 32 * OST_LD;
static_assert(LDS_TOT <= MISC_OFF, "attention LDS");
constexpr float NEG = -1e30f, MINIT = -1e20f, THR2 = 8.f, L2E = 1.4426950408889634f;
#define KSWZ(row, colB) ((row) * 256 + ((colB) ^ (((row) & 15) << 4)))
#define SBAR() __builtin_amdgcn_sched_barrier(0)
__device__ __forceinline__ int crow(int r, int hi) { return (r & 3) + 8 * (r >> 2) + 4 * hi; }
__device__ __forceinline__ int v_st(int k, int c) { const int kk = (k & ~0xC) | ((k & 4) << 1) | ((k & 8) >> 1); return ((kk >> 3) * 4 + (c >> 5)) * 512 + ((kk & 7) * 32 + (c & 31)) * 2; }
__device__ __forceinline__ int v_rd_base(int lane) { return ((lane & 3) << 3) | (((lane >> 2) & 3) << 6) | (((lane >> 4) & 1) << 5) | (((lane >> 5) & 1) << 8); }
constexpr int v_rd_off(int d0, int ks, int half) { return d0 * 512 + ks * 4096 + half * 2048; }
template <int OFF> __device__ __forceinline__ s16x4 tr_read(int vb) { s16x4 r; asm volatile("ds_read_b64_tr_b16 %0, %1 offset:%2" : "=&v"(r) : "v"(vb), "i"(OFF) : "memory"); return r; }
template <int D0> __device__ __forceinline__ void pv_one(f32x16& od, int vb, bf16x8 pa0, bf16x8 pa1, bf16x8 pa2, bf16x8 pa3) {
    const s16x4 l0 = tr_read<v_rd_off(D0, 0, 0)>(vb), h0 = tr_read<v_rd_off(D0, 0, 1)>(vb), l1 = tr_read<v_rd_off(D0, 1, 0)>(vb), h1 = tr_read<v_rd_off(D0, 1, 1)>(vb);
    const s16x4 l2 = tr_read<v_rd_off(D0, 2, 0)>(vb), h2 = tr_read<v_rd_off(D0, 2, 1)>(vb), l3 = tr_read<v_rd_off(D0, 3, 0)>(vb), h3 = tr_read<v_rd_off(D0, 3, 1)>(vb);
    asm volatile("s_waitcnt lgkmcnt(0)" ::: "memory"); SBAR();
#define PK(L, H) (bf16x8){L[0], L[1], L[2], L[3], H[0], H[1], H[2], H[3]}
    od = __builtin_amdgcn_mfma_f32_32x32x16_bf16(pa0, PK(l0, h0), od, 0, 0, 0);
    od = __builtin_amdgcn_mfma_f32_32x32x16_bf16(pa1, PK(l1, h1), od, 0, 0, 0);
    od = __builtin_amdgcn_mfma_f32_32x32x16_bf16(pa2, PK(l2, h2), od, 0, 0, 0);
    od = __builtin_amdgcn_mfma_f32_32x32x16_bf16(pa3, PK(l3, h3), od, 0, 0, 0);
#undef PK
}
__device__ __forceinline__ void qkt(f32x16& p0, f32x16& p1, const LAS unsigned char* Ks, const bf16x8* qr, float init, int r32, int hi) {
#pragma unroll
    for (int r = 0; r < 16; ++r) { p0[r] = init; p1[r] = init; }
#pragma unroll
    for (int d0 = 0; d0 < 8; ++d0) { const int cb = (d0 * 16 + hi * 8) * 2;
        const bf16x8 b0 = *(const LAS bf16x8*)(Ks + KSWZ(r32, cb)), b1 = *(const LAS bf16x8*)(Ks + KSWZ(32 + r32, cb));
        p0 = __builtin_amdgcn_mfma_f32_32x32x16_bf16(b0, qr[d0], p0, 0, 0, 0);
        p1 = __builtin_amdgcn_mfma_f32_32x32x16_bf16(b1, qr[d0], p1, 0, 0, 0); }
}
}

template <bool PR>
__device__ __forceinline__ void attn_unit(Frame& F, int b, int c, int g, int sp) {
    using namespace att;
    int tid_ = F.tid; asm volatile("" : "+v"(tid_));
    const int tid = tid_, lane = tid & 63, w = F.wave, r32 = lane & 31, hi = lane >> 5, hd = w >> 1, th = w & 1;
    LAS unsigned char* L = F.lds;
    const int qrow0 = PR ? b * TP + NMETA + 64 * (c - 1) : RPR + b * DSEQ, qpos0 = PR ? NMETA + 64 * (c - 1) : PAST;
    const int jt0 = PR ? 0 : (sp == 0 ? 0 : 1 + 8 * sp), NT = PR ? c + 1 : 9 + 8 * sp;
    bf16_t* Q = (bf16_t*)(F.ob + DO_Q);
    const bf16_t* Kb = (const bf16_t*)(F.ws + WS_K); const bf16_t* Vb = (const bf16_t*)(F.ws + WS_V); const bf16_t* CK = (const bf16_t*)(F.ws + WS_CK); const bf16_t* CV = (const bf16_t*)(F.ob + DO_CV);
    const float* relb = F.in[8];
    { LAS float* tab = (LAS float*)(L + OFF_TAB);
      for (int e = tid; e < 4 * 320; e += NTHR) { const int h4 = e / 320, rel = e - h4 * 320 - 192; tab[e] = relb[t5_bucket(rel) * 8 + g * 4 + h4] * L2E; } }
    const float cfar = relb[15 * 8 + g * 4 + hd] * L2E;
    bf16x8 qr[8];
    { const bf16_t* qp = Q + (size_t)(qrow0 + 32 * th + r32) * 1024 + g * 512 + hd * 128 + hi * 8; const float* qnw = F.in[17] + hi * 8;
      constexpr float QSC = 0.08838834764831845f * L2E;
      u32x4 qraw[8]; float ss = 0.f;
#pragma unroll
      for (int d0 = 0; d0 < 8; ++d0) qraw[d0] = *(const u32x4*)(qp + d0 * 16);
#pragma unroll
      for (int d0 = 0; d0 < 8; ++d0)
#pragma unroll
          for (int j = 0; j < 4; ++j) { const float a = bf_lo(qraw[d0][j]), b2 = bf_hi(qraw[d0][j]); ss += a * a + b2 * b2; }
      { const auto rr = __builtin_amdgcn_permlane32_swap(__float_as_uint(ss), __float_as_uint(ss), false, false); ss = __uint_as_float(rr[0]) + __uint_as_float(rr[1]); }
      const float rs = __builtin_amdgcn_rsqf(ss * (1.f / HD) + EPS) * QSC;
#pragma unroll
      for (int d0 = 0; d0 < 8; ++d0) { const f32x4 w0 = *(const f32x4*)(qnw + d0 * 16), w1 = *(const f32x4*)(qnw + d0 * 16 + 4); const u32x4 v = qraw[d0];
          const u32x4 o_ = {cvt_pk_bf16(bf_lo(v.x) * rs * w0.x, bf_hi(v.x) * rs * w0.y), cvt_pk_bf16(bf_lo(v.y) * rs * w0.z, bf_hi(v.y) * rs * w0.w),
                            cvt_pk_bf16(bf_lo(v.z) * rs * w1.x, bf_hi(v.z) * rs * w1.y), cvt_pk_bf16(bf_lo(v.w) * rs * w1.z, bf_hi(v.w) * rs * w1.w)};
          qr[d0] = __builtin_bit_cast(bf16x8, o_); } }
    const unsigned* mrow = PR ? (const unsigned*)(F.ws + WS_MASK) + (size_t)(qrow0 + 32 * th + r32) * MASK_LDP : (const unsigned*)(F.ws + WS_MASKS) + (size_t)(qrow0 - RPR + 32 * th + r32) * MASK_LDS;
    LAS float* wsf = (LAS float*)(L + OFF_WS) + w * 64;
    const int sr = tid >> 4, scol = (tid & 15) * 8, vst0 = v_st(sr, scol), vst1 = v_st(32 + sr, scol);
    const int vb0 = (int)(uintptr_t)(L + OFF_V) + v_rd_base(lane);
    float m_reg = MINIT, l_reg = 0.f; f32x16 o[4] = {};
    u32x4 sv0, sv1, sk0, sk1;
#define ATT_SRC(j, kt, vt) const bf16_t* kt; const bf16_t* vt; { if (PR) { kt = Kb + (size_t)(b * TP + 64 * (j)) * 256 + g * 128; vt = Vb + (size_t)(b * TP + 64 * (j)) * 256 + g * 128; } \
        else if ((j) < PAST / 64) { kt = CK + ((size_t)b * PAST + 64 * (j)) * 256 + g * 128; vt = CV + ((size_t)b * PAST + 64 * (j)) * 256 + g * 128; } \
        else { kt = Kb + (size_t)(RPR + b * DSEQ) * 256 + g * 128; vt = Vb + (size_t)(RPR + b * DSEQ) * 256 + g * 128; } }
#define ATT_SLOAD(j) do { ATT_SRC(j, kt_, vt_); sv0 = *(const u32x4*)(vt_ + (size_t)sr * 256 + scol); sv1 = *(const u32x4*)(vt_ + (size_t)(32 + sr) * 256 + scol); \
        sk0 = *(const u32x4*)(kt_ + (size_t)sr * 256 + scol); sk1 = *(const u32x4*)(kt_ + (size_t)(32 + sr) * 256 + scol); } while (0)
#define ATT_SWRITE(bf) do { *(LAS u32x4*)(L + OFF_V + (bf) * SHM_V + vst0) = sv0; *(LAS u32x4*)(L + OFF_V + (bf) * SHM_V + vst1) = sv1; const int kc_ = scol * 2; \
        *(LAS u32x4*)(L + OFF_K + (bf) * SHM_K + KSWZ(sr, kc_)) = sk0; *(LAS u32x4*)(L + OFF_K + (bf) * SHM_K + KSWZ(32 + sr, kc_)) = sk1; } while (0)
    const int qlo = qpos0 + 32 * th;
    const LAS float* tabh = (const LAS float*)(L + OFF_TAB) + hd * 320;
    const bool evn = !((NT - jt0) & 1);
    int jtb = jt0; const int NTR = (NT - jt0) - (evn ? 1 : 0);
    f32x16 pA0, pA1, pB0, pB1; float alA = 1.f, alB = 1.f, cmA = 0.f, cmB = 0.f; u32x2 mwA = {0u, 0u}, mwB = {0u, 0u}; bf16x8 pa0, pa1, pa2, pa3;
#define ATT_MLOAD(k, MW) do { MW = *(const u32x2*)(mrow + 2 * (jtb + (k))); } while (0)
#define ATT_SCORE(P0, P1, k, bfk, MW, CADD) do { const int jj_ = jtb + (k); \
        qkt(P0, P1, L + OFF_K + (bfk) * SHM_K, qr, 0.f, r32, hi); \
        const bool far_ = (64 * jj_ + 63 - qlo) <= -91; CADD = far_ ? cfar : 0.f; \
        if (!far_) { const LAS float* tp = tabh + (64 * jj_ - qlo - r32 + 4 * hi + 192); \
            _Pragma("unroll") for (int r = 0; r < 16; ++r) { const int o_ = (r & 3) + 8 * (r >> 2); P0[r] += tp[o_]; P1[r] += tp[o_ + 32]; } } } while (0)
#define ATT_PARTIAL(P0, P1, MW, CADD, AL, CM) do { float pmax = P0[0]; \
        _Pragma("unroll") for (int r = 1; r < 16; ++r) pmax = fmaxf(pmax, P0[r]); \
        _Pragma("unroll") for (int r = 0; r < 16; ++r) pmax = fmaxf(pmax, P1[r]); \
        { const auto rr = __builtin_amdgcn_permlane32_swap(__float_as_uint(pmax), __float_as_uint(pmax), false, false); pmax = fmaxf(__uint_as_float(rr[0]), __uint_as_float(rr[1])) + CADD; } \
        if (__builtin_expect(__all(pmax - m_reg <= THR2), 1)) { AL = 1.f; } else { const float mn = fmaxf(m_reg, pmax); AL = __builtin_amdgcn_exp2f(m_reg - mn); m_reg = mn; } \
        CM = CADD - m_reg; const int m0_ = (int)(MW.x >> (4 * hi)); \
        _Pragma("unroll") for (int r = 0; r < 16; ++r) { const int o_ = (r & 3) + 8 * (r >> 2); \
            const float e_ = __builtin_amdgcn_exp2f(P0[r] + CM); asm("v_bfe_i32 %0, %2, %3, 1\n\tv_and_b32 %0, %0, %1" : "=&v"(P0[r]) : "v"(e_), "v"(m0_), "n"(o_)); } } while (0)
#define ATT_FINISH(P0, P1, MW, AL, CM) do { const int m1_ = (int)(MW.y >> (4 * hi)); float ps = 0.f; \
        _Pragma("unroll") for (int r = 0; r < 16; ++r) { const int o_ = (r & 3) + 8 * (r >> 2); \
            const float e_ = __builtin_amdgcn_exp2f(P1[r] + CM); asm("v_bfe_i32 %0, %2, %3, 1\n\tv_and_b32 %0, %0, %1" : "=&v"(P1[r]) : "v"(e_), "v"(m1_), "n"(o_)); ps += P0[r] + P1[r]; } \
        { const auto rr = __builtin_amdgcn_permlane32_swap(__float_as_uint(ps), __float_as_uint(ps), false, false); ps = __uint_as_float(rr[0]) + __uint_as_float(rr[1]); } \
        l_reg = l_reg * AL + ps; \
        ATT_PK4(P0, 0, pa0); ATT_PK4(P0, 8, pa1); ATT_PK4(P1, 0, pa2); ATT_PK4(P1, 8, pa3); } while (0)
#define ATT_PK4(P, BASE, OUT) do { const unsigned a0 = cvt_pk_bf16(P[BASE + 0], P[BASE + 1]), a1 = cvt_pk_bf16(P[BASE + 2], P[BASE + 3]); \
        const unsigned b0 = cvt_pk_bf16(P[BASE + 4], P[BASE + 5]), b1 = cvt_pk_bf16(P[BASE + 6], P[BASE + 7]); \
        const auto r0_ = __builtin_amdgcn_permlane32_swap(a0, b0, false, false); const auto r1_ = __builtin_amdgcn_permlane32_swap(a1, b1, false, false); \
        const u32x4 w_ = {r0_[0], r1_[0], r0_[1], r1_[1]}; OUT = __builtin_bit_cast(bf16x8, w_); } while (0)
#define ATT_PV(bfk) do { const int vb = vb0 + (bfk) * SHM_V; \
        pv_one<0>(o[0], vb, pa0, pa1, pa2, pa3); pv_one<1>(o[1], vb, pa0, pa1, pa2, pa3); pv_one<2>(o[2], vb, pa0, pa1, pa2, pa3); pv_one<3>(o[3], vb, pa0, pa1, pa2, pa3); } while (0)
#define ATT_RESC(AL) do { if (__any((AL) < 1.f)) { if (hi == 0) wsf[r32] = (AL); asm volatile("s_waitcnt lgkmcnt(0)" ::: "memory"); \
        _Pragma("unroll") for (int d = 0; d < 4; ++d) _Pragma("unroll") for (int r = 0; r < 16; ++r) o[d][r] *= wsf[crow(r, hi)]; } } while (0)
#define ATT_STAGE_LOAD(k) ATT_SLOAD(jtb + (k))
    if (evn) {
        ATT_STAGE_LOAD(0); ATT_SWRITE(1);
        __syncthreads();
        ATT_MLOAD(0, mwB); ATT_SCORE(pB0, pB1, 0, 1, mwB, cmB); { const float cadd_ = cmB; ATT_PARTIAL(pB0, pB1, mwB, cadd_, alB, cmB); }
        ATT_FINISH(pB0, pB1, mwB, alB, cmB); SBAR();
        ATT_PV(1);
        __syncthreads();
        jtb = jt0 + 1;
    }
    ATT_STAGE_LOAD(0); ATT_SWRITE(0);
    __syncthreads();
    ATT_MLOAD(0, mwA); ATT_SCORE(pA0, pA1, 0, 0, mwA, cmA); { const float cadd_ = cmA; ATT_PARTIAL(pA0, pA1, mwA, cadd_, alA, cmA); }
    if (NTR > 1) { ATT_STAGE_LOAD(1); ATT_SWRITE(1); }
    __syncthreads();
    ATT_RESC(alA);
#pragma unroll 1
    for (int k = 1; k + 1 < NTR; k += 2) {
        SBAR(); ATT_SCORE(pB0, pB1, k, 1, mwB, cmB);
        ATT_FINISH(pA0, pA1, mwA, alA, cmA); SBAR();
        ATT_STAGE_LOAD(k + 1); ATT_MLOAD(k, mwB); SBAR();
        ATT_PV(0); { const float cadd_ = cmB; ATT_PARTIAL(pB0, pB1, mwB, cadd_, alB, cmB); }
        __syncthreads(); ATT_SWRITE(0);
        ATT_RESC(alB); __syncthreads();
        SBAR(); ATT_SCORE(pA0, pA1, k + 1, 0, mwA, cmA);
        ATT_FINISH(pB0, pB1, mwB, alB, cmB); SBAR();
        if (k + 2 < NTR) ATT_STAGE_LOAD(k + 2); ATT_MLOAD(k + 1, mwA); SBAR();
        ATT_PV(1); { const float cadd_ = cmA; ATT_PARTIAL(pA0, pA1, mwA, cadd_, alA, cmA); }
        __syncthreads(); if (k + 2 < NTR) ATT_SWRITE(1);
        ATT_RESC(alA); __syncthreads();
    }
    SBAR(); ATT_FINISH(pA0, pA1, mwA, alA, cmA); SBAR();
    ATT_PV(0);
    __syncthreads();
#undef ATT_SCORE
#undef ATT_MLOAD
#undef ATT_PARTIAL
#undef ATT_FINISH
#undef ATT_PK4
#undef ATT_PV
#undef ATT_RESC
#undef ATT_STAGE_LOAD
#undef ATT_SRC
#undef ATT_SLOAD
#undef ATT_SWRITE
    int b_ = b, g_ = g, sp_ = sp; asm volatile("" : "+v"(b_), "+v"(g_), "+v"(sp_));
    LAS unsigned char* stg = L + OFF_OST + w * 32 * OST_LD;
    bf16_t* ob = (bf16_t*)(F.ob + DO_Q) + (size_t)((PR ? b_ * TP + NMETA + 64 * (c - 1) : RPR + b_ * DSEQ) + 32 * th) * 1024 + g_ * 512 + hd * 128;
    if (!PR) {
        float* pbase = (float*)(F.ob + DO_QI) + (size_t)((b_ * 2 + g_) * 8) * (256 * 132);
        float* pw = pbase + (size_t)sp_ * (256 * 132) + w * (64 * 64 + 128);
        { float* pp = pw + lane * 4;
#pragma unroll
          for (int d0 = 0; d0 < 4; ++d0) {
#pragma unroll
            for (int r4 = 0; r4 < 4; ++r4) { const u32x4 v = {__float_as_uint(o[d0][4 * r4]), __float_as_uint(o[d0][4 * r4 + 1]), __float_as_uint(o[d0][4 * r4 + 2]), __float_as_uint(o[d0][4 * r4 + 3])}; wt_store16(pp + r4 * 256, v); }
            pp += 16 * 64; asm volatile("" : "+v"(pp) :: "memory"); } }
        wt_store8(pw + 4096 + 2 * lane, (u32x2){__float_as_uint(m_reg), __float_as_uint(l_reg)});
        asm volatile("s_waitcnt vmcnt(0)" ::: "memory");
        __syncthreads();
        LAS int* flag = (LAS int*)(L + OFF_WS) + 8 * 64;
        if (tid == 0) {
            const unsigned old = __hip_atomic_fetch_add((unsigned*)(F.ctl + CW_Q + 128 + 64 * (b_ * 2 + g_)), 1u, __ATOMIC_RELAXED, __HIP_MEMORY_SCOPE_AGENT);
            if (old == 7u) { __builtin_amdgcn_fence(__ATOMIC_ACQUIRE, "agent"); asm volatile("s_waitcnt vmcnt(0)" ::: "memory"); }
            *flag = (int)old; }
        __syncthreads();
        const bool last = (*flag == 7);
        __syncthreads();
        if (!last) return;
        float mi[8], li[8];
#pragma unroll
        for (int s8 = 0; s8 < 8; ++s8) { const float* pq = pbase + (size_t)s8 * (256 * 132) + w * (64 * 64 + 128); const f32x2 ml = *(const f32x2*)(pq + 4096 + 2 * lane); mi[s8] = ml.x; li[s8] = ml.y; }
        float mm = mi[0];
#pragma unroll
        for (int s8 = 1; s8 < 8; ++s8) mm = fmaxf(mm, mi[s8]);
        float den = 0.f;
#pragma unroll
        for (int s8 = 0; s8 < 8; ++s8) { mi[s8] = __builtin_amdgcn_exp2f(mi[s8] - mm); den += mi[s8] * li[s8]; }
        const float rl = __builtin_amdgcn_rcpf(den);
        LAS float* wq = (LAS float*)(L + OFF_K) + w * 256;
        if (hi == 0) {
#pragma unroll
            for (int s8 = 0; s8 < 8; ++s8) wq[s8 * 32 + r32] = mi[s8] * rl; }
        asm volatile("s_waitcnt lgkmcnt(0)" ::: "memory");
#pragma unroll 1
        for (int d0 = 0; d0 < 4; ++d0) {
            f32x4 pv[4][8];
#pragma unroll
            for (int r4 = 0; r4 < 4; ++r4) { const float* pq = pbase + w * (64 * 64 + 128) + d0 * 16 * 64 + lane * 4 + r4 * 256;
#pragma unroll
                for (int s8 = 0; s8 < 8; ++s8) pv[r4][s8] = *(const f32x4*)(pq + (size_t)s8 * (256 * 132)); }
#pragma unroll
            for (int r4 = 0; r4 < 4; ++r4) { f32x4 acc4 = {0.f, 0.f, 0.f, 0.f};
#pragma unroll
                for (int s8 = 0; s8 < 8; ++s8) {
#pragma unroll
                    for (int e = 0; e < 4; ++e) acc4[e] += pv[r4][s8][e] * wq[s8 * 32 + crow(4 * r4 + e, hi)]; }
#pragma unroll
                for (int e = 0; e < 4; ++e) *(LAS bf16_t*)(stg + crow(4 * r4 + e, hi) * OST_LD + (d0 * 32 + r32) * 2) = f2bf(acc4[e]); } }
    } else {
        if (hi == 0) wsf[r32] = l_reg; asm volatile("s_waitcnt lgkmcnt(0)" ::: "memory");
        float rli[16];
#pragma unroll
        for (int r = 0; r < 16; ++r) rli[r] = __builtin_amdgcn_rcpf(wsf[crow(r, hi)]);
#pragma unroll
        for (int r = 0; r < 16; ++r) { const int orow = crow(r, hi);
#pragma unroll
            for (int d0 = 0; d0 < 4; ++d0) *(LAS bf16_t*)(stg + orow * OST_LD + (d0 * 32 + r32) * 2) = f2bf(o[d0][r] * rli[r]); }
    }
    asm volatile("s_waitcnt lgkmcnt(0)" ::: "memory");
#pragma unroll
    for (int i = 0; i < 8; ++i) { const int row = i * 4 + (lane >> 4), ch = lane & 15; const u32x4 v = *(const LAS u32x4*)(stg + row * OST_LD + ch * 16);
        if (PR) *(u32x4*)(ob + (size_t)row * 1024 + ch * 8) = v; else wt_store16(ob + (size_t)row * 1024 + ch * 8, v); }
    if (!PR) unit_publish_wt(F, CW_DEP);
    __syncthreads();
}
__device__ __forceinline__ int yrow_to_r(int pm) { return pm * 256 + (pm < 64 ? 16 * ((pm >> 3) + 1) : 128); }
struct SchedP5 {
    const char* A0; const char* A1; const char* B0; const char* B1; int G, c;
    __device__ __forceinline__ bool next(int i, pg8::Unit& u) const {
        const int L = (i >> 1) * G + c; if (L >= 64 * 4) return false;
        pg8::tile_of(L, 64, 4, u.pm, u.pn); u.part = i & 1;
        u.A = (u.part ? A1 : A0) + (size_t)yrow_to_r(u.pm) * 1024 * 2; u.B = (u.part ? B1 : B0) + (size_t)u.pn * 256 * 1024 * 2; return true; }
};
template <bool WT> struct EpiP5T {
    static constexpr bool PERM = true;
    const bf16_t* GS; const bf16_t* GA; const float* SSQ1; bf16_t* MERGED;
    __device__ __forceinline__ bool operator()(pg8::Acc& acc, const pg8::Unit& u, int wr, int wc, int fr, int fq) const {
        const int rr0 = yrow_to_r(u.pm) + wr * 64 + fr, ry0 = u.pm * 256 + wr * 64 + fr, col = u.pn * 256 + wc * 32 + 8 * fq;
#pragma unroll
        for (int ai = 0; ai < 2; ++ai)
#pragma unroll
            for (int m = 0; m < 4; ++m) { const int rr = rr0 + ai * 128 + m * 16, ry = ry0 + ai * 128 + m * 16;
                float rstd = 0.f; if (u.part == 0) rstd = __builtin_amdgcn_rsqf(SSQ1[rr] * (1.f / 1024.f) + EPS);
#pragma unroll
                for (int bj = 0; bj < 2; ++bj) {
                    const u32x4 ga = *(const u32x4*)(GA + (size_t)rr * 1024 + col + bj * 128);
                    float sa[8] = {bf_lo(ga.x), bf_hi(ga.x), bf_lo(ga.y), bf_hi(ga.y), bf_lo(ga.z), bf_hi(ga.z), bf_lo(ga.w), bf_hi(ga.w)};
                    if (u.part == 0) {
                        const u32x4 gs = *(const u32x4*)(GS + (size_t)rr * 1024 + col + bj * 128);
                        const float ss[8] = {bf_lo(gs.x), bf_hi(gs.x), bf_lo(gs.y), bf_hi(gs.y), bf_lo(gs.z), bf_hi(gs.z), bf_lo(gs.w), bf_hi(gs.w)};
#pragma unroll
                        for (int e = 0; e < 8; ++e) {
                            const float f = rstd * (1.f + __builtin_amdgcn_exp2f(-1.4426950408889634f * sa[e])) * __builtin_amdgcn_rcpf(1.f + __builtin_amdgcn_exp2f(-1.4426950408889634f * ss[e]));
                            acc[ai][bj][m][e >> 2][e & 3] *= f; }
                    } else {
                        float o[8];
#pragma unroll
                        for (int e = 0; e < 8; ++e) o[e] = acc[ai][bj][m][e >> 2][e & 3] * sigmoidf_(sa[e]);
                        u32x4 w; w.x = cvt_pk_bf16(o[0], o[1]); w.y = cvt_pk_bf16(o[2], o[3]); w.z = cvt_pk_bf16(o[4], o[5]); w.w = cvt_pk_bf16(o[6], o[7]);
                        if (WT) wt_store16(MERGED + (size_t)ry * 1024 + col + bj * 128, w); else *(u32x4*)(MERGED + (size_t)ry * 1024 + col + bj * 128) = w; } } }
        return u.part == 0;
    }
};
typedef EpiP5T<false> EpiP5;
struct EpiP5A {
    static constexpr bool PERM = true;
    const bf16_t* GS; const float* SSQ1; bf16_t* MERGED;
    __device__ __forceinline__ bool operator()(pg8::Acc& acc, const pg8::Unit& u, int wr, int wc, int fr, int fq) const {
        const int rr0 = yrow_to_r(u.pm) + wr * 64 + fr, ry0 = u.pm * 256 + wr * 64 + fr, col = u.pn * 256 + wc * 32 + 8 * fq;
#pragma unroll
        for (int ai = 0; ai < 2; ++ai)
#pragma unroll
            for (int m = 0; m < 4; ++m) { const int rr = rr0 + ai * 128 + m * 16, ry = ry0 + ai * 128 + m * 16; const float rstd = __builtin_amdgcn_rsqf(SSQ1[rr] * (1.f / 1024.f) + EPS);
#pragma unroll
                for (int bj = 0; bj < 2; ++bj) { const u32x4 gs = *(const u32x4*)(GS + (size_t)rr * 1024 + col + bj * 128);
                    const float ss[8] = {bf_lo(gs.x), bf_hi(gs.x), bf_lo(gs.y), bf_hi(gs.y), bf_lo(gs.z), bf_hi(gs.z), bf_lo(gs.w), bf_hi(gs.w)}; float o[8];
#pragma unroll
                    for (int e = 0; e < 8; ++e) o[e] = acc[ai][bj][m][e >> 2][e & 3] * rstd * sigmoidf_(ss[e]);
                    u32x4 w; w.x = cvt_pk_bf16(o[0], o[1]); w.y = cvt_pk_bf16(o[2], o[3]); w.z = cvt_pk_bf16(o[4], o[5]); w.w = cvt_pk_bf16(o[6], o[7]);
                    wt_store16(MERGED + (size_t)ry * 1024 + col + bj * 128, w); } }
        return false;
    }
};
struct EpiP5B {
    static constexpr bool PERM = true;
    const bf16_t* GA; bf16_t* MERGED;
    __device__ __forceinline__ bool operator()(pg8::Acc& acc, const pg8::Unit& u, int wr, int wc, int fr, int fq) const {
        const int rr0 = yrow_to_r(u.pm) + wr * 64 + fr, ry0 = u.pm * 256 + wr * 64 + fr, col = u.pn * 256 + wc * 32 + 8 * fq;
#pragma unroll
        for (int ai = 0; ai < 2; ++ai)
#pragma unroll
            for (int m = 0; m < 4; ++m) { const int rr = rr0 + ai * 128 + m * 16, ry = ry0 + ai * 128 + m * 16;
#pragma unroll
                for (int bj = 0; bj < 2; ++bj) { const u32x4 ga = *(const u32x4*)(GA + (size_t)rr * 1024 + col + bj * 128); bf16_t* mp = MERGED + (size_t)ry * 1024 + col + bj * 128; const u32x4 t = *(const u32x4*)mp;
                    const float sa[8] = {bf_lo(ga.x), bf_hi(ga.x), bf_lo(ga.y), bf_hi(ga.y), bf_lo(ga.z), bf_hi(ga.z), bf_lo(ga.w), bf_hi(ga.w)};
                    const float tv[8] = {bf_lo(t.x), bf_hi(t.x), bf_lo(t.y), bf_hi(t.y), bf_lo(t.z), bf_hi(t.z), bf_lo(t.w), bf_hi(t.w)}; float o[8];
#pragma unroll
                    for (int e = 0; e < 8; ++e) o[e] = tv[e] + acc[ai][bj][m][e >> 2][e & 3] * sigmoidf_(sa[e]);
                    u32x4 w; w.x = cvt_pk_bf16(o[0], o[1]); w.y = cvt_pk_bf16(o[2], o[3]); w.z = cvt_pk_bf16(o[4], o[5]); w.w = cvt_pk_bf16(o[6], o[7]);
                    wt_store16(mp, w); } }
        return false;
    }
};
struct SchedY {
    const char* A; const char* B; int nN, K, G, c;
    __device__ __forceinline__ bool next(int i, pg8::Unit& u) const {
        const int L = i * G + c; if (L >= 64 * nN) return false;
        pg8::tile_of(L, 64, nN, u.pm, u.pn); u.part = 0; u.A = A + (size_t)u.pm * 256 * K * 2; u.B = B + (size_t)u.pn * 256 * K * 2; return true; }
};
struct SchedTile {
    const char* A0; const char* A1; const char* B0; const char* B1; int pm, pn, nparts;
    __device__ __forceinline__ bool next(int i, pg8::Unit& u) const { if (i >= nparts) return false; u.pm = pm; u.pn = pn; u.part = i; u.A = i ? A1 : A0; u.B = i ? B1 : B0; return true; }
};
struct SchedP8 {
    const char* A; const char* B; int c;
    __device__ __forceinline__ bool next(int i, pg8::Unit& u) const {
        int L; if (c < 8) { if (i >= 3) return false; L = i * 8 + c; } else { L = 24 + i * 248 + (c - 8); if (L >= 64 * 22) return false; }
        pg8::tile_of(L, 64, 22, u.pm, u.pn); u.part = 0; u.A = A + (size_t)u.pm * 256 * 1024 * 2; u.B = B + (size_t)u.pn * 256 * 1024 * 2; return true; }
};
template <bool WT> struct EpiP6T {
    static constexpr bool PERM = false;
    const float* xp; const float* xs; bf16_t* HB; float* SSQ2;
    __device__ __forceinline__ bool operator()(pg8::Acc& acc, const pg8::Unit& u, int wr, int wc, int fr, int fq) const {
        const int ry0 = u.pm * 256 + wr * 64 + fr, col0 = u.pn * 256 + wc * 32 + 4 * fq;
#pragma unroll
        for (int ai = 0; ai < 2; ++ai)
#pragma unroll
            for (int m = 0; m < 4; ++m) { const int ry = ry0 + ai * 128 + m * 16;
                const float* xrow = ry < YPR ? xp + (size_t)ry * 1024 : xs + (size_t)(ry - YPR) * 1024; float ss = 0.f;
#pragma unroll
                for (int bj = 0; bj < 2; ++bj)
#pragma unroll
                    for (int n = 0; n < 2; ++n) { const int c = col0 + bj * 128 + n * 16; const f32x4 h = *(const f32x4*)(xrow + c) + acc[ai][bj][m][n];
                        ss += (h.x * h.x + h.y * h.y) + (h.z * h.z + h.w * h.w);
                        const u32x2 hv = {cvt_pk_bf16(h.x, h.y), cvt_pk_bf16(h.z, h.w)};
                        if (WT) wt_store8(HB + (size_t)ry * 1024 + c, hv); else *(u32x2*)(HB + (size_t)ry * 1024 + c) = hv; }
                ss += __shfl_xor(ss, 16); ss += __shfl_xor(ss, 32);
                if (fq == 0) atomicAdd(SSQ2 + ry, ss); }
        return false;
    }
};
typedef EpiP6T<false> EpiP6;
struct EpiP7 {
    static constexpr bool PERM = true;
    const float* SSQ2; bf16_t* ACT;
    __device__ __forceinline__ bool operator()(pg8::Acc& acc, const pg8::Unit& u, int wr, int wc, int fr, int fq) const {
        const int ry0 = u.pm * 256 + wr * 64 + fr, ch0 = u.pn * 128 + wc * 16 + 4 * fq;
#pragma unroll
        for (int ai = 0; ai < 2; ++ai)
#pragma unroll
            for (int m = 0; m < 4; ++m) { const int ry = ry0 + ai * 128 + m * 16; const float rs = __builtin_amdgcn_rsqf(SSQ2[ry] * (1.f / 1024.f) + EPS);
#pragma unroll
                for (int bj = 0; bj < 2; ++bj) { const f32x4 g = acc[ai][bj][m][0] * rs, up = acc[ai][bj][m][1] * rs;
                    const float a0 = siluf_(g.x) * up.x, a1 = siluf_(g.y) * up.y, a2 = siluf_(g.z) * up.z, a3 = siluf_(g.w) * up.w;
                    *(u32x2*)(ACT + (size_t)ry * DFF + ch0 + bj * 64) = (u32x2){cvt_pk_bf16(a0, a1), cvt_pk_bf16(a2, a3)}; } }
        return false;
    }
};
struct EpiP8 {
    static constexpr bool PERM = false;
    const bf16_t* HB; float* Y;
    __device__ __forceinline__ bool operator()(pg8::Acc& acc, const pg8::Unit& u, int wr, int wc, int fr, int fq) const {
        const int ry0 = u.pm * 256 + wr * 64 + fr, col0 = u.pn * 256 + wc * 32 + 4 * fq;
#pragma unroll
        for (int ai = 0; ai < 2; ++ai)
#pragma unroll
            for (int m = 0; m < 4; ++m) { const size_t ro = (size_t)(ry0 + ai * 128 + m * 16) * 1024 + col0;
#pragma unroll
                for (int bj = 0; bj < 2; ++bj)
#pragma unroll
                    for (int n = 0; n < 2; ++n) { const u32x2 hv = *(const u32x2*)(HB + ro + bj * 128 + n * 16);
                        const f32x4 h = {__uint_as_float(hv.x << 16), __uint_as_float(hv.x & 0xffff0000u), __uint_as_float(hv.y << 16), __uint_as_float(hv.y & 0xffff0000u)};
                        __builtin_nontemporal_store(h + acc[ai][bj][m][n], (f32x4*)(Y + ro + bj * 128 + n * 16)); } }
        return false;
    }
};

constexpr size_t WS_MS = WS_CK, WS_HBS = WS_CK + (1u << 20), WS_ACTS = WS_CK + (2u << 20);
static_assert(WS_ACTS + (size_t)RSR * DFF * 2 <= WS_MASK, "sample intermediates");
__device__ __forceinline__ void mixer_units(Frame& F) {
    constexpr int Q0 = 128, Q1 = Q0 + 128, QA = Q1 + 8, Q2 = QA + 8, Q3 = Q2 + 128, Q4 = Q3 + 96, Q5 = Q4 + 8, Q6 = Q5 + 160, Q7 = Q6 + 44, Q8 = Q7 + 256;
    LAS int* qslot = (LAS int*)(F.lds + MISC_OFF) + 16;
    for (bool first = true; ; first = false) {
        refresh_ids(F);
        if (F.tid == 0) *qslot = first ? (int)blockIdx.x : (int)(F.G + __hip_atomic_fetch_add((unsigned*)(F.ctl + CW_Q), 1u, __ATOMIC_RELAXED, __HIP_MEMORY_SCOPE_AGENT));
        __syncthreads();
        const int u = __builtin_amdgcn_readfirstlane(*qslot);
        __syncthreads();
        if (u >= Q8) break;
        if (u < Q0) { attn_unit<false>(F, u >> 4, 0, (u >> 3) & 1, u & 7); }
        else if (u < Q1) ssd_chain_unit(F, 128 + (u - Q0));
        else if (u < QA) {
            const int k = u - Q1, pm = 64 + (k >> 2), pn = k & 3;
            unit_wait(F, CW_DEP + 192, 128u);
            SchedTile S{(const char*)(F.ws + WS_XS) + (size_t)yrow_to_r(pm) * 1024 * 2, nullptr, (const char*)(F.ws + WS_WBS) + (size_t)pn * 256 * 1024 * 2, nullptr, pm, pn, 1};
            EpiP5A E{(const bf16_t*)(F.ws + WS_GS), (const float*)(F.ws + WS_SSQ1), (bf16_t*)(F.ws + WS_MS) - (size_t)YPR * 1024};
            pg8::gemm_phase<EpiP5A, SchedTile>(F.lds, 1024, S, E, F.wave);
            unit_publish_wt(F, CW_DEP + 256);
        }
        else if (u < Q2) {
            const int k = u - QA, pm = 64 + (k >> 2), pn = k & 3;
            unit_wait(F, CW_DEP, 16u); unit_wait(F, CW_DEP + 256, 8u);
            SchedTile S{(const char*)(F.ob + DO_Q) + (size_t)yrow_to_r(pm) * 1024 * 2, nullptr, (const char*)(F.ws + WS_WBA) + (size_t)pn * 256 * 1024 * 2, nullptr, pm, pn, 1};
            EpiP5B E{(const bf16_t*)(F.ws + WS_GA), (bf16_t*)(F.ws + WS_MS) - (size_t)YPR * 1024};
            pg8::gemm_phase<EpiP5B, SchedTile>(F.lds, 1024, S, E, F.wave);
            unit_publish_wt(F, CW_DEP + 64);
        }
        else if (u < Q3) ssd_chain_unit(F, u - Q2);
        else if (u >= Q4 && u < Q5) {
            const int k = u - Q4, pm = 64 + (k >> 2), pn = k & 3;
            unit_wait(F, CW_DEP + 64, 8u);
            SchedTile S{(const char*)(F.ws + WS_MS) + (size_t)(pm - 64) * 256 * 1024 * 2, nullptr, (const char*)(F.ws + WS_WOUT) + (size_t)pn * 256 * 1024 * 2, nullptr, pm, pn, 1};
            EpiP6T<true> E{F.in[0], F.in[1], (bf16_t*)(F.ws + WS_HBS) - (size_t)YPR * 1024, (float*)(F.ws + WS_SSQ2)};
            pg8::gemm_phase<EpiP6T<true>, SchedTile>(F.lds, 1024, S, E, F.wave);
            unit_publish_wt(F, CW_DEP + 128);
        }
        else if (u >= Q6 && u < Q7) {
            const int k = u - Q6, pm = 64 + k / 22, pn = k % 22;
            unit_wait(F, CW_DEP + 128, 8u);
            SchedTile S{(const char*)(F.ws + WS_HBS) + (size_t)(pm - 64) * 256 * 1024 * 2, nullptr, (const char*)(F.ws + WS_WGU) + (size_t)pn * 256 * 1024 * 2, nullptr, pm, pn, 1};
            EpiP7 E{(const float*)(F.ws + WS_SSQ2), (bf16_t*)(F.ws + WS_ACTS) - (size_t)YPR * DFF};
            pg8::gemm_phase<EpiP7, SchedTile>(F.lds, 1024, S, E, F.wave);
        } else {
            const int v = u < Q4 ? u - Q3 : (u < Q6 ? 96 + (u - Q5) : 256 + (u - Q7));
            const int bg = v & 15, c = 32 - (v >> 4); attn_unit<true>(F, bg >> 1, c, bg & 1, 0);
        }
    }
}

constexpr int NPHASE = 9;
#ifndef PROBE_TIMING
#define PROBE_TIMING 0
#endif
#ifndef PROBE_BASE
#define PROBE_BASE 0
#endif
__global__ void __launch_bounds__(NTHR, 2) hybrid_fwd(Args args) {
    extern __shared__ __attribute__((aligned(16))) unsigned char lds[];
    Frame F;
    F.lds = (LAS unsigned char*)lds; F.MISC = (volatile LAS unsigned*)(F.lds + MISC_OFF);
    F.tid = threadIdx.x; F.lane = F.tid & 63; F.wave = __builtin_amdgcn_readfirstlane(F.tid >> 6);
    F.G = gridDim.x; { const int bx = blockIdx.x; F.vcu = (F.G % 8 == 0) ? (bx % 8) * (F.G / 8) + bx / 8 : bx; }
    F.in = args.in; F.out = args.out; F.ws = args.ws; F.ob = (unsigned char*)args.out; F.ctl = (gu32*)(args.ws + WS_CTL);
    if (F.tid < 64) ((LAS unsigned*)(F.lds + MISC_OFF))[F.tid] = 0u;
    __syncthreads();
    const int lo = args.ph_lo, hi = args.ph_hi;
    const bool multi = (hi - lo) > 1;
    XcdBarrier bar; bar.bar = (unsigned*)(F.ctl + CW_BAR) + args.li * XCD_BAR_WORDS; bar.x = 0; bar.st = nullptr;
    if (multi) bar = xcd_barrier_post((unsigned*)(F.ctl + CW_BAR) + args.li * XCD_BAR_WORDS, F.MISC + 8, F.tid);
#define IN(k) (lo <= (k) && (k) < hi)
#if PROBE_TIMING
    LAS unsigned long long* tst = (LAS unsigned long long*)(F.lds + MISC_OFF + 128); int nst = 0;
#define STAMP() do { if (F.tid == 0) tst[nst] = __builtin_amdgcn_s_memrealtime(); ++nst; } while (0)
#else
#define STAMP() do {} while (0)
#endif
    STAMP();
#define SEAM(k) do { refresh_ids(F); if (IN(k) && IN((k) + 1)) xcd_barrier(bar, F.tid); STAMP(); } while (0)
    if (IN(0)) { p0_prologue(F); SEAM(0); }
    if (IN(1)) {
        SchedP1 S{(const char*)(F.ob + DO_HN), (const char*)(F.ws + WS_WIN), F.G, (int)blockIdx.x};
        EpiP1 E{F.ws, F.ob};
        pg8::gemm_phase<EpiP1, SchedP1>(F.lds, 1024, S, E, F.wave);
        { constexpr int FULL = (67 * 29) % 256; if ((int)blockIdx.x >= FULL) cache_to_bf16(F, (int)blockIdx.x - FULL, 256 - FULL); }
        SEAM(1);
    }
    if (IN(2)) { p2_rows(F); SEAM(2); }
    if (IN(3)) { idx_conv_units(F); SEAM(3); }
    if (IN(4)) { mixer_units(F); SEAM(4); }
    if (IN(5)) {
        SchedP5 S{(const char*)(F.ws + WS_XS), (const char*)(F.ob + DO_Q), (const char*)(F.ws + WS_WBS), (const char*)(F.ws + WS_WBA), F.G, (int)blockIdx.x};
        EpiP5 E{(const bf16_t*)(F.ws + WS_GS), (const bf16_t*)(F.ws + WS_GA), (const float*)(F.ws + WS_SSQ1), (bf16_t*)(F.ws + WS_MERGED)};
        pg8::gemm_phase<EpiP5, SchedP5>(F.lds, 1024, S, E, F.wave);
        SEAM(5);
    }
    if (IN(6)) {
        SchedY S{(const char*)(F.ws + WS_MERGED), (const char*)(F.ws + WS_WOUT), 4, 1024, F.G, (int)blockIdx.x};
        EpiP6 E{F.in[0], F.in[1], (bf16_t*)(F.ws + WS_HB), (float*)(F.ws + WS_SSQ2)};
        pg8::gemm_phase<EpiP6, SchedY>(F.lds, 1024, S, E, F.wave);
        SEAM(6);
    }
    if (IN(7)) {
        if (blockIdx.x < 8) {
            const int k = (int)blockIdx.x, pm = 64 + (k >> 2), pn = k & 3;
            SchedTile S{(const char*)(F.ws + WS_ACTS) + (size_t)(pm - 64) * 256 * DFF * 2, nullptr, (const char*)(F.ws + WS_WDN) + (size_t)pn * 256 * DFF * 2, nullptr, pm, pn, 1};
            EpiP8 E{(const bf16_t*)(F.ws + WS_HBS) - (size_t)YPR * 1024, F.out};
            pg8::gemm_phase<EpiP8, SchedTile>(F.lds, DFF, S, E, F.wave);
        }
        SchedP8 S{(const char*)(F.ws + WS_HB), (const char*)(F.ws + WS_WGU), (int)blockIdx.x};
        EpiP7 E{(const float*)(F.ws + WS_SSQ2), (bf16_t*)(F.ws + WS_ACT)};
        pg8::gemm_phase<EpiP7, SchedP8>(F.lds, 1024, S, E, F.wave);
        SEAM(7);
    }
    if (IN(8)) {
        SchedY S{(const char*)(F.ws + WS_ACT), (const char*)(F.ws + WS_WDN), 4, DFF, F.G, (int)blockIdx.x};
        EpiP8 E{(const bf16_t*)(F.ws + WS_HB), F.out};
        pg8::gemm_phase<EpiP8, SchedY>(F.lds, DFF, S, E, F.wave);
        STAMP();
    }
#if PROBE_TIMING
    __syncthreads();
    if (blockIdx.x == 0 && F.tid < 64) {
        const size_t ooff[5] = {O_KP, O_VP, O_KIP, O_SSMP, O_SSMS};
#pragma unroll
        for (int i = 0; i < 5; ++i) { const int n = (int)((tst[PROBE_BASE + i + 1] - tst[PROBE_BASE + i] + 200) / 400); for (int e = F.tid; e < n && e < 32000; e += 64) ((unsigned*)F.out)[ooff[i] + e] = 0xAAAAAAAAu; }
    }
#endif
#undef IN
#undef SEAM
}

extern "C" void kernel_launch(void* const* d_in, const int* in_sizes, int n_in, void* d_out, int out_size, void* d_ws, size_t ws_size, hipStream_t stream) {
    static int grid = 0;
    if (grid == 0) {
        if (n_in != 27 || out_size != (int)O_END || ws_size < WS_END) { fprintf(stderr, "kernel_launch: unexpected shapes: n_in %d out %d ws %zu (need %zu)\n", n_in, out_size, ws_size, (size_t)WS_END); grid = -1; return; }
        int dev = 0, cus = 0;
        if (hipGetDevice(&dev) != hipSuccess || hipDeviceGetAttribute(&cus, hipDeviceAttributeMultiprocessorCount, dev) != hipSuccess) { grid = -1; return; }
        if (hipFuncSetAttribute((const void*)hybrid_fwd, hipFuncAttributeMaxDynamicSharedMemorySize, LDS_BYTES) != hipSuccess) { fprintf(stderr, "kernel_launch: hipFuncSetAttribute failed\n"); grid = -1; return; }
        (void)hipGetLastError();
        if (cus < 256) { fprintf(stderr, "kernel_launch: built for a 256-CU device (one resident workgroup per CU), found %d CUs\n", cus); grid = -1; return; }
        grid = 256;
    }
    if (grid < 0) return;
    (void)hipMemsetAsync((char*)d_ws + WS_CTL, 0, CTL_ZERO_BYTES, stream);
    Args a{};
    for (int i = 0; i < 27; ++i) a.in[i] = (const float*)d_in[i];
    a.out = (float*)d_out; a.ws = (unsigned char*)d_ws;
#ifndef MK_SPLIT
#define MK_SPLIT 0
#endif
#if MK_SPLIT
    for (int p = 0; p < NPHASE; ++p) { a.ph_lo = p; a.ph_hi = p + 1; a.li = 0; hipLaunchKernelGGL(hybrid_fwd, dim3(grid), dim3(NTHR), LDS_BYTES, stream, a); }
#else
    a.ph_lo = 0; a.ph_hi = NPHASE; a.li = 0; hipLaunchKernelGGL(hybrid_fwd, dim3(grid), dim3(NTHR), LDS_BYTES, stream, a);
#endif
    const hipError_t le = hipPeekAtLastError();
    if (le != hipSuccess) fprintf(stderr, "kernel_launch: launch failed: %s\n", hipGetErrorName(le));
}
```
